# Optimizing an MI355X kernel written in HIP

```python
import math
import jax, jax.numpy as jnp
from jax import lax
import numpy as np

D_MODEL = 1024
BATCH = 8
SEQ = 2048
DEPTH = 4

BRANCH_WIDTH = 512
N_BRANCH = 3
EPS = 1e-6
NEG_BIG = -1e30
HG_HEADS = 4
HG_DIM = 128
HG_CHUNK = 64
AT_HEADS = 4
AT_DIM = 128
IDX_HEADS = 8
IDX_DIM = 64
TOPK_MAX = 256
Q_BLOCK = 128
ROPE_THETA = 10000.0
S5_GROUP = 16
S5_GROUPS = BRANCH_WIDTH // S5_GROUP
S5_STATE = 64

IN_SPLITS = (
    HG_HEADS * HG_DIM, HG_HEADS * HG_DIM, HG_HEADS * HG_DIM, BRANCH_WIDTH,
    AT_HEADS * AT_DIM, AT_DIM, AT_DIM, BRANCH_WIDTH,
    IDX_HEADS * IDX_DIM, IDX_DIM, IDX_HEADS,
    BRANCH_WIDTH, BRANCH_WIDTH,
    N_BRANCH * D_MODEL,
)
N_IN = 4 * BRANCH_WIDTH + (2 * BRANCH_WIDTH + 2 * AT_DIM) + (IDX_HEADS * IDX_DIM + IDX_DIM + IDX_HEADS) + 2 * BRANCH_WIDTH + N_BRANCH * D_MODEL

kernel_name = "hybrid_hgrn2_dsa_s5_gated_trunk"


def rms_norm(x, g):
    x32 = x.astype(jnp.float32)
    r = lax.rsqrt(jnp.mean(x32 * x32, axis=-1, keepdims=True) + EPS)
    return (x32 * r).astype(x.dtype) * g


def rope_tables(positions, dim):
    inv_freq = ROPE_THETA ** (-jnp.arange(0, dim, 2, dtype=jnp.float32) / dim)
    ang = positions.astype(jnp.float32)[..., None] * inv_freq
    return jnp.cos(ang)[:, :, None, :], jnp.sin(ang)[:, :, None, :]


def apply_rope(x, cos, sin):
    half = x.shape[-1] // 2
    x1 = x[..., :half].astype(jnp.float32)
    x2 = x[..., half:].astype(jnp.float32)
    out = jnp.concatenate([x1 * cos - x2 * sin, x2 * cos + x1 * sin], axis=-1)
    return out.astype(x.dtype)


def split_cols(p):
    out = []
    o = 0
    for n in IN_SPLITS:
        out.append(p[..., o:o + n])
        o += n
    return out


def hgrn2_mixer(q, fz, i, lb, onorm_g):
    B, S, W = q.shape
    C = HG_CHUNK
    NC = S // C
    lb = lb.astype(jnp.float32)
    sg = jax.nn.sigmoid(fz.astype(jnp.float32))
    f = lb + (1.0 - lb) * sg
    log_f = jnp.log(jnp.maximum(f, 1e-30))
    k = 1.0 - f

    def to_chunks(a):
        return a.astype(jnp.float32).reshape(B, NC, C, HG_HEADS, HG_DIM).transpose(1, 0, 3, 2, 4)

    tri = jnp.tril(jnp.ones((C, C), dtype=bool))[None, None, :, :, None]

    def step(state, inp):
        qc, kc, vc, lfc = inp
        b = jnp.cumsum(lfc, axis=2)
        o_inter = jnp.einsum('bhtd,bhde->bhte', qc * jnp.exp(b), state)
        diff = b[:, :, :, None, :] - b[:, :, None, :, :]
        decay = jnp.where(tri, jnp.exp(jnp.where(tri, diff, 0.0)), 0.0)
        scores = jnp.einsum('bhtd,bhsd,bhtsd->bhts', qc, kc, decay)
        o_intra = jnp.einsum('bhts,bhse->bhte', scores, vc)
        b_last = b[:, :, -1:, :]
        k_dec = kc * jnp.exp(b_last - b)
        state = jnp.exp(b_last[:, :, 0, :])[..., None] * state + jnp.einsum('bhsd,bhse->bhde', k_dec, vc)
        return state, o_inter + o_intra

    state0 = jnp.zeros((B, HG_HEADS, HG_DIM, HG_DIM), jnp.float32)
    _, o = lax.scan(step, state0, (to_chunks(q), to_chunks(k), to_chunks(i), to_chunks(log_f)))
    o = o.transpose(1, 0, 3, 2, 4).reshape(B, S, HG_HEADS, HG_DIM).astype(q.dtype)
    o = rms_norm(o, onorm_g)
    return o.reshape(B, S, W)


def dsa_mixer(q, k, v, iq, ik, iw, positions, qn_g, kn_g):
    B, S, _ = q.shape
    topk = min(TOPK_MAX, S // 4)
    NB = S // Q_BLOCK
    cos, sin = rope_tables(positions, AT_DIM)
    cos_i, sin_i = rope_tables(positions, IDX_DIM)
    q = apply_rope(rms_norm(q.reshape(B, S, AT_HEADS, AT_DIM), qn_g), cos, sin)
    k = apply_rope(rms_norm(k[:, :, None, :], kn_g), cos, sin)[:, :, 0, :]
    iq = apply_rope(iq.reshape(B, S, IDX_HEADS, IDX_DIM), cos_i, sin_i)
    ik = apply_rope(ik[:, :, None, :], cos_i, sin_i)[:, :, 0, :]
    scale = 1.0 / math.sqrt(AT_DIM)
    key_pos = jnp.arange(S)

    def blocks(a):
        return jnp.moveaxis(a.reshape((B, NB, Q_BLOCK) + a.shape[2:]), 1, 0)

    def one_block(args):
        qb, iqb, iwb, blk = args
        qpos = blk * Q_BLOCK + jnp.arange(Q_BLOCK)
        rel = jax.nn.relu(jnp.einsum('bqhd,bsd->bqhs', iqb, ik).astype(jnp.float32))
        isc = jnp.einsum('bqhs,bqh->bqs', rel, iwb.astype(jnp.float32))
        causal = key_pos[None, :] <= qpos[:, None]
        isc = jnp.where(causal[None], isc, NEG_BIG)
        _, idx = lax.top_k(isc, topk)
        ksel = jax.vmap(lambda kk, ii: kk[ii])(k, idx)
        vsel = jax.vmap(lambda vv, ii: vv[ii])(v, idx)
        logits = jnp.einsum('bqhd,bqkd->bqhk', qb, ksel).astype(jnp.float32) * scale
        valid = idx <= qpos[None, :, None]
        logits = jnp.where(valid[:, :, None, :], logits, NEG_BIG)
        p = jax.nn.softmax(logits, axis=-1).astype(v.dtype)
        return jnp.einsum('bqhk,bqkd->bqhd', p, vsel)

    out = lax.map(one_block, (blocks(q), blocks(iq), blocks(iw), jnp.arange(NB)))
    return jnp.moveaxis(out, 0, 1).reshape(B, S, AT_HEADS * AT_DIM)


def s5_mixer(u, a_re, a_im, log_dt, b_re, b_im, c_re, c_im, d_skip, glu_w, glu_b):
    B, S, W = u.shape
    f32 = jnp.float32
    ug = u.astype(f32).reshape(B, S, S5_GROUPS, S5_GROUP)
    a_re = a_re.astype(f32); a_im = a_im.astype(f32)
    dt = jnp.exp(log_dt.astype(f32))[:, None]
    mag = jnp.exp(a_re * dt)
    ang = a_im * dt
    abar_re = mag * jnp.cos(ang)
    abar_im = mag * jnp.sin(ang)
    nr = abar_re - 1.0
    ni = abar_im
    den = a_re * a_re + a_im * a_im
    fr = (nr * a_re + ni * a_im) / den
    fi = (ni * a_re - nr * a_im) / den
    b_re = b_re.astype(f32); b_im = b_im.astype(f32)
    bbar_re = fr[..., None] * b_re - fi[..., None] * b_im
    bbar_im = fr[..., None] * b_im + fi[..., None] * b_re
    bu_re = jnp.einsum('bsgc,gpc->bsgp', ug, bbar_re)
    bu_im = jnp.einsum('bsgc,gpc->bsgp', ug, bbar_im)
    ar_t = jnp.broadcast_to(abar_re, bu_re.shape)
    ai_t = jnp.broadcast_to(abar_im, bu_re.shape)

    def combine(e1, e2):
        a1r, a1i, b1r, b1i = e1
        a2r, a2i, b2r, b2i = e2
        return (a2r * a1r - a2i * a1i,
                a2r * a1i + a2i * a1r,
                a2r * b1r - a2i * b1i + b2r,
                a2r * b1i + a2i * b1r + b2i)

    _, _, xr, xi = lax.associative_scan(combine, (ar_t, ai_t, bu_re, bu_im), axis=1)
    y = (jnp.einsum('gcp,bsgp->bsgc', c_re.astype(f32), xr)
         - jnp.einsum('gcp,bsgp->bsgc', c_im.astype(f32), xi))
    y = y.reshape(B, S, W) + d_skip.astype(f32) * u.astype(f32)
    y = jax.nn.gelu(y).astype(u.dtype)
    return y * jax.nn.sigmoid(y @ glu_w + glu_b)


def hybrid_layer(x, c, lb, ada_w, ada_b, norm_g, w_in, hg_onorm_g, at_qnorm_g, at_knorm_g,
                 s5_a_re, s5_a_im, s5_log_dt, s5_b_re, s5_b_im, s5_c_re, s5_c_im, s5_d,
                 s5_glu_w, s5_glu_b, w_branch, w_out, positions):
    B, S, D = x.shape
    mod = jax.nn.silu(c) @ ada_w + ada_b
    shift, scale, gate = jnp.split(mod[:, None, :], 3, axis=-1)
    h = rms_norm(x, norm_g) * (1.0 + scale) + shift
    proj = h @ w_in
    (hg_q, hg_f, hg_i, hg_g, at_q, at_k, at_v, at_g,
     ix_q, ix_k, ix_w, s5_u, s5_g, merge_g) = split_cols(proj)
    ya = hgrn2_mixer(hg_q, hg_f, hg_i, lb, hg_onorm_g) * jax.nn.silu(hg_g)
    yb = dsa_mixer(at_q, at_k, at_v, ix_q, ix_k, ix_w, positions, at_qnorm_g, at_knorm_g) * jax.nn.silu(at_g)
    yc = s5_mixer(s5_u, s5_a_re, s5_a_im, s5_log_dt, s5_b_re, s5_b_im, s5_c_re, s5_c_im,
                  s5_d, s5_glu_w, s5_glu_b) * jax.nn.silu(s5_g)
    ys = jnp.stack([ya, yb, yc], axis=2)
    yd = jnp.einsum('bsnw,nwd->bsnd', ys, w_branch)
    gates = jax.nn.sigmoid(merge_g).reshape(B, S, N_BRANCH, D)
    merged = jnp.einsum('bsnd,bsnd->bsd', gates, yd)
    return x + gate * (merged @ w_out)


def setup_inputs(seed: int = 0) -> dict:
    key = jax.random.key(seed)
    ks = jax.random.split(key, 26)
    f32 = jnp.float32
    L, D, W, G, P = DEPTH, D_MODEL, BRANCH_WIDTH, S5_GROUPS, S5_STATE
    nrm = lambda k, shape, s: jax.random.normal(k, shape, f32) * s
    x = nrm(ks[0], (BATCH, SEQ, D), 1.0)
    c = nrm(ks[1], (BATCH, D), 1.0)
    offsets = jax.random.randint(ks[2], (BATCH, 1), 0, 1024, dtype=jnp.int32)
    positions = (offsets + jnp.arange(SEQ, dtype=jnp.int32)[None, :]).astype(jnp.int32)
    n_idx = jnp.arange(P, dtype=f32)
    return {
        "x": x,
        "c": c,
        "positions": positions,
        "ada_w": nrm(ks[3], (L, D, 3 * D), 0.5 * D ** -0.5),
        "ada_b": nrm(ks[4], (L, 3 * D), 0.02),
        "norm_g": 1.0 + nrm(ks[5], (L, D), 0.01),
        "w_in": nrm(ks[6], (L, D, N_IN), D ** -0.5),
        "hg_lb_logits": nrm(ks[7], (L, HG_HEADS * HG_DIM), 0.1),
        "hg_onorm_g": 1.0 + nrm(ks[8], (L, HG_DIM), 0.01),
        "at_qnorm_g": 1.0 + nrm(ks[9], (L, AT_DIM), 0.01),
        "at_knorm_g": 1.0 + nrm(ks[10], (L, AT_DIM), 0.01),
        "s5_a_re": -0.5 + nrm(ks[11], (L, G, P), 0.01),
        "s5_a_im": math.pi * n_idx[None, None, :] + nrm(ks[12], (L, G, P), 0.01),
        "s5_log_dt": jax.random.uniform(ks[13], (L, G), f32, math.log(1e-3), math.log(1e-1)),
        "s5_b_re": nrm(ks[14], (L, G, P, S5_GROUP), (2.0 * S5_GROUP) ** -0.5),
        "s5_b_im": nrm(ks[15], (L, G, P, S5_GROUP), (2.0 * S5_GROUP) ** -0.5),
        "s5_c_re": nrm(ks[16], (L, G, S5_GROUP, P), (2.0 * P) ** -0.5),
        "s5_c_im": nrm(ks[17], (L, G, S5_GROUP, P), (2.0 * P) ** -0.5),
        "s5_d": nrm(ks[18], (L, W), 1.0),
        "s5_glu_w": nrm(ks[19], (L, W, W), W ** -0.5),
        "s5_glu_b": nrm(ks[20], (L, W), 0.02),
        "w_branch": nrm(ks[21], (L, N_BRANCH, W, D), W ** -0.5),
        "w_out": nrm(ks[22], (L, D, D), D ** -0.5),
    }


def reference(x, c, positions, ada_w, ada_b, norm_g, w_in, hg_lb_logits, hg_onorm_g,
              at_qnorm_g, at_knorm_g, s5_a_re, s5_a_im, s5_log_dt, s5_b_re, s5_b_im,
              s5_c_re, s5_c_im, s5_d, s5_glu_w, s5_glu_b, w_branch, w_out):
    p = jax.nn.softmax(hg_lb_logits.astype(jnp.float32), axis=0)
    lb_all = jnp.cumsum(p, axis=0) - p[0:1]
    for l in range(DEPTH):
        x = hybrid_layer(x, c, lb_all[l], ada_w[l], ada_b[l], norm_g[l], w_in[l], hg_onorm_g[l],
                         at_qnorm_g[l], at_knorm_g[l], s5_a_re[l], s5_a_im[l], s5_log_dt[l],
                         s5_b_re[l], s5_b_im[l], s5_c_re[l], s5_c_im[l], s5_d[l],
                         s5_glu_w[l], s5_glu_b[l], w_branch[l], w_out[l], positions)
    return x
```

```cpp
#include <hip/hip_runtime.h>
#include <hip/hip_cooperative_groups.h>
#include <hip/hip_fp16.h>
#include <cstdio>
namespace cg = cooperative_groups;

constexpr int D = 1024, NB = 8, S = 2048, T = NB * S, NL = 4, W = 512, NIN = 8008, NP = 4936;
constexpr int C_HGQ = 0, C_HGF = 512, C_HGI = 1024, C_HGG = 1536, C_ATQ = 2048, C_ATK = 2560, C_ATV = 2688, C_ATG = 2816,
              C_IXQ = 3328, C_IXK = 3840, C_IXW = 3904, C_S5U = 3912, C_S5G = 4424, C_MG = 4936;
constexpr float EPS = 1e-6f;
constexpr int LDS_BYTES = 135168;

struct Params {
    const float *x, *c; const int* pos;
    const float *ada_w, *ada_b, *norm_g, *w_in, *lb_logits, *onorm_g, *qn_g, *kn_g;
    const float *a_re, *a_im, *log_dt, *b_re, *b_im, *c_re, *c_im, *s5_d, *glu_w, *glu_b, *w_branch, *w_out;
    float* out;
    float *mod, *lb, *abar, *bbar, *ropeA, *ropeI, *h, *proj, *ypre; __half* ys;
};

__device__ __forceinline__ float sigmoid_f(float v) { return 1.f / (1.f + expf(-v)); }
__device__ __forceinline__ float silu_f(float v) { return v / (1.f + expf(-v)); }
__device__ __forceinline__ float gelu_tanh_f(float v) { return 0.5f * v * (1.f + tanhf(0.7978845608028654f * (v + 0.044715f * v * v * v))); }
__device__ __forceinline__ float wave_sum(float v) {
#pragma unroll
    for (int o = 32; o > 0; o >>= 1) v += __shfl_xor(v, o);
    return v;
}
__device__ __forceinline__ void lds_fence() { asm volatile("s_waitcnt lgkmcnt(0)" ::: "memory"); }

__device__ void phase0(const Params& p) {
    const size_t gtid = (size_t)blockIdx.x * blockDim.x + threadIdx.x, nth = (size_t)gridDim.x * blockDim.x;
    for (size_t i = gtid; i < (size_t)NL * NB * 3072; i += nth) {
        const int col = (int)(i % 3072), b = (int)((i / 3072) % NB), l = (int)(i / (3072 * NB));
        const float* w = p.ada_w + (size_t)l * 1024 * 3072 + col;
        const float* cc = p.c + b * 1024;
        float acc = p.ada_b[l * 3072 + col];
        for (int k = 0; k < 1024; ++k) { const float cv = cc[k]; acc += silu_f(cv) * w[(size_t)k * 3072]; }
        p.mod[i] = acc;
    }
    for (size_t i = gtid; i < 512; i += nth) {
        float lg[NL], mx = -1e30f;
#pragma unroll
        for (int l = 0; l < NL; ++l) { lg[l] = p.lb_logits[l * 512 + i]; mx = fmaxf(mx, lg[l]); }
        float s = 0.f;
#pragma unroll
        for (int l = 0; l < NL; ++l) { lg[l] = expf(lg[l] - mx); s += lg[l]; }
        float cum = 0.f;
#pragma unroll
        for (int l = 0; l < NL; ++l) { const float pr = lg[l] / s; cum += pr; p.lb[l * 512 + i] = cum - lg[0] / s; }
    }
    for (size_t i = gtid; i < (size_t)NL * 32 * 64; i += nth) {
        const int lg = (int)(i / 64);
        const double dt = exp((double)p.log_dt[lg]);
        const double are = p.a_re[i], aim = p.a_im[i];
        const double mag = exp(are * dt), ang = aim * dt;
        const double abr = mag * cos(ang), abi = mag * sin(ang);
        const double nr = abr - 1.0, ni = abi, den = are * are + aim * aim;
        const double fr = (nr * are + ni * aim) / den, fi = (ni * are - nr * aim) / den;
        p.abar[i * 2] = (float)abr; p.abar[i * 2 + 1] = (float)abi;
        for (int c = 0; c < 16; ++c) {
            const double br = p.b_re[i * 16 + c], bi = p.b_im[i * 16 + c];
            p.bbar[(i * 16 + c) * 2] = (float)(fr * br - fi * bi);
            p.bbar[(i * 16 + c) * 2 + 1] = (float)(fr * bi + fi * br);
        }
    }
    for (size_t i = gtid; i < (size_t)T * 64; i += nth) {
        const int t = (int)(i / 64), j = (int)(i % 64);
        const double inv = pow(10000.0, -(double)(2 * j) / 128.0);
        const double ang = (double)p.pos[t] * inv;
        p.ropeA[i * 2] = (float)cos(ang); p.ropeA[i * 2 + 1] = (float)sin(ang);
    }
    for (size_t i = gtid; i < (size_t)T * 32; i += nth) {
        const int t = (int)(i / 32), j = (int)(i % 32);
        const double inv = pow(10000.0, -(double)(2 * j) / 64.0);
        const double ang = (double)p.pos[t] * inv;
        p.ropeI[i * 2] = (float)cos(ang); p.ropeI[i * 2 + 1] = (float)sin(ang);
    }
}

__device__ void phase_h(const Params& p, int l) {
    const float* xin = l == 0 ? p.x : p.out;
    const int w = threadIdx.x >> 6, lane = threadIdx.x & 63;
    for (int row = blockIdx.x * 8 + w; row < T; row += gridDim.x * 8) {
        const int b = row / S;
        const float* xr = xin + (size_t)row * D;
        float4 v[4]; float ss = 0.f;
#pragma unroll
        for (int i = 0; i < 4; ++i) { v[i] = *(const float4*)(xr + i * 256 + lane * 4); ss += v[i].x * v[i].x + v[i].y * v[i].y + v[i].z * v[i].z + v[i].w * v[i].w; }
        ss = wave_sum(ss);
        const float r = rsqrtf(ss * (1.f / D) + EPS);
        const float* md = p.mod + ((size_t)l * NB + b) * 3072;
#pragma unroll
        for (int i = 0; i < 4; ++i) {
            const int k = i * 256 + lane * 4;
            const float4 g = *(const float4*)(p.norm_g + l * D + k), sh = *(const float4*)(md + k), sc = *(const float4*)(md + D + k);
            float4 o;
            o.x = v[i].x * r * g.x * (1.f + sc.x) + sh.x; o.y = v[i].y * r * g.y * (1.f + sc.y) + sh.y;
            o.z = v[i].z * r * g.z * (1.f + sc.z) + sh.z; o.w = v[i].w * r * g.w * (1.f + sc.w) + sh.w;
            *(float4*)(p.h + (size_t)row * D + k) = o;
        }
    }
}

template <typename TA> __device__ __forceinline__ float4 ldA4(const TA* q);
template <> __device__ __forceinline__ float4 ldA4<float>(const float* q) { return *(const float4*)q; }
template <> __device__ __forceinline__ float4 ldA4<__half>(const __half* q) {
    const uint2 u = *(const uint2*)q; const __half2 a = *(const __half2*)&u.x, b = *(const __half2*)&u.y;
    const float2 fa = __half22float2(a), fb = __half22float2(b); return make_float4(fa.x, fa.y, fb.x, fb.y);
}
template <typename TA>
__device__ void gemm_tile_acc(const TA* __restrict__ A, int lda, const float* __restrict__ Bm, int ldb, int K, int nvalid, float (&acc)[4][8], float* lds) {
    float (*As)[132] = (float (*)[132])lds;
    float (*Bs)[132] = (float (*)[132])(lds + 16 * 132);
    const int tid = threadIdx.x, ty = tid >> 4, tx = tid & 15;
    const int ar = tid >> 2, ak = (tid & 3) * 4, bk = tid >> 5, bn = (tid & 31) * 4;
    const bool bval = bn < nvalid;
    float4 ra = ldA4<TA>(A + (size_t)ar * lda + ak);
    float4 rb = bval ? *(const float4*)(Bm + (size_t)bk * ldb + bn) : make_float4(0.f, 0.f, 0.f, 0.f);
    for (int k0 = 0; k0 < K; k0 += 16) {
        __syncthreads();
        As[ak + 0][ar] = ra.x; As[ak + 1][ar] = ra.y; As[ak + 2][ar] = ra.z; As[ak + 3][ar] = ra.w;
        *(float4*)&Bs[bk][bn] = rb;
        __syncthreads();
        if (k0 + 16 < K) {
            ra = ldA4<TA>(A + (size_t)ar * lda + k0 + 16 + ak);
            rb = bval ? *(const float4*)(Bm + (size_t)(k0 + 16 + bk) * ldb + bn) : make_float4(0.f, 0.f, 0.f, 0.f);
        }
#pragma unroll 4
        for (int kk = 0; kk < 16; ++kk) {
            const float4 a = *(const float4*)&As[kk][ty * 4];
            const float4 b0 = *(const float4*)&Bs[kk][tx * 8], b1 = *(const float4*)&Bs[kk][tx * 8 + 4];
            const float av[4] = {a.x, a.y, a.z, a.w};
            const float bv[8] = {b0.x, b0.y, b0.z, b0.w, b1.x, b1.y, b1.z, b1.w};
#pragma unroll
            for (int i = 0; i < 4; ++i)
#pragma unroll
                for (int j = 0; j < 8; ++j) acc[i][j] += av[i] * bv[j];
        }
    }
    __syncthreads();
}
#define ZERO_ACC(a) _Pragma("unroll") for (int _i = 0; _i < 4; ++_i) _Pragma("unroll") for (int _j = 0; _j < 8; ++_j) a[_i][_j] = 0.f

__device__ void phase_proj(const Params& p, int l, float* lds) {
    const int ty = threadIdx.x >> 4, tx = threadIdx.x & 15;
    const float* wl = p.w_in + (size_t)l * D * NIN;
    constexpr int NT = (NP + 127) / 128;
    for (int tile = blockIdx.x; tile < 128 * NT; tile += gridDim.x) {
        const int mt = tile % 128, nt = tile / 128, m0 = mt * 128, n0 = nt * 128;
        float acc[4][8]; ZERO_ACC(acc);
        gemm_tile_acc<float>(p.h + (size_t)m0 * D, D, wl + n0, NIN, D, NP - n0, acc, lds);
#pragma unroll
        for (int i = 0; i < 4; ++i) {
            float* o = p.proj + (size_t)(m0 + ty * 4 + i) * NP + n0 + tx * 8;
            if (n0 + tx * 8 < NP) { *(float4*)o = make_float4(acc[i][0], acc[i][1], acc[i][2], acc[i][3]); *(float4*)(o + 4) = make_float4(acc[i][4], acc[i][5], acc[i][6], acc[i][7]); }
        }
    }
}

__device__ void phase_fix(const Params& p, int l) {
    const int w = threadIdx.x >> 6, lane = threadIdx.x & 63;
    for (int t = blockIdx.x * 8 + w; t < T; t += gridDim.x * 8) {
        float* row = p.proj + (size_t)t * NP;
        const float cA = p.ropeA[((size_t)t * 64 + lane) * 2], sA = p.ropeA[((size_t)t * 64 + lane) * 2 + 1];
        for (int hh = 0; hh < 5; ++hh) {
            float* q = hh < 4 ? row + C_ATQ + hh * 128 : row + C_ATK;
            const float* g = hh < 4 ? p.qn_g + l * 128 : p.kn_g + l * 128;
            const float x1 = q[lane], x2 = q[64 + lane];
            const float ss = wave_sum(x1 * x1 + x2 * x2);
            const float r = rsqrtf(ss * (1.f / 128.f) + EPS);
            const float a = x1 * r * g[lane], b2 = x2 * r * g[64 + lane];
            q[lane] = a * cA - b2 * sA; q[64 + lane] = b2 * cA + a * sA;
        }
        for (int i = 0; i < 5; ++i) {
            const int idx = lane + 64 * i;
            if (i == 4 && lane >= 32) break;
            const int hh = idx >> 5, j = idx & 31;
            float* q = i < 4 ? row + C_IXQ + hh * 64 : row + C_IXK;
            const float cI = p.ropeI[((size_t)t * 32 + j) * 2], sI = p.ropeI[((size_t)t * 32 + j) * 2 + 1];
            const float x1 = q[j], x2 = q[32 + j];
            q[j] = x1 * cI - x2 * sI; q[32 + j] = x2 * cI + x1 * sI;
        }
    }
}

__device__ void mixA(const Params& p, int l, int item, float* lds) {
    const int b = item >> 2, hd = item & 3;
    float* qs = lds; float* fs = qs + 32 * 128; float* ks = fs + 32 * 128; float* vs = ks + 32 * 128; float* op = vs + 32 * 128;
    const int tid = threadIdx.x, e = tid & 127, dq = tid >> 7, w = tid >> 6, lane = tid & 63;
    float St[32];
#pragma unroll
    for (int i = 0; i < 32; ++i) St[i] = 0.f;
    const float* lbp = p.lb + l * 512 + hd * 128;
    const float* on = p.onorm_g + l * 128;
    __half* ya = p.ys;
    for (int c0 = 0; c0 < S; c0 += 32) {
        for (int i = tid; i < 32 * 128; i += 512) {
            const int tt = i >> 7, d = i & 127; const size_t row = (size_t)(b * S + c0 + tt) * NP;
            const float q = p.proj[row + C_HGQ + hd * 128 + d], fz = p.proj[row + C_HGF + hd * 128 + d], v = p.proj[row + C_HGI + hd * 128 + d];
            const float lb = lbp[d], f = lb + (1.f - lb) * sigmoid_f(fz);
            qs[i] = q; fs[i] = f; ks[i] = 1.f - f; vs[i] = v;
        }
        __syncthreads();
#pragma unroll 1
        for (int tt = 0; tt < 32; ++tt) {
            const float ve = vs[tt * 128 + e]; float part = 0.f;
            const float4* f4 = (const float4*)(fs + tt * 128 + dq * 32); const float4* k4 = (const float4*)(ks + tt * 128 + dq * 32); const float4* q4 = (const float4*)(qs + tt * 128 + dq * 32);
#pragma unroll
            for (int j = 0; j < 8; ++j) {
                const float4 f = f4[j], k = k4[j], q = q4[j];
                St[4 * j + 0] = f.x * St[4 * j + 0] + k.x * ve; part += q.x * St[4 * j + 0];
                St[4 * j + 1] = f.y * St[4 * j + 1] + k.y * ve; part += q.y * St[4 * j + 1];
                St[4 * j + 2] = f.z * St[4 * j + 2] + k.z * ve; part += q.z * St[4 * j + 2];
                St[4 * j + 3] = f.w * St[4 * j + 3] + k.w * ve; part += q.w * St[4 * j + 3];
            }
            op[(tt * 4 + dq) * 128 + e] = part;
        }
        __syncthreads();
        for (int i = 0; i < 4; ++i) {
            const int tt = w * 4 + i;
            float o0 = 0.f, o1 = 0.f;
#pragma unroll
            for (int q = 0; q < 4; ++q) { o0 += op[(tt * 4 + q) * 128 + lane]; o1 += op[(tt * 4 + q) * 128 + 64 + lane]; }
            const float ss = wave_sum(o0 * o0 + o1 * o1);
            const float r = rsqrtf(ss * (1.f / 128.f) + EPS);
            const size_t row = (size_t)(b * S + c0 + tt);
            const float g0 = p.proj[row * NP + C_HGG + hd * 128 + lane], g1 = p.proj[row * NP + C_HGG + hd * 128 + 64 + lane];
            ya[row * W + hd * 128 + lane] = __float2half(o0 * r * on[lane] * silu_f(g0));
            ya[row * W + hd * 128 + 64 + lane] = __float2half(o1 * r * on[64 + lane] * silu_f(g1));
        }
        __syncthreads();
    }
}

__device__ void mixC(const Params& p, int l, int item, float* lds) {
    const int w = threadIdx.x >> 6, lane = threadIdx.x & 63;
    const int idx = item * 8 + w, b = idx >> 5, g = idx & 31;
    float* wl = lds + w * 3328;
    float* cre = wl; float* cim = cre + 16 * 65; float* xrs = cim + 16 * 65; float* xis = xrs + 512; float* us = xis + 512;
    const size_t lg = (size_t)l * 32 + g;
    const float abr = p.abar[(lg * 64 + lane) * 2], abi = p.abar[(lg * 64 + lane) * 2 + 1];
    float bre[16], bim[16];
#pragma unroll
    for (int c = 0; c < 16; ++c) { bre[c] = p.bbar[((lg * 64 + lane) * 16 + c) * 2]; bim[c] = p.bbar[((lg * 64 + lane) * 16 + c) * 2 + 1]; }
    for (int c = 0; c < 16; ++c) { cre[c * 65 + lane] = p.c_re[(lg * 16 + c) * 64 + lane]; cim[c * 65 + lane] = p.c_im[(lg * 16 + c) * 64 + lane]; }
    float xr = 0.f, xi = 0.f;
    for (int t0 = 0; t0 < S; t0 += 8) {
#pragma unroll
        for (int i = 0; i < 2; ++i) { const int q = lane + 64 * i; us[q] = p.proj[(size_t)(b * S + t0 + (q >> 4)) * NP + C_S5U + g * 16 + (q & 15)]; }
        __syncthreads();
#pragma unroll 1
        for (int tt = 0; tt < 8; ++tt) {
            float bur = 0.f, bui = 0.f;
#pragma unroll
            for (int c = 0; c < 16; ++c) { const float u = us[tt * 16 + c]; bur += u * bre[c]; bui += u * bim[c]; }
            const float nxr = abr * xr - abi * xi + bur, nxi = abr * xi + abi * xr + bui;
            xr = nxr; xi = nxi;
            xrs[tt * 64 + lane] = xr; xis[tt * 64 + lane] = xi;
        }
        __syncthreads();
#pragma unroll
        for (int i = 0; i < 2; ++i) {
            const int q = lane + 64 * i, tt = q >> 4, c = q & 15;
            float y = 0.f;
#pragma unroll 8
            for (int s = 0; s < 64; ++s) y += cre[c * 65 + s] * xrs[tt * 64 + s] - cim[c * 65 + s] * xis[tt * 64 + s];
            y += p.s5_d[l * W + g * 16 + c] * us[q];
            p.ypre[(size_t)(b * S + t0 + tt) * W + g * 16 + c] = gelu_tanh_f(y);
        }
        __syncthreads();
    }
}

__device__ __forceinline__ unsigned f2key(float f) { const unsigned u = __float_as_uint(f); return (u & 0x80000000u) ? ~u : (u | 0x80000000u); }
__device__ void mixB(const Params& p, int l, int item, float* lds) {
    const int w = threadIdx.x >> 6, lane = threadIdx.x & 63;
    const int t = item * 8 + w, b = t / S, qi = t % S;
    float* wl = lds + w * 2816;
    float* scl = wl; float* iql = scl + 2048; int* sidx = (int*)(iql + 512);
    const float* row = p.proj + (size_t)t * NP;
    for (int i = 0; i < 8; ++i) iql[lane + 64 * i] = row[C_IXQ + lane + 64 * i];
    float iw[8];
#pragma unroll
    for (int hh = 0; hh < 8; ++hh) iw[hh] = row[C_IXW + hh];
    lds_fence();
    const int iend = qi / 64 + 1;
#pragma unroll 1
    for (int i = 0; i < 32; ++i) {
        const int s = lane + 64 * i;
        float sc = -INFINITY;
        if (i < iend && s <= qi) {
            const float4* kp = (const float4*)(p.proj + (size_t)(b * S + s) * NP + C_IXK);
            float d[8];
#pragma unroll
            for (int hh = 0; hh < 8; ++hh) d[hh] = 0.f;
#pragma unroll 4
            for (int j = 0; j < 16; ++j) {
                const float4 kv = kp[j];
#pragma unroll
                for (int hh = 0; hh < 8; ++hh) { const float4 qv = *(const float4*)(iql + hh * 64 + j * 4); d[hh] += qv.x * kv.x + qv.y * kv.y + qv.z * kv.z + qv.w * kv.w; }
            }
            sc = 0.f;
#pragma unroll
            for (int hh = 0; hh < 8; ++hh) sc += fmaxf(d[hh], 0.f) * iw[hh];
        }
        scl[s] = sc;
    }
    lds_fence();
    const int n = qi + 1;
    const bool all = n <= 256;
    unsigned thr = 0; int rrem = 0;
    if (!all) {
        unsigned key[32];
#pragma unroll
        for (int i = 0; i < 32; ++i) key[i] = f2key(scl[lane + 64 * i]);
        unsigned prefix = 0;
#pragma unroll 1
        for (int bit = 31; bit >= 0; --bit) {
            const unsigned cand = prefix | (1u << bit);
            int c = 0;
#pragma unroll
            for (int i = 0; i < 32; ++i) c += (key[i] >= cand) ? 1 : 0;
#pragma unroll
            for (int o = 32; o > 0; o >>= 1) c += __shfl_xor(c, o);
            if (c >= 256) prefix = cand;
        }
        int c = 0;
#pragma unroll
        for (int i = 0; i < 32; ++i) c += (key[i] > prefix) ? 1 : 0;
#pragma unroll
        for (int o = 32; o > 0; o >>= 1) c += __shfl_xor(c, o);
        thr = prefix; rrem = 256 - c;
    }
    int cnt = 0;
    {
        const unsigned long long lt = (1ull << lane) - 1ull;
#pragma unroll 1
        for (int i = 0; i < 32; ++i) {
            const int s = lane + 64 * i;
            const unsigned k = f2key(scl[s]);
            bool sl;
            if (all) sl = s <= qi;
            else {
                const bool eq = k == thr;
                const unsigned long long m = __ballot(eq);
                sl = (k > thr) || (eq && __popcll(m & lt) < rrem);
                rrem -= __popcll(m); if (rrem < 0) rrem = 0;
            }
            const unsigned long long m2 = __ballot(sl);
            if (sl) sidx[cnt + __popcll(m2 & lt)] = s;
            cnt += __popcll(m2);
        }
    }
    lds_fence();
    float qv[4][2];
#pragma unroll
    for (int hh = 0; hh < 4; ++hh) { qv[hh][0] = row[C_ATQ + hh * 128 + lane]; qv[hh][1] = row[C_ATQ + hh * 128 + 64 + lane]; }
    float mx[4], ls[4], a0[4], a1[4];
#pragma unroll
    for (int hh = 0; hh < 4; ++hh) { mx[hh] = -INFINITY; ls[hh] = 0.f; a0[hh] = 0.f; a1[hh] = 0.f; }
    const float scale = 0.08838834764831845f;
#pragma unroll 2
    for (int j = 0; j < cnt; ++j) {
        const int s = sidx[j];
        const float* kr = p.proj + (size_t)(b * S + s) * NP;
        const float k0 = kr[C_ATK + lane], k1 = kr[C_ATK + 64 + lane], v0 = kr[C_ATV + lane], v1 = kr[C_ATV + 64 + lane];
#pragma unroll
        for (int hh = 0; hh < 4; ++hh) {
            const float lg = wave_sum(qv[hh][0] * k0 + qv[hh][1] * k1) * scale;
            const float mn = fmaxf(mx[hh], lg);
            const float cs = expf(mx[hh] - mn), pe = expf(lg - mn);
            ls[hh] = ls[hh] * cs + pe; a0[hh] = a0[hh] * cs + pe * v0; a1[hh] = a1[hh] * cs + pe * v1; mx[hh] = mn;
        }
    }
    __half* yb = p.ys + (size_t)T * W;
#pragma unroll
    for (int hh = 0; hh < 4; ++hh) {
        const float g0 = row[C_ATG + hh * 128 + lane], g1 = row[C_ATG + hh * 128 + 64 + lane];
        yb[(size_t)t * W + hh * 128 + lane] = __float2half(a0[hh] / ls[hh] * silu_f(g0));
        yb[(size_t)t * W + hh * 128 + 64 + lane] = __float2half(a1[hh] / ls[hh] * silu_f(g1));
    }
}

__device__ void phase_mix(const Params& p, int l, float* lds) {
    constexpr int NA = 32, NC = 32, NBQ = T / 8;
    for (int item = blockIdx.x; item < NA + NC + NBQ; item += gridDim.x) {
        if (item < NA) mixA(p, l, item, lds);
        else if (item < NA + NC) mixC(p, l, item - NA, lds);
        else mixB(p, l, item - NA - NC, lds);
        __syncthreads();
    }
}

__device__ void phase_glu(const Params& p, int l, float* lds) {
    const int ty = threadIdx.x >> 4, tx = threadIdx.x & 15;
    __half* yc = p.ys + (size_t)2 * T * W;
    for (int tile = blockIdx.x; tile < 128 * 4; tile += gridDim.x) {
        const int mt = tile % 128, nt = tile / 128, m0 = mt * 128, n0 = nt * 128;
        float acc[4][8]; ZERO_ACC(acc);
        gemm_tile_acc<float>(p.ypre + (size_t)m0 * W, W, p.glu_w + (size_t)l * W * W + n0, W, W, 128, acc, lds);
#pragma unroll
        for (int i = 0; i < 4; ++i)
#pragma unroll
            for (int j = 0; j < 8; ++j) {
                const size_t r = m0 + ty * 4 + i; const int cc = n0 + tx * 8 + j;
                const float y = p.ypre[r * W + cc];
                const float o = y * sigmoid_f(acc[i][j] + p.glu_b[l * W + cc]) * silu_f(p.proj[r * NP + C_S5G + cc]);
                yc[r * W + cc] = __float2half(o);
            }
    }
}

__device__ void phase_merge(const Params& p, int l, float* lds) {
    const int ty = threadIdx.x >> 4, tx = threadIdx.x & 15;
    float* merged = p.proj;
    for (int tile = blockIdx.x; tile < 128 * 8; tile += gridDim.x) {
        const int mt = tile % 128, nt = tile / 128, m0 = mt * 128, n0 = nt * 128;
        float mg[4][8]; ZERO_ACC(mg);
        for (int n = 0; n < 3; ++n) {
            float ag[4][8], ay[4][8]; ZERO_ACC(ag); ZERO_ACC(ay);
            gemm_tile_acc<float>(p.h + (size_t)m0 * D, D, p.w_in + (size_t)l * D * NIN + C_MG + n * D + n0, NIN, D, 128, ag, lds);
#pragma unroll
            for (int i = 0; i < 4; ++i)
#pragma unroll
                for (int j = 0; j < 8; ++j) ag[i][j] = sigmoid_f(ag[i][j]);
            gemm_tile_acc<__half>(p.ys + (size_t)n * T * W + (size_t)m0 * W, W, p.w_branch + ((size_t)l * 3 + n) * W * D + n0, D, W, 128, ay, lds);
#pragma unroll
            for (int i = 0; i < 4; ++i)
#pragma unroll
                for (int j = 0; j < 8; ++j) mg[i][j] += ag[i][j] * ay[i][j];
        }
#pragma unroll
        for (int i = 0; i < 4; ++i) {
            float* o = merged + (size_t)(m0 + ty * 4 + i) * D + n0 + tx * 8;
            *(float4*)o = make_float4(mg[i][0], mg[i][1], mg[i][2], mg[i][3]); *(float4*)(o + 4) = make_float4(mg[i][4], mg[i][5], mg[i][6], mg[i][7]);
        }
    }
}

__device__ void phase_out(const Params& p, int l, float* lds) {
    const int ty = threadIdx.x >> 4, tx = threadIdx.x & 15;
    const float* xin = l == 0 ? p.x : p.out;
    const float* merged = p.proj;
    for (int tile = blockIdx.x; tile < 128 * 8; tile += gridDim.x) {
        const int mt = tile % 128, nt = tile / 128, m0 = mt * 128, n0 = nt * 128;
        float acc[4][8]; ZERO_ACC(acc);
        gemm_tile_acc<float>(merged + (size_t)m0 * D, D, p.w_out + (size_t)l * D * D + n0, D, D, 128, acc, lds);
#pragma unroll
        for (int i = 0; i < 4; ++i) {
            const size_t r = m0 + ty * 4 + i; const int b = (int)(r / S);
            const float* gt = p.mod + ((size_t)l * NB + b) * 3072 + 2 * D + n0 + tx * 8;
#pragma unroll
            for (int j = 0; j < 8; ++j) p.out[r * D + n0 + tx * 8 + j] = xin[r * D + n0 + tx * 8 + j] + gt[j] * acc[i][j];
        }
    }
}

__global__ void __launch_bounds__(512) mega(Params p) {
    extern __shared__ __attribute__((aligned(16))) float lds[];
    cg::grid_group grid = cg::this_grid();
    phase0(p);
    grid.sync();
    for (int l = 0; l < NL; ++l) {
        phase_h(p, l);          grid.sync();
        phase_proj(p, l, lds);  grid.sync();
        phase_fix(p, l);        grid.sync();
        phase_mix(p, l, lds);   grid.sync();
        phase_glu(p, l, lds);   grid.sync();
        phase_merge(p, l, lds); grid.sync();
        phase_out(p, l, lds);   grid.sync();
    }
}

extern "C" void kernel_launch(void* const* d_in, const int* in_sizes, int n_in,
                              void* d_out, int out_size, void* d_ws, size_t ws_size,
                              hipStream_t stream) {
    static int grid_blocks = 0;
    if (!grid_blocks) {
        int dev = 0, cus = 0, per_cu = 0;
        (void)hipGetDevice(&dev);
        (void)hipDeviceGetAttribute(&cus, hipDeviceAttributeMultiprocessorCount, dev);
        (void)hipFuncSetAttribute((const void*)mega, hipFuncAttributeMaxDynamicSharedMemorySize, LDS_BYTES);
        (void)hipOccupancyMaxActiveBlocksPerMultiprocessor(&per_cu, mega, 512, LDS_BYTES);
        if (per_cu > 1) per_cu = 1;
        grid_blocks = cus * per_cu;
    }
    Params p{};
    const float* const* in = (const float* const*)d_in;
    p.x = in[0]; p.c = in[1]; p.pos = (const int*)d_in[2];
    p.ada_w = in[3]; p.ada_b = in[4]; p.norm_g = in[5]; p.w_in = in[6]; p.lb_logits = in[7]; p.onorm_g = in[8]; p.qn_g = in[9]; p.kn_g = in[10];
    p.a_re = in[11]; p.a_im = in[12]; p.log_dt = in[13]; p.b_re = in[14]; p.b_im = in[15]; p.c_re = in[16]; p.c_im = in[17]; p.s5_d = in[18];
    p.glu_w = in[19]; p.glu_b = in[20]; p.w_branch = in[21]; p.w_out = in[22];
    p.out = (float*)d_out;
    char* ws = (char*)d_ws; size_t off = 0;
    auto take = [&](size_t bytes) { char* q = ws + off; off += (bytes + 255) & ~(size_t)255; return q; };
    p.mod = (float*)take((size_t)NL * NB * 3072 * 4);
    p.lb = (float*)take((size_t)NL * 512 * 4);
    p.abar = (float*)take((size_t)NL * 32 * 64 * 2 * 4);
    p.bbar = (float*)take((size_t)NL * 32 * 64 * 16 * 2 * 4);
    p.ropeA = (float*)take((size_t)T * 64 * 2 * 4);
    p.ropeI = (float*)take((size_t)T * 32 * 2 * 4);
    p.h = (float*)take((size_t)T * D * 4);
    p.proj = (float*)take((size_t)T * NP * 4);
    p.ypre = (float*)take((size_t)T * W * 4);
    p.ys = (__half*)take((size_t)3 * T * W * 2);
    if (off > ws_size) { fprintf(stderr, "workspace too small: need %zu have %zu\n", off, ws_size); return; }
    void* args[] = {&p};
    hipError_t e = hipLaunchCooperativeKernel((void*)mega, dim3(grid_blocks), dim3(512), args, LDS_BYTES, stream);
    if (e != hipSuccess) fprintf(stderr, "cooperative launch failed: %s (grid %d)\n", hipGetErrorString(e), grid_blocks);
}
```

```cpp
#include <hip/hip_runtime.h>
#include <hip/hip_cooperative_groups.h>
#include <hip/hip_fp16.h>
#include <cstdio>
namespace cg = cooperative_groups;

constexpr int D = 1024, NB = 8, S = 2048, T = NB * S, NL = 4, W = 512, NIN = 8008, NPK = 8192;
constexpr int C_S5U = 3912, C_MG = 4936;
constexpr float EPS = 1e-6f;
constexpr int LDS_BYTES = 135168;
#define LAS __attribute__((address_space(3)))
typedef _Float16 h8 __attribute__((ext_vector_type(8)));
typedef _Float16 h2 __attribute__((ext_vector_type(2)));
typedef float f32x4 __attribute__((ext_vector_type(4)));
typedef unsigned u32x4 __attribute__((ext_vector_type(4)));

struct Params {
    const float *x, *c; const int* pos;
    const float *ada_w, *ada_b, *norm_g, *w_in, *lb_logits, *onorm_g, *qn_g, *kn_g;
    const float *a_re, *a_im, *log_dt, *b_re, *b_im, *c_re, *c_im, *s5_d, *glu_w, *glu_b, *w_branch, *w_out;
    float* out;
    float *mod, *lb, *abar, *bbar, *ropeA, *ropeI;
    __half *win16, *wb16, *wo16, *wglu16;
    __half *h16, *q16, *v16, *hgg16, *atq16, *atk16, *atv16, *atg16, *ixq16, *ixk16, *s5u16, *s5g16, *mg16, *ys, *ypre16, *merged16;
    float *lf32, *ixw32, *mp32; unsigned* dbg;
};

__device__ __forceinline__ float sigmoid_f(float v) { return 1.f / (1.f + expf(-v)); }
__device__ __forceinline__ float silu_f(float v) { return v / (1.f + expf(-v)); }
__device__ __forceinline__ float gelu_tanh_f(float v) { return 0.5f * v * (1.f + tanhf(0.7978845608028654f * (v + 0.044715f * v * v * v))); }
__device__ __forceinline__ float wave_sum(float v) {
#pragma unroll
    for (int o = 32; o > 0; o >>= 1) v += __shfl_xor(v, o);
    return v;
}
__device__ __forceinline__ void lds_fence() { asm volatile("s_waitcnt lgkmcnt(0)" ::: "memory"); }
__device__ __forceinline__ int tidx() { int t = threadIdx.x; asm volatile("" : "+v"(t)); return t; }

__device__ void phase0(const Params& p) {
    const size_t gtid = (size_t)blockIdx.x * blockDim.x + tidx(), nth = (size_t)gridDim.x * blockDim.x;
    for (size_t i = gtid; i < (size_t)NL * NB * 3072; i += nth) {
        const int col = (int)(i % 3072), b = (int)((i / 3072) % NB), l = (int)(i / (3072 * NB));
        const float* w = p.ada_w + (size_t)l * 1024 * 3072 + col;
        const float* cc = p.c + b * 1024;
        float acc = p.ada_b[l * 3072 + col];
        for (int k = 0; k < 1024; ++k) { const float cv = cc[k]; acc += silu_f(cv) * w[(size_t)k * 3072]; }
        p.mod[i] = acc;
    }
    for (size_t i = gtid; i < 512; i += nth) {
        float lg[NL], mx = -1e30f;
#pragma unroll
        for (int l = 0; l < NL; ++l) { lg[l] = p.lb_logits[l * 512 + i]; mx = fmaxf(mx, lg[l]); }
        float s = 0.f;
#pragma unroll
        for (int l = 0; l < NL; ++l) { lg[l] = expf(lg[l] - mx); s += lg[l]; }
        float cum = 0.f;
#pragma unroll
        for (int l = 0; l < NL; ++l) { const float pr = lg[l] / s; cum += pr; p.lb[l * 512 + i] = cum - lg[0] / s; }
    }
    for (size_t i = gtid; i < (size_t)NL * 32 * 64; i += nth) {
        const int lg = (int)(i / 64);
        const double dt = exp((double)p.log_dt[lg]);
        const double are = p.a_re[i], aim = p.a_im[i];
        const double mag = exp(are * dt), ang = aim * dt;
        const double abr = mag * cos(ang), abi = mag * sin(ang);
        const double nr = abr - 1.0, ni = abi, den = are * are + aim * aim;
        const double fr = (nr * are + ni * aim) / den, fi = (ni * are - nr * aim) / den;
        p.abar[i * 2] = (float)abr; p.abar[i * 2 + 1] = (float)abi;
        for (int c = 0; c < 16; ++c) {
            const double br = p.b_re[i * 16 + c], bi = p.b_im[i * 16 + c];
            p.bbar[(i * 16 + c) * 2] = (float)(fr * br - fi * bi);
            p.bbar[(i * 16 + c) * 2 + 1] = (float)(fr * bi + fi * br);
        }
    }
    for (size_t i = gtid; i < (size_t)T * 64; i += nth) {
        const int t = (int)(i / 64), j = (int)(i % 64);
        const double inv = pow(10000.0, -(double)(2 * j) / 128.0);
        const double ang = (double)p.pos[t] * inv;
        p.ropeA[i * 2] = (float)cos(ang); p.ropeA[i * 2 + 1] = (float)sin(ang);
    }
    for (size_t i = gtid; i < (size_t)T * 32; i += nth) {
        const int t = (int)(i / 32), j = (int)(i % 32);
        const double inv = pow(10000.0, -(double)(2 * j) / 64.0);
        const double ang = (double)p.pos[t] * inv;
        p.ropeI[i * 2] = (float)cos(ang); p.ropeI[i * 2 + 1] = (float)sin(ang);
    }
}

__device__ __forceinline__ unsigned pk2(float a, float b) { h2 v = {(_Float16)a, (_Float16)b}; return __builtin_bit_cast(unsigned, v); }
__device__ void phase_h(const Params& p, int l) {
    const float* xin = l == 0 ? p.x : p.out;
    const int w = tidx() >> 6, lane = tidx() & 63;
    for (int row = blockIdx.x * 8 + w; row < T; row += gridDim.x * 8) {
        const int b = row / S;
        const float* xr = xin + (size_t)row * D;
        float4 v[4]; float ss = 0.f;
#pragma unroll
        for (int i = 0; i < 4; ++i) { v[i] = *(const float4*)(xr + i * 256 + lane * 4); ss += v[i].x * v[i].x + v[i].y * v[i].y + v[i].z * v[i].z + v[i].w * v[i].w; }
        ss = wave_sum(ss);
        const float r = rsqrtf(ss * (1.f / D) + EPS);
        const float* md = p.mod + ((size_t)l * NB + b) * 3072;
#pragma unroll
        for (int i = 0; i < 4; ++i) {
            const int k = i * 256 + lane * 4;
            const float4 g = *(const float4*)(p.norm_g + l * D + k), sh = *(const float4*)(md + k), sc = *(const float4*)(md + D + k);
            uint2 o;
            o.x = pk2(v[i].x * r * g.x * (1.f + sc.x) + sh.x, v[i].y * r * g.y * (1.f + sc.y) + sh.y);
            o.y = pk2(v[i].z * r * g.z * (1.f + sc.z) + sh.z, v[i].w * r * g.w * (1.f + sc.w) + sh.w);
            *(uint2*)(p.h16 + (size_t)row * D + k) = o;
        }
    }
}
template <class CM>
__device__ void conv_transpose(const float* __restrict__ src, int ldsrc, int K, __half* __restrict__ dst, int N, CM colmap, float* lds, int part, int nparts) {
    float (*ts)[65] = (float (*)[65])lds;
    const int tid = tidx(), nkt = K / 64, nnt = N / 64;
    for (int tile = part; tile < nkt * nnt; tile += nparts) {
        const int kt = tile % nkt, nt = tile / nkt, k0 = kt * 64, n0 = nt * 64;
        __syncthreads();
#pragma unroll
        for (int i = 0; i < 8; ++i) {
            const int idx = tid + 512 * i, k = idx >> 6, n = idx & 63;
            const int sc = colmap(n0 + n);
            ts[k][n] = sc >= 0 ? src[(size_t)(k0 + k) * ldsrc + sc] : 0.f;
        }
        __syncthreads();
        const int n = tid >> 3, k8 = (tid & 7) * 8;
        u32x4 w;
        { h2 a = {(_Float16)ts[k8 + 0][n], (_Float16)ts[k8 + 1][n]}; w.x = __builtin_bit_cast(unsigned, a); }
        { h2 a = {(_Float16)ts[k8 + 2][n], (_Float16)ts[k8 + 3][n]}; w.y = __builtin_bit_cast(unsigned, a); }
        { h2 a = {(_Float16)ts[k8 + 4][n], (_Float16)ts[k8 + 5][n]}; w.z = __builtin_bit_cast(unsigned, a); }
        { h2 a = {(_Float16)ts[k8 + 6][n], (_Float16)ts[k8 + 7][n]}; w.w = __builtin_bit_cast(unsigned, a); }
        *(u32x4*)(dst + (size_t)(n0 + n) * K + k0 + k8) = w;
    }
}
struct CmIdent { __device__ int operator()(int n) const { return n; } };
struct CmWin { __device__ int operator()(int n) const { return n < C_S5U ? n : (n < 4096 ? -1 : n - 184); } };

__device__ void phase0_conv(const Params& p, float* lds) {
    for (int l = 0; l < NL; ++l) {
        conv_transpose(p.w_in + (size_t)l * D * NIN, NIN, D, p.win16 + (size_t)l * NPK * D, NPK, CmWin(), lds, blockIdx.x, gridDim.x);
        for (int n = 0; n < 3; ++n)
            conv_transpose(p.w_branch + ((size_t)l * 3 + n) * W * D, D, W, p.wb16 + ((size_t)l * 3 + n) * D * W, D, CmIdent(), lds, blockIdx.x, gridDim.x);
        conv_transpose(p.w_out + (size_t)l * D * D, D, D, p.wo16 + (size_t)l * D * D, D, CmIdent(), lds, blockIdx.x, gridDim.x);
        conv_transpose(p.glu_w + (size_t)l * W * W, W, W, p.wglu16 + (size_t)l * W * W, W, CmIdent(), lds, blockIdx.x, gridDim.x);
    }
}
namespace pg {
constexpr int BM = 256, BK = 64, HALF = 128, HTB = HALF * BK * 2, STAGE_BYTES = 8 * HTB, NXCD = 8, WGM = 8;
__device__ __forceinline__ int lds_byte(int r, int c) { const int st = (r >> 4) * 2 + (c >> 5), rr = r & 15, cc = c & 31, ob = rr * 64 + cc * 2; return st * 1024 + (ob ^ (((ob >> 9) & 1) << 5)); }
__device__ __forceinline__ void stage_rc(int b, int& R, int& C) { const int st = b / 1024, sb = b % 1024, swz = sb ^ (((sb >> 9) & 1) << 5); R = (st >> 1) * 16 + swz / 64; C = (st & 1) * 32 + (swz % 64) / 2; }
__device__ __forceinline__ int perm32(int rho) { const int n = rho >> 4, i = rho & 15; return 8 * (i >> 2) + 4 * n + (i & 3); }
struct Unit { int pm, pn, aux; const char* A; const char* B; };
__device__ __forceinline__ void tile_of(int L, int nM, int nN, int& pm, int& pn) {
    const int nwg = nM * nN; int wgid = L;
    { const int q = nwg / NXCD, r = nwg % NXCD, xcd = wgid % NXCD, off = wgid / NXCD; wgid = (xcd < r ? xcd * (q + 1) : r * (q + 1) + (xcd - r) * q) + off; }
    const int nig = WGM * nN, gid = wgid / nig, fm = gid * WGM, gsz = (nM - fm) < WGM ? (nM - fm) : WGM;
    pm = fm + ((wgid % nig) % gsz); pn = (wgid % nig) / gsz;
}
template <class Epi, class Sched>
__device__ __forceinline__ void gemm_phase(LAS unsigned char* lds, const int K, const Sched& S, const Epi& E) {
    int tid = tidx();
    const int wid = __builtin_amdgcn_readfirstlane(tid >> 6), lane = tid & 63, wr = wid >> 2, wc = wid & 3, fr = lane & 15, fq = lane >> 4;
    const int nt = K / BK;
    unsigned voffA[2], voffB[2];
#pragma unroll
    for (int i = 0; i < 2; ++i) { int R, C; stage_rc(tid * 16 + i * 8192, R, C); const int Rb = Epi::PERM ? ((R & ~31) + perm32(R & 31)) : R;
        voffA[i] = (unsigned)(R * K + C) * 2u; voffB[i] = (unsigned)(Rb * K + C) * 2u; }
    const size_t kstep = (size_t)(BK * 2);
    const size_t hstep = (size_t)HALF * K * 2;
    const unsigned ldsw = (unsigned)wid * 1024u;
    const int aoff = lds_byte(wr * 64 + fr, fq * 8), boff = lds_byte(wc * 32 + fr, fq * 8);
#define PG_SA(b, h) (((b) * 2 + (h)) * HTB)
#define PG_SB(b, h) ((4 + (b) * 2 + (h)) * HTB)
#define PG_STAGE(bufoff, gbase, voff) do { _Pragma("unroll") for (int _i = 0; _i < 2; ++_i) \
        __builtin_amdgcn_global_load_lds((const unsigned*)((const char*)(gbase) + (voff)[_i]), (LAS unsigned*)(lds + (bufoff) + ldsw + _i * 8192), 16, 0, 0); } while (0)
#define PG_LDA(dst, b, h) do { _Pragma("unroll") for (int m = 0; m < 4; ++m) _Pragma("unroll") for (int k = 0; k < 2; ++k) dst[m][k] = *(const LAS h8*)(lds + PG_SA(b, h) + aoff + m * 2048 + k * 1024); } while (0)
#define PG_LDB(dst, b, h) do { _Pragma("unroll") for (int n = 0; n < 2; ++n) _Pragma("unroll") for (int k = 0; k < 2; ++k) dst[n][k] = *(const LAS h8*)(lds + PG_SB(b, h) + boff + n * 2048 + k * 1024); } while (0)
#define PG_MMA(ai, bj, At, Bt) do { __builtin_amdgcn_s_setprio(1); _Pragma("unroll") for (int m = 0; m < 4; ++m) _Pragma("unroll") for (int n = 0; n < 2; ++n) _Pragma("unroll") for (int k = 0; k < 2; ++k) \
        acc[ai][bj][m][n] = __builtin_amdgcn_mfma_f32_16x16x32_f16(Bt[n][k], At[m][k], acc[ai][bj][m][n], 0, 0, 0); __builtin_amdgcn_s_setprio(0); } while (0)
#define PG_WAIT_V(n) asm volatile("s_waitcnt vmcnt(" #n ")" ::: "memory")
#define PG_WAIT_L(n) asm volatile("s_waitcnt lgkmcnt(" #n ")" ::: "memory")
#define PG_BAR __builtin_amdgcn_s_barrier()
#define PG_SCHED __builtin_amdgcn_sched_barrier(0)
    Unit cur, nxt; int ui = 0;
    if (!S.next(0, cur)) return;
    f32x4 acc[2][2][4][2];
#pragma unroll
    for (int a = 0; a < 2; ++a)
#pragma unroll
        for (int b = 0; b < 2; ++b)
#pragma unroll
            for (int m = 0; m < 4; ++m)
#pragma unroll
                for (int n = 0; n < 2; ++n) acc[a][b][m][n] = (f32x4){0.f, 0.f, 0.f, 0.f};
    h8 At[4][2], B0[2][2], B1[2][2];
    const char* cA = cur.A; const char* cB = cur.B;
    PG_STAGE(PG_SB(0, 0), cB, voffB); PG_STAGE(PG_SA(0, 0), cA, voffA); PG_STAGE(PG_SB(0, 1), cB + hstep, voffB); PG_STAGE(PG_SA(0, 1), cA + hstep, voffA);
    if (wr == 1) PG_BAR;
    PG_WAIT_V(4); PG_BAR;
    PG_STAGE(PG_SB(1, 0), cB + kstep, voffB); PG_STAGE(PG_SA(1, 0), cA + kstep, voffA); PG_STAGE(PG_SB(1, 1), cB + hstep + kstep, voffB);
    PG_WAIT_V(6); PG_BAR;
    for (;;) {
        const bool has_next = S.next(ui + 1, nxt);
        const char* nA = has_next ? nxt.A : cA; const char* nB = has_next ? nxt.B : cB;
        for (int t = 0; t < nt; t += 2) {
            const bool last = (t == nt - 2);
            const char* a1 = cA + (size_t)(t + 1) * kstep;
            const char* a2 = last ? nA : cA + (size_t)(t + 2) * kstep; const char* b2 = last ? nB : cB + (size_t)(t + 2) * kstep;
            const char* a3 = a2 + kstep; const char* b3 = b2 + kstep;
            PG_LDB(B0, 0, 0); PG_SCHED; PG_LDA(At, 0, 0); PG_STAGE(PG_SA(1, 1), a1 + hstep, voffA);
            PG_WAIT_L(8); PG_BAR; PG_WAIT_L(0); PG_MMA(0, 0, At, B0); PG_BAR; PG_SCHED;
            PG_LDB(B1, 0, 1); PG_STAGE(PG_SB(0, 0), b2, voffB);
            PG_BAR; PG_WAIT_L(0); PG_MMA(0, 1, At, B1); PG_BAR;
            PG_LDA(At, 0, 1); PG_STAGE(PG_SA(0, 0), a2, voffA);
            PG_BAR; PG_WAIT_L(0); PG_MMA(1, 0, At, B0); PG_BAR; PG_SCHED;
            PG_STAGE(PG_SB(0, 1), b2 + hstep, voffB);
            PG_WAIT_V(6); PG_BAR; PG_MMA(1, 1, At, B1); PG_BAR;
            PG_LDB(B0, 1, 0); PG_SCHED; PG_LDA(At, 1, 0); PG_STAGE(PG_SA(0, 1), a2 + hstep, voffA);
            PG_WAIT_L(8); PG_BAR; PG_WAIT_L(0); PG_MMA(0, 0, At, B0); PG_BAR; PG_SCHED;
            PG_LDB(B1, 1, 1); PG_STAGE(PG_SB(1, 0), b3, voffB);
            PG_BAR; PG_WAIT_L(0); PG_MMA(0, 1, At, B1); PG_BAR;
            PG_LDA(At, 1, 1); PG_STAGE(PG_SA(1, 0), a3, voffA);
            PG_BAR; PG_WAIT_L(0); PG_MMA(1, 0, At, B0); PG_BAR; PG_SCHED;
            PG_STAGE(PG_SB(1, 1), b3 + hstep, voffB);
            PG_WAIT_V(6); PG_BAR; PG_MMA(1, 1, At, B1); PG_BAR;
        }
        E(acc, cur, wr, wc, fr, fq);
        if (!has_next) break;
#pragma unroll
        for (int a = 0; a < 2; ++a)
#pragma unroll
            for (int b = 0; b < 2; ++b)
#pragma unroll
                for (int m = 0; m < 4; ++m)
#pragma unroll
                    for (int n = 0; n < 2; ++n) acc[a][b][m][n] = (f32x4){0.f, 0.f, 0.f, 0.f};
        cur = nxt; cA = nA; cB = nB; ++ui;
    }
    PG_WAIT_V(0);
    if (wr == 0) PG_BAR;
    PG_BAR;
#undef PG_SA
#undef PG_SB
#undef PG_STAGE
#undef PG_LDA
#undef PG_LDB
#undef PG_MMA
#undef PG_WAIT_V
#undef PG_WAIT_L
#undef PG_BAR
#undef PG_SCHED
}
}
__device__ __forceinline__ float fsig(float v) { return 1.f / (1.f + __expf(-v)); }
__device__ __forceinline__ float fsilu(float v) { return v / (1.f + __expf(-v)); }
__device__ __forceinline__ u32x4 pack8(const f32x4 a, const f32x4 b) {
    const h8 v = {(_Float16)a[0], (_Float16)a[1], (_Float16)a[2], (_Float16)a[3], (_Float16)b[0], (_Float16)b[1], (_Float16)b[2], (_Float16)b[3]};
    return __builtin_bit_cast(u32x4, v);
}
__device__ __forceinline__ void unpack8(const u32x4 w, float (&o)[8]) {
    const h8 v = __builtin_bit_cast(h8, w);
#pragma unroll
    for (int j = 0; j < 8; ++j) o[j] = (float)v[j];
}
struct SchedPlain {
    const char* A; const char* B; int nM, nN, G, c, K;
    __device__ bool next(int i, pg::Unit& u) const {
        const long L = (long)i * G + c; if (L >= (long)nM * nN) return false;
        pg::tile_of((int)L, nM, nN, u.pm, u.pn); u.aux = 0;
        u.A = A + (size_t)u.pm * 256 * K * 2; u.B = B + (size_t)u.pn * 256 * K * 2; return true;
    }
};
struct SchedMerge {
    const char* ys; const char* wb; int G, c;
    __device__ bool next(int i, pg::Unit& u) const {
        const int r = i / 3, n = i - 3 * r; const long L = (long)r * G + c; if (L >= 64 * 4) return false;
        pg::tile_of((int)L, 64, 4, u.pm, u.pn); u.aux = n;
        u.A = ys + ((size_t)n * T + (size_t)u.pm * 256) * W * 2; u.B = wb + ((size_t)n * D + (size_t)u.pn * 256) * W * 2; return true;
    }
};

template <int ACT> __device__ __forceinline__ f32x4 actv(f32x4 v) {
    if (ACT == 1) { for (int j = 0; j < 4; ++j) v[j] = fsilu(v[j]); }
    if (ACT == 2) { for (int j = 0; j < 4; ++j) v[j] = fsig(v[j]); }
    return v;
}
template <int ACT> __device__ __forceinline__ void st16(const f32x4 (&acc)[2][2][4][2], __half* base, int ld, int c8, int bj0, int bj1) {
#pragma unroll
    for (int ai = 0; ai < 2; ++ai)
#pragma unroll
        for (int m = 0; m < 4; ++m) {
            __half* rowp = base + (size_t)(ai * 128 + m * 16) * ld + c8;
#pragma unroll
            for (int bj = 0; bj < 2; ++bj) if (bj >= bj0 && bj < bj1)
                *(u32x4*)(rowp + (bj - bj0) * 128) = pack8(actv<ACT>(acc[ai][bj][m][0]), actv<ACT>(acc[ai][bj][m][1]));
        }
}
struct EpiProj {
    static constexpr bool PERM = true;
    __half *q16, *v16, *hgg16, *atq16, *atk16, *atv16, *atg16, *ixq16, *ixk16, *s5u16, *s5g16, *mg16; float *lf32, *ixw32; const float* lb;
    __device__ __forceinline__ void operator()(const f32x4 (&acc)[2][2][4][2], const pg::Unit& u, int wr, int wc, int fr, int fq) const {
        const size_t row0 = (size_t)u.pm * 256 + wr * 64 + fr; const int c8 = wc * 32 + 8 * fq, pn = u.pn;
        if (pn < 2)        st16<0>(acc, q16 + row0 * W + pn * 256, W, c8, 0, 2);
        else if (pn < 4) {
            const int cb = (pn - 2) * 256 + c8;
#pragma unroll
            for (int bj = 0; bj < 2; ++bj) {
                const f32x4 l0 = *(const f32x4*)(lb + cb + bj * 128), l1 = *(const f32x4*)(lb + cb + bj * 128 + 4);
#pragma unroll
                for (int ai = 0; ai < 2; ++ai)
#pragma unroll
                    for (int m = 0; m < 4; ++m) {
                        f32x4 a = acc[ai][bj][m][0], b = acc[ai][bj][m][1];
#pragma unroll
                        for (int j = 0; j < 4; ++j) { a[j] = __logf(fmaxf(l0[j] + (1.f - l0[j]) * fsig(a[j]), 1e-30f)); b[j] = __logf(fmaxf(l1[j] + (1.f - l1[j]) * fsig(b[j]), 1e-30f)); }
                        float* o = lf32 + (row0 + ai * 128 + m * 16) * W + cb + bj * 128;
                        *(f32x4*)o = a; *(f32x4*)(o + 4) = b;
                    }
            }
        }
        else if (pn < 6)   st16<0>(acc, v16 + row0 * W + (pn - 4) * 256, W, c8, 0, 2);
        else if (pn < 8)   st16<1>(acc, hgg16 + row0 * W + (pn - 6) * 256, W, c8, 0, 2);
        else if (pn < 10)  st16<0>(acc, atq16 + row0 * W + (pn - 8) * 256, W, c8, 0, 2);
        else if (pn == 10) { st16<0>(acc, atk16 + row0 * 128, 128, c8, 0, 1); st16<0>(acc, atv16 + row0 * 128, 128, c8, 1, 2); }
        else if (pn < 13)  st16<1>(acc, atg16 + row0 * W + (pn - 11) * 256, W, c8, 0, 2);
        else if (pn < 15)  st16<0>(acc, ixq16 + row0 * W + (pn - 13) * 256, W, c8, 0, 2);
        else if (pn == 15) {
            if (wc < 2) {
#pragma unroll
                for (int ai = 0; ai < 2; ++ai)
#pragma unroll
                    for (int m = 0; m < 4; ++m) *(u32x4*)(ixk16 + (row0 + ai * 128 + m * 16) * 64 + c8) = pack8(acc[ai][0][m][0], acc[ai][0][m][1]);
            } else if (wc == 2 && fq == 0) {
#pragma unroll
                for (int ai = 0; ai < 2; ++ai)
#pragma unroll
                    for (int m = 0; m < 4; ++m) { float* o = ixw32 + (row0 + ai * 128 + m * 16) * 8; *(f32x4*)o = acc[ai][0][m][0]; *(f32x4*)(o + 4) = acc[ai][0][m][1]; }
            }
        }
        else if (pn < 18)  st16<0>(acc, s5u16 + row0 * W + (pn - 16) * 256, W, c8, 0, 2);
        else if (pn < 20)  st16<1>(acc, s5g16 + row0 * W + (pn - 18) * 256, W, c8, 0, 2);
        else               st16<2>(acc, mg16 + row0 * 3072 + (pn - 20) * 256, 3072, c8, 0, 2);
    }
};
struct EpiGlu {
    static constexpr bool PERM = true;
    const __half* ypre16; const __half* s5g16; const float* bias; __half* yc; float* raw;
    __device__ __forceinline__ void operator()(const f32x4 (&acc)[2][2][4][2], const pg::Unit& u, int wr, int wc, int fr, int fq) const {
        const size_t row0 = (size_t)u.pm * 256 + wr * 64 + fr; const int c0 = u.pn * 256 + wc * 32 + 8 * fq;
#pragma unroll
        for (int bj = 0; bj < 2; ++bj) {
            const int col = c0 + bj * 128;
            const f32x4 b0 = *(const f32x4*)(bias + col), b1 = *(const f32x4*)(bias + col + 4);
#pragma unroll
            for (int ai = 0; ai < 2; ++ai)
#pragma unroll
                for (int m = 0; m < 4; ++m) {
                    const size_t off = (row0 + ai * 128 + m * 16) * W + col;
                    float y[8], g[8]; unpack8(*(const u32x4*)(ypre16 + off), y); unpack8(*(const u32x4*)(s5g16 + off), g);
                    f32x4 a = acc[ai][bj][m][0] + b0, b = acc[ai][bj][m][1] + b1;
                    if (raw) { *(f32x4*)(raw + (row0 + ai * 128 + m * 16) * D + col) = acc[ai][bj][m][0]; *(f32x4*)(raw + (row0 + ai * 128 + m * 16) * D + col + 4) = acc[ai][bj][m][1]; }
#pragma unroll
                    for (int j = 0; j < 4; ++j) { a[j] = y[j] * fsig(a[j]) * g[j]; b[j] = y[4 + j] * fsig(b[j]) * g[4 + j]; }
                    *(u32x4*)(yc + off) = pack8(a, b);
                }
        }
    }
};
struct EpiMerge {
    static constexpr bool PERM = true;
    const __half* mg16; float* mp32; __half* merged16;
    __device__ __forceinline__ void operator()(const f32x4 (&acc)[2][2][4][2], const pg::Unit& u, int wr, int wc, int fr, int fq) const {
        const size_t row0 = (size_t)u.pm * 256 + wr * 64 + fr; const int c0 = u.pn * 256 + wc * 32 + 8 * fq, n = u.aux;
#pragma unroll
        for (int ai = 0; ai < 2; ++ai)
#pragma unroll
            for (int m = 0; m < 4; ++m)
#pragma unroll
                for (int bj = 0; bj < 2; ++bj) {
                    const size_t r = row0 + ai * 128 + m * 16; const int col = c0 + bj * 128;
                    float g[8]; unpack8(*(const u32x4*)(mg16 + r * 3072 + n * D + col), g);
                    f32x4 a = acc[ai][bj][m][0], b = acc[ai][bj][m][1];
#pragma unroll
                    for (int j = 0; j < 4; ++j) { a[j] *= g[j]; b[j] *= g[4 + j]; }
                    float* pp = mp32 + r * D + col;
                    if (n > 0) { a += *(const f32x4*)pp; b += *(const f32x4*)(pp + 4); }
                    if (n < 2) { *(f32x4*)pp = a; *(f32x4*)(pp + 4) = b; }
                    else *(u32x4*)(merged16 + r * D + col) = pack8(a, b);
                }
    }
};
struct EpiOut {
    static constexpr bool PERM = false;
    const float* xin; float* out; const float* gate;
    __device__ __forceinline__ void operator()(const f32x4 (&acc)[2][2][4][2], const pg::Unit& u, int wr, int wc, int fr, int fq) const {
        const size_t row0 = (size_t)u.pm * 256 + wr * 64 + fr; const int c0 = u.pn * 256 + wc * 32 + 4 * fq;
        const int b = (u.pm * 256) / S;
#pragma unroll
        for (int bj = 0; bj < 2; ++bj)
#pragma unroll
            for (int n = 0; n < 2; ++n) {
                const int col = c0 + bj * 128 + n * 16;
                const f32x4 gv = *(const f32x4*)(gate + (size_t)b * 3072 + col);
#pragma unroll
                for (int ai = 0; ai < 2; ++ai)
#pragma unroll
                    for (int m = 0; m < 4; ++m) {
                        const size_t off = (row0 + ai * 128 + m * 16) * D + col;
                        *(f32x4*)(out + off) = *(const f32x4*)(xin + off) + gv * acc[ai][bj][m][n];
                    }
            }
    }
};
__device__ void phase_fix(const Params& p, int l) {
    const int w = tidx() >> 6, lane = tidx() & 63;
    for (int t = blockIdx.x * 8 + w; t < T; t += gridDim.x * 8) {
        const float cA = p.ropeA[((size_t)t * 64 + lane) * 2], sA = p.ropeA[((size_t)t * 64 + lane) * 2 + 1];
        for (int hh = 0; hh < 5; ++hh) {
            __half* q = hh < 4 ? p.atq16 + (size_t)t * W + hh * 128 : p.atk16 + (size_t)t * 128;
            const float* g = hh < 4 ? p.qn_g + l * 128 : p.kn_g + l * 128;
            const float x1 = __half2float(q[lane]), x2 = __half2float(q[64 + lane]);
            const float ss = wave_sum(x1 * x1 + x2 * x2);
            const float r = rsqrtf(ss * (1.f / 128.f) + EPS);
            const float a = x1 * r * g[lane], b2 = x2 * r * g[64 + lane];
            q[lane] = __float2half(a * cA - b2 * sA); q[64 + lane] = __float2half(b2 * cA + a * sA);
        }
        for (int i = 0; i < 5; ++i) {
            const int idx = lane + 64 * i;
            if (i == 4 && lane >= 32) break;
            const int hh = idx >> 5, j = idx & 31;
            __half* q = i < 4 ? p.ixq16 + (size_t)t * W + hh * 64 : p.ixk16 + (size_t)t * 64;
            const float cI = p.ropeI[((size_t)t * 32 + j) * 2], sI = p.ropeI[((size_t)t * 32 + j) * 2 + 1];
            const float x1 = __half2float(q[j]), x2 = __half2float(q[32 + j]);
            q[j] = __float2half(x1 * cI - x2 * sI); q[32 + j] = __float2half(x2 * cI + x1 * sI);
        }
    }
}

__device__ void mixA(const Params& p, int l, int item, float* lds) {
    const int b = item >> 2, hd = item & 3;
    float* qs = lds; float* fs = qs + 32 * 128; float* ks = fs + 32 * 128; float* vs = ks + 32 * 128; float* op = vs + 32 * 128;
    const int tid = tidx(), e = tid & 127, dq = tid >> 7, w = tid >> 6, lane = tid & 63;
    float St[32];
#pragma unroll
    for (int i = 0; i < 32; ++i) St[i] = 0.f;
    const float* on = p.onorm_g + l * 128;
    __half* ya = p.ys;
    for (int c0 = 0; c0 < S; c0 += 32) {
        for (int i = tid; i < 32 * 128; i += 512) {
            const int tt = i >> 7, d = i & 127; const size_t o = (size_t)(b * S + c0 + tt) * W + hd * 128 + d;
            const float f = __expf(p.lf32[o]);
            qs[i] = __half2float(p.q16[o]); fs[i] = f; ks[i] = 1.f - f; vs[i] = __half2float(p.v16[o]);
        }
        __syncthreads();
#pragma unroll 1
        for (int tt = 0; tt < 32; ++tt) {
            const float ve = vs[tt * 128 + e]; float part = 0.f;
            const float4* f4 = (const float4*)(fs + tt * 128 + dq * 32); const float4* k4 = (const float4*)(ks + tt * 128 + dq * 32); const float4* q4 = (const float4*)(qs + tt * 128 + dq * 32);
#pragma unroll
            for (int j = 0; j < 8; ++j) {
                const float4 f = f4[j], k = k4[j], q = q4[j];
                St[4 * j + 0] = f.x * St[4 * j + 0] + k.x * ve; part += q.x * St[4 * j + 0];
                St[4 * j + 1] = f.y * St[4 * j + 1] + k.y * ve; part += q.y * St[4 * j + 1];
                St[4 * j + 2] = f.z * St[4 * j + 2] + k.z * ve; part += q.z * St[4 * j + 2];
                St[4 * j + 3] = f.w * St[4 * j + 3] + k.w * ve; part += q.w * St[4 * j + 3];
            }
            op[(tt * 4 + dq) * 128 + e] = part;
        }
        __syncthreads();
        for (int i = 0; i < 4; ++i) {
            const int tt = w * 4 + i;
            float o0 = 0.f, o1 = 0.f;
#pragma unroll
            for (int q = 0; q < 4; ++q) { o0 += op[(tt * 4 + q) * 128 + lane]; o1 += op[(tt * 4 + q) * 128 + 64 + lane]; }
            const float ss = wave_sum(o0 * o0 + o1 * o1);
            const float r = rsqrtf(ss * (1.f / 128.f) + EPS);
            const size_t o = (size_t)(b * S + c0 + tt) * W + hd * 128;
            ya[o + lane] = __float2half(o0 * r * on[lane] * __half2float(p.hgg16[o + lane]));
            ya[o + 64 + lane] = __float2half(o1 * r * on[64 + lane] * __half2float(p.hgg16[o + 64 + lane]));
        }
        __syncthreads();
    }
}

__device__ void mixC(const Params& p, int l, int item, float* lds) {
    const int w = tidx() >> 6, lane = tidx() & 63;
    const int idx = item * 8 + w, b = idx >> 5, g = idx & 31;
    float* wl = lds + w * 3328;
    float* cre = wl; float* cim = cre + 16 * 65; float* xrs = cim + 16 * 65; float* xis = xrs + 512; float* us = xis + 512;
    const size_t lg = (size_t)l * 32 + g;
    const float abr = p.abar[(lg * 64 + lane) * 2], abi = p.abar[(lg * 64 + lane) * 2 + 1];
    float bre[16], bim[16];
#pragma unroll
    for (int c = 0; c < 16; ++c) { bre[c] = p.bbar[((lg * 64 + lane) * 16 + c) * 2]; bim[c] = p.bbar[((lg * 64 + lane) * 16 + c) * 2 + 1]; }
    for (int c = 0; c < 16; ++c) { cre[c * 65 + lane] = p.c_re[(lg * 16 + c) * 64 + lane]; cim[c * 65 + lane] = p.c_im[(lg * 16 + c) * 64 + lane]; }
    float xr = 0.f, xi = 0.f;
    for (int t0 = 0; t0 < S; t0 += 8) {
#pragma unroll
        for (int i = 0; i < 2; ++i) { const int q = lane + 64 * i; us[q] = __half2float(p.s5u16[(size_t)(b * S + t0 + (q >> 4)) * W + g * 16 + (q & 15)]); }
        __syncthreads();
#pragma unroll 1
        for (int tt = 0; tt < 8; ++tt) {
            float bur = 0.f, bui = 0.f;
#pragma unroll
            for (int c = 0; c < 16; ++c) { const float u = us[tt * 16 + c]; bur += u * bre[c]; bui += u * bim[c]; }
            const float nxr = abr * xr - abi * xi + bur, nxi = abr * xi + abi * xr + bui;
            xr = nxr; xi = nxi;
            xrs[tt * 64 + lane] = xr; xis[tt * 64 + lane] = xi;
        }
        __syncthreads();
#pragma unroll
        for (int i = 0; i < 2; ++i) {
            const int q = lane + 64 * i, tt = q >> 4, c = q & 15;
            float y = 0.f;
#pragma unroll 8
            for (int s = 0; s < 64; ++s) y += cre[c * 65 + s] * xrs[tt * 64 + s] - cim[c * 65 + s] * xis[tt * 64 + s];
            y += p.s5_d[l * W + g * 16 + c] * us[q];
            p.ypre16[(size_t)(b * S + t0 + tt) * W + g * 16 + c] = __float2half(gelu_tanh_f(y));
        }
        __syncthreads();
    }
}
__device__ __forceinline__ unsigned f2key(float f) { const unsigned u = __float_as_uint(f); return (u & 0x80000000u) ? ~u : (u | 0x80000000u); }
__device__ void mixB(const Params& p, int l, int item, float* lds) {
    const int w = tidx() >> 6, lane = tidx() & 63;
    const int t = item * 8 + w, b = t / S, qi = t % S;
    float* wl = lds + w * 2816;
    float* scl = wl; float* iql = scl + 2048; int* sidx = (int*)(iql + 512);
    for (int i = 0; i < 8; ++i) iql[lane + 64 * i] = __half2float(p.ixq16[(size_t)t * W + lane + 64 * i]);
    float iw[8];
#pragma unroll
    for (int hh = 0; hh < 8; ++hh) iw[hh] = p.ixw32[(size_t)t * 8 + hh];
    lds_fence();
    const int iend = qi / 64 + 1;
#pragma unroll 1
    for (int i = 0; i < 32; ++i) {
        const int s = lane + 64 * i;
        float sc = -INFINITY;
        if (i < iend && s <= qi) {
            const u32x4* kp = (const u32x4*)(p.ixk16 + (size_t)(b * S + s) * 64);
            float d[8];
#pragma unroll
            for (int hh = 0; hh < 8; ++hh) d[hh] = 0.f;
#pragma unroll 2
            for (int j = 0; j < 8; ++j) {
                float kv[8]; unpack8(kp[j], kv);
#pragma unroll
                for (int hh = 0; hh < 8; ++hh) {
                    const float4 qa = *(const float4*)(iql + hh * 64 + j * 8), qb = *(const float4*)(iql + hh * 64 + j * 8 + 4);
                    d[hh] += qa.x * kv[0] + qa.y * kv[1] + qa.z * kv[2] + qa.w * kv[3] + qb.x * kv[4] + qb.y * kv[5] + qb.z * kv[6] + qb.w * kv[7];
                }
            }
            sc = 0.f;
#pragma unroll
            for (int hh = 0; hh < 8; ++hh) sc += fmaxf(d[hh], 0.f) * iw[hh];
        }
        scl[s] = sc;
    }
    lds_fence();
    const int n = qi + 1;
    const bool all = n <= 256;
    unsigned thr = 0; int rrem = 0;
    if (!all) {
        unsigned key[32];
#pragma unroll
        for (int i = 0; i < 32; ++i) key[i] = f2key(scl[lane + 64 * i]);
        unsigned prefix = 0;
#pragma unroll 1
        for (int bit = 31; bit >= 0; --bit) {
            const unsigned cand = prefix | (1u << bit);
            int c = 0;
#pragma unroll
            for (int i = 0; i < 32; ++i) c += (key[i] >= cand) ? 1 : 0;
#pragma unroll
            for (int o = 32; o > 0; o >>= 1) c += __shfl_xor(c, o);
            if (c >= 256) prefix = cand;
        }
        int c = 0;
#pragma unroll
        for (int i = 0; i < 32; ++i) c += (key[i] > prefix) ? 1 : 0;
#pragma unroll
        for (int o = 32; o > 0; o >>= 1) c += __shfl_xor(c, o);
        thr = prefix; rrem = 256 - c;
    }
    int cnt = 0;
    {
        const unsigned long long lt = (1ull << lane) - 1ull;
#pragma unroll 1
        for (int i = 0; i < 32; ++i) {
            const int s = lane + 64 * i;
            const unsigned k = f2key(scl[s]);
            bool sl;
            if (all) sl = s <= qi;
            else {
                const bool eq = k == thr;
                const unsigned long long m = __ballot(eq);
                sl = (k > thr) || (eq && __popcll(m & lt) < rrem);
                rrem -= __popcll(m); if (rrem < 0) rrem = 0;
            }
            const unsigned long long m2 = __ballot(sl);
            if (sl) sidx[cnt + __popcll(m2 & lt)] = s;
            cnt += __popcll(m2);
        }
    }
    lds_fence();
    float qv[4][2];
#pragma unroll
    for (int hh = 0; hh < 4; ++hh) { qv[hh][0] = __half2float(p.atq16[(size_t)t * W + hh * 128 + lane]); qv[hh][1] = __half2float(p.atq16[(size_t)t * W + hh * 128 + 64 + lane]); }
    float mx[4], ls[4], a0[4], a1[4];
#pragma unroll
    for (int hh = 0; hh < 4; ++hh) { mx[hh] = -INFINITY; ls[hh] = 0.f; a0[hh] = 0.f; a1[hh] = 0.f; }
    const float scale = 0.08838834764831845f;
#pragma unroll 2
    for (int j = 0; j < cnt; ++j) {
        const int s = sidx[j];
        const size_t kr = (size_t)(b * S + s) * 128;
        const float k0 = __half2float(p.atk16[kr + lane]), k1 = __half2float(p.atk16[kr + 64 + lane]), v0 = __half2float(p.atv16[kr + lane]), v1 = __half2float(p.atv16[kr + 64 + lane]);
#pragma unroll
        for (int hh = 0; hh < 4; ++hh) {
            const float lg = wave_sum(qv[hh][0] * k0 + qv[hh][1] * k1) * scale;
            const float mn = fmaxf(mx[hh], lg);
            const float cs = expf(mx[hh] - mn), pe = expf(lg - mn);
            ls[hh] = ls[hh] * cs + pe; a0[hh] = a0[hh] * cs + pe * v0; a1[hh] = a1[hh] * cs + pe * v1; mx[hh] = mn;
        }
    }
    __half* yb = p.ys + (size_t)T * W;
#pragma unroll
    for (int hh = 0; hh < 4; ++hh) {
        const float g0 = __half2float(p.atg16[(size_t)t * W + hh * 128 + lane]), g1 = __half2float(p.atg16[(size_t)t * W + hh * 128 + 64 + lane]);
        yb[(size_t)t * W + hh * 128 + lane] = __float2half(a0[hh] / ls[hh] * g0);
        yb[(size_t)t * W + hh * 128 + 64 + lane] = __float2half(a1[hh] / ls[hh] * g1);
    }
}

__device__ void phase_mix(const Params& p, int l, float* lds) {
    constexpr int NA = 32, NC = 32, NBQ = T / 8;
    for (int item = blockIdx.x; item < NA + NC + NBQ; item += gridDim.x) {
        if (item < NA) mixA(p, l, item, lds);
        else if (item < NA + NC) mixC(p, l, item - NA, lds);
        else mixB(p, l, item - NA - NC, lds);
        __syncthreads();
    }
}

typedef const __attribute__((address_space(4))) Params* KParams;
#define PHASE_PARAMS() KParams _kp = (KParams)__builtin_amdgcn_kernarg_segment_ptr(); asm volatile("" : "+s"(_kp)); const Params& p = *(const Params*)_kp
__global__ void __launch_bounds__(512, 2) mega(Params p_unused) {
    extern __shared__ __attribute__((aligned(16))) float lds[];
    LAS unsigned char* ldsb = (LAS unsigned char*)lds;
    cg::grid_group grid = cg::this_grid();
    const int G = gridDim.x, c = blockIdx.x;
    { PHASE_PARAMS(); phase0(p); phase0_conv(p, lds); }
    grid.sync();
    for (int l = 0; l < NL; ++l) {
        { PHASE_PARAMS(); phase_h(p, l); }
        grid.sync();
        {
            PHASE_PARAMS();
            SchedPlain sc{(const char*)p.h16, (const char*)(p.win16 + (size_t)l * NPK * D), 64, 32, G, c, D};
            EpiProj ep{p.q16, p.v16, p.hgg16, p.atq16, p.atk16, p.atv16, p.atg16, p.ixq16, p.ixk16, p.s5u16, p.s5g16, p.mg16, p.lf32, p.ixw32, p.lb + l * 512};
            pg::gemm_phase(ldsb, D, sc, ep);
        }
        grid.sync();
        { PHASE_PARAMS(); phase_fix(p, l); }
        grid.sync();
        { PHASE_PARAMS(); phase_mix(p, l, lds); }
        grid.sync();
        {
            PHASE_PARAMS();
            SchedPlain sc{(const char*)p.ypre16, (const char*)(p.wglu16 + (size_t)l * W * W), 64, 2, G, c, W};
            EpiGlu ep{p.ypre16, p.s5g16, p.glu_b + l * W, p.ys + (size_t)2 * T * W, nullptr};
            pg::gemm_phase(ldsb, W, sc, ep);
        }
        grid.sync();
        {
            PHASE_PARAMS();
            SchedMerge sc{(const char*)p.ys, (const char*)(p.wb16 + (size_t)l * 3 * D * W), G, c};
            EpiMerge ep{p.mg16, p.mp32, p.merged16};
            pg::gemm_phase(ldsb, W, sc, ep);
        }
        grid.sync();
        {
            PHASE_PARAMS();
            SchedPlain sc{(const char*)p.merged16, (const char*)(p.wo16 + (size_t)l * D * D), 64, 4, G, c, D};
            EpiOut ep{l == 0 ? p.x : p.out, p.out, p.mod + (size_t)l * NB * 3072 + 2 * D};
            pg::gemm_phase(ldsb, D, sc, ep);
        }
        grid.sync();
    }
}

extern "C" void kernel_launch(void* const* d_in, const int* in_sizes, int n_in,
                              void* d_out, int out_size, void* d_ws, size_t ws_size,
                              hipStream_t stream) {
    static int grid_blocks = 0;
    if (!grid_blocks) {
        int dev = 0, cus = 0, per_cu = 0;
        (void)hipGetDevice(&dev);
        (void)hipDeviceGetAttribute(&cus, hipDeviceAttributeMultiprocessorCount, dev);
        (void)hipFuncSetAttribute((const void*)mega, hipFuncAttributeMaxDynamicSharedMemorySize, LDS_BYTES);
        (void)hipOccupancyMaxActiveBlocksPerMultiprocessor(&per_cu, mega, 512, LDS_BYTES);
        if (per_cu > 1) per_cu = 1;
        grid_blocks = cus * per_cu;
    }
    Params p{};
    const float* const* in = (const float* const*)d_in;
    p.x = in[0]; p.c = in[1]; p.pos = (const int*)d_in[2];
    p.ada_w = in[3]; p.ada_b = in[4]; p.norm_g = in[5]; p.w_in = in[6]; p.lb_logits = in[7]; p.onorm_g = in[8]; p.qn_g = in[9]; p.kn_g = in[10];
    p.a_re = in[11]; p.a_im = in[12]; p.log_dt = in[13]; p.b_re = in[14]; p.b_im = in[15]; p.c_re = in[16]; p.c_im = in[17]; p.s5_d = in[18];
    p.glu_w = in[19]; p.glu_b = in[20]; p.w_branch = in[21]; p.w_out = in[22];
    p.out = (float*)d_out;
    char* ws = (char*)d_ws; size_t off = 0;
    auto take = [&](size_t bytes) { char* q = ws + off; off += (bytes + 255) & ~(size_t)255; return q; };
    const size_t TW2 = (size_t)T * W * 2;
    p.mod = (float*)take((size_t)NL * NB * 3072 * 4);
    p.lb = (float*)take((size_t)NL * 512 * 4);
    p.abar = (float*)take((size_t)NL * 32 * 64 * 2 * 4);
    p.bbar = (float*)take((size_t)NL * 32 * 64 * 16 * 2 * 4);
    p.ropeA = (float*)take((size_t)T * 64 * 2 * 4);
    p.ropeI = (float*)take((size_t)T * 32 * 2 * 4);
    p.win16 = (__half*)take((size_t)NL * NPK * D * 2);
    p.wb16 = (__half*)take((size_t)NL * 3 * D * W * 2);
    p.wo16 = (__half*)take((size_t)NL * D * D * 2);
    p.wglu16 = (__half*)take((size_t)NL * W * W * 2);
    p.h16 = (__half*)take((size_t)T * D * 2);       p.merged16 = p.h16;
    p.q16 = (__half*)take(TW2);                     p.mp32 = (float*)p.q16;
    p.lf32 = (float*)take((size_t)T * W * 4);
    p.v16 = (__half*)take(TW2);
    p.hgg16 = (__half*)take(TW2);
    p.atq16 = (__half*)take(TW2);
    p.atk16 = (__half*)take((size_t)T * 128 * 2);
    p.atv16 = (__half*)take((size_t)T * 128 * 2);
    p.atg16 = (__half*)take(TW2);
    p.ixq16 = (__half*)take(TW2);
    p.ixk16 = (__half*)take((size_t)T * 64 * 2);
    p.ixw32 = (float*)take((size_t)T * 8 * 4);
    p.s5u16 = (__half*)take(TW2);
    p.s5g16 = (__half*)take(TW2);
    p.mg16 = (__half*)take((size_t)T * 3072 * 2);
    p.ys = (__half*)take(3 * TW2);
    p.ypre16 = (__half*)take(TW2);
    p.dbg = (unsigned*)take(256);
    if (off > ws_size) { fprintf(stderr, "workspace too small: need %zu have %zu\n", off, ws_size); return; }
    void* args[] = {&p};
    hipError_t e = hipLaunchCooperativeKernel((void*)mega, dim3(grid_blocks), dim3(512), args, LDS_BYTES, stream);
    if (e != hipSuccess) fprintf(stderr, "cooperative launch failed: %s (grid %d)\n", hipGetErrorString(e), grid_blocks);
}
```

```cpp
#include <hip/hip_runtime.h>
#include <hip/hip_cooperative_groups.h>
#include <hip/hip_fp16.h>
#include <cstdio>
namespace cg = cooperative_groups;

constexpr int D = 1024, NB = 8, S = 2048, T = NB * S, NL = 4, W = 512, NIN = 8008, NPK = 8192;
constexpr int C_S5U = 3912, C_MG = 4936;
constexpr float EPS = 1e-6f;
constexpr int LDS_BYTES = 135168;
#define LAS __attribute__((address_space(3)))
typedef _Float16 h8 __attribute__((ext_vector_type(8)));
typedef _Float16 h2 __attribute__((ext_vector_type(2)));
typedef float f32x4 __attribute__((ext_vector_type(4)));
typedef unsigned u32x4 __attribute__((ext_vector_type(4)));

struct Params {
    const float *x, *c; const int* pos;
    const float *ada_w, *ada_b, *norm_g, *w_in, *lb_logits, *onorm_g, *qn_g, *kn_g;
    const float *a_re, *a_im, *log_dt, *b_re, *b_im, *c_re, *c_im, *s5_d, *glu_w, *glu_b, *w_branch, *w_out;
    float* out;
    float *mod, *lb, *abar, *bbar, *ropeA, *ropeI;
    __half *win16, *wb16, *wo16, *wglu16;
    __half *h16, *q16, *v16, *hgg16, *atq16, *atk16, *atv16, *atg16, *ixq16, *ixk16, *s5u16, *s5g16, *mg16, *ys, *ypre16, *merged16;
    float *lf32, *ixw32, *mp32; unsigned* dbg; unsigned* mask; __half* atvT16;
};

__device__ __forceinline__ float sigmoid_f(float v) { return 1.f / (1.f + expf(-v)); }
__device__ __forceinline__ float silu_f(float v) { return v / (1.f + expf(-v)); }
__device__ __forceinline__ float gelu_tanh_f(float v) { return 0.5f * v * (1.f + tanhf(0.7978845608028654f * (v + 0.044715f * v * v * v))); }
__device__ __forceinline__ float wave_sum(float v) {
#pragma unroll
    for (int o = 32; o > 0; o >>= 1) v += __shfl_xor(v, o);
    return v;
}
__device__ __forceinline__ void lds_fence() { asm volatile("s_waitcnt lgkmcnt(0)" ::: "memory"); }
__device__ __forceinline__ int tidx() { int t = threadIdx.x; asm volatile("" : "+v"(t)); return t; }

__device__ void phase0(const Params& p) {
    const size_t gtid = (size_t)blockIdx.x * blockDim.x + tidx(), nth = (size_t)gridDim.x * blockDim.x;
    for (size_t i = gtid; i < (size_t)NL * NB * 3072; i += nth) {
        const int col = (int)(i % 3072), b = (int)((i / 3072) % NB), l = (int)(i / (3072 * NB));
        const float* w = p.ada_w + (size_t)l * 1024 * 3072 + col;
        const float* cc = p.c + b * 1024;
        float acc = p.ada_b[l * 3072 + col];
        for (int k = 0; k < 1024; ++k) { const float cv = cc[k]; acc += silu_f(cv) * w[(size_t)k * 3072]; }
        p.mod[i] = acc;
    }
    for (size_t i = gtid; i < 512; i += nth) {
        float lg[NL], mx = -1e30f;
#pragma unroll
        for (int l = 0; l < NL; ++l) { lg[l] = p.lb_logits[l * 512 + i]; mx = fmaxf(mx, lg[l]); }
        float s = 0.f;
#pragma unroll
        for (int l = 0; l < NL; ++l) { lg[l] = expf(lg[l] - mx); s += lg[l]; }
        float cum = 0.f;
#pragma unroll
        for (int l = 0; l < NL; ++l) { const float pr = lg[l] / s; cum += pr; p.lb[l * 512 + i] = cum - lg[0] / s; }
    }
    for (size_t i = gtid; i < (size_t)NL * 32 * 64; i += nth) {
        const int lg = (int)(i / 64);
        const double dt = exp((double)p.log_dt[lg]);
        const double are = p.a_re[i], aim = p.a_im[i];
        const double mag = exp(are * dt), ang = aim * dt;
        const double abr = mag * cos(ang), abi = mag * sin(ang);
        const double nr = abr - 1.0, ni = abi, den = are * are + aim * aim;
        const double fr = (nr * are + ni * aim) / den, fi = (ni * are - nr * aim) / den;
        p.abar[i * 2] = (float)abr; p.abar[i * 2 + 1] = (float)abi;
        for (int c = 0; c < 16; ++c) {
            const double br = p.b_re[i * 16 + c], bi = p.b_im[i * 16 + c];
            p.bbar[(i * 16 + c) * 2] = (float)(fr * br - fi * bi);
            p.bbar[(i * 16 + c) * 2 + 1] = (float)(fr * bi + fi * br);
        }
    }
    for (size_t i = gtid; i < (size_t)T * 64; i += nth) {
        const int t = (int)(i / 64), j = (int)(i % 64);
        const double inv = pow(10000.0, -(double)(2 * j) / 128.0);
        const double ang = (double)p.pos[t] * inv;
        p.ropeA[i * 2] = (float)cos(ang); p.ropeA[i * 2 + 1] = (float)sin(ang);
    }
    for (size_t i = gtid; i < (size_t)T * 32; i += nth) {
        const int t = (int)(i / 32), j = (int)(i % 32);
        const double inv = pow(10000.0, -(double)(2 * j) / 64.0);
        const double ang = (double)p.pos[t] * inv;
        p.ropeI[i * 2] = (float)cos(ang); p.ropeI[i * 2 + 1] = (float)sin(ang);
    }
}

__device__ __forceinline__ unsigned pk2(float a, float b) { h2 v = {(_Float16)a, (_Float16)b}; return __builtin_bit_cast(unsigned, v); }
__device__ void phase_h(const Params& p, int l) {
    const float* xin = l == 0 ? p.x : p.out;
    const int w = tidx() >> 6, lane = tidx() & 63;
    for (int row = blockIdx.x * 8 + w; row < T; row += gridDim.x * 8) {
        const int b = row / S;
        const float* xr = xin + (size_t)row * D;
        float4 v[4]; float ss = 0.f;
#pragma unroll
        for (int i = 0; i < 4; ++i) { v[i] = *(const float4*)(xr + i * 256 + lane * 4); ss += v[i].x * v[i].x + v[i].y * v[i].y + v[i].z * v[i].z + v[i].w * v[i].w; }
        ss = wave_sum(ss);
        const float r = rsqrtf(ss * (1.f / D) + EPS);
        const float* md = p.mod + ((size_t)l * NB + b) * 3072;
#pragma unroll
        for (int i = 0; i < 4; ++i) {
            const int k = i * 256 + lane * 4;
            const float4 g = *(const float4*)(p.norm_g + l * D + k), sh = *(const float4*)(md + k), sc = *(const float4*)(md + D + k);
            uint2 o;
            o.x = pk2(v[i].x * r * g.x * (1.f + sc.x) + sh.x, v[i].y * r * g.y * (1.f + sc.y) + sh.y);
            o.y = pk2(v[i].z * r * g.z * (1.f + sc.z) + sh.z, v[i].w * r * g.w * (1.f + sc.w) + sh.w);
            *(uint2*)(p.h16 + (size_t)row * D + k) = o;
        }
    }
}
template <class CM>
__device__ void conv_transpose(const float* __restrict__ src, int ldsrc, int K, __half* __restrict__ dst, int N, CM colmap, float* lds, int part, int nparts) {
    float (*ts)[65] = (float (*)[65])lds;
    const int tid = tidx(), nkt = K / 64, nnt = N / 64;
    for (int tile = part; tile < nkt * nnt; tile += nparts) {
        const int kt = tile % nkt, nt = tile / nkt, k0 = kt * 64, n0 = nt * 64;
        __syncthreads();
#pragma unroll
        for (int i = 0; i < 8; ++i) {
            const int idx = tid + 512 * i, k = idx >> 6, n = idx & 63;
            const int sc = colmap(n0 + n);
            ts[k][n] = sc >= 0 ? src[(size_t)(k0 + k) * ldsrc + sc] : 0.f;
        }
        __syncthreads();
        const int n = tid >> 3, k8 = (tid & 7) * 8;
        u32x4 w;
        { h2 a = {(_Float16)ts[k8 + 0][n], (_Float16)ts[k8 + 1][n]}; w.x = __builtin_bit_cast(unsigned, a); }
        { h2 a = {(_Float16)ts[k8 + 2][n], (_Float16)ts[k8 + 3][n]}; w.y = __builtin_bit_cast(unsigned, a); }
        { h2 a = {(_Float16)ts[k8 + 4][n], (_Float16)ts[k8 + 5][n]}; w.z = __builtin_bit_cast(unsigned, a); }
        { h2 a = {(_Float16)ts[k8 + 6][n], (_Float16)ts[k8 + 7][n]}; w.w = __builtin_bit_cast(unsigned, a); }
        *(u32x4*)(dst + (size_t)(n0 + n) * K + k0 + k8) = w;
    }
}
struct CmIdent { __device__ int operator()(int n) const { return n; } };
struct CmWin { __device__ int operator()(int n) const { return n < C_S5U ? n : (n < 4096 ? -1 : n - 184); } };

__device__ void phase0_conv(const Params& p, float* lds) {
    for (int l = 0; l < NL; ++l) {
        conv_transpose(p.w_in + (size_t)l * D * NIN, NIN, D, p.win16 + (size_t)l * NPK * D, NPK, CmWin(), lds, blockIdx.x, gridDim.x);
        for (int n = 0; n < 3; ++n)
            conv_transpose(p.w_branch + ((size_t)l * 3 + n) * W * D, D, W, p.wb16 + ((size_t)l * 3 + n) * D * W, D, CmIdent(), lds, blockIdx.x, gridDim.x);
        conv_transpose(p.w_out + (size_t)l * D * D, D, D, p.wo16 + (size_t)l * D * D, D, CmIdent(), lds, blockIdx.x, gridDim.x);
        conv_transpose(p.glu_w + (size_t)l * W * W, W, W, p.wglu16 + (size_t)l * W * W, W, CmIdent(), lds, blockIdx.x, gridDim.x);
    }
}
namespace pg {
constexpr int BM = 256, BK = 64, HALF = 128, HTB = HALF * BK * 2, STAGE_BYTES = 8 * HTB, NXCD = 8, WGM = 8;
__device__ __forceinline__ int lds_byte(int r, int c) { const int st = (r >> 4) * 2 + (c >> 5), rr = r & 15, cc = c & 31, ob = rr * 64 + cc * 2; return st * 1024 + (ob ^ (((ob >> 9) & 1) << 5)); }
__device__ __forceinline__ void stage_rc(int b, int& R, int& C) { const int st = b / 1024, sb = b % 1024, swz = sb ^ (((sb >> 9) & 1) << 5); R = (st >> 1) * 16 + swz / 64; C = (st & 1) * 32 + (swz % 64) / 2; }
__device__ __forceinline__ int perm32(int rho) { const int n = rho >> 4, i = rho & 15; return 8 * (i >> 2) + 4 * n + (i & 3); }
struct Unit { int pm, pn, aux; const char* A; const char* B; };
__device__ __forceinline__ void tile_of(int L, int nM, int nN, int& pm, int& pn) {
    const int nwg = nM * nN; int wgid = L;
    { const int q = nwg / NXCD, r = nwg % NXCD, xcd = wgid % NXCD, off = wgid / NXCD; wgid = (xcd < r ? xcd * (q + 1) : r * (q + 1) + (xcd - r) * q) + off; }
    const int nig = WGM * nN, gid = wgid / nig, fm = gid * WGM, gsz = (nM - fm) < WGM ? (nM - fm) : WGM;
    pm = fm + ((wgid % nig) % gsz); pn = (wgid % nig) / gsz;
}
template <class Epi, class Sched>
__device__ __forceinline__ void gemm_phase(LAS unsigned char* lds, const int K, const Sched& S, const Epi& E) {
    int tid = tidx();
    const int wid = __builtin_amdgcn_readfirstlane(tid >> 6), lane = tid & 63, wr = wid >> 2, wc = wid & 3, fr = lane & 15, fq = lane >> 4;
    const int nt = K / BK;
    unsigned voffA[2], voffB[2];
#pragma unroll
    for (int i = 0; i < 2; ++i) { int R, C; stage_rc(tid * 16 + i * 8192, R, C); const int Rb = Epi::PERM ? ((R & ~31) + perm32(R & 31)) : R;
        voffA[i] = (unsigned)(R * K + C) * 2u; voffB[i] = (unsigned)(Rb * K + C) * 2u; }
    const size_t kstep = (size_t)(BK * 2);
    const size_t hstep = (size_t)HALF * K * 2;
    const unsigned ldsw = (unsigned)wid * 1024u;
    const int aoff = lds_byte(wr * 64 + fr, fq * 8), boff = lds_byte(wc * 32 + fr, fq * 8);
#define PG_SA(b, h) (((b) * 2 + (h)) * HTB)
#define PG_SB(b, h) ((4 + (b) * 2 + (h)) * HTB)
#define PG_STAGE(bufoff, gbase, voff) do { _Pragma("unroll") for (int _i = 0; _i < 2; ++_i) \
        __builtin_amdgcn_global_load_lds((const unsigned*)((const char*)(gbase) + (voff)[_i]), (LAS unsigned*)(lds + (bufoff) + ldsw + _i * 8192), 16, 0, 0); } while (0)
#define PG_LDA(dst, b, h) do { _Pragma("unroll") for (int m = 0; m < 4; ++m) _Pragma("unroll") for (int k = 0; k < 2; ++k) dst[m][k] = *(const LAS h8*)(lds + PG_SA(b, h) + aoff + m * 2048 + k * 1024); } while (0)
#define PG_LDB(dst, b, h) do { _Pragma("unroll") for (int n = 0; n < 2; ++n) _Pragma("unroll") for (int k = 0; k < 2; ++k) dst[n][k] = *(const LAS h8*)(lds + PG_SB(b, h) + boff + n * 2048 + k * 1024); } while (0)
#define PG_MMA(ai, bj, At, Bt) do { __builtin_amdgcn_s_setprio(1); _Pragma("unroll") for (int m = 0; m < 4; ++m) _Pragma("unroll") for (int n = 0; n < 2; ++n) _Pragma("unroll") for (int k = 0; k < 2; ++k) \
        acc[ai][bj][m][n] = __builtin_amdgcn_mfma_f32_16x16x32_f16(Bt[n][k], At[m][k], acc[ai][bj][m][n], 0, 0, 0); __builtin_amdgcn_s_setprio(0); } while (0)
#define PG_WAIT_V(n) asm volatile("s_waitcnt vmcnt(" #n ")" ::: "memory")
#define PG_WAIT_L(n) asm volatile("s_waitcnt lgkmcnt(" #n ")" ::: "memory")
#define PG_BAR __builtin_amdgcn_s_barrier()
#define PG_SCHED __builtin_amdgcn_sched_barrier(0)
    Unit cur, nxt; int ui = 0;
    if (!S.next(0, cur)) return;
    f32x4 acc[2][2][4][2];
#pragma unroll
    for (int a = 0; a < 2; ++a)
#pragma unroll
        for (int b = 0; b < 2; ++b)
#pragma unroll
            for (int m = 0; m < 4; ++m)
#pragma unroll
                for (int n = 0; n < 2; ++n) acc[a][b][m][n] = (f32x4){0.f, 0.f, 0.f, 0.f};
    h8 At[4][2], B0[2][2], B1[2][2];
    const char* cA = cur.A; const char* cB = cur.B;
    PG_STAGE(PG_SB(0, 0), cB, voffB); PG_STAGE(PG_SA(0, 0), cA, voffA); PG_STAGE(PG_SB(0, 1), cB + hstep, voffB); PG_STAGE(PG_SA(0, 1), cA + hstep, voffA);
    if (wr == 1) PG_BAR;
    PG_WAIT_V(4); PG_BAR;
    PG_STAGE(PG_SB(1, 0), cB + kstep, voffB); PG_STAGE(PG_SA(1, 0), cA + kstep, voffA); PG_STAGE(PG_SB(1, 1), cB + hstep + kstep, voffB);
    PG_WAIT_V(6); PG_BAR;
    for (;;) {
        const bool has_next = S.next(ui + 1, nxt);
        const char* nA = has_next ? nxt.A : cA; const char* nB = has_next ? nxt.B : cB;
        for (int t = 0; t < nt; t += 2) {
            const bool last = (t == nt - 2);
            const char* a1 = cA + (size_t)(t + 1) * kstep;
            const char* a2 = last ? nA : cA + (size_t)(t + 2) * kstep; const char* b2 = last ? nB : cB + (size_t)(t + 2) * kstep;
            const char* a3 = a2 + kstep; const char* b3 = b2 + kstep;
            PG_LDB(B0, 0, 0); PG_SCHED; PG_LDA(At, 0, 0); PG_STAGE(PG_SA(1, 1), a1 + hstep, voffA);
            PG_WAIT_L(8); PG_BAR; PG_WAIT_L(0); PG_MMA(0, 0, At, B0); PG_BAR; PG_SCHED;
            PG_LDB(B1, 0, 1); PG_STAGE(PG_SB(0, 0), b2, voffB);
            PG_BAR; PG_WAIT_L(0); PG_MMA(0, 1, At, B1); PG_BAR;
            PG_LDA(At, 0, 1); PG_STAGE(PG_SA(0, 0), a2, voffA);
            PG_BAR; PG_WAIT_L(0); PG_MMA(1, 0, At, B0); PG_BAR; PG_SCHED;
            PG_STAGE(PG_SB(0, 1), b2 + hstep, voffB);
            PG_WAIT_V(6); PG_BAR; PG_MMA(1, 1, At, B1); PG_BAR;
            PG_LDB(B0, 1, 0); PG_SCHED; PG_LDA(At, 1, 0); PG_STAGE(PG_SA(0, 1), a2 + hstep, voffA);
            PG_WAIT_L(8); PG_BAR; PG_WAIT_L(0); PG_MMA(0, 0, At, B0); PG_BAR; PG_SCHED;
            PG_LDB(B1, 1, 1); PG_STAGE(PG_SB(1, 0), b3, voffB);
            PG_BAR; PG_WAIT_L(0); PG_MMA(0, 1, At, B1); PG_BAR;
            PG_LDA(At, 1, 1); PG_STAGE(PG_SA(1, 0), a3, voffA);
            PG_BAR; PG_WAIT_L(0); PG_MMA(1, 0, At, B0); PG_BAR; PG_SCHED;
            PG_STAGE(PG_SB(1, 1), b3 + hstep, voffB);
            PG_WAIT_V(6); PG_BAR; PG_MMA(1, 1, At, B1); PG_BAR;
        }
        E(acc, cur, wr, wc, fr, fq);
        if (!has_next) break;
#pragma unroll
        for (int a = 0; a < 2; ++a)
#pragma unroll
            for (int b = 0; b < 2; ++b)
#pragma unroll
                for (int m = 0; m < 4; ++m)
#pragma unroll
                    for (int n = 0; n < 2; ++n) acc[a][b][m][n] = (f32x4){0.f, 0.f, 0.f, 0.f};
        cur = nxt; cA = nA; cB = nB; ++ui;
    }
    PG_WAIT_V(0);
    if (wr == 0) PG_BAR;
    PG_BAR;
#undef PG_SA
#undef PG_SB
#undef PG_STAGE
#undef PG_LDA
#undef PG_LDB
#undef PG_MMA
#undef PG_WAIT_V
#undef PG_WAIT_L
#undef PG_BAR
#undef PG_SCHED
}
}
__device__ __forceinline__ float fsig(float v) { return 1.f / (1.f + __expf(-v)); }
__device__ __forceinline__ float fsilu(float v) { return v / (1.f + __expf(-v)); }
__device__ __forceinline__ u32x4 pack8(const f32x4 a, const f32x4 b) {
    const h8 v = {(_Float16)a[0], (_Float16)a[1], (_Float16)a[2], (_Float16)a[3], (_Float16)b[0], (_Float16)b[1], (_Float16)b[2], (_Float16)b[3]};
    return __builtin_bit_cast(u32x4, v);
}
__device__ __forceinline__ void unpack8(const u32x4 w, float (&o)[8]) {
    const h8 v = __builtin_bit_cast(h8, w);
#pragma unroll
    for (int j = 0; j < 8; ++j) o[j] = (float)v[j];
}
struct SchedPlain {
    const char* A; const char* B; int nM, nN, G, c, K;
    __device__ bool next(int i, pg::Unit& u) const {
        const long L = (long)i * G + c; if (L >= (long)nM * nN) return false;
        pg::tile_of((int)L, nM, nN, u.pm, u.pn); u.aux = 0;
        u.A = A + (size_t)u.pm * 256 * K * 2; u.B = B + (size_t)u.pn * 256 * K * 2; return true;
    }
};
struct SchedMerge {
    const char* ys; const char* wb; int G, c;
    __device__ bool next(int i, pg::Unit& u) const {
        const int r = i / 3, n = i - 3 * r; const long L = (long)r * G + c; if (L >= 64 * 4) return false;
        pg::tile_of((int)L, 64, 4, u.pm, u.pn); u.aux = n;
        u.A = ys + ((size_t)n * T + (size_t)u.pm * 256) * W * 2; u.B = wb + ((size_t)n * D + (size_t)u.pn * 256) * W * 2; return true;
    }
};

template <int ACT> __device__ __forceinline__ f32x4 actv(f32x4 v) {
    if (ACT == 1) { for (int j = 0; j < 4; ++j) v[j] = fsilu(v[j]); }
    if (ACT == 2) { for (int j = 0; j < 4; ++j) v[j] = fsig(v[j]); }
    return v;
}
template <int ACT> __device__ __forceinline__ void st16(const f32x4 (&acc)[2][2][4][2], __half* base, int ld, int c8, int bj0, int bj1) {
#pragma unroll
    for (int ai = 0; ai < 2; ++ai)
#pragma unroll
        for (int m = 0; m < 4; ++m) {
            __half* rowp = base + (size_t)(ai * 128 + m * 16) * ld + c8;
#pragma unroll
            for (int bj = 0; bj < 2; ++bj) if (bj >= bj0 && bj < bj1)
                *(u32x4*)(rowp + (bj - bj0) * 128) = pack8(actv<ACT>(acc[ai][bj][m][0]), actv<ACT>(acc[ai][bj][m][1]));
        }
}
struct EpiProj {
    static constexpr bool PERM = true;
    __half *q16, *v16, *hgg16, *atq16, *atk16, *atv16, *atg16, *ixq16, *ixk16, *s5u16, *s5g16, *mg16; float *lf32, *ixw32; const float* lb;
    __device__ __forceinline__ void operator()(const f32x4 (&acc)[2][2][4][2], const pg::Unit& u, int wr, int wc, int fr, int fq) const {
        const size_t row0 = (size_t)u.pm * 256 + wr * 64 + fr; const int c8 = wc * 32 + 8 * fq, pn = u.pn;
        if (pn < 2)        st16<0>(acc, q16 + row0 * W + pn * 256, W, c8, 0, 2);
        else if (pn < 4) {
            const int cb = (pn - 2) * 256 + c8;
#pragma unroll
            for (int bj = 0; bj < 2; ++bj) {
                const f32x4 l0 = *(const f32x4*)(lb + cb + bj * 128), l1 = *(const f32x4*)(lb + cb + bj * 128 + 4);
#pragma unroll
                for (int ai = 0; ai < 2; ++ai)
#pragma unroll
                    for (int m = 0; m < 4; ++m) {
                        f32x4 a = acc[ai][bj][m][0], b = acc[ai][bj][m][1];
#pragma unroll
                        for (int j = 0; j < 4; ++j) { a[j] = __logf(fmaxf(l0[j] + (1.f - l0[j]) * fsig(a[j]), 1e-30f)); b[j] = __logf(fmaxf(l1[j] + (1.f - l1[j]) * fsig(b[j]), 1e-30f)); }
                        float* o = lf32 + (row0 + ai * 128 + m * 16) * W + cb + bj * 128;
                        *(f32x4*)o = a; *(f32x4*)(o + 4) = b;
                    }
            }
        }
        else if (pn < 6)   st16<0>(acc, v16 + row0 * W + (pn - 4) * 256, W, c8, 0, 2);
        else if (pn < 8)   st16<1>(acc, hgg16 + row0 * W + (pn - 6) * 256, W, c8, 0, 2);
        else if (pn < 10)  st16<0>(acc, atq16 + row0 * W + (pn - 8) * 256, W, c8, 0, 2);
        else if (pn == 10) { st16<0>(acc, atk16 + row0 * 128, 128, c8, 0, 1); st16<0>(acc, atv16 + row0 * 128, 128, c8, 1, 2); }
        else if (pn < 13)  st16<1>(acc, atg16 + row0 * W + (pn - 11) * 256, W, c8, 0, 2);
        else if (pn < 15)  st16<0>(acc, ixq16 + row0 * W + (pn - 13) * 256, W, c8, 0, 2);
        else if (pn == 15) {
            if (wc < 2) {
#pragma unroll
                for (int ai = 0; ai < 2; ++ai)
#pragma unroll
                    for (int m = 0; m < 4; ++m) *(u32x4*)(ixk16 + (row0 + ai * 128 + m * 16) * 64 + c8) = pack8(acc[ai][0][m][0], acc[ai][0][m][1]);
            } else if (wc == 2 && fq == 0) {
#pragma unroll
                for (int ai = 0; ai < 2; ++ai)
#pragma unroll
                    for (int m = 0; m < 4; ++m) { float* o = ixw32 + (row0 + ai * 128 + m * 16) * 8; *(f32x4*)o = acc[ai][0][m][0]; *(f32x4*)(o + 4) = acc[ai][0][m][1]; }
            }
        }
        else if (pn < 18)  st16<0>(acc, s5u16 + row0 * W + (pn - 16) * 256, W, c8, 0, 2);
        else if (pn < 20)  st16<1>(acc, s5g16 + row0 * W + (pn - 18) * 256, W, c8, 0, 2);
        else               st16<2>(acc, mg16 + row0 * 3072 + (pn - 20) * 256, 3072, c8, 0, 2);
    }
};
struct EpiGlu {
    static constexpr bool PERM = true;
    const __half* ypre16; const __half* s5g16; const float* bias; __half* yc; float* raw;
    __device__ __forceinline__ void operator()(const f32x4 (&acc)[2][2][4][2], const pg::Unit& u, int wr, int wc, int fr, int fq) const {
        const size_t row0 = (size_t)u.pm * 256 + wr * 64 + fr; const int c0 = u.pn * 256 + wc * 32 + 8 * fq;
#pragma unroll
        for (int bj = 0; bj < 2; ++bj) {
            const int col = c0 + bj * 128;
            const f32x4 b0 = *(const f32x4*)(bias + col), b1 = *(const f32x4*)(bias + col + 4);
#pragma unroll
            for (int ai = 0; ai < 2; ++ai)
#pragma unroll
                for (int m = 0; m < 4; ++m) {
                    const size_t off = (row0 + ai * 128 + m * 16) * W + col;
                    float y[8], g[8]; unpack8(*(const u32x4*)(ypre16 + off), y); unpack8(*(const u32x4*)(s5g16 + off), g);
                    f32x4 a = acc[ai][bj][m][0] + b0, b = acc[ai][bj][m][1] + b1;
                    if (raw) { *(f32x4*)(raw + (row0 + ai * 128 + m * 16) * D + col) = acc[ai][bj][m][0]; *(f32x4*)(raw + (row0 + ai * 128 + m * 16) * D + col + 4) = acc[ai][bj][m][1]; }
#pragma unroll
                    for (int j = 0; j < 4; ++j) { a[j] = y[j] * fsig(a[j]) * g[j]; b[j] = y[4 + j] * fsig(b[j]) * g[4 + j]; }
                    *(u32x4*)(yc + off) = pack8(a, b);
                }
        }
    }
};
struct EpiMerge {
    static constexpr bool PERM = true;
    const __half* mg16; float* mp32; __half* merged16;
    __device__ __forceinline__ void operator()(const f32x4 (&acc)[2][2][4][2], const pg::Unit& u, int wr, int wc, int fr, int fq) const {
        const size_t row0 = (size_t)u.pm * 256 + wr * 64 + fr; const int c0 = u.pn * 256 + wc * 32 + 8 * fq, n = u.aux;
#pragma unroll
        for (int ai = 0; ai < 2; ++ai)
#pragma unroll
            for (int m = 0; m < 4; ++m)
#pragma unroll
                for (int bj = 0; bj < 2; ++bj) {
                    const size_t r = row0 + ai * 128 + m * 16; const int col = c0 + bj * 128;
                    float g[8]; unpack8(*(const u32x4*)(mg16 + r * 3072 + n * D + col), g);
                    f32x4 a = acc[ai][bj][m][0], b = acc[ai][bj][m][1];
#pragma unroll
                    for (int j = 0; j < 4; ++j) { a[j] *= g[j]; b[j] *= g[4 + j]; }
                    float* pp = mp32 + r * D + col;
                    if (n > 0) { a += *(const f32x4*)pp; b += *(const f32x4*)(pp + 4); }
                    if (n < 2) { *(f32x4*)pp = a; *(f32x4*)(pp + 4) = b; }
                    else *(u32x4*)(merged16 + r * D + col) = pack8(a, b);
                }
    }
};
struct EpiOut {
    static constexpr bool PERM = false;
    const float* xin; float* out; const float* gate;
    __device__ __forceinline__ void operator()(const f32x4 (&acc)[2][2][4][2], const pg::Unit& u, int wr, int wc, int fr, int fq) const {
        const size_t row0 = (size_t)u.pm * 256 + wr * 64 + fr; const int c0 = u.pn * 256 + wc * 32 + 4 * fq;
        const int b = (u.pm * 256) / S;
#pragma unroll
        for (int bj = 0; bj < 2; ++bj)
#pragma unroll
            for (int n = 0; n < 2; ++n) {
                const int col = c0 + bj * 128 + n * 16;
                const f32x4 gv = *(const f32x4*)(gate + (size_t)b * 3072 + col);
#pragma unroll
                for (int ai = 0; ai < 2; ++ai)
#pragma unroll
                    for (int m = 0; m < 4; ++m) {
                        const size_t off = (row0 + ai * 128 + m * 16) * D + col;
                        *(f32x4*)(out + off) = *(const f32x4*)(xin + off) + gv * acc[ai][bj][m][n];
                    }
            }
    }
};
__device__ void phase_fix(const Params& p, int l, float* lds) {
    {
        __half* tl = (__half*)lds;
        const int tid = tidx();
        for (int tile = blockIdx.x; tile < T / 64; tile += gridDim.x) {
            const int t0 = tile * 64, b = t0 / S, s0 = t0 % S;
            __syncthreads();
            for (int i = tid; i < 64 * 64; i += 512) { const int tt = i >> 6, e2 = (i & 63) * 2; *(h2*)(tl + tt * 130 + e2) = *(const h2*)(p.atv16 + (size_t)(t0 + tt) * 128 + e2); }
            __syncthreads();
            const int e = tid >> 2, part = tid & 3;
            h8 v0, v1;
#pragma unroll
            for (int j = 0; j < 8; ++j) { v0[j] = (_Float16)tl[(part * 16 + j) * 130 + e]; v1[j] = (_Float16)tl[(part * 16 + 8 + j) * 130 + e]; }
            __half* dst = p.atvT16 + (size_t)(b * 128 + e) * S + s0 + part * 16;
            *(h8*)dst = v0; *(h8*)(dst + 8) = v1;
        }
    }
    const int w = tidx() >> 6, lane = tidx() & 63;
    for (int t = blockIdx.x * 8 + w; t < T; t += gridDim.x * 8) {
        const float cA = p.ropeA[((size_t)t * 64 + lane) * 2], sA = p.ropeA[((size_t)t * 64 + lane) * 2 + 1];
        for (int hh = 0; hh < 5; ++hh) {
            __half* q = hh < 4 ? p.atq16 + (size_t)t * W + hh * 128 : p.atk16 + (size_t)t * 128;
            const float* g = hh < 4 ? p.qn_g + l * 128 : p.kn_g + l * 128;
            const float x1 = __half2float(q[lane]), x2 = __half2float(q[64 + lane]);
            const float ss = wave_sum(x1 * x1 + x2 * x2);
            const float r = rsqrtf(ss * (1.f / 128.f) + EPS);
            const float a = x1 * r * g[lane], b2 = x2 * r * g[64 + lane];
            q[lane] = __float2half(a * cA - b2 * sA); q[64 + lane] = __float2half(b2 * cA + a * sA);
        }
        for (int i = 0; i < 5; ++i) {
            const int idx = lane + 64 * i;
            if (i == 4 && lane >= 32) break;
            const int hh = idx >> 5, j = idx & 31;
            __half* q = i < 4 ? p.ixq16 + (size_t)t * W + hh * 64 : p.ixk16 + (size_t)t * 64;
            const float cI = p.ropeI[((size_t)t * 32 + j) * 2], sI = p.ropeI[((size_t)t * 32 + j) * 2 + 1];
            const float x1 = __half2float(q[j]), x2 = __half2float(q[32 + j]);
            q[j] = __float2half(x1 * cI - x2 * sI); q[32 + j] = __float2half(x2 * cI + x1 * sI);
        }
    }
}

__device__ void mixA(const Params& p, int l, int item, float* lds) {
    const int b = item >> 2, hd = item & 3;
    float* qs = lds; float* fs = qs + 32 * 128; float* ks = fs + 32 * 128; float* vs = ks + 32 * 128; float* op = vs + 32 * 128;
    const int tid = tidx(), e = tid & 127, dq = tid >> 7, w = tid >> 6, lane = tid & 63;
    float St[32];
#pragma unroll
    for (int i = 0; i < 32; ++i) St[i] = 0.f;
    const float* on = p.onorm_g + l * 128;
    __half* ya = p.ys;
    for (int c0 = 0; c0 < S; c0 += 32) {
        for (int i = tid; i < 32 * 128; i += 512) {
            const int tt = i >> 7, d = i & 127; const size_t o = (size_t)(b * S + c0 + tt) * W + hd * 128 + d;
            const float f = __expf(p.lf32[o]);
            qs[i] = __half2float(p.q16[o]); fs[i] = f; ks[i] = 1.f - f; vs[i] = __half2float(p.v16[o]);
        }
        __syncthreads();
#pragma unroll 1
        for (int tt = 0; tt < 32; ++tt) {
            const float ve = vs[tt * 128 + e]; float part = 0.f;
            const float4* f4 = (const float4*)(fs + tt * 128 + dq * 32); const float4* k4 = (const float4*)(ks + tt * 128 + dq * 32); const float4* q4 = (const float4*)(qs + tt * 128 + dq * 32);
#pragma unroll
            for (int j = 0; j < 8; ++j) {
                const float4 f = f4[j], k = k4[j], q = q4[j];
                St[4 * j + 0] = f.x * St[4 * j + 0] + k.x * ve; part += q.x * St[4 * j + 0];
                St[4 * j + 1] = f.y * St[4 * j + 1] + k.y * ve; part += q.y * St[4 * j + 1];
                St[4 * j + 2] = f.z * St[4 * j + 2] + k.z * ve; part += q.z * St[4 * j + 2];
                St[4 * j + 3] = f.w * St[4 * j + 3] + k.w * ve; part += q.w * St[4 * j + 3];
            }
            op[(tt * 4 + dq) * 128 + e] = part;
        }
        __syncthreads();
        for (int i = 0; i < 4; ++i) {
            const int tt = w * 4 + i;
            float o0 = 0.f, o1 = 0.f;
#pragma unroll
            for (int q = 0; q < 4; ++q) { o0 += op[(tt * 4 + q) * 128 + lane]; o1 += op[(tt * 4 + q) * 128 + 64 + lane]; }
            const float ss = wave_sum(o0 * o0 + o1 * o1);
            const float r = rsqrtf(ss * (1.f / 128.f) + EPS);
            const size_t o = (size_t)(b * S + c0 + tt) * W + hd * 128;
            ya[o + lane] = __float2half(o0 * r * on[lane] * __half2float(p.hgg16[o + lane]));
            ya[o + 64 + lane] = __float2half(o1 * r * on[64 + lane] * __half2float(p.hgg16[o + 64 + lane]));
        }
        __syncthreads();
    }
}

__device__ void mixC(const Params& p, int l, int item, float* lds) {
    const int w = tidx() >> 6, lane = tidx() & 63;
    const int idx = item * 8 + w, b = idx >> 5, g = idx & 31;
    float* wl = lds + w * 3328;
    float* cre = wl; float* cim = cre + 16 * 65; float* xrs = cim + 16 * 65; float* xis = xrs + 512; float* us = xis + 512;
    const size_t lg = (size_t)l * 32 + g;
    const float abr = p.abar[(lg * 64 + lane) * 2], abi = p.abar[(lg * 64 + lane) * 2 + 1];
    float bre[16], bim[16];
#pragma unroll
    for (int c = 0; c < 16; ++c) { bre[c] = p.bbar[((lg * 64 + lane) * 16 + c) * 2]; bim[c] = p.bbar[((lg * 64 + lane) * 16 + c) * 2 + 1]; }
    for (int c = 0; c < 16; ++c) { cre[c * 65 + lane] = p.c_re[(lg * 16 + c) * 64 + lane]; cim[c * 65 + lane] = p.c_im[(lg * 16 + c) * 64 + lane]; }
    float xr = 0.f, xi = 0.f;
    for (int t0 = 0; t0 < S; t0 += 8) {
#pragma unroll
        for (int i = 0; i < 2; ++i) { const int q = lane + 64 * i; us[q] = __half2float(p.s5u16[(size_t)(b * S + t0 + (q >> 4)) * W + g * 16 + (q & 15)]); }
        __syncthreads();
#pragma unroll 1
        for (int tt = 0; tt < 8; ++tt) {
            float bur = 0.f, bui = 0.f;
#pragma unroll
            for (int c = 0; c < 16; ++c) { const float u = us[tt * 16 + c]; bur += u * bre[c]; bui += u * bim[c]; }
            const float nxr = abr * xr - abi * xi + bur, nxi = abr * xi + abi * xr + bui;
            xr = nxr; xi = nxi;
            xrs[tt * 64 + lane] = xr; xis[tt * 64 + lane] = xi;
        }
        __syncthreads();
#pragma unroll
        for (int i = 0; i < 2; ++i) {
            const int q = lane + 64 * i, tt = q >> 4, c = q & 15;
            float y = 0.f;
#pragma unroll 8
            for (int s = 0; s < 64; ++s) y += cre[c * 65 + s] * xrs[tt * 64 + s] - cim[c * 65 + s] * xis[tt * 64 + s];
            y += p.s5_d[l * W + g * 16 + c] * us[q];
            p.ypre16[(size_t)(b * S + t0 + tt) * W + g * 16 + c] = __float2half(gelu_tanh_f(y));
        }
        __syncthreads();
    }
}
__device__ __forceinline__ unsigned f2key(float f) { const unsigned u = __float_as_uint(f); return (u & 0x80000000u) ? ~u : (u | 0x80000000u); }
typedef float f32x16 __attribute__((ext_vector_type(16)));
typedef _Float16 h4 __attribute__((ext_vector_type(4)));
__device__ void dsa_select(const Params& p, int b, int q0, float* lds) {
    const int tid = tidx(), w = tid >> 6, lane = tid & 63, half = lane >> 5, col = lane & 31;
    float* sc = lds;
    {
        const int wq = w & 3, par = w >> 2;
        const int blk = col >> 2, wi = col & 3, ql = 2 * (blk & 1) + (blk >> 2), head = 4 * ((blk >> 1) & 1) + wi;
        const __half* qrow = p.ixq16 + (size_t)(b * S + q0 + wq * 4 + ql) * W + head * 64 + 8 * half;
        h8 af[4];
#pragma unroll
        for (int ks = 0; ks < 4; ++ks) af[ks] = *(const h8*)(qrow + 16 * ks);
        const int qa = wq * 4 + 2 * half;
        float iw0[8], iw1[8];
#pragma unroll
        for (int hh = 0; hh < 8; ++hh) { iw0[hh] = p.ixw32[(size_t)(b * S + q0 + qa) * 8 + hh]; iw1[hh] = p.ixw32[(size_t)(b * S + q0 + qa + 1) * 8 + hh]; }
        const int ntiles = (q0 + 15) / 32 + 1;
        for (int kt = par; kt < ntiles; kt += 2) {
            const int key = kt * 32 + col;
            const __half* krow = p.ixk16 + (size_t)(b * S + key) * 64 + 8 * half;
            f32x16 acc;
#pragma unroll
            for (int r = 0; r < 16; ++r) acc[r] = 0.f;
#pragma unroll
            for (int ks = 0; ks < 4; ++ks) acc = __builtin_amdgcn_mfma_f32_32x32x16_f16(af[ks], *(const h8*)(krow + 16 * ks), acc, 0, 0, 0);
            float s0 = 0.f, s1 = 0.f;
#pragma unroll
            for (int r = 0; r < 8; ++r) { s0 += fmaxf(acc[r], 0.f) * iw0[r]; s1 += fmaxf(acc[8 + r], 0.f) * iw1[r]; }
            sc[qa * 2048 + key] = key <= q0 + qa ? s0 : -INFINITY;
            sc[(qa + 1) * 2048 + key] = key <= q0 + qa + 1 ? s1 : -INFINITY;
        }
        for (int i = ntiles * 32 + tid; i < 2048; i += 512) {
#pragma unroll
            for (int q = 0; q < 16; ++q) sc[q * 2048 + i] = -INFINITY;
        }
    }
    __syncthreads();
    for (int qq = 0; qq < 2; ++qq) {
        const int ql = 2 * w + qq, qi = q0 + ql;
        const float* scl = sc + ql * 2048;
        const bool all = qi + 1 <= 256;
        unsigned thr = 0; int rrem = 0;
        if (!all) {
            unsigned key[32];
#pragma unroll
            for (int i = 0; i < 32; ++i) key[i] = f2key(scl[lane + 64 * i]);
            unsigned prefix = 0;
#pragma unroll 1
            for (int bit = 31; bit >= 0; --bit) {
                const unsigned cand = prefix | (1u << bit);
                int c = 0;
#pragma unroll
                for (int i = 0; i < 32; ++i) c += (key[i] >= cand) ? 1 : 0;
#pragma unroll
                for (int o = 32; o > 0; o >>= 1) c += __shfl_xor(c, o);
                if (c >= 256) prefix = cand;
            }
            int c = 0;
#pragma unroll
            for (int i = 0; i < 32; ++i) c += (key[i] > prefix) ? 1 : 0;
#pragma unroll
            for (int o = 32; o > 0; o >>= 1) c += __shfl_xor(c, o);
            thr = prefix; rrem = 256 - c;
        }
        const unsigned long long lt = (1ull << lane) - 1ull;
        unsigned mylo = 0, myhi = 0;
#pragma unroll 1
        for (int i = 0; i < 32; ++i) {
            const int s = lane + 64 * i;
            const unsigned k = f2key(scl[s]);
            bool sl;
            if (all) sl = s <= qi;
            else {
                const bool eq = k == thr;
                const unsigned long long m = __ballot(eq);
                sl = (k > thr) || (eq && __popcll(m & lt) < rrem);
                rrem -= __popcll(m); if (rrem < 0) rrem = 0;
            }
            const unsigned long long m2 = __ballot(sl);
            if (lane == i) { mylo = (unsigned)m2; myhi = (unsigned)(m2 >> 32); }
        }
        if (lane < 32) *(uint2*)(p.mask + (size_t)(b * S + qi) * 64 + 2 * lane) = make_uint2(mylo, myhi);
    }
    __syncthreads();
}

__device__ void dsa_attend(const Params& p, int b, int g) {
    const int lane = tidx() & 63, half = lane >> 5, col = lane & 31;
    const int q0 = 8 * g, qi = q0 + (col >> 2), hd = col & 3;
    const __half* qp = p.atq16 + (size_t)(b * S + qi) * W + hd * 128 + 8 * half;
    h8 qf[8];
#pragma unroll
    for (int ks = 0; ks < 8; ++ks) qf[ks] = *(const h8*)(qp + 16 * ks);
    f32x16 o[4];
#pragma unroll
    for (int et = 0; et < 4; ++et)
#pragma unroll
        for (int r = 0; r < 16; ++r) o[et][r] = 0.f;
    float m = -INFINITY, l = 0.f;
    const int ntiles = (q0 + 7) / 32 + 1;
    const unsigned* mrow = p.mask + (size_t)(b * S + qi) * 64;
    const float scale = 0.08838834764831845f;
#pragma unroll 1
    for (int kt = 0; kt < ntiles; ++kt) {
        const __half* kp = p.atk16 + (size_t)(b * S + kt * 32 + col) * 128 + 8 * half;
        f32x16 s;
#pragma unroll
        for (int r = 0; r < 16; ++r) s[r] = 0.f;
#pragma unroll
        for (int ks = 0; ks < 8; ++ks) s = __builtin_amdgcn_mfma_f32_32x32x16_f16(*(const h8*)(kp + 16 * ks), qf[ks], s, 0, 0, 0);
        const unsigned mw = mrow[kt];
        float tmax = -INFINITY;
#pragma unroll
        for (int r = 0; r < 16; ++r) {
            const int bit = (r & 3) + 8 * (r >> 2) + 4 * half;
            s[r] = ((mw >> bit) & 1u) ? s[r] * scale : -INFINITY;
            tmax = fmaxf(tmax, s[r]);
        }
        tmax = fmaxf(tmax, __shfl_xor(tmax, 32));
        const float mn = fmaxf(m, tmax);
        const float ms = mn == -INFINITY ? 0.f : mn;
        const float cs = __expf(m - ms);
        float ps = 0.f;
#pragma unroll
        for (int r = 0; r < 16; ++r) { s[r] = __expf(s[r] - ms); ps += s[r]; }
        l = l * cs + ps; m = mn;
#pragma unroll
        for (int et = 0; et < 4; ++et)
#pragma unroll
            for (int r = 0; r < 16; ++r) o[et][r] *= cs;
        h8 pb[2];
#pragma unroll
        for (int s2 = 0; s2 < 2; ++s2)
#pragma unroll
            for (int j = 0; j < 8; ++j) pb[s2][j] = (_Float16)s[8 * s2 + j];
#pragma unroll
        for (int et = 0; et < 4; ++et) {
            const __half* vp = p.atvT16 + (size_t)(b * 128 + 32 * et + col) * S + kt * 32 + 4 * half;
#pragma unroll
            for (int s2 = 0; s2 < 2; ++s2) {
                const h4 v0 = *(const h4*)(vp + 16 * s2), v1 = *(const h4*)(vp + 16 * s2 + 8);
                const h8 vf = {v0[0], v0[1], v0[2], v0[3], v1[0], v1[1], v1[2], v1[3]};
                o[et] = __builtin_amdgcn_mfma_f32_32x32x16_f16(vf, pb[s2], o[et], 0, 0, 0);
            }
        }
    }
    l += __shfl_xor(l, 32);
    const float inv = 1.f / l;
    __half* yb = p.ys + (size_t)T * W + (size_t)(b * S + qi) * W + hd * 128;
    const __half* gp = p.atg16 + (size_t)(b * S + qi) * W + hd * 128;
#pragma unroll
    for (int et = 0; et < 4; ++et)
#pragma unroll
        for (int r4 = 0; r4 < 4; ++r4) {
            const int e0 = 32 * et + 8 * r4 + 4 * half;
            const h4 gv = *(const h4*)(gp + e0);
            h4 ov;
#pragma unroll
            for (int j = 0; j < 4; ++j) ov[j] = (_Float16)(o[et][4 * r4 + j] * inv * (float)gv[j]);
            *(h4*)(yb + e0) = ov;
        }
}

__device__ void phase_mix1(const Params& p, int l, float* lds) {
    const int c = blockIdx.x, G = gridDim.x;
    if (G >= 128) {
        if (c < 32) mixA(p, l, c, lds);
        else if (c < 64) mixC(p, l, c - 32, lds);
        else for (int it = c - 64; it < NB * 64; it += G - 64) { const int b = it >> 6, jp = it & 63; dsa_select(p, b, jp * 16, lds); dsa_select(p, b, (127 - jp) * 16, lds); }
    } else {
        for (int it = c; it < 64 + NB * 64; it += G) {
            if (it < 32) mixA(p, l, it, lds); else if (it < 64) mixC(p, l, it - 32, lds);
            else { const int k = it - 64, b = k >> 6, jp = k & 63; dsa_select(p, b, jp * 16, lds); dsa_select(p, b, (127 - jp) * 16, lds); }
            __syncthreads();
        }
    }
}
__device__ void phase_mix2(const Params& p, int l) {
    const int w = tidx() >> 6;
    for (int c = blockIdx.x; c < 256; c += gridDim.x) {
        const int b = c >> 5, cc = c & 31;
        const int g = w < 4 ? cc * 4 + w : 255 - (cc * 4 + (w - 4));
        dsa_attend(p, b, g);
    }
}

typedef const __attribute__((address_space(4))) Params* KParams;
#define PHASE_PARAMS() KParams _kp = (KParams)__builtin_amdgcn_kernarg_segment_ptr(); asm volatile("" : "+s"(_kp)); const Params& p = *(const Params*)_kp
__global__ void __launch_bounds__(512, 2) mega(Params p_unused) {
    extern __shared__ __attribute__((aligned(16))) float lds[];
    LAS unsigned char* ldsb = (LAS unsigned char*)lds;
    cg::grid_group grid = cg::this_grid();
    const int G = gridDim.x, c = blockIdx.x;
    { PHASE_PARAMS(); phase0(p); phase0_conv(p, lds); }
    grid.sync();
    for (int l = 0; l < NL; ++l) {
        { PHASE_PARAMS(); phase_h(p, l); }
        grid.sync();
        {
            PHASE_PARAMS();
            SchedPlain sc{(const char*)p.h16, (const char*)(p.win16 + (size_t)l * NPK * D), 64, 32, G, c, D};
            EpiProj ep{p.q16, p.v16, p.hgg16, p.atq16, p.atk16, p.atv16, p.atg16, p.ixq16, p.ixk16, p.s5u16, p.s5g16, p.mg16, p.lf32, p.ixw32, p.lb + l * 512};
            pg::gemm_phase(ldsb, D, sc, ep);
        }
        grid.sync();
        { PHASE_PARAMS(); phase_fix(p, l, lds); }
        grid.sync();
        { PHASE_PARAMS(); phase_mix1(p, l, lds); }
        grid.sync();
        { PHASE_PARAMS(); phase_mix2(p, l); }
        grid.sync();
        {
            PHASE_PARAMS();
            SchedPlain sc{(const char*)p.ypre16, (const char*)(p.wglu16 + (size_t)l * W * W), 64, 2, G, c, W};
            EpiGlu ep{p.ypre16, p.s5g16, p.glu_b + l * W, p.ys + (size_t)2 * T * W, nullptr};
            pg::gemm_phase(ldsb, W, sc, ep);
        }
        grid.sync();
        {
            PHASE_PARAMS();
            SchedMerge sc{(const char*)p.ys, (const char*)(p.wb16 + (size_t)l * 3 * D * W), G, c};
            EpiMerge ep{p.mg16, p.mp32, p.merged16};
            pg::gemm_phase(ldsb, W, sc, ep);
        }
        grid.sync();
        {
            PHASE_PARAMS();
            SchedPlain sc{(const char*)p.merged16, (const char*)(p.wo16 + (size_t)l * D * D), 64, 4, G, c, D};
            EpiOut ep{l == 0 ? p.x : p.out, p.out, p.mod + (size_t)l * NB * 3072 + 2 * D};
            pg::gemm_phase(ldsb, D, sc, ep);
        }
        grid.sync();
    }
}

extern "C" void kernel_launch(void* const* d_in, const int* in_sizes, int n_in,
                              void* d_out, int out_size, void* d_ws, size_t ws_size,
                              hipStream_t stream) {
    static int grid_blocks = 0;
    if (!grid_blocks) {
        int dev = 0, cus = 0, per_cu = 0;
        (void)hipGetDevice(&dev);
        (void)hipDeviceGetAttribute(&cus, hipDeviceAttributeMultiprocessorCount, dev);
        (void)hipFuncSetAttribute((const void*)mega, hipFuncAttributeMaxDynamicSharedMemorySize, LDS_BYTES);
        (void)hipOccupancyMaxActiveBlocksPerMultiprocessor(&per_cu, mega, 512, LDS_BYTES);
        if (per_cu > 1) per_cu = 1;
        grid_blocks = cus * per_cu;
    }
    Params p{};
    const float* const* in = (const float* const*)d_in;
    p.x = in[0]; p.c = in[1]; p.pos = (const int*)d_in[2];
    p.ada_w = in[3]; p.ada_b = in[4]; p.norm_g = in[5]; p.w_in = in[6]; p.lb_logits = in[7]; p.onorm_g = in[8]; p.qn_g = in[9]; p.kn_g = in[10];
    p.a_re = in[11]; p.a_im = in[12]; p.log_dt = in[13]; p.b_re = in[14]; p.b_im = in[15]; p.c_re = in[16]; p.c_im = in[17]; p.s5_d = in[18];
    p.glu_w = in[19]; p.glu_b = in[20]; p.w_branch = in[21]; p.w_out = in[22];
    p.out = (float*)d_out;
    char* ws = (char*)d_ws; size_t off = 0;
    auto take = [&](size_t bytes) { char* q = ws + off; off += (bytes + 255) & ~(size_t)255; return q; };
    const size_t TW2 = (size_t)T * W * 2;
    p.mod = (float*)take((size_t)NL * NB * 3072 * 4);
    p.lb = (float*)take((size_t)NL * 512 * 4);
    p.abar = (float*)take((size_t)NL * 32 * 64 * 2 * 4);
    p.bbar = (float*)take((size_t)NL * 32 * 64 * 16 * 2 * 4);
    p.ropeA = (float*)take((size_t)T * 64 * 2 * 4);
    p.ropeI = (float*)take((size_t)T * 32 * 2 * 4);
    p.win16 = (__half*)take((size_t)NL * NPK * D * 2);
    p.wb16 = (__half*)take((size_t)NL * 3 * D * W * 2);
    p.wo16 = (__half*)take((size_t)NL * D * D * 2);
    p.wglu16 = (__half*)take((size_t)NL * W * W * 2);
    p.h16 = (__half*)take((size_t)T * D * 2);       p.merged16 = p.h16;
    p.q16 = (__half*)take(TW2);                     p.mp32 = (float*)p.q16;
    p.lf32 = (float*)take((size_t)T * W * 4);
    p.v16 = (__half*)take(TW2);
    p.hgg16 = (__half*)take(TW2);
    p.atq16 = (__half*)take(TW2);
    p.atk16 = (__half*)take((size_t)T * 128 * 2);
    p.atv16 = (__half*)take((size_t)T * 128 * 2);
    p.atg16 = (__half*)take(TW2);
    p.ixq16 = (__half*)take(TW2);
    p.ixk16 = (__half*)take((size_t)T * 64 * 2);
    p.ixw32 = (float*)take((size_t)T * 8 * 4);
    p.s5u16 = (__half*)take(TW2);
    p.s5g16 = (__half*)take(TW2);
    p.mg16 = (__half*)take((size_t)T * 3072 * 2);
    p.ys = (__half*)take(3 * TW2);
    p.ypre16 = (__half*)take(TW2);
    p.dbg = (unsigned*)take(256);
    p.mask = (unsigned*)take((size_t)T * 64 * 4);
    p.atvT16 = (__half*)take((size_t)T * 128 * 2);
    if (off > ws_size) { fprintf(stderr, "workspace too small: need %zu have %zu\n", off, ws_size); return; }
    void* args[] = {&p};
    hipError_t e = hipLaunchCooperativeKernel((void*)mega, dim3(grid_blocks), dim3(512), args, LDS_BYTES, stream);
    if (e != hipSuccess) fprintf(stderr, "cooperative launch failed: %s (grid %d)\n", hipGetErrorString(e), grid_blocks);
}
```

```cpp
#include <hip/hip_runtime.h>
#include <hip/hip_cooperative_groups.h>
#include <hip/hip_fp16.h>
#include <cstdio>
namespace cg = cooperative_groups;

constexpr int D = 1024, NB = 8, S = 2048, T = NB * S, NL = 4, W = 512, NIN = 8008, NPK = 8192;
constexpr int C_S5U = 3912, C_MG = 4936;
constexpr float EPS = 1e-6f;
constexpr int LDS_BYTES = 135168;
#define LAS __attribute__((address_space(3)))
typedef _Float16 h8 __attribute__((ext_vector_type(8)));
typedef _Float16 h2 __attribute__((ext_vector_type(2)));
typedef float f32x4 __attribute__((ext_vector_type(4)));
typedef unsigned u32x4 __attribute__((ext_vector_type(4)));

struct Params {
    const float *x, *c; const int* pos;
    const float *ada_w, *ada_b, *norm_g, *w_in, *lb_logits, *onorm_g, *qn_g, *kn_g;
    const float *a_re, *a_im, *log_dt, *b_re, *b_im, *c_re, *c_im, *s5_d, *glu_w, *glu_b, *w_branch, *w_out;
    float* out;
    float *mod, *lb, *abar, *bbar, *ropeA, *ropeI;
    __half *win16, *wb16, *wo16, *wglu16;
    __half *h16, *q16, *v16, *hgg16, *atq16, *atk16, *atv16, *atg16, *ixq16, *ixk16, *s5u16, *s5g16, *mg16, *ys, *ypre16, *merged16;
    float *lf32, *ixw32, *mp32; unsigned* dbg; unsigned* mask; __half* atvT16; __half* stT16; float* dec32;
};

__device__ __forceinline__ float sigmoid_f(float v) { return 1.f / (1.f + expf(-v)); }
__device__ __forceinline__ float silu_f(float v) { return v / (1.f + expf(-v)); }
__device__ __forceinline__ float gelu_tanh_f(float v) { return 0.5f * v * (1.f + tanhf(0.7978845608028654f * (v + 0.044715f * v * v * v))); }
__device__ __forceinline__ float wave_sum(float v) {
#pragma unroll
    for (int o = 32; o > 0; o >>= 1) v += __shfl_xor(v, o);
    return v;
}
__device__ __forceinline__ void lds_fence() { asm volatile("s_waitcnt lgkmcnt(0)" ::: "memory"); }
__device__ __forceinline__ int tidx() { int t = threadIdx.x; asm volatile("" : "+v"(t)); return t; }

__device__ void phase0(const Params& p) {
    const size_t gtid = (size_t)blockIdx.x * blockDim.x + tidx(), nth = (size_t)gridDim.x * blockDim.x;
    for (size_t i = gtid; i < (size_t)NL * NB * 3072; i += nth) {
        const int col = (int)(i % 3072), b = (int)((i / 3072) % NB), l = (int)(i / (3072 * NB));
        const float* w = p.ada_w + (size_t)l * 1024 * 3072 + col;
        const float* cc = p.c + b * 1024;
        float acc = p.ada_b[l * 3072 + col];
        for (int k = 0; k < 1024; ++k) { const float cv = cc[k]; acc += silu_f(cv) * w[(size_t)k * 3072]; }
        p.mod[i] = acc;
    }
    for (size_t i = gtid; i < 512; i += nth) {
        float lg[NL], mx = -1e30f;
#pragma unroll
        for (int l = 0; l < NL; ++l) { lg[l] = p.lb_logits[l * 512 + i]; mx = fmaxf(mx, lg[l]); }
        float s = 0.f;
#pragma unroll
        for (int l = 0; l < NL; ++l) { lg[l] = expf(lg[l] - mx); s += lg[l]; }
        float cum = 0.f;
#pragma unroll
        for (int l = 0; l < NL; ++l) { const float pr = lg[l] / s; cum += pr; p.lb[l * 512 + i] = cum - lg[0] / s; }
    }
    for (size_t i = gtid; i < (size_t)NL * 32 * 64; i += nth) {
        const int lg = (int)(i / 64);
        const double dt = exp((double)p.log_dt[lg]);
        const double are = p.a_re[i], aim = p.a_im[i];
        const double mag = exp(are * dt), ang = aim * dt;
        const double abr = mag * cos(ang), abi = mag * sin(ang);
        const double nr = abr - 1.0, ni = abi, den = are * are + aim * aim;
        const double fr = (nr * are + ni * aim) / den, fi = (ni * are - nr * aim) / den;
        p.abar[i * 2] = (float)abr; p.abar[i * 2 + 1] = (float)abi;
        for (int c = 0; c < 16; ++c) {
            const double br = p.b_re[i * 16 + c], bi = p.b_im[i * 16 + c];
            p.bbar[(i * 16 + c) * 2] = (float)(fr * br - fi * bi);
            p.bbar[(i * 16 + c) * 2 + 1] = (float)(fr * bi + fi * br);
        }
    }
    for (size_t i = gtid; i < (size_t)T * 64; i += nth) {
        const int t = (int)(i / 64), j = (int)(i % 64);
        const double inv = pow(10000.0, -(double)(2 * j) / 128.0);
        const double ang = (double)p.pos[t] * inv;
        p.ropeA[i * 2] = (float)cos(ang); p.ropeA[i * 2 + 1] = (float)sin(ang);
    }
    for (size_t i = gtid; i < (size_t)T * 32; i += nth) {
        const int t = (int)(i / 32), j = (int)(i % 32);
        const double inv = pow(10000.0, -(double)(2 * j) / 64.0);
        const double ang = (double)p.pos[t] * inv;
        p.ropeI[i * 2] = (float)cos(ang); p.ropeI[i * 2 + 1] = (float)sin(ang);
    }
}

__device__ __forceinline__ unsigned pk2(float a, float b) { h2 v = {(_Float16)a, (_Float16)b}; return __builtin_bit_cast(unsigned, v); }
__device__ void phase_h(const Params& p, int l) {
    const float* xin = l == 0 ? p.x : p.out;
    const int w = tidx() >> 6, lane = tidx() & 63;
    for (int row = blockIdx.x * 8 + w; row < T; row += gridDim.x * 8) {
        const int b = row / S;
        const float* xr = xin + (size_t)row * D;
        float4 v[4]; float ss = 0.f;
#pragma unroll
        for (int i = 0; i < 4; ++i) { v[i] = *(const float4*)(xr + i * 256 + lane * 4); ss += v[i].x * v[i].x + v[i].y * v[i].y + v[i].z * v[i].z + v[i].w * v[i].w; }
        ss = wave_sum(ss);
        const float r = rsqrtf(ss * (1.f / D) + EPS);
        const float* md = p.mod + ((size_t)l * NB + b) * 3072;
#pragma unroll
        for (int i = 0; i < 4; ++i) {
            const int k = i * 256 + lane * 4;
            const float4 g = *(const float4*)(p.norm_g + l * D + k), sh = *(const float4*)(md + k), sc = *(const float4*)(md + D + k);
            uint2 o;
            o.x = pk2(v[i].x * r * g.x * (1.f + sc.x) + sh.x, v[i].y * r * g.y * (1.f + sc.y) + sh.y);
            o.y = pk2(v[i].z * r * g.z * (1.f + sc.z) + sh.z, v[i].w * r * g.w * (1.f + sc.w) + sh.w);
            *(uint2*)(p.h16 + (size_t)row * D + k) = o;
        }
    }
}
template <class CM>
__device__ void conv_transpose(const float* __restrict__ src, int ldsrc, int K, __half* __restrict__ dst, int N, CM colmap, float* lds, int part, int nparts) {
    float (*ts)[65] = (float (*)[65])lds;
    const int tid = tidx(), nkt = K / 64, nnt = N / 64;
    for (int tile = part; tile < nkt * nnt; tile += nparts) {
        const int kt = tile % nkt, nt = tile / nkt, k0 = kt * 64, n0 = nt * 64;
        __syncthreads();
#pragma unroll
        for (int i = 0; i < 8; ++i) {
            const int idx = tid + 512 * i, k = idx >> 6, n = idx & 63;
            const int sc = colmap(n0 + n);
            ts[k][n] = sc >= 0 ? src[(size_t)(k0 + k) * ldsrc + sc] : 0.f;
        }
        __syncthreads();
        const int n = tid >> 3, k8 = (tid & 7) * 8;
        u32x4 w;
        { h2 a = {(_Float16)ts[k8 + 0][n], (_Float16)ts[k8 + 1][n]}; w.x = __builtin_bit_cast(unsigned, a); }
        { h2 a = {(_Float16)ts[k8 + 2][n], (_Float16)ts[k8 + 3][n]}; w.y = __builtin_bit_cast(unsigned, a); }
        { h2 a = {(_Float16)ts[k8 + 4][n], (_Float16)ts[k8 + 5][n]}; w.z = __builtin_bit_cast(unsigned, a); }
        { h2 a = {(_Float16)ts[k8 + 6][n], (_Float16)ts[k8 + 7][n]}; w.w = __builtin_bit_cast(unsigned, a); }
        *(u32x4*)(dst + (size_t)(n0 + n) * K + k0 + k8) = w;
    }
}
struct CmIdent { __device__ int operator()(int n) const { return n; } };
struct CmWin { __device__ int operator()(int n) const { return n < C_S5U ? n : (n < 4096 ? -1 : n - 184); } };

__device__ void phase0_conv(const Params& p, float* lds) {
    for (int l = 0; l < NL; ++l) {
        conv_transpose(p.w_in + (size_t)l * D * NIN, NIN, D, p.win16 + (size_t)l * NPK * D, NPK, CmWin(), lds, blockIdx.x, gridDim.x);
        for (int n = 0; n < 3; ++n)
            conv_transpose(p.w_branch + ((size_t)l * 3 + n) * W * D, D, W, p.wb16 + ((size_t)l * 3 + n) * D * W, D, CmIdent(), lds, blockIdx.x, gridDim.x);
        conv_transpose(p.w_out + (size_t)l * D * D, D, D, p.wo16 + (size_t)l * D * D, D, CmIdent(), lds, blockIdx.x, gridDim.x);
        conv_transpose(p.glu_w + (size_t)l * W * W, W, W, p.wglu16 + (size_t)l * W * W, W, CmIdent(), lds, blockIdx.x, gridDim.x);
    }
}
namespace pg {
constexpr int BM = 256, BK = 64, HALF = 128, HTB = HALF * BK * 2, STAGE_BYTES = 8 * HTB, NXCD = 8, WGM = 8;
__device__ __forceinline__ int lds_byte(int r, int c) { const int st = (r >> 4) * 2 + (c >> 5), rr = r & 15, cc = c & 31, ob = rr * 64 + cc * 2; return st * 1024 + (ob ^ (((ob >> 9) & 1) << 5)); }
__device__ __forceinline__ void stage_rc(int b, int& R, int& C) { const int st = b / 1024, sb = b % 1024, swz = sb ^ (((sb >> 9) & 1) << 5); R = (st >> 1) * 16 + swz / 64; C = (st & 1) * 32 + (swz % 64) / 2; }
__device__ __forceinline__ int perm32(int rho) { const int n = rho >> 4, i = rho & 15; return 8 * (i >> 2) + 4 * n + (i & 3); }
struct Unit { int pm, pn, aux; const char* A; const char* B; };
__device__ __forceinline__ void tile_of(int L, int nM, int nN, int& pm, int& pn) {
    const int nwg = nM * nN; int wgid = L;
    { const int q = nwg / NXCD, r = nwg % NXCD, xcd = wgid % NXCD, off = wgid / NXCD; wgid = (xcd < r ? xcd * (q + 1) : r * (q + 1) + (xcd - r) * q) + off; }
    const int nig = WGM * nN, gid = wgid / nig, fm = gid * WGM, gsz = (nM - fm) < WGM ? (nM - fm) : WGM;
    pm = fm + ((wgid % nig) % gsz); pn = (wgid % nig) / gsz;
}
template <class Epi, class Sched>
__device__ __forceinline__ void gemm_phase(LAS unsigned char* lds, const int K, const Sched& S, const Epi& E) {
    int tid = tidx();
    const int wid = __builtin_amdgcn_readfirstlane(tid >> 6), lane = tid & 63, wr = wid >> 2, wc = wid & 3, fr = lane & 15, fq = lane >> 4;
    const int nt = K / BK;
    unsigned voffA[2], voffB[2];
#pragma unroll
    for (int i = 0; i < 2; ++i) { int R, C; stage_rc(tid * 16 + i * 8192, R, C); const int Rb = Epi::PERM ? ((R & ~31) + perm32(R & 31)) : R;
        voffA[i] = (unsigned)(R * K + C) * 2u; voffB[i] = (unsigned)(Rb * K + C) * 2u; }
    const size_t kstep = (size_t)(BK * 2);
    const size_t hstep = (size_t)HALF * K * 2;
    const unsigned ldsw = (unsigned)wid * 1024u;
    const int aoff = lds_byte(wr * 64 + fr, fq * 8), boff = lds_byte(wc * 32 + fr, fq * 8);
#define PG_SA(b, h) (((b) * 2 + (h)) * HTB)
#define PG_SB(b, h) ((4 + (b) * 2 + (h)) * HTB)
#define PG_STAGE(bufoff, gbase, voff) do { _Pragma("unroll") for (int _i = 0; _i < 2; ++_i) \
        __builtin_amdgcn_global_load_lds((const unsigned*)((const char*)(gbase) + (voff)[_i]), (LAS unsigned*)(lds + (bufoff) + ldsw + _i * 8192), 16, 0, 0); } while (0)
#define PG_LDA(dst, b, h) do { _Pragma("unroll") for (int m = 0; m < 4; ++m) _Pragma("unroll") for (int k = 0; k < 2; ++k) dst[m][k] = *(const LAS h8*)(lds + PG_SA(b, h) + aoff + m * 2048 + k * 1024); } while (0)
#define PG_LDB(dst, b, h) do { _Pragma("unroll") for (int n = 0; n < 2; ++n) _Pragma("unroll") for (int k = 0; k < 2; ++k) dst[n][k] = *(const LAS h8*)(lds + PG_SB(b, h) + boff + n * 2048 + k * 1024); } while (0)
#define PG_MMA(ai, bj, At, Bt) do { __builtin_amdgcn_s_setprio(1); _Pragma("unroll") for (int m = 0; m < 4; ++m) _Pragma("unroll") for (int n = 0; n < 2; ++n) _Pragma("unroll") for (int k = 0; k < 2; ++k) \
        acc[ai][bj][m][n] = __builtin_amdgcn_mfma_f32_16x16x32_f16(Bt[n][k], At[m][k], acc[ai][bj][m][n], 0, 0, 0); __builtin_amdgcn_s_setprio(0); } while (0)
#define PG_WAIT_V(n) asm volatile("s_waitcnt vmcnt(" #n ")" ::: "memory")
#define PG_WAIT_L(n) asm volatile("s_waitcnt lgkmcnt(" #n ")" ::: "memory")
#define PG_BAR __builtin_amdgcn_s_barrier()
#define PG_SCHED __builtin_amdgcn_sched_barrier(0)
    Unit cur, nxt; int ui = 0;
    if (!S.next(0, cur)) return;
    f32x4 acc[2][2][4][2];
#pragma unroll
    for (int a = 0; a < 2; ++a)
#pragma unroll
        for (int b = 0; b < 2; ++b)
#pragma unroll
            for (int m = 0; m < 4; ++m)
#pragma unroll
                for (int n = 0; n < 2; ++n) acc[a][b][m][n] = (f32x4){0.f, 0.f, 0.f, 0.f};
    h8 At[4][2], B0[2][2], B1[2][2];
    const char* cA = cur.A; const char* cB = cur.B;
    PG_STAGE(PG_SB(0, 0), cB, voffB); PG_STAGE(PG_SA(0, 0), cA, voffA); PG_STAGE(PG_SB(0, 1), cB + hstep, voffB); PG_STAGE(PG_SA(0, 1), cA + hstep, voffA);
    if (wr == 1) PG_BAR;
    PG_WAIT_V(4); PG_BAR;
    PG_STAGE(PG_SB(1, 0), cB + kstep, voffB); PG_STAGE(PG_SA(1, 0), cA + kstep, voffA); PG_STAGE(PG_SB(1, 1), cB + hstep + kstep, voffB);
    PG_WAIT_V(6); PG_BAR;
    for (;;) {
        const bool has_next = S.next(ui + 1, nxt);
        const char* nA = has_next ? nxt.A : cA; const char* nB = has_next ? nxt.B : cB;
        for (int t = 0; t < nt; t += 2) {
            const bool last = (t == nt - 2);
            const char* a1 = cA + (size_t)(t + 1) * kstep;
            const char* a2 = last ? nA : cA + (size_t)(t + 2) * kstep; const char* b2 = last ? nB : cB + (size_t)(t + 2) * kstep;
            const char* a3 = a2 + kstep; const char* b3 = b2 + kstep;
            PG_LDB(B0, 0, 0); PG_SCHED; PG_LDA(At, 0, 0); PG_STAGE(PG_SA(1, 1), a1 + hstep, voffA);
            PG_WAIT_L(8); PG_BAR; PG_WAIT_L(0); PG_MMA(0, 0, At, B0); PG_BAR; PG_SCHED;
            PG_LDB(B1, 0, 1); PG_STAGE(PG_SB(0, 0), b2, voffB);
            PG_BAR; PG_WAIT_L(0); PG_MMA(0, 1, At, B1); PG_BAR;
            PG_LDA(At, 0, 1); PG_STAGE(PG_SA(0, 0), a2, voffA);
            PG_BAR; PG_WAIT_L(0); PG_MMA(1, 0, At, B0); PG_BAR; PG_SCHED;
            PG_STAGE(PG_SB(0, 1), b2 + hstep, voffB);
            PG_WAIT_V(6); PG_BAR; PG_MMA(1, 1, At, B1); PG_BAR;
            PG_LDB(B0, 1, 0); PG_SCHED; PG_LDA(At, 1, 0); PG_STAGE(PG_SA(0, 1), a2 + hstep, voffA);
            PG_WAIT_L(8); PG_BAR; PG_WAIT_L(0); PG_MMA(0, 0, At, B0); PG_BAR; PG_SCHED;
            PG_LDB(B1, 1, 1); PG_STAGE(PG_SB(1, 0), b3, voffB);
            PG_BAR; PG_WAIT_L(0); PG_MMA(0, 1, At, B1); PG_BAR;
            PG_LDA(At, 1, 1); PG_STAGE(PG_SA(1, 0), a3, voffA);
            PG_BAR; PG_WAIT_L(0); PG_MMA(1, 0, At, B0); PG_BAR; PG_SCHED;
            PG_STAGE(PG_SB(1, 1), b3 + hstep, voffB);
            PG_WAIT_V(6); PG_BAR; PG_MMA(1, 1, At, B1); PG_BAR;
        }
        E(acc, cur, wr, wc, fr, fq);
        if (!has_next) break;
#pragma unroll
        for (int a = 0; a < 2; ++a)
#pragma unroll
            for (int b = 0; b < 2; ++b)
#pragma unroll
                for (int m = 0; m < 4; ++m)
#pragma unroll
                    for (int n = 0; n < 2; ++n) acc[a][b][m][n] = (f32x4){0.f, 0.f, 0.f, 0.f};
        cur = nxt; cA = nA; cB = nB; ++ui;
    }
    PG_WAIT_V(0);
    if (wr == 0) PG_BAR;
    PG_BAR;
#undef PG_SA
#undef PG_SB
#undef PG_STAGE
#undef PG_LDA
#undef PG_LDB
#undef PG_MMA
#undef PG_WAIT_V
#undef PG_WAIT_L
#undef PG_BAR
#undef PG_SCHED
}
}
__device__ __forceinline__ float fsig(float v) { return 1.f / (1.f + __expf(-v)); }
__device__ __forceinline__ float fsilu(float v) { return v / (1.f + __expf(-v)); }
__device__ __forceinline__ u32x4 pack8(const f32x4 a, const f32x4 b) {
    const h8 v = {(_Float16)a[0], (_Float16)a[1], (_Float16)a[2], (_Float16)a[3], (_Float16)b[0], (_Float16)b[1], (_Float16)b[2], (_Float16)b[3]};
    return __builtin_bit_cast(u32x4, v);
}
__device__ __forceinline__ void unpack8(const u32x4 w, float (&o)[8]) {
    const h8 v = __builtin_bit_cast(h8, w);
#pragma unroll
    for (int j = 0; j < 8; ++j) o[j] = (float)v[j];
}
struct SchedPlain {
    const char* A; const char* B; int nM, nN, G, c, K;
    __device__ bool next(int i, pg::Unit& u) const {
        const long L = (long)i * G + c; if (L >= (long)nM * nN) return false;
        pg::tile_of((int)L, nM, nN, u.pm, u.pn); u.aux = 0;
        u.A = A + (size_t)u.pm * 256 * K * 2; u.B = B + (size_t)u.pn * 256 * K * 2; return true;
    }
};
struct SchedMerge {
    const char* ys; const char* wb; int G, c;
    __device__ bool next(int i, pg::Unit& u) const {
        const int r = i / 3, n = i - 3 * r; const long L = (long)r * G + c; if (L >= 64 * 4) return false;
        pg::tile_of((int)L, 64, 4, u.pm, u.pn); u.aux = n;
        u.A = ys + ((size_t)n * T + (size_t)u.pm * 256) * W * 2; u.B = wb + ((size_t)n * D + (size_t)u.pn * 256) * W * 2; return true;
    }
};

template <int ACT> __device__ __forceinline__ f32x4 actv(f32x4 v) {
    if (ACT == 1) { for (int j = 0; j < 4; ++j) v[j] = fsilu(v[j]); }
    if (ACT == 2) { for (int j = 0; j < 4; ++j) v[j] = fsig(v[j]); }
    return v;
}
template <int ACT> __device__ __forceinline__ void st16(const f32x4 (&acc)[2][2][4][2], __half* base, int ld, int c8, int bj0, int bj1) {
#pragma unroll
    for (int ai = 0; ai < 2; ++ai)
#pragma unroll
        for (int m = 0; m < 4; ++m) {
            __half* rowp = base + (size_t)(ai * 128 + m * 16) * ld + c8;
#pragma unroll
            for (int bj = 0; bj < 2; ++bj) if (bj >= bj0 && bj < bj1)
                *(u32x4*)(rowp + (bj - bj0) * 128) = pack8(actv<ACT>(acc[ai][bj][m][0]), actv<ACT>(acc[ai][bj][m][1]));
        }
}
struct EpiProj {
    static constexpr bool PERM = true;
    __half *q16, *v16, *hgg16, *atq16, *atk16, *atv16, *atg16, *ixq16, *ixk16, *s5u16, *s5g16, *mg16; float *lf32, *ixw32; const float* lb;
    __device__ __forceinline__ void operator()(const f32x4 (&acc)[2][2][4][2], const pg::Unit& u, int wr, int wc, int fr, int fq) const {
        const size_t row0 = (size_t)u.pm * 256 + wr * 64 + fr; const int c8 = wc * 32 + 8 * fq, pn = u.pn;
        if (pn < 2)        st16<0>(acc, q16 + row0 * W + pn * 256, W, c8, 0, 2);
        else if (pn < 4) {
            const int cb = (pn - 2) * 256 + c8;
#pragma unroll
            for (int bj = 0; bj < 2; ++bj) {
                const f32x4 l0 = *(const f32x4*)(lb + cb + bj * 128), l1 = *(const f32x4*)(lb + cb + bj * 128 + 4);
#pragma unroll
                for (int ai = 0; ai < 2; ++ai)
#pragma unroll
                    for (int m = 0; m < 4; ++m) {
                        f32x4 a = acc[ai][bj][m][0], b = acc[ai][bj][m][1];
#pragma unroll
                        for (int j = 0; j < 4; ++j) { a[j] = __logf(fmaxf(l0[j] + (1.f - l0[j]) * fsig(a[j]), 1e-30f)); b[j] = __logf(fmaxf(l1[j] + (1.f - l1[j]) * fsig(b[j]), 1e-30f)); }
                        float* o = lf32 + (row0 + ai * 128 + m * 16) * W + cb + bj * 128;
                        *(f32x4*)o = a; *(f32x4*)(o + 4) = b;
                    }
            }
        }
        else if (pn < 6)   st16<0>(acc, v16 + row0 * W + (pn - 4) * 256, W, c8, 0, 2);
        else if (pn < 8)   st16<1>(acc, hgg16 + row0 * W + (pn - 6) * 256, W, c8, 0, 2);
        else if (pn < 10)  st16<0>(acc, atq16 + row0 * W + (pn - 8) * 256, W, c8, 0, 2);
        else if (pn == 10) { st16<0>(acc, atk16 + row0 * 128, 128, c8, 0, 1); st16<0>(acc, atv16 + row0 * 128, 128, c8, 1, 2); }
        else if (pn < 13)  st16<1>(acc, atg16 + row0 * W + (pn - 11) * 256, W, c8, 0, 2);
        else if (pn < 15)  st16<0>(acc, ixq16 + row0 * W + (pn - 13) * 256, W, c8, 0, 2);
        else if (pn == 15) {
            if (wc < 2) {
#pragma unroll
                for (int ai = 0; ai < 2; ++ai)
#pragma unroll
                    for (int m = 0; m < 4; ++m) *(u32x4*)(ixk16 + (row0 + ai * 128 + m * 16) * 64 + c8) = pack8(acc[ai][0][m][0], acc[ai][0][m][1]);
            } else if (wc == 2 && fq == 0) {
#pragma unroll
                for (int ai = 0; ai < 2; ++ai)
#pragma unroll
                    for (int m = 0; m < 4; ++m) { float* o = ixw32 + (row0 + ai * 128 + m * 16) * 8; *(f32x4*)o = acc[ai][0][m][0]; *(f32x4*)(o + 4) = acc[ai][0][m][1]; }
            }
        }
        else if (pn < 18)  st16<0>(acc, s5u16 + row0 * W + (pn - 16) * 256, W, c8, 0, 2);
        else if (pn < 20)  st16<1>(acc, s5g16 + row0 * W + (pn - 18) * 256, W, c8, 0, 2);
        else               st16<2>(acc, mg16 + row0 * 3072 + (pn - 20) * 256, 3072, c8, 0, 2);
    }
};
struct EpiGlu {
    static constexpr bool PERM = true;
    const __half* ypre16; const __half* s5g16; const float* bias; __half* yc; float* raw;
    __device__ __forceinline__ void operator()(const f32x4 (&acc)[2][2][4][2], const pg::Unit& u, int wr, int wc, int fr, int fq) const {
        const size_t row0 = (size_t)u.pm * 256 + wr * 64 + fr; const int c0 = u.pn * 256 + wc * 32 + 8 * fq;
#pragma unroll
        for (int bj = 0; bj < 2; ++bj) {
            const int col = c0 + bj * 128;
            const f32x4 b0 = *(const f32x4*)(bias + col), b1 = *(const f32x4*)(bias + col + 4);
#pragma unroll
            for (int ai = 0; ai < 2; ++ai)
#pragma unroll
                for (int m = 0; m < 4; ++m) {
                    const size_t off = (row0 + ai * 128 + m * 16) * W + col;
                    float y[8], g[8]; unpack8(*(const u32x4*)(ypre16 + off), y); unpack8(*(const u32x4*)(s5g16 + off), g);
                    f32x4 a = acc[ai][bj][m][0] + b0, b = acc[ai][bj][m][1] + b1;
                    if (raw) { *(f32x4*)(raw + (row0 + ai * 128 + m * 16) * D + col) = acc[ai][bj][m][0]; *(f32x4*)(raw + (row0 + ai * 128 + m * 16) * D + col + 4) = acc[ai][bj][m][1]; }
#pragma unroll
                    for (int j = 0; j < 4; ++j) { a[j] = y[j] * fsig(a[j]) * g[j]; b[j] = y[4 + j] * fsig(b[j]) * g[4 + j]; }
                    *(u32x4*)(yc + off) = pack8(a, b);
                }
        }
    }
};
struct EpiMerge {
    static constexpr bool PERM = true;
    const __half* mg16; float* mp32; __half* merged16;
    __device__ __forceinline__ void operator()(const f32x4 (&acc)[2][2][4][2], const pg::Unit& u, int wr, int wc, int fr, int fq) const {
        const size_t row0 = (size_t)u.pm * 256 + wr * 64 + fr; const int c0 = u.pn * 256 + wc * 32 + 8 * fq, n = u.aux;
#pragma unroll
        for (int ai = 0; ai < 2; ++ai)
#pragma unroll
            for (int m = 0; m < 4; ++m)
#pragma unroll
                for (int bj = 0; bj < 2; ++bj) {
                    const size_t r = row0 + ai * 128 + m * 16; const int col = c0 + bj * 128;
                    float g[8]; unpack8(*(const u32x4*)(mg16 + r * 3072 + n * D + col), g);
                    f32x4 a = acc[ai][bj][m][0], b = acc[ai][bj][m][1];
#pragma unroll
                    for (int j = 0; j < 4; ++j) { a[j] *= g[j]; b[j] *= g[4 + j]; }
                    float* pp = mp32 + r * D + col;
                    if (n > 0) { a += *(const f32x4*)pp; b += *(const f32x4*)(pp + 4); }
                    if (n < 2) { *(f32x4*)pp = a; *(f32x4*)(pp + 4) = b; }
                    else *(u32x4*)(merged16 + r * D + col) = pack8(a, b);
                }
    }
};
struct EpiOut {
    static constexpr bool PERM = false;
    const float* xin; float* out; const float* gate;
    __device__ __forceinline__ void operator()(const f32x4 (&acc)[2][2][4][2], const pg::Unit& u, int wr, int wc, int fr, int fq) const {
        const size_t row0 = (size_t)u.pm * 256 + wr * 64 + fr; const int c0 = u.pn * 256 + wc * 32 + 4 * fq;
        const int b = (u.pm * 256) / S;
#pragma unroll
        for (int bj = 0; bj < 2; ++bj)
#pragma unroll
            for (int n = 0; n < 2; ++n) {
                const int col = c0 + bj * 128 + n * 16;
                const f32x4 gv = *(const f32x4*)(gate + (size_t)b * 3072 + col);
#pragma unroll
                for (int ai = 0; ai < 2; ++ai)
#pragma unroll
                    for (int m = 0; m < 4; ++m) {
                        const size_t off = (row0 + ai * 128 + m * 16) * D + col;
                        *(f32x4*)(out + off) = *(const f32x4*)(xin + off) + gv * acc[ai][bj][m][n];
                    }
            }
    }
};
__device__ void phase_fix(const Params& p, int l, float* lds) {
    {
        __half* tl = (__half*)lds;
        const int tid = tidx();
        for (int tile = blockIdx.x; tile < T / 64; tile += gridDim.x) {
            const int t0 = tile * 64, b = t0 / S, s0 = t0 % S;
            __syncthreads();
            for (int i = tid; i < 64 * 64; i += 512) { const int tt = i >> 6, e2 = (i & 63) * 2; *(h2*)(tl + tt * 130 + e2) = *(const h2*)(p.atv16 + (size_t)(t0 + tt) * 128 + e2); }
            __syncthreads();
            const int e = tid >> 2, part = tid & 3;
            h8 v0, v1;
#pragma unroll
            for (int j = 0; j < 8; ++j) { v0[j] = (_Float16)tl[(part * 16 + j) * 130 + e]; v1[j] = (_Float16)tl[(part * 16 + 8 + j) * 130 + e]; }
            __half* dst = p.atvT16 + (size_t)(b * 128 + e) * S + s0 + part * 16;
            *(h8*)dst = v0; *(h8*)(dst + 8) = v1;
        }
    }
    const int w = tidx() >> 6, lane = tidx() & 63;
    for (int t = blockIdx.x * 8 + w; t < T; t += gridDim.x * 8) {
        const float cA = p.ropeA[((size_t)t * 64 + lane) * 2], sA = p.ropeA[((size_t)t * 64 + lane) * 2 + 1];
        for (int hh = 0; hh < 5; ++hh) {
            __half* q = hh < 4 ? p.atq16 + (size_t)t * W + hh * 128 : p.atk16 + (size_t)t * 128;
            const float* g = hh < 4 ? p.qn_g + l * 128 : p.kn_g + l * 128;
            const float x1 = __half2float(q[lane]), x2 = __half2float(q[64 + lane]);
            const float ss = wave_sum(x1 * x1 + x2 * x2);
            const float r = rsqrtf(ss * (1.f / 128.f) + EPS);
            const float a = x1 * r * g[lane], b2 = x2 * r * g[64 + lane];
            q[lane] = __float2half(a * cA - b2 * sA); q[64 + lane] = __float2half(b2 * cA + a * sA);
        }
        for (int i = 0; i < 5; ++i) {
            const int idx = lane + 64 * i;
            if (i == 4 && lane >= 32) break;
            const int hh = idx >> 5, j = idx & 31;
            __half* q = i < 4 ? p.ixq16 + (size_t)t * W + hh * 64 : p.ixk16 + (size_t)t * 64;
            const float cI = p.ropeI[((size_t)t * 32 + j) * 2], sI = p.ropeI[((size_t)t * 32 + j) * 2 + 1];
            const float x1 = __half2float(q[j]), x2 = __half2float(q[32 + j]);
            q[j] = __float2half(x1 * cI - x2 * sI); q[32 + j] = __float2half(x2 * cI + x1 * sI);
        }
    }
}

__device__ void mixC(const Params& p, int l, int item, float* lds) {
    const int w = tidx() >> 6, lane = tidx() & 63;
    const int idx = item * 8 + w, b = idx >> 5, g = idx & 31;
    float* wl = lds + w * 3328;
    float* cre = wl; float* cim = cre + 16 * 65; float* xrs = cim + 16 * 65; float* xis = xrs + 512; float* us = xis + 512;
    const size_t lg = (size_t)l * 32 + g;
    const float abr = p.abar[(lg * 64 + lane) * 2], abi = p.abar[(lg * 64 + lane) * 2 + 1];
    float bre[16], bim[16];
#pragma unroll
    for (int c = 0; c < 16; ++c) { bre[c] = p.bbar[((lg * 64 + lane) * 16 + c) * 2]; bim[c] = p.bbar[((lg * 64 + lane) * 16 + c) * 2 + 1]; }
    for (int c = 0; c < 16; ++c) { cre[c * 65 + lane] = p.c_re[(lg * 16 + c) * 64 + lane]; cim[c * 65 + lane] = p.c_im[(lg * 16 + c) * 64 + lane]; }
    float xr = 0.f, xi = 0.f;
    for (int t0 = 0; t0 < S; t0 += 8) {
#pragma unroll
        for (int i = 0; i < 2; ++i) { const int q = lane + 64 * i; us[q] = __half2float(p.s5u16[(size_t)(b * S + t0 + (q >> 4)) * W + g * 16 + (q & 15)]); }
        __syncthreads();
#pragma unroll 1
        for (int tt = 0; tt < 8; ++tt) {
            float bur = 0.f, bui = 0.f;
#pragma unroll
            for (int c = 0; c < 16; ++c) { const float u = us[tt * 16 + c]; bur += u * bre[c]; bui += u * bim[c]; }
            const float nxr = abr * xr - abi * xi + bur, nxi = abr * xi + abi * xr + bui;
            xr = nxr; xi = nxi;
            xrs[tt * 64 + lane] = xr; xis[tt * 64 + lane] = xi;
        }
        __syncthreads();
#pragma unroll
        for (int i = 0; i < 2; ++i) {
            const int q = lane + 64 * i, tt = q >> 4, c = q & 15;
            float y = 0.f;
#pragma unroll 8
            for (int s = 0; s < 64; ++s) y += cre[c * 65 + s] * xrs[tt * 64 + s] - cim[c * 65 + s] * xis[tt * 64 + s];
            y += p.s5_d[l * W + g * 16 + c] * us[q];
            p.ypre16[(size_t)(b * S + t0 + tt) * W + g * 16 + c] = __float2half(gelu_tanh_f(y));
        }
        __syncthreads();
    }
}
__device__ __forceinline__ unsigned f2key(float f) { const unsigned u = __float_as_uint(f); return (u & 0x80000000u) ? ~u : (u | 0x80000000u); }
typedef float f32x16 __attribute__((ext_vector_type(16)));
typedef _Float16 h4 __attribute__((ext_vector_type(4)));
__device__ void dsa_select(const Params& p, int b, int q0, float* lds) {
    const int tid = tidx(), w = tid >> 6, lane = tid & 63, half = lane >> 5, col = lane & 31;
    float* sc = lds;
    {
        const int wq = w & 3, par = w >> 2;
        const int blk = col >> 2, wi = col & 3, ql = 2 * (blk & 1) + (blk >> 2), head = 4 * ((blk >> 1) & 1) + wi;
        const __half* qrow = p.ixq16 + (size_t)(b * S + q0 + wq * 4 + ql) * W + head * 64 + 8 * half;
        h8 af[4];
#pragma unroll
        for (int ks = 0; ks < 4; ++ks) af[ks] = *(const h8*)(qrow + 16 * ks);
        const int qa = wq * 4 + 2 * half;
        float iw0[8], iw1[8];
#pragma unroll
        for (int hh = 0; hh < 8; ++hh) { iw0[hh] = p.ixw32[(size_t)(b * S + q0 + qa) * 8 + hh]; iw1[hh] = p.ixw32[(size_t)(b * S + q0 + qa + 1) * 8 + hh]; }
        const int ntiles = (q0 + 15) / 32 + 1;
        for (int kt = par; kt < ntiles; kt += 2) {
            const int key = kt * 32 + col;
            const __half* krow = p.ixk16 + (size_t)(b * S + key) * 64 + 8 * half;
            f32x16 acc;
#pragma unroll
            for (int r = 0; r < 16; ++r) acc[r] = 0.f;
#pragma unroll
            for (int ks = 0; ks < 4; ++ks) acc = __builtin_amdgcn_mfma_f32_32x32x16_f16(af[ks], *(const h8*)(krow + 16 * ks), acc, 0, 0, 0);
            float s0 = 0.f, s1 = 0.f;
#pragma unroll
            for (int r = 0; r < 8; ++r) { s0 += fmaxf(acc[r], 0.f) * iw0[r]; s1 += fmaxf(acc[8 + r], 0.f) * iw1[r]; }
            sc[qa * 2048 + key] = key <= q0 + qa ? s0 : -INFINITY;
            sc[(qa + 1) * 2048 + key] = key <= q0 + qa + 1 ? s1 : -INFINITY;
        }
        for (int i = ntiles * 32 + tid; i < 2048; i += 512) {
#pragma unroll
            for (int q = 0; q < 16; ++q) sc[q * 2048 + i] = -INFINITY;
        }
    }
    __syncthreads();
    for (int qq = 0; qq < 2; ++qq) {
        const int ql = 2 * w + qq, qi = q0 + ql;
        const float* scl = sc + ql * 2048;
        const bool all = qi + 1 <= 256;
        unsigned thr = 0; int rrem = 0;
        if (!all) {
            unsigned key[32];
#pragma unroll
            for (int i = 0; i < 32; ++i) key[i] = f2key(scl[lane + 64 * i]);
            unsigned prefix = 0;
#pragma unroll 1
            for (int bit = 31; bit >= 0; --bit) {
                const unsigned cand = prefix | (1u << bit);
                int c = 0;
#pragma unroll
                for (int i = 0; i < 32; ++i) c += (key[i] >= cand) ? 1 : 0;
#pragma unroll
                for (int o = 32; o > 0; o >>= 1) c += __shfl_xor(c, o);
                if (c >= 256) prefix = cand;
            }
            int c = 0;
#pragma unroll
            for (int i = 0; i < 32; ++i) c += (key[i] > prefix) ? 1 : 0;
#pragma unroll
            for (int o = 32; o > 0; o >>= 1) c += __shfl_xor(c, o);
            thr = prefix; rrem = 256 - c;
        }
        const unsigned long long lt = (1ull << lane) - 1ull;
        unsigned mylo = 0, myhi = 0;
#pragma unroll 1
        for (int i = 0; i < 32; ++i) {
            const int s = lane + 64 * i;
            const unsigned k = f2key(scl[s]);
            bool sl;
            if (all) sl = s <= qi;
            else {
                const bool eq = k == thr;
                const unsigned long long m = __ballot(eq);
                sl = (k > thr) || (eq && __popcll(m & lt) < rrem);
                rrem -= __popcll(m); if (rrem < 0) rrem = 0;
            }
            const unsigned long long m2 = __ballot(sl);
            if (lane == i) { mylo = (unsigned)m2; myhi = (unsigned)(m2 >> 32); }
        }
        if (lane < 32) *(uint2*)(p.mask + (size_t)(b * S + qi) * 64 + 2 * lane) = make_uint2(mylo, myhi);
    }
    __syncthreads();
}

__device__ void dsa_attend(const Params& p, int b, int g) {
    const int lane = tidx() & 63, half = lane >> 5, col = lane & 31;
    const int q0 = 8 * g, qi = q0 + (col >> 2), hd = col & 3;
    const __half* qp = p.atq16 + (size_t)(b * S + qi) * W + hd * 128 + 8 * half;
    h8 qf[8];
#pragma unroll
    for (int ks = 0; ks < 8; ++ks) qf[ks] = *(const h8*)(qp + 16 * ks);
    f32x16 o[4];
#pragma unroll
    for (int et = 0; et < 4; ++et)
#pragma unroll
        for (int r = 0; r < 16; ++r) o[et][r] = 0.f;
    float m = -INFINITY, l = 0.f;
    const int ntiles = (q0 + 7) / 32 + 1;
    const unsigned* mrow = p.mask + (size_t)(b * S + qi) * 64;
    const float scale = 0.08838834764831845f;
#pragma unroll 1
    for (int kt = 0; kt < ntiles; ++kt) {
        const __half* kp = p.atk16 + (size_t)(b * S + kt * 32 + col) * 128 + 8 * half;
        f32x16 s;
#pragma unroll
        for (int r = 0; r < 16; ++r) s[r] = 0.f;
#pragma unroll
        for (int ks = 0; ks < 8; ++ks) s = __builtin_amdgcn_mfma_f32_32x32x16_f16(*(const h8*)(kp + 16 * ks), qf[ks], s, 0, 0, 0);
        const unsigned mw = mrow[kt];
        float tmax = -INFINITY;
#pragma unroll
        for (int r = 0; r < 16; ++r) {
            const int bit = (r & 3) + 8 * (r >> 2) + 4 * half;
            s[r] = ((mw >> bit) & 1u) ? s[r] * scale : -INFINITY;
            tmax = fmaxf(tmax, s[r]);
        }
        tmax = fmaxf(tmax, __shfl_xor(tmax, 32));
        const float mn = fmaxf(m, tmax);
        const float ms = mn == -INFINITY ? 0.f : mn;
        const float cs = __expf(m - ms);
        float ps = 0.f;
#pragma unroll
        for (int r = 0; r < 16; ++r) { s[r] = __expf(s[r] - ms); ps += s[r]; }
        l = l * cs + ps; m = mn;
#pragma unroll
        for (int et = 0; et < 4; ++et)
#pragma unroll
            for (int r = 0; r < 16; ++r) o[et][r] *= cs;
        h8 pb[2];
#pragma unroll
        for (int s2 = 0; s2 < 2; ++s2)
#pragma unroll
            for (int j = 0; j < 8; ++j) pb[s2][j] = (_Float16)s[8 * s2 + j];
#pragma unroll
        for (int et = 0; et < 4; ++et) {
            const __half* vp = p.atvT16 + (size_t)(b * 128 + 32 * et + col) * S + kt * 32 + 4 * half;
#pragma unroll
            for (int s2 = 0; s2 < 2; ++s2) {
                const h4 v0 = *(const h4*)(vp + 16 * s2), v1 = *(const h4*)(vp + 16 * s2 + 8);
                const h8 vf = {v0[0], v0[1], v0[2], v0[3], v1[0], v1[1], v1[2], v1[3]};
                o[et] = __builtin_amdgcn_mfma_f32_32x32x16_f16(vf, pb[s2], o[et], 0, 0, 0);
            }
        }
    }
    l += __shfl_xor(l, 32);
    const float inv = 1.f / l;
    __half* yb = p.ys + (size_t)T * W + (size_t)(b * S + qi) * W + hd * 128;
    const __half* gp = p.atg16 + (size_t)(b * S + qi) * W + hd * 128;
#pragma unroll
    for (int et = 0; et < 4; ++et)
#pragma unroll
        for (int r4 = 0; r4 < 4; ++r4) {
            const int e0 = 32 * et + 8 * r4 + 4 * half;
            const h4 gv = *(const h4*)(gp + e0);
            h4 ov;
#pragma unroll
            for (int j = 0; j < 4; ++j) ov[j] = (_Float16)(o[et][4 * r4 + j] * inv * (float)gv[j]);
            *(h4*)(yb + e0) = ov;
        }
}

typedef __bf16 bf8 __attribute__((ext_vector_type(8)));
constexpr int HG_QS = 136;
constexpr int HG_VS = 72;
__device__ __forceinline__ void hg_cumsum(const Params& p, int tok0, int hd, int tid, float* segt, float (&lf)[16], float (&bcs)[16], float& blast, float& bref) {
    const int d = tid & 127, seg = tid >> 7;
    float run = 0.f;
#pragma unroll
    for (int i = 0; i < 16; ++i) { lf[i] = p.lf32[(size_t)(tok0 + seg * 16 + i) * W + hd * 128 + d]; run += lf[i]; bcs[i] = run; }
    segt[seg * 128 + d] = run;
    __syncthreads();
    const float s0 = segt[d], s1 = segt[128 + d], s2 = segt[256 + d], s3 = segt[384 + d];
    const float off = seg == 0 ? 0.f : (seg == 1 ? s0 : (seg == 2 ? s0 + s1 : s0 + s1 + s2));
#pragma unroll
    for (int i = 0; i < 16; ++i) bcs[i] += off;
    blast = s0 + s1 + s2 + s3; bref = s0 + s1;
}
__device__ __forceinline__ void hg_load_vt(const Params& p, int tok0, int hd, int tid, __half* VT) {
    const int e = tid & 127, seg = tid >> 7;
    h8 v0, v1;
#pragma unroll
    for (int i = 0; i < 8; ++i) { v0[i] = __builtin_bit_cast(_Float16, p.v16[(size_t)(tok0 + seg * 16 + i) * W + hd * 128 + e]); v1[i] = __builtin_bit_cast(_Float16, p.v16[(size_t)(tok0 + seg * 16 + 8 + i) * W + hd * 128 + e]); }
    *(h8*)(VT + e * HG_VS + seg * 16) = v0; *(h8*)(VT + e * HG_VS + seg * 16 + 8) = v1;
}
__device__ void hg_pass1(const Params& p, int u, float* lds) {
    const int tid = tidx(), w = tid >> 6, lane = tid & 63, half = lane >> 5, col = lane & 31;
    const int c = u & 31, bh = u >> 5, hd = bh & 3, b = bh >> 2, tok0 = b * S + c * 64;
    __half* KH = (__half*)lds;
    __half* VT = KH + 128 * HG_VS;
    float* segt = (float*)(VT + 128 * HG_VS);
    __syncthreads();
    float lf[16], bcs[16], blast, bref;
    hg_cumsum(p, tok0, hd, tid, segt, lf, bcs, blast, bref);
    {
        const int d = tid & 127, seg = tid >> 7;
        h8 k0, k1;
#pragma unroll
        for (int i = 0; i < 8; ++i) { k0[i] = (_Float16)((1.f - __expf(lf[i])) * __expf(blast - bcs[i])); k1[i] = (_Float16)((1.f - __expf(lf[8 + i])) * __expf(blast - bcs[8 + i])); }
        *(h8*)(KH + d * HG_VS + seg * 16) = k0; *(h8*)(KH + d * HG_VS + seg * 16 + 8) = k1;
        if (seg == 0) p.dec32[(size_t)u * 128 + d] = __expf(blast);
    }
    hg_load_vt(p, tok0, hd, tid, VT);
    __syncthreads();
    const int dt = w >> 1;
    h8 af[4];
#pragma unroll
    for (int ks = 0; ks < 4; ++ks) af[ks] = *(const h8*)(KH + (dt * 32 + col) * HG_VS + 16 * ks + 8 * half);
#pragma unroll
    for (int ee = 0; ee < 2; ++ee) {
        const int et = (w & 1) * 2 + ee;
        f32x16 acc;
#pragma unroll
        for (int r = 0; r < 16; ++r) acc[r] = 0.f;
#pragma unroll
        for (int ks = 0; ks < 4; ++ks) acc = __builtin_amdgcn_mfma_f32_32x32x16_f16(af[ks], *(const h8*)(VT + (et * 32 + col) * HG_VS + 16 * ks + 8 * half), acc, 0, 0, 0);
        __half* dst = p.stT16 + ((size_t)u * 128 + et * 32 + col) * 128 + dt * 32 + 4 * half;
#pragma unroll
        for (int r4 = 0; r4 < 4; ++r4) { h4 o = {(_Float16)acc[4 * r4], (_Float16)acc[4 * r4 + 1], (_Float16)acc[4 * r4 + 2], (_Float16)acc[4 * r4 + 3]}; *(h4*)(dst + 8 * r4) = o; }
    }
}
__device__ void hg_scan(const Params& p) {
    const int gt = blockIdx.x * 512 + tidx();
    if (gt >= 32 * 128 * 16) return;
    const int d8 = (gt & 15) * 8, e = (gt >> 4) & 127, bh = gt >> 11;
    float s[8];
#pragma unroll
    for (int j = 0; j < 8; ++j) s[j] = 0.f;
    for (int c = 0; c < 32; ++c) {
        const size_t u = (size_t)bh * 32 + c;
        h8* ptr = (h8*)(p.stT16 + (u * 128 + e) * 128 + d8);
        const h8 t = *ptr;
        const f32x4 g0 = *(const f32x4*)(p.dec32 + u * 128 + d8), g1 = *(const f32x4*)(p.dec32 + u * 128 + d8 + 4);
        h8 o;
#pragma unroll
        for (int j = 0; j < 8; ++j) o[j] = (_Float16)s[j];
        *ptr = o;
#pragma unroll
        for (int j = 0; j < 4; ++j) { s[j] = g0[j] * s[j] + (float)t[j]; s[4 + j] = g1[j] * s[4 + j] + (float)t[4 + j]; }
    }
}
__device__ void hg_pass3(const Params& p, int l, int u, float* lds) {
    const int tid = tidx(), w = tid >> 6, lane = tid & 63, half = lane >> 5, col = lane & 31;
    const int c = u & 31, bh = u >> 5, hd = bh & 3, b = bh >> 2, tok0 = b * S + c * 64;
    __half* QI = (__half*)lds;
    __bf16* QM = (__bf16*)(QI + 64 * HG_QS);
    __bf16* KM = QM + 64 * HG_QS;
    __half* VT = (__half*)(KM + 64 * HG_QS);
    float* segt = (float*)(VT + 128 * HG_VS);
    float* part = segt + 512;
    __syncthreads();
    float lf[16], bcs[16], blast, bref;
    hg_cumsum(p, tok0, hd, tid, segt, lf, bcs, blast, bref);
    {
        const int d = tid & 127, seg = tid >> 7;
#pragma unroll
        for (int i = 0; i < 16; ++i) {
            const int tk = seg * 16 + i;
            const float q = __half2float(p.q16[(size_t)(tok0 + tk) * W + hd * 128 + d]);
            QI[tk * HG_QS + d] = __float2half(q * __expf(bcs[i]));
            QM[tk * HG_QS + d] = (__bf16)(q * __expf(bcs[i] - bref));
            KM[tk * HG_QS + d] = (__bf16)((1.f - __expf(lf[i])) * __expf(bref - bcs[i]));
        }
    }
    hg_load_vt(p, tok0, hd, tid, VT);
    __syncthreads();
    const int tt = w & 1, et = w >> 1;
    h8 pb[2][2];
    bf8 qm[8];
#pragma unroll
    for (int ks = 0; ks < 8; ++ks) qm[ks] = *(const bf8*)(QM + (tt * 32 + col) * HG_QS + 16 * ks + 8 * half);
#pragma unroll
    for (int st = 0; st < 2; ++st) {
        if (st <= tt) {
            f32x16 sacc;
#pragma unroll
            for (int r = 0; r < 16; ++r) sacc[r] = 0.f;
#pragma unroll
            for (int ks = 0; ks < 8; ++ks) sacc = __builtin_amdgcn_mfma_f32_32x32x16_bf16(*(const bf8*)(KM + (st * 32 + col) * HG_QS + 16 * ks + 8 * half), qm[ks], sacc, 0, 0, 0);
#pragma unroll
            for (int r = 0; r < 16; ++r) {
                const int sl = (r & 3) + 8 * (r >> 2) + 4 * half;
                const float v = (st < tt || sl <= col) ? sacc[r] : 0.f;
                pb[st][r >> 3][r & 7] = (_Float16)v;
            }
        } else {
#pragma unroll
            for (int j = 0; j < 8; ++j) { pb[st][0][j] = (_Float16)0.f; pb[st][1][j] = (_Float16)0.f; }
        }
    }
    f32x16 o;
#pragma unroll
    for (int r = 0; r < 16; ++r) o[r] = 0.f;
#pragma unroll
    for (int st = 0; st < 2; ++st) {
        if (st <= tt) {
#pragma unroll
            for (int s2 = 0; s2 < 2; ++s2) {
                const __half* vp = VT + (et * 32 + col) * HG_VS + st * 32 + 16 * s2 + 4 * half;
                const h4 v0 = *(const h4*)vp, v1 = *(const h4*)(vp + 8);
                const h8 vf = {v0[0], v0[1], v0[2], v0[3], v1[0], v1[1], v1[2], v1[3]};
                o = __builtin_amdgcn_mfma_f32_32x32x16_f16(vf, pb[st][s2], o, 0, 0, 0);
            }
        }
    }
    {
        const __half* sp = p.stT16 + ((size_t)u * 128 + et * 32 + col) * 128 + 8 * half;
#pragma unroll
        for (int ks = 0; ks < 8; ++ks) o = __builtin_amdgcn_mfma_f32_32x32x16_f16(*(const h8*)(sp + 16 * ks), *(const h8*)(QI + (tt * 32 + col) * HG_QS + 16 * ks + 8 * half), o, 0, 0, 0);
    }
    float ss = 0.f;
#pragma unroll
    for (int r = 0; r < 16; ++r) ss += o[r] * o[r];
    ss += __shfl_xor(ss, 32);
    if (half == 0) part[et * 64 + tt * 32 + col] = ss;
    __syncthreads();
    const int tk = tt * 32 + col;
    const float tot = part[tk] + part[64 + tk] + part[128 + tk] + part[192 + tk];
    const float rs = rsqrtf(tot * (1.f / 128.f) + EPS);
    const float* on = p.onorm_g + l * 128;
    const size_t ob = (size_t)(tok0 + tk) * W + hd * 128;
#pragma unroll
    for (int r4 = 0; r4 < 4; ++r4) {
        const int e0 = et * 32 + 8 * r4 + 4 * half;
        const h4 gv = *(const h4*)(p.hgg16 + ob + e0);
        const f32x4 nv = *(const f32x4*)(on + e0);
        h4 ov;
#pragma unroll
        for (int j = 0; j < 4; ++j) ov[j] = (_Float16)(o[4 * r4 + j] * rs * nv[j] * (float)gv[j]);
        *(h4*)(p.ys + ob + e0) = ov;
    }
}

__device__ void phase_mix1(const Params& p, int l, float* lds) {
    const int c = blockIdx.x, G = gridDim.x;
    if (c < 32) { mixC(p, l, c, lds); return; }
    for (int u = c - 32; u < 1024; u += G - 32) hg_pass1(p, u, lds);
    __syncthreads();
    for (int it = c - 32; it < NB * 64; it += G - 32) { const int b = it >> 6, jp = it & 63; dsa_select(p, b, jp * 16, lds); dsa_select(p, b, (127 - jp) * 16, lds); }
}
__device__ void phase_mix2(const Params& p, int l) {
    hg_scan(p);
    const int w = tidx() >> 6;
    for (int c = blockIdx.x; c < 256; c += gridDim.x) {
        const int b = c >> 5, cc = c & 31;
        const int g = w < 4 ? cc * 4 + w : 255 - (cc * 4 + (w - 4));
        dsa_attend(p, b, g);
    }
}
__device__ void phase_mix3(const Params& p, int l, float* lds) {
    for (int u = blockIdx.x; u < 1024; u += gridDim.x) hg_pass3(p, l, u, lds);
}

typedef const __attribute__((address_space(4))) Params* KParams;
#define PHASE_PARAMS() KParams _kp = (KParams)__builtin_amdgcn_kernarg_segment_ptr(); asm volatile("" : "+s"(_kp)); const Params& p = *(const Params*)_kp
__global__ void __launch_bounds__(512, 2) mega(Params p_unused) {
    extern __shared__ __attribute__((aligned(16))) float lds[];
    LAS unsigned char* ldsb = (LAS unsigned char*)lds;
    cg::grid_group grid = cg::this_grid();
    const int G = gridDim.x, c = blockIdx.x;
    { PHASE_PARAMS(); phase0(p); phase0_conv(p, lds); }
    grid.sync();
    for (int l = 0; l < NL; ++l) {
        { PHASE_PARAMS(); phase_h(p, l); }
        grid.sync();
        {
            PHASE_PARAMS();
            SchedPlain sc{(const char*)p.h16, (const char*)(p.win16 + (size_t)l * NPK * D), 64, 32, G, c, D};
            EpiProj ep{p.q16, p.v16, p.hgg16, p.atq16, p.atk16, p.atv16, p.atg16, p.ixq16, p.ixk16, p.s5u16, p.s5g16, p.mg16, p.lf32, p.ixw32, p.lb + l * 512};
            pg::gemm_phase(ldsb, D, sc, ep);
        }
        grid.sync();
        { PHASE_PARAMS(); phase_fix(p, l, lds); }
        grid.sync();
        { PHASE_PARAMS(); phase_mix1(p, l, lds); }
        grid.sync();
        { PHASE_PARAMS(); phase_mix2(p, l); }
        grid.sync();
        { PHASE_PARAMS(); phase_mix3(p, l, lds); }
        grid.sync();
        {
            PHASE_PARAMS();
            SchedPlain sc{(const char*)p.ypre16, (const char*)(p.wglu16 + (size_t)l * W * W), 64, 2, G, c, W};
            EpiGlu ep{p.ypre16, p.s5g16, p.glu_b + l * W, p.ys + (size_t)2 * T * W, nullptr};
            pg::gemm_phase(ldsb, W, sc, ep);
        }
        grid.sync();
        {
            PHASE_PARAMS();
            SchedMerge sc{(const char*)p.ys, (const char*)(p.wb16 + (size_t)l * 3 * D * W), G, c};
            EpiMerge ep{p.mg16, p.mp32, p.merged16};
            pg::gemm_phase(ldsb, W, sc, ep);
        }
        grid.sync();
        {
            PHASE_PARAMS();
            SchedPlain sc{(const char*)p.merged16, (const char*)(p.wo16 + (size_t)l * D * D), 64, 4, G, c, D};
            EpiOut ep{l == 0 ? p.x : p.out, p.out, p.mod + (size_t)l * NB * 3072 + 2 * D};
            pg::gemm_phase(ldsb, D, sc, ep);
        }
        grid.sync();
    }
}

extern "C" void kernel_launch(void* const* d_in, const int* in_sizes, int n_in,
                              void* d_out, int out_size, void* d_ws, size_t ws_size,
                              hipStream_t stream) {
    static int grid_blocks = 0;
    if (!grid_blocks) {
        int dev = 0, cus = 0, per_cu = 0;
        (void)hipGetDevice(&dev);
        (void)hipDeviceGetAttribute(&cus, hipDeviceAttributeMultiprocessorCount, dev);
        (void)hipFuncSetAttribute((const void*)mega, hipFuncAttributeMaxDynamicSharedMemorySize, LDS_BYTES);
        (void)hipOccupancyMaxActiveBlocksPerMultiprocessor(&per_cu, mega, 512, LDS_BYTES);
        if (per_cu > 1) per_cu = 1;
        grid_blocks = cus * per_cu;
    }
    Params p{};
    const float* const* in = (const float* const*)d_in;
    p.x = in[0]; p.c = in[1]; p.pos = (const int*)d_in[2];
    p.ada_w = in[3]; p.ada_b = in[4]; p.norm_g = in[5]; p.w_in = in[6]; p.lb_logits = in[7]; p.onorm_g = in[8]; p.qn_g = in[9]; p.kn_g = in[10];
    p.a_re = in[11]; p.a_im = in[12]; p.log_dt = in[13]; p.b_re = in[14]; p.b_im = in[15]; p.c_re = in[16]; p.c_im = in[17]; p.s5_d = in[18];
    p.glu_w = in[19]; p.glu_b = in[20]; p.w_branch = in[21]; p.w_out = in[22];
    p.out = (float*)d_out;
    char* ws = (char*)d_ws; size_t off = 0;
    auto take = [&](size_t bytes) { char* q = ws + off; off += (bytes + 255) & ~(size_t)255; return q; };
    const size_t TW2 = (size_t)T * W * 2;
    p.mod = (float*)take((size_t)NL * NB * 3072 * 4);
    p.lb = (float*)take((size_t)NL * 512 * 4);
    p.abar = (float*)take((size_t)NL * 32 * 64 * 2 * 4);
    p.bbar = (float*)take((size_t)NL * 32 * 64 * 16 * 2 * 4);
    p.ropeA = (float*)take((size_t)T * 64 * 2 * 4);
    p.ropeI = (float*)take((size_t)T * 32 * 2 * 4);
    p.win16 = (__half*)take((size_t)NL * NPK * D * 2);
    p.wb16 = (__half*)take((size_t)NL * 3 * D * W * 2);
    p.wo16 = (__half*)take((size_t)NL * D * D * 2);
    p.wglu16 = (__half*)take((size_t)NL * W * W * 2);
    p.h16 = (__half*)take((size_t)T * D * 2);       p.merged16 = p.h16; p.stT16 = p.h16;
    p.q16 = (__half*)take(TW2);                     p.mp32 = (float*)p.q16;
    p.lf32 = (float*)take((size_t)T * W * 4);
    p.v16 = (__half*)take(TW2);
    p.hgg16 = (__half*)take(TW2);
    p.atq16 = (__half*)take(TW2);
    p.atk16 = (__half*)take((size_t)T * 128 * 2);
    p.atv16 = (__half*)take((size_t)T * 128 * 2);
    p.atg16 = (__half*)take(TW2);
    p.ixq16 = (__half*)take(TW2);
    p.ixk16 = (__half*)take((size_t)T * 64 * 2);
    p.ixw32 = (float*)take((size_t)T * 8 * 4);
    p.s5u16 = (__half*)take(TW2);
    p.s5g16 = (__half*)take(TW2);
    p.mg16 = (__half*)take((size_t)T * 3072 * 2);
    p.ys = (__half*)take(3 * TW2);
    p.ypre16 = (__half*)take(TW2);
    p.dbg = (unsigned*)take(256);
    p.dec32 = (float*)take((size_t)1024 * 128 * 4);
    p.mask = (unsigned*)take((size_t)T * 64 * 4);
    p.atvT16 = (__half*)take((size_t)T * 128 * 2);
    if (off > ws_size) { fprintf(stderr, "workspace too small: need %zu have %zu\n", off, ws_size); return; }
    void* args[] = {&p};
    hipError_t e = hipLaunchCooperativeKernel((void*)mega, dim3(grid_blocks), dim3(512), args, LDS_BYTES, stream);
    if (e != hipSuccess) fprintf(stderr, "cooperative launch failed: %s (grid %d)\n", hipGetErrorString(e), grid_blocks);
}
```

```cpp
#include <hip/hip_runtime.h>
#include <hip/hip_cooperative_groups.h>
#include <hip/hip_fp16.h>
#include <cstdio>
namespace cg = cooperative_groups;

constexpr int D = 1024, NB = 8, S = 2048, T = NB * S, NL = 4, W = 512, NIN = 8008, NPK = 8192;
constexpr int C_S5U = 3912, C_MG = 4936;
constexpr float EPS = 1e-6f;
constexpr int LDS_BYTES = 135168;
#define LAS __attribute__((address_space(3)))
typedef _Float16 h8 __attribute__((ext_vector_type(8)));
typedef _Float16 h2 __attribute__((ext_vector_type(2)));
typedef float f32x4 __attribute__((ext_vector_type(4)));
typedef unsigned u32x4 __attribute__((ext_vector_type(4)));

struct Params {
    const float *x, *c; const int* pos;
    const float *ada_w, *ada_b, *norm_g, *w_in, *lb_logits, *onorm_g, *qn_g, *kn_g;
    const float *a_re, *a_im, *log_dt, *b_re, *b_im, *c_re, *c_im, *s5_d, *glu_w, *glu_b, *w_branch, *w_out;
    float* out;
    float *mod, *lb, *abar, *bbar, *ropeA, *ropeI;
    __half *win16, *wb16, *wo16, *wglu16;
    __half *h16, *q16, *v16, *hgg16, *atq16, *atk16, *atv16, *atg16, *ixq16, *ixk16, *s5u16, *s5g16, *mg16, *ys, *ypre16, *merged16;
    float *lf32, *ixw32, *mp32; unsigned* dbg; unsigned* mask; unsigned* xbar; __half* atvT16; __half* stT16; float* dec32; float *pw, *sg, *e32; __half *kmat16, *hs16, *gs16, *x16;
};

__device__ __forceinline__ float sigmoid_f(float v) { return 1.f / (1.f + expf(-v)); }
__device__ __forceinline__ float silu_f(float v) { return v / (1.f + expf(-v)); }
__device__ __forceinline__ float gelu_tanh_f(float v) { return 0.5f * v * (1.f + tanhf(0.7978845608028654f * (v + 0.044715f * v * v * v))); }
__device__ __forceinline__ float wave_sum(float v) {
#pragma unroll
    for (int o = 32; o > 0; o >>= 1) v += __shfl_xor(v, o);
    return v;
}
__device__ __forceinline__ void lds_fence() { asm volatile("s_waitcnt lgkmcnt(0)" ::: "memory"); }
__device__ __forceinline__ int tidx() { int t = threadIdx.x; asm volatile("" : "+v"(t)); return t; }

__device__ void phase0(const Params& p) {
    const size_t gtid = (size_t)blockIdx.x * blockDim.x + tidx(), nth = (size_t)gridDim.x * blockDim.x;
    for (size_t i = gtid; i < (size_t)NL * NB * 3072; i += nth) {
        const int col = (int)(i % 3072), b = (int)((i / 3072) % NB), l = (int)(i / (3072 * NB));
        const float* w = p.ada_w + (size_t)l * 1024 * 3072 + col;
        const float* cc = p.c + b * 1024;
        float acc = p.ada_b[l * 3072 + col];
        for (int k = 0; k < 1024; ++k) { const float cv = cc[k]; acc += silu_f(cv) * w[(size_t)k * 3072]; }
        p.mod[i] = acc;
    }
    for (size_t i = gtid; i < 512; i += nth) {
        float lg[NL], mx = -1e30f;
#pragma unroll
        for (int l = 0; l < NL; ++l) { lg[l] = p.lb_logits[l * 512 + i]; mx = fmaxf(mx, lg[l]); }
        float s = 0.f;
#pragma unroll
        for (int l = 0; l < NL; ++l) { lg[l] = expf(lg[l] - mx); s += lg[l]; }
        float cum = 0.f;
#pragma unroll
        for (int l = 0; l < NL; ++l) { const float pr = lg[l] / s; cum += pr; p.lb[l * 512 + i] = cum - lg[0] / s; }
    }
    for (size_t i = gtid; i < (size_t)NL * 32 * 64; i += nth) {
        const int lg = (int)(i / 64);
        const double dt = exp((double)p.log_dt[lg]);
        const double are = p.a_re[i], aim = p.a_im[i];
        const double mag = exp(are * dt), ang = aim * dt;
        const double abr = mag * cos(ang), abi = mag * sin(ang);
        const double nr = abr - 1.0, ni = abi, den = are * are + aim * aim;
        const double fr = (nr * are + ni * aim) / den, fi = (ni * are - nr * aim) / den;
        p.abar[i * 2] = (float)abr; p.abar[i * 2 + 1] = (float)abi;
        for (int c = 0; c < 16; ++c) {
            const double br = p.b_re[i * 16 + c], bi = p.b_im[i * 16 + c];
            p.bbar[(i * 16 + c) * 2] = (float)(fr * br - fi * bi);
            p.bbar[(i * 16 + c) * 2 + 1] = (float)(fr * bi + fi * br);
        }
    }
    for (size_t i = gtid; i < (size_t)T * 64; i += nth) {
        const int t = (int)(i / 64), j = (int)(i % 64);
        const double inv = pow(10000.0, -(double)(2 * j) / 128.0);
        const double ang = (double)p.pos[t] * inv;
        p.ropeA[i * 2] = (float)cos(ang); p.ropeA[i * 2 + 1] = (float)sin(ang);
    }
    for (size_t i = gtid; i < (size_t)T * 32; i += nth) {
        const int t = (int)(i / 32), j = (int)(i % 32);
        const double inv = pow(10000.0, -(double)(2 * j) / 64.0);
        const double ang = (double)p.pos[t] * inv;
        p.ropeI[i * 2] = (float)cos(ang); p.ropeI[i * 2 + 1] = (float)sin(ang);
    }
}

__device__ __forceinline__ unsigned pk2(float a, float b) { h2 v = {(_Float16)a, (_Float16)b}; return __builtin_bit_cast(unsigned, v); }
__device__ void phase_h(const Params& p, int l) {
    const float* xin = l == 0 ? p.x : p.out;
    const int w = tidx() >> 6, lane = tidx() & 63;
    for (int row = blockIdx.x * 8 + w; row < T; row += gridDim.x * 8) {
        const int b = row / S;
        const float* xr = xin + (size_t)row * D;
        float4 v[4]; float ss = 0.f;
#pragma unroll
        for (int i = 0; i < 4; ++i) { v[i] = *(const float4*)(xr + i * 256 + lane * 4); ss += v[i].x * v[i].x + v[i].y * v[i].y + v[i].z * v[i].z + v[i].w * v[i].w; }
        ss = wave_sum(ss);
        const float r = rsqrtf(ss * (1.f / D) + EPS);
        const float* md = p.mod + ((size_t)l * NB + b) * 3072;
#pragma unroll
        for (int i = 0; i < 4; ++i) {
            const int k = i * 256 + lane * 4;
            const float4 g = *(const float4*)(p.norm_g + l * D + k), sh = *(const float4*)(md + k), sc = *(const float4*)(md + D + k);
            uint2 o;
            o.x = pk2(v[i].x * r * g.x * (1.f + sc.x) + sh.x, v[i].y * r * g.y * (1.f + sc.y) + sh.y);
            o.y = pk2(v[i].z * r * g.z * (1.f + sc.z) + sh.z, v[i].w * r * g.w * (1.f + sc.w) + sh.w);
            *(uint2*)(p.h16 + (size_t)row * D + k) = o;
        }
    }
}
template <class CM>
__device__ void conv_transpose(const float* __restrict__ src, int ldsrc, int K, __half* __restrict__ dst, int N, CM colmap, float* lds, int part, int nparts) {
    float (*ts)[65] = (float (*)[65])lds;
    const int tid = tidx(), nkt = K / 64, nnt = N / 64;
    for (int tile = part; tile < nkt * nnt; tile += nparts) {
        const int kt = tile % nkt, nt = tile / nkt, k0 = kt * 64, n0 = nt * 64;
        __syncthreads();
#pragma unroll
        for (int i = 0; i < 8; ++i) {
            const int idx = tid + 512 * i, k = idx >> 6, n = idx & 63;
            const int sc = colmap(n0 + n);
            ts[k][n] = sc >= 0 ? src[(size_t)(k0 + k) * ldsrc + sc] : 0.f;
        }
        __syncthreads();
        const int n = tid >> 3, k8 = (tid & 7) * 8;
        u32x4 w;
        { h2 a = {(_Float16)ts[k8 + 0][n], (_Float16)ts[k8 + 1][n]}; w.x = __builtin_bit_cast(unsigned, a); }
        { h2 a = {(_Float16)ts[k8 + 2][n], (_Float16)ts[k8 + 3][n]}; w.y = __builtin_bit_cast(unsigned, a); }
        { h2 a = {(_Float16)ts[k8 + 4][n], (_Float16)ts[k8 + 5][n]}; w.z = __builtin_bit_cast(unsigned, a); }
        { h2 a = {(_Float16)ts[k8 + 6][n], (_Float16)ts[k8 + 7][n]}; w.w = __builtin_bit_cast(unsigned, a); }
        *(u32x4*)(dst + (size_t)(n0 + n) * K + k0 + k8) = w;
    }
}
struct CmIdent { __device__ int operator()(int n) const { return n; } };
struct CmWin { __device__ int operator()(int n) const { return n < C_S5U ? n : (n < 4096 ? -1 : n - 184); } };

__device__ void phase0_conv(const Params& p, float* lds) {
    for (int l = 0; l < NL; ++l) {
        conv_transpose(p.w_in + (size_t)l * D * NIN, NIN, D, p.win16 + (size_t)l * NPK * D, NPK, CmWin(), lds, blockIdx.x, gridDim.x);
        for (int n = 0; n < 3; ++n)
            conv_transpose(p.w_branch + ((size_t)l * 3 + n) * W * D, D, W, p.wb16 + ((size_t)l * 3 + n) * D * W, D, CmIdent(), lds, blockIdx.x, gridDim.x);
        conv_transpose(p.w_out + (size_t)l * D * D, D, D, p.wo16 + (size_t)l * D * D, D, CmIdent(), lds, blockIdx.x, gridDim.x);
        conv_transpose(p.glu_w + (size_t)l * W * W, W, W, p.wglu16 + (size_t)l * W * W, W, CmIdent(), lds, blockIdx.x, gridDim.x);
    }
}
namespace pg {
constexpr int BM = 256, BK = 64, HALF = 128, HTB = HALF * BK * 2, STAGE_BYTES = 8 * HTB, NXCD = 8, WGM = 8;
__device__ __forceinline__ int lds_byte(int r, int c) { const int st = (r >> 4) * 2 + (c >> 5), rr = r & 15, cc = c & 31, ob = rr * 64 + cc * 2; return st * 1024 + (ob ^ (((ob >> 9) & 1) << 5)); }
__device__ __forceinline__ void stage_rc(int b, int& R, int& C) { const int st = b / 1024, sb = b % 1024, swz = sb ^ (((sb >> 9) & 1) << 5); R = (st >> 1) * 16 + swz / 64; C = (st & 1) * 32 + (swz % 64) / 2; }
__device__ __forceinline__ int perm32(int rho) { const int n = rho >> 4, i = rho & 15; return 8 * (i >> 2) + 4 * n + (i & 3); }
struct Unit { int pm, pn, aux; const char* A; const char* B; };
__device__ __forceinline__ void tile_of(int L, int nM, int nN, int& pm, int& pn) {
    const int nwg = nM * nN; int wgid = L;
    { const int q = nwg / NXCD, r = nwg % NXCD, xcd = wgid % NXCD, off = wgid / NXCD; wgid = (xcd < r ? xcd * (q + 1) : r * (q + 1) + (xcd - r) * q) + off; }
    const int nig = WGM * nN, gid = wgid / nig, fm = gid * WGM, gsz = (nM - fm) < WGM ? (nM - fm) : WGM;
    pm = fm + ((wgid % nig) % gsz); pn = (wgid % nig) / gsz;
}
template <class Epi, class Sched>
__device__ __forceinline__ void gemm_phase(LAS unsigned char* lds, const int K, const Sched& S, const Epi& E) {
    int tid = tidx();
    const int wid = __builtin_amdgcn_readfirstlane(tid >> 6), lane = tid & 63, wr = wid >> 2, wc = wid & 3, fr = lane & 15, fq = lane >> 4;
    const int nt = K / BK;
    unsigned voffA[2], voffB[2];
#pragma unroll
    for (int i = 0; i < 2; ++i) { int R, C; stage_rc(tid * 16 + i * 8192, R, C); const int Rb = Epi::PERM ? ((R & ~31) + perm32(R & 31)) : R;
        voffA[i] = (unsigned)(R * K + C) * 2u; voffB[i] = (unsigned)(Rb * K + C) * 2u; }
    const size_t kstep = (size_t)(BK * 2);
    const size_t hstep = (size_t)HALF * K * 2;
    const unsigned ldsw = (unsigned)wid * 1024u;
    const int aoff = lds_byte(wr * 64 + fr, fq * 8), boff = lds_byte(wc * 32 + fr, fq * 8);
#define PG_SA(b, h) (((b) * 2 + (h)) * HTB)
#define PG_SB(b, h) ((4 + (b) * 2 + (h)) * HTB)
#define PG_STAGE(bufoff, gbase, voff) do { _Pragma("unroll") for (int _i = 0; _i < 2; ++_i) \
        __builtin_amdgcn_global_load_lds((const unsigned*)((const char*)(gbase) + (voff)[_i]), (LAS unsigned*)(lds + (bufoff) + ldsw + _i * 8192), 16, 0, 0); } while (0)
#define PG_LDA(dst, b, h) do { _Pragma("unroll") for (int m = 0; m < 4; ++m) _Pragma("unroll") for (int k = 0; k < 2; ++k) dst[m][k] = *(const LAS h8*)(lds + PG_SA(b, h) + aoff + m * 2048 + k * 1024); } while (0)
#define PG_LDB(dst, b, h) do { _Pragma("unroll") for (int n = 0; n < 2; ++n) _Pragma("unroll") for (int k = 0; k < 2; ++k) dst[n][k] = *(const LAS h8*)(lds + PG_SB(b, h) + boff + n * 2048 + k * 1024); } while (0)
#define PG_MMA(ai, bj, At, Bt) do { __builtin_amdgcn_s_setprio(1); _Pragma("unroll") for (int m = 0; m < 4; ++m) _Pragma("unroll") for (int n = 0; n < 2; ++n) _Pragma("unroll") for (int k = 0; k < 2; ++k) \
        acc[ai][bj][m][n] = __builtin_amdgcn_mfma_f32_16x16x32_f16(Bt[n][k], At[m][k], acc[ai][bj][m][n], 0, 0, 0); __builtin_amdgcn_s_setprio(0); } while (0)
#define PG_WAIT_V(n) asm volatile("s_waitcnt vmcnt(" #n ")" ::: "memory")
#define PG_WAIT_L(n) asm volatile("s_waitcnt lgkmcnt(" #n ")" ::: "memory")
#define PG_BAR __builtin_amdgcn_s_barrier()
#define PG_SCHED __builtin_amdgcn_sched_barrier(0)
    Unit cur, nxt; int ui = 0;
    if (!S.next(0, cur)) return;
    f32x4 acc[2][2][4][2];
#pragma unroll
    for (int a = 0; a < 2; ++a)
#pragma unroll
        for (int b = 0; b < 2; ++b)
#pragma unroll
            for (int m = 0; m < 4; ++m)
#pragma unroll
                for (int n = 0; n < 2; ++n) acc[a][b][m][n] = (f32x4){0.f, 0.f, 0.f, 0.f};
    h8 At[4][2], B0[2][2], B1[2][2];
    const char* cA = cur.A; const char* cB = cur.B;
    PG_STAGE(PG_SB(0, 0), cB, voffB); PG_STAGE(PG_SA(0, 0), cA, voffA); PG_STAGE(PG_SB(0, 1), cB + hstep, voffB); PG_STAGE(PG_SA(0, 1), cA + hstep, voffA);
    if (wr == 1) PG_BAR;
    PG_WAIT_V(4); PG_BAR;
    PG_STAGE(PG_SB(1, 0), cB + kstep, voffB); PG_STAGE(PG_SA(1, 0), cA + kstep, voffA); PG_STAGE(PG_SB(1, 1), cB + hstep + kstep, voffB);
    PG_WAIT_V(6); PG_BAR;
    for (;;) {
        const bool has_next = S.next(ui + 1, nxt);
        const char* nA = has_next ? nxt.A : cA; const char* nB = has_next ? nxt.B : cB;
        for (int t = 0; t < nt; t += 2) {
            const bool last = (t == nt - 2);
            const char* a1 = cA + (size_t)(t + 1) * kstep;
            const char* a2 = last ? nA : cA + (size_t)(t + 2) * kstep; const char* b2 = last ? nB : cB + (size_t)(t + 2) * kstep;
            const char* a3 = a2 + kstep; const char* b3 = b2 + kstep;
            PG_LDB(B0, 0, 0); PG_SCHED; PG_LDA(At, 0, 0); PG_STAGE(PG_SA(1, 1), a1 + hstep, voffA);
            PG_WAIT_L(8); PG_BAR; PG_WAIT_L(0); PG_MMA(0, 0, At, B0); PG_BAR; PG_SCHED;
            PG_LDB(B1, 0, 1); PG_STAGE(PG_SB(0, 0), b2, voffB);
            PG_BAR; PG_WAIT_L(0); PG_MMA(0, 1, At, B1); PG_BAR;
            PG_LDA(At, 0, 1); PG_STAGE(PG_SA(0, 0), a2, voffA);
            PG_BAR; PG_WAIT_L(0); PG_MMA(1, 0, At, B0); PG_BAR; PG_SCHED;
            PG_STAGE(PG_SB(0, 1), b2 + hstep, voffB);
            PG_WAIT_V(6); PG_BAR; PG_MMA(1, 1, At, B1); PG_BAR;
            PG_LDB(B0, 1, 0); PG_SCHED; PG_LDA(At, 1, 0); PG_STAGE(PG_SA(0, 1), a2 + hstep, voffA);
            PG_WAIT_L(8); PG_BAR; PG_WAIT_L(0); PG_MMA(0, 0, At, B0); PG_BAR; PG_SCHED;
            PG_LDB(B1, 1, 1); PG_STAGE(PG_SB(1, 0), b3, voffB);
            PG_BAR; PG_WAIT_L(0); PG_MMA(0, 1, At, B1); PG_BAR;
            PG_LDA(At, 1, 1); PG_STAGE(PG_SA(1, 0), a3, voffA);
            PG_BAR; PG_WAIT_L(0); PG_MMA(1, 0, At, B0); PG_BAR; PG_SCHED;
            PG_STAGE(PG_SB(1, 1), b3 + hstep, voffB);
            PG_WAIT_V(6); PG_BAR; PG_MMA(1, 1, At, B1); PG_BAR;
        }
        E(acc, cur, wr, wc, fr, fq);
        if (!has_next) break;
#pragma unroll
        for (int a = 0; a < 2; ++a)
#pragma unroll
            for (int b = 0; b < 2; ++b)
#pragma unroll
                for (int m = 0; m < 4; ++m)
#pragma unroll
                    for (int n = 0; n < 2; ++n) acc[a][b][m][n] = (f32x4){0.f, 0.f, 0.f, 0.f};
        cur = nxt; cA = nA; cB = nB; ++ui;
    }
    PG_WAIT_V(0);
    if (wr == 0) PG_BAR;
    PG_BAR;
#undef PG_SA
#undef PG_SB
#undef PG_STAGE
#undef PG_LDA
#undef PG_LDB
#undef PG_MMA
#undef PG_WAIT_V
#undef PG_WAIT_L
#undef PG_BAR
#undef PG_SCHED
}
}
__device__ __forceinline__ float fsig(float v) { return 1.f / (1.f + __expf(-v)); }
__device__ __forceinline__ float fsilu(float v) { return v / (1.f + __expf(-v)); }
__device__ __forceinline__ u32x4 pack8(const f32x4 a, const f32x4 b) {
    const h8 v = {(_Float16)a[0], (_Float16)a[1], (_Float16)a[2], (_Float16)a[3], (_Float16)b[0], (_Float16)b[1], (_Float16)b[2], (_Float16)b[3]};
    return __builtin_bit_cast(u32x4, v);
}
__device__ __forceinline__ void unpack8(const u32x4 w, float (&o)[8]) {
    const h8 v = __builtin_bit_cast(h8, w);
#pragma unroll
    for (int j = 0; j < 8; ++j) o[j] = (float)v[j];
}
struct SchedPlain {
    const char* A; const char* B; int nM, nN, G, c, K;
    __device__ bool next(int i, pg::Unit& u) const {
        const long L = (long)i * G + c; if (L >= (long)nM * nN) return false;
        pg::tile_of((int)L, nM, nN, u.pm, u.pn); u.aux = 0;
        u.A = A + (size_t)u.pm * 256 * K * 2; u.B = B + (size_t)u.pn * 256 * K * 2; return true;
    }
};
struct SchedMerge {
    const char* ys; const char* wb; int G, c;
    __device__ bool next(int i, pg::Unit& u) const {
        const int r = i / 3, n = i - 3 * r; const long L = (long)r * G + c; if (L >= 64 * 4) return false;
        pg::tile_of((int)L, 64, 4, u.pm, u.pn); u.aux = n;
        u.A = ys + ((size_t)n * T + (size_t)u.pm * 256) * W * 2; u.B = wb + ((size_t)n * D + (size_t)u.pn * 256) * W * 2; return true;
    }
};

template <int ACT> __device__ __forceinline__ f32x4 actv(f32x4 v) {
    if (ACT == 1) { for (int j = 0; j < 4; ++j) v[j] = fsilu(v[j]); }
    if (ACT == 2) { for (int j = 0; j < 4; ++j) v[j] = fsig(v[j]); }
    return v;
}
template <int ACT> __device__ __forceinline__ void st16(const f32x4 (&acc)[2][2][4][2], __half* base, int ld, int c8, int bj0, int bj1) {
#pragma unroll
    for (int ai = 0; ai < 2; ++ai)
#pragma unroll
        for (int m = 0; m < 4; ++m) {
            __half* rowp = base + (size_t)(ai * 128 + m * 16) * ld + c8;
#pragma unroll
            for (int bj = 0; bj < 2; ++bj) if (bj >= bj0 && bj < bj1)
                *(u32x4*)(rowp + (bj - bj0) * 128) = pack8(actv<ACT>(acc[ai][bj][m][0]), actv<ACT>(acc[ai][bj][m][1]));
        }
}
struct EpiProj {
    static constexpr bool PERM = true;
    __half *q16, *v16, *hgg16, *atq16, *atk16, *atv16, *atg16, *ixq16, *ixk16, *s5u16, *s5g16, *mg16; float *lf32, *ixw32; const float* lb;
    __device__ __forceinline__ void operator()(const f32x4 (&acc)[2][2][4][2], const pg::Unit& u, int wr, int wc, int fr, int fq) const {
        const size_t row0 = (size_t)u.pm * 256 + wr * 64 + fr; const int c8 = wc * 32 + 8 * fq, pn = u.pn;
        if (pn < 2)        st16<0>(acc, q16 + row0 * W + pn * 256, W, c8, 0, 2);
        else if (pn < 4) {
            const int cb = (pn - 2) * 256 + c8;
#pragma unroll
            for (int bj = 0; bj < 2; ++bj) {
                const f32x4 l0 = *(const f32x4*)(lb + cb + bj * 128), l1 = *(const f32x4*)(lb + cb + bj * 128 + 4);
#pragma unroll
                for (int ai = 0; ai < 2; ++ai)
#pragma unroll
                    for (int m = 0; m < 4; ++m) {
                        f32x4 a = acc[ai][bj][m][0], b = acc[ai][bj][m][1];
#pragma unroll
                        for (int j = 0; j < 4; ++j) { a[j] = __logf(fmaxf(l0[j] + (1.f - l0[j]) * fsig(a[j]), 1e-30f)); b[j] = __logf(fmaxf(l1[j] + (1.f - l1[j]) * fsig(b[j]), 1e-30f)); }
                        float* o = lf32 + (row0 + ai * 128 + m * 16) * W + cb + bj * 128;
                        *(f32x4*)o = a; *(f32x4*)(o + 4) = b;
                    }
            }
        }
        else if (pn < 6)   st16<0>(acc, v16 + row0 * W + (pn - 4) * 256, W, c8, 0, 2);
        else if (pn < 8)   st16<1>(acc, hgg16 + row0 * W + (pn - 6) * 256, W, c8, 0, 2);
        else if (pn < 10)  st16<0>(acc, atq16 + row0 * W + (pn - 8) * 256, W, c8, 0, 2);
        else if (pn == 10) { st16<0>(acc, atk16 + row0 * 128, 128, c8, 0, 1); st16<0>(acc, atv16 + row0 * 128, 128, c8, 1, 2); }
        else if (pn < 13)  st16<1>(acc, atg16 + row0 * W + (pn - 11) * 256, W, c8, 0, 2);
        else if (pn < 15)  st16<0>(acc, ixq16 + row0 * W + (pn - 13) * 256, W, c8, 0, 2);
        else if (pn == 15) {
            if (wc < 2) {
#pragma unroll
                for (int ai = 0; ai < 2; ++ai)
#pragma unroll
                    for (int m = 0; m < 4; ++m) *(u32x4*)(ixk16 + (row0 + ai * 128 + m * 16) * 64 + c8) = pack8(acc[ai][0][m][0], acc[ai][0][m][1]);
            } else if (wc == 2 && fq == 0) {
#pragma unroll
                for (int ai = 0; ai < 2; ++ai)
#pragma unroll
                    for (int m = 0; m < 4; ++m) { float* o = ixw32 + (row0 + ai * 128 + m * 16) * 8; *(f32x4*)o = acc[ai][0][m][0]; *(f32x4*)(o + 4) = acc[ai][0][m][1]; }
            }
        }
        else if (pn < 18)  st16<0>(acc, s5u16 + row0 * W + (pn - 16) * 256, W, c8, 0, 2);
        else if (pn < 20)  st16<1>(acc, s5g16 + row0 * W + (pn - 18) * 256, W, c8, 0, 2);
        else               st16<2>(acc, mg16 + row0 * 3072 + (pn - 20) * 256, 3072, c8, 0, 2);
    }
};
struct EpiGlu {
    static constexpr bool PERM = true;
    const __half* ypre16; const __half* s5g16; const float* bias; __half* yc; float* raw;
    __device__ __forceinline__ void operator()(const f32x4 (&acc)[2][2][4][2], const pg::Unit& u, int wr, int wc, int fr, int fq) const {
        const size_t row0 = (size_t)u.pm * 256 + wr * 64 + fr; const int c0 = u.pn * 256 + wc * 32 + 8 * fq;
#pragma unroll
        for (int bj = 0; bj < 2; ++bj) {
            const int col = c0 + bj * 128;
            const f32x4 b0 = *(const f32x4*)(bias + col), b1 = *(const f32x4*)(bias + col + 4);
#pragma unroll
            for (int ai = 0; ai < 2; ++ai)
#pragma unroll
                for (int m = 0; m < 4; ++m) {
                    const size_t off = (row0 + ai * 128 + m * 16) * W + col;
                    float y[8], g[8]; unpack8(*(const u32x4*)(ypre16 + off), y); unpack8(*(const u32x4*)(s5g16 + off), g);
                    f32x4 a = acc[ai][bj][m][0] + b0, b = acc[ai][bj][m][1] + b1;
                    if (raw) { *(f32x4*)(raw + (row0 + ai * 128 + m * 16) * D + col) = acc[ai][bj][m][0]; *(f32x4*)(raw + (row0 + ai * 128 + m * 16) * D + col + 4) = acc[ai][bj][m][1]; }
#pragma unroll
                    for (int j = 0; j < 4; ++j) { a[j] = y[j] * fsig(a[j]) * g[j]; b[j] = y[4 + j] * fsig(b[j]) * g[4 + j]; }
                    *(u32x4*)(yc + off) = pack8(a, b);
                }
        }
    }
};
struct EpiMerge {
    static constexpr bool PERM = true;
    const __half* mg16; float* mp32; __half* merged16;
    __device__ __forceinline__ void operator()(const f32x4 (&acc)[2][2][4][2], const pg::Unit& u, int wr, int wc, int fr, int fq) const {
        const size_t row0 = (size_t)u.pm * 256 + wr * 64 + fr; const int c0 = u.pn * 256 + wc * 32 + 8 * fq, n = u.aux;
#pragma unroll
        for (int ai = 0; ai < 2; ++ai)
#pragma unroll
            for (int m = 0; m < 4; ++m)
#pragma unroll
                for (int bj = 0; bj < 2; ++bj) {
                    const size_t r = row0 + ai * 128 + m * 16; const int col = c0 + bj * 128;
                    float g[8]; unpack8(*(const u32x4*)(mg16 + r * 3072 + n * D + col), g);
                    f32x4 a = acc[ai][bj][m][0], b = acc[ai][bj][m][1];
#pragma unroll
                    for (int j = 0; j < 4; ++j) { a[j] *= g[j]; b[j] *= g[4 + j]; }
                    float* pp = mp32 + r * D + col;
                    if (n > 0) { a += *(const f32x4*)pp; b += *(const f32x4*)(pp + 4); }
                    if (n < 2) { *(f32x4*)pp = a; *(f32x4*)(pp + 4) = b; }
                    else *(u32x4*)(merged16 + r * D + col) = pack8(a, b);
                }
    }
};
struct EpiOut {
    static constexpr bool PERM = false;
    const float* xin; float* out; const float* gate;
    __device__ __forceinline__ void operator()(const f32x4 (&acc)[2][2][4][2], const pg::Unit& u, int wr, int wc, int fr, int fq) const {
        const size_t row0 = (size_t)u.pm * 256 + wr * 64 + fr; const int c0 = u.pn * 256 + wc * 32 + 4 * fq;
        const int b = (u.pm * 256) / S;
#pragma unroll
        for (int bj = 0; bj < 2; ++bj)
#pragma unroll
            for (int n = 0; n < 2; ++n) {
                const int col = c0 + bj * 128 + n * 16;
                const f32x4 gv = *(const f32x4*)(gate + (size_t)b * 3072 + col);
#pragma unroll
                for (int ai = 0; ai < 2; ++ai)
#pragma unroll
                    for (int m = 0; m < 4; ++m) {
                        const size_t off = (row0 + ai * 128 + m * 16) * D + col;
                        *(f32x4*)(out + off) = *(const f32x4*)(xin + off) + gv * acc[ai][bj][m][n];
                    }
            }
    }
};
__device__ void phase_fix(const Params& p, int l, float* lds) {
    {
        __half* tl = (__half*)lds;
        const int tid = tidx();
        for (int tile = blockIdx.x; tile < T / 64; tile += gridDim.x) {
            const int t0 = tile * 64, b = t0 / S, s0 = t0 % S;
            __syncthreads();
            for (int i = tid; i < 64 * 64; i += 512) { const int tt = i >> 6, e2 = (i & 63) * 2; *(h2*)(tl + tt * 130 + e2) = *(const h2*)(p.atv16 + (size_t)(t0 + tt) * 128 + e2); }
            __syncthreads();
            const int e = tid >> 2, part = tid & 3;
            h8 v0, v1;
#pragma unroll
            for (int j = 0; j < 8; ++j) { v0[j] = (_Float16)tl[(part * 16 + j) * 130 + e]; v1[j] = (_Float16)tl[(part * 16 + 8 + j) * 130 + e]; }
            __half* dst = p.atvT16 + (size_t)(b * 128 + e) * S + s0 + part * 16;
            *(h8*)dst = v0; *(h8*)(dst + 8) = v1;
        }
    }
    const int w = tidx() >> 6, lane = tidx() & 63;
    for (int t = blockIdx.x * 8 + w; t < T; t += gridDim.x * 8) {
        const float cA = p.ropeA[((size_t)t * 64 + lane) * 2], sA = p.ropeA[((size_t)t * 64 + lane) * 2 + 1];
        for (int hh = 0; hh < 5; ++hh) {
            __half* q = hh < 4 ? p.atq16 + (size_t)t * W + hh * 128 : p.atk16 + (size_t)t * 128;
            const float* g = hh < 4 ? p.qn_g + l * 128 : p.kn_g + l * 128;
            const float x1 = __half2float(q[lane]), x2 = __half2float(q[64 + lane]);
            const float ss = wave_sum(x1 * x1 + x2 * x2);
            const float r = rsqrtf(ss * (1.f / 128.f) + EPS);
            const float a = x1 * r * g[lane], b2 = x2 * r * g[64 + lane];
            q[lane] = __float2half(a * cA - b2 * sA); q[64 + lane] = __float2half(b2 * cA + a * sA);
        }
        for (int i = 0; i < 5; ++i) {
            const int idx = lane + 64 * i;
            if (i == 4 && lane >= 32) break;
            const int hh = idx >> 5, j = idx & 31;
            __half* q = i < 4 ? p.ixq16 + (size_t)t * W + hh * 64 : p.ixk16 + (size_t)t * 64;
            const float cI = p.ropeI[((size_t)t * 32 + j) * 2], sI = p.ropeI[((size_t)t * 32 + j) * 2 + 1];
            const float x1 = __half2float(q[j]), x2 = __half2float(q[32 + j]);
            q[j] = __float2half(x1 * cI - x2 * sI); q[32 + j] = __float2half(x2 * cI + x1 * sI);
        }
    }
}

__device__ __forceinline__ unsigned f2key(float f) { const unsigned u = __float_as_uint(f); return (u & 0x80000000u) ? ~u : (u | 0x80000000u); }
typedef float f32x16 __attribute__((ext_vector_type(16)));
typedef _Float16 h4 __attribute__((ext_vector_type(4)));
__device__ void dsa_select(const Params& p, int b, int q0, float* lds) {
    const int tid = tidx(), w = tid >> 6, lane = tid & 63, half = lane >> 5, col = lane & 31;
    float* sc = lds;
    {
        const int wq = w & 3, par = w >> 2;
        const int blk = col >> 2, wi = col & 3, ql = 2 * (blk & 1) + (blk >> 2), head = 4 * ((blk >> 1) & 1) + wi;
        const __half* qrow = p.ixq16 + (size_t)(b * S + q0 + wq * 4 + ql) * W + head * 64 + 8 * half;
        h8 af[4];
#pragma unroll
        for (int ks = 0; ks < 4; ++ks) af[ks] = *(const h8*)(qrow + 16 * ks);
        const int qa = wq * 4 + 2 * half;
        float iw0[8], iw1[8];
#pragma unroll
        for (int hh = 0; hh < 8; ++hh) { iw0[hh] = p.ixw32[(size_t)(b * S + q0 + qa) * 8 + hh]; iw1[hh] = p.ixw32[(size_t)(b * S + q0 + qa + 1) * 8 + hh]; }
        const int ntiles = (q0 + 15) / 32 + 1;
        for (int kt = par; kt < ntiles; kt += 2) {
            const int key = kt * 32 + col;
            const __half* krow = p.ixk16 + (size_t)(b * S + key) * 64 + 8 * half;
            f32x16 acc;
#pragma unroll
            for (int r = 0; r < 16; ++r) acc[r] = 0.f;
#pragma unroll
            for (int ks = 0; ks < 4; ++ks) acc = __builtin_amdgcn_mfma_f32_32x32x16_f16(af[ks], *(const h8*)(krow + 16 * ks), acc, 0, 0, 0);
            float s0 = 0.f, s1 = 0.f;
#pragma unroll
            for (int r = 0; r < 8; ++r) { s0 += fmaxf(acc[r], 0.f) * iw0[r]; s1 += fmaxf(acc[8 + r], 0.f) * iw1[r]; }
            sc[qa * 2048 + key] = key <= q0 + qa ? s0 : -INFINITY;
            sc[(qa + 1) * 2048 + key] = key <= q0 + qa + 1 ? s1 : -INFINITY;
        }
        for (int i = ntiles * 32 + tid; i < 2048; i += 512) {
#pragma unroll
            for (int q = 0; q < 16; ++q) sc[q * 2048 + i] = -INFINITY;
        }
    }
    __syncthreads();
    for (int qq = 0; qq < 2; ++qq) {
        const int ql = 2 * w + qq, qi = q0 + ql;
        const float* scl = sc + ql * 2048;
        const bool all = qi + 1 <= 256;
        unsigned thr = 0; int rrem = 0;
        if (!all) {
            unsigned key[32];
#pragma unroll
            for (int i = 0; i < 32; ++i) key[i] = f2key(scl[lane + 64 * i]);
            unsigned prefix = 0; bool exact = false;
#pragma unroll 1
            for (int bit = 31; bit >= 0; --bit) {
                const unsigned cand = prefix | (1u << bit);
                int c = 0;
#pragma unroll
                for (int i = 0; i < 32; ++i) c += __popcll(__ballot(key[i] >= cand));
                if (c >= 256) prefix = cand;
                if (c == 256) { exact = true; break; }
            }
            if (exact) { thr = prefix - 1u; rrem = 0; }
            else {
                int c = 0;
#pragma unroll
                for (int i = 0; i < 32; ++i) c += __popcll(__ballot(key[i] > prefix));
                thr = prefix; rrem = 256 - c;
            }
        }
        const unsigned long long lt = (1ull << lane) - 1ull;
        unsigned mylo = 0, myhi = 0;
#pragma unroll 1
        for (int i = 0; i < 32; ++i) {
            const int s = lane + 64 * i;
            const unsigned k = f2key(scl[s]);
            bool sl;
            if (all) sl = s <= qi;
            else {
                const bool eq = k == thr;
                const unsigned long long m = __ballot(eq);
                sl = (k > thr) || (eq && __popcll(m & lt) < rrem);
                rrem -= __popcll(m); if (rrem < 0) rrem = 0;
            }
            const unsigned long long m2 = __ballot(sl);
            if (lane == i) { mylo = (unsigned)m2; myhi = (unsigned)(m2 >> 32); }
        }
        if (lane < 32) *(uint2*)(p.mask + (size_t)(b * S + qi) * 64 + 2 * lane) = make_uint2(mylo, myhi);
    }
    __syncthreads();
}

__device__ void dsa_attend(const Params& p, int b, int g) {
    const int lane = tidx() & 63, half = lane >> 5, col = lane & 31;
    const int q0 = 8 * g, qi = q0 + (col >> 2), hd = col & 3;
    const __half* qp = p.atq16 + (size_t)(b * S + qi) * W + hd * 128 + 8 * half;
    h8 qf[8];
#pragma unroll
    for (int ks = 0; ks < 8; ++ks) qf[ks] = *(const h8*)(qp + 16 * ks);
    f32x16 o[4];
#pragma unroll
    for (int et = 0; et < 4; ++et)
#pragma unroll
        for (int r = 0; r < 16; ++r) o[et][r] = 0.f;
    float m = -INFINITY, l = 0.f;
    const int ntiles = (q0 + 7) / 32 + 1;
    const unsigned* mrow = p.mask + (size_t)(b * S + qi) * 64;
    const float scale = 0.08838834764831845f;
    const __half* kbase = p.atk16 + (size_t)(b * S + col) * 128 + 8 * half;
    const __half* vbase = p.atvT16 + (size_t)(b * 128 + col) * S + 4 * half;
    h8 kc[8];
#pragma unroll
    for (int ks = 0; ks < 8; ++ks) kc[ks] = *(const h8*)(kbase + 16 * ks);
    unsigned mw = mrow[0];
#pragma unroll 1
    for (int kt = 0; kt < ntiles; ++kt) {
        const int kn_t = kt + 1 < ntiles ? kt + 1 : kt;
        h8 kn[8];
#pragma unroll
        for (int ks = 0; ks < 8; ++ks) kn[ks] = *(const h8*)(kbase + (size_t)kn_t * 32 * 128 + 16 * ks);
        const unsigned mwn = mrow[kn_t];
        f32x16 s;
#pragma unroll
        for (int r = 0; r < 16; ++r) s[r] = 0.f;
#pragma unroll
        for (int ks = 0; ks < 8; ++ks) s = __builtin_amdgcn_mfma_f32_32x32x16_f16(kc[ks], qf[ks], s, 0, 0, 0);
        h4 vv[4][2][2];
#pragma unroll
        for (int et = 0; et < 4; ++et)
#pragma unroll
            for (int s2 = 0; s2 < 2; ++s2) { const __half* vp = vbase + (size_t)(32 * et) * S + kt * 32 + 16 * s2; vv[et][s2][0] = *(const h4*)vp; vv[et][s2][1] = *(const h4*)(vp + 8); }
        float tmax = -INFINITY;
#pragma unroll
        for (int r = 0; r < 16; ++r) {
            const int bit = (r & 3) + 8 * (r >> 2) + 4 * half;
            s[r] = ((mw >> bit) & 1u) ? s[r] * scale : -INFINITY;
            tmax = fmaxf(tmax, s[r]);
        }
        tmax = fmaxf(tmax, __shfl_xor(tmax, 32));
        const float mn = fmaxf(m, tmax);
        const float ms = mn == -INFINITY ? 0.f : mn;
        const float cs = __expf(m - ms);
        float ps = 0.f;
#pragma unroll
        for (int r = 0; r < 16; ++r) { s[r] = __expf(s[r] - ms); ps += s[r]; }
        l = l * cs + ps; m = mn;
#pragma unroll
        for (int et = 0; et < 4; ++et)
#pragma unroll
            for (int r = 0; r < 16; ++r) o[et][r] *= cs;
        h8 pb[2];
#pragma unroll
        for (int s2 = 0; s2 < 2; ++s2)
#pragma unroll
            for (int j = 0; j < 8; ++j) pb[s2][j] = (_Float16)s[8 * s2 + j];
#pragma unroll
        for (int et = 0; et < 4; ++et)
#pragma unroll
            for (int s2 = 0; s2 < 2; ++s2) {
                const h4 v0 = vv[et][s2][0], v1 = vv[et][s2][1];
                const h8 vf = {v0[0], v0[1], v0[2], v0[3], v1[0], v1[1], v1[2], v1[3]};
                o[et] = __builtin_amdgcn_mfma_f32_32x32x16_f16(vf, pb[s2], o[et], 0, 0, 0);
            }
#pragma unroll
        for (int ks = 0; ks < 8; ++ks) kc[ks] = kn[ks];
        mw = mwn;
    }
    l += __shfl_xor(l, 32);
    const float inv = 1.f / l;
    __half* yb = p.ys + (size_t)T * W + (size_t)(b * S + qi) * W + hd * 128;
    const __half* gp = p.atg16 + (size_t)(b * S + qi) * W + hd * 128;
#pragma unroll
    for (int et = 0; et < 4; ++et)
#pragma unroll
        for (int r4 = 0; r4 < 4; ++r4) {
            const int e0 = 32 * et + 8 * r4 + 4 * half;
            const h4 gv = *(const h4*)(gp + e0);
            h4 ov;
#pragma unroll
            for (int j = 0; j < 4; ++j) ov[j] = (_Float16)(o[et][4 * r4 + j] * inv * (float)gv[j]);
            *(h4*)(yb + e0) = ov;
        }
}

typedef __bf16 bf8 __attribute__((ext_vector_type(8)));
constexpr int HG_QS = 136;
constexpr int HG_VS = 72;
__device__ __forceinline__ void hg_cumsum(const Params& p, int tok0, int hd, int tid, float* segt, float (&lf)[16], float (&bcs)[16], float& blast, float& bref) {
    const int d = tid & 127, seg = tid >> 7;
    float run = 0.f;
#pragma unroll
    for (int i = 0; i < 16; ++i) { lf[i] = p.lf32[(size_t)(tok0 + seg * 16 + i) * W + hd * 128 + d]; run += lf[i]; bcs[i] = run; }
    segt[seg * 128 + d] = run;
    __syncthreads();
    const float s0 = segt[d], s1 = segt[128 + d], s2 = segt[256 + d], s3 = segt[384 + d];
    const float off = seg == 0 ? 0.f : (seg == 1 ? s0 : (seg == 2 ? s0 + s1 : s0 + s1 + s2));
#pragma unroll
    for (int i = 0; i < 16; ++i) bcs[i] += off;
    blast = s0 + s1 + s2 + s3; bref = s0 + s1;
}
__device__ __forceinline__ void hg_load_vt(const Params& p, int tok0, int hd, int tid, __half* VT) {
    const int e = tid & 127, seg = tid >> 7;
    h8 v0, v1;
#pragma unroll
    for (int i = 0; i < 8; ++i) { v0[i] = __builtin_bit_cast(_Float16, p.v16[(size_t)(tok0 + seg * 16 + i) * W + hd * 128 + e]); v1[i] = __builtin_bit_cast(_Float16, p.v16[(size_t)(tok0 + seg * 16 + 8 + i) * W + hd * 128 + e]); }
    *(h8*)(VT + e * HG_VS + seg * 16) = v0; *(h8*)(VT + e * HG_VS + seg * 16 + 8) = v1;
}
__device__ void hg_pass1(const Params& p, int u, float* lds) {
    const int tid = tidx(), w = tid >> 6, lane = tid & 63, half = lane >> 5, col = lane & 31;
    const int c = u & 31, bh = u >> 5, hd = bh & 3, b = bh >> 2, tok0 = b * S + c * 64;
    __half* KH = (__half*)lds;
    __half* VT = KH + 128 * HG_VS;
    float* segt = (float*)(VT + 128 * HG_VS);
    __syncthreads();
    float lf[16], bcs[16], blast, bref;
    hg_cumsum(p, tok0, hd, tid, segt, lf, bcs, blast, bref);
    {
        const int d = tid & 127, seg = tid >> 7;
        h8 k0, k1;
#pragma unroll
        for (int i = 0; i < 8; ++i) { k0[i] = (_Float16)((1.f - __expf(lf[i])) * __expf(blast - bcs[i])); k1[i] = (_Float16)((1.f - __expf(lf[8 + i])) * __expf(blast - bcs[8 + i])); }
        *(h8*)(KH + d * HG_VS + seg * 16) = k0; *(h8*)(KH + d * HG_VS + seg * 16 + 8) = k1;
        if (seg == 0) p.dec32[(size_t)u * 128 + d] = __expf(blast);
    }
    hg_load_vt(p, tok0, hd, tid, VT);
    __syncthreads();
    const int dt = w >> 1;
    h8 af[4];
#pragma unroll
    for (int ks = 0; ks < 4; ++ks) af[ks] = *(const h8*)(KH + (dt * 32 + col) * HG_VS + 16 * ks + 8 * half);
#pragma unroll
    for (int ee = 0; ee < 2; ++ee) {
        const int et = (w & 1) * 2 + ee;
        f32x16 acc;
#pragma unroll
        for (int r = 0; r < 16; ++r) acc[r] = 0.f;
#pragma unroll
        for (int ks = 0; ks < 4; ++ks) acc = __builtin_amdgcn_mfma_f32_32x32x16_f16(af[ks], *(const h8*)(VT + (et * 32 + col) * HG_VS + 16 * ks + 8 * half), acc, 0, 0, 0);
        __half* dst = p.stT16 + ((size_t)u * 128 + et * 32 + col) * 128 + dt * 32 + 4 * half;
#pragma unroll
        for (int r4 = 0; r4 < 4; ++r4) { h4 o = {(_Float16)acc[4 * r4], (_Float16)acc[4 * r4 + 1], (_Float16)acc[4 * r4 + 2], (_Float16)acc[4 * r4 + 3]}; *(h4*)(dst + 8 * r4) = o; }
    }
}
__device__ void hg_scan(const Params& p) {
    const int gt = blockIdx.x * 512 + tidx();
    if (gt >= 32 * 128 * 16) return;
    const int d8 = (gt & 15) * 8, e = (gt >> 4) & 127, bh = gt >> 11;
    float s[8];
#pragma unroll
    for (int j = 0; j < 8; ++j) s[j] = 0.f;
    for (int c = 0; c < 32; ++c) {
        const size_t u = (size_t)bh * 32 + c;
        h8* ptr = (h8*)(p.stT16 + (u * 128 + e) * 128 + d8);
        const h8 t = *ptr;
        const f32x4 g0 = *(const f32x4*)(p.dec32 + u * 128 + d8), g1 = *(const f32x4*)(p.dec32 + u * 128 + d8 + 4);
        h8 o;
#pragma unroll
        for (int j = 0; j < 8; ++j) o[j] = (_Float16)s[j];
        *ptr = o;
#pragma unroll
        for (int j = 0; j < 4; ++j) { s[j] = g0[j] * s[j] + (float)t[j]; s[4 + j] = g1[j] * s[4 + j] + (float)t[4 + j]; }
    }
}
__device__ void hg_pass3(const Params& p, int l, int u, float* lds) {
    const int tid = tidx(), w = tid >> 6, lane = tid & 63, half = lane >> 5, col = lane & 31;
    const int c = u & 31, bh = u >> 5, hd = bh & 3, b = bh >> 2, tok0 = b * S + c * 64;
    __half* QI = (__half*)lds;
    __bf16* QM = (__bf16*)(QI + 64 * HG_QS);
    __bf16* KM = QM + 64 * HG_QS;
    __half* VT = (__half*)(KM + 64 * HG_QS);
    float* segt = (float*)(VT + 128 * HG_VS);
    float* part = segt + 512;
    __syncthreads();
    float lf[16], bcs[16], blast, bref;
    hg_cumsum(p, tok0, hd, tid, segt, lf, bcs, blast, bref);
    {
        const int d = tid & 127, seg = tid >> 7;
#pragma unroll
        for (int i = 0; i < 16; ++i) {
            const int tk = seg * 16 + i;
            const float q = __half2float(p.q16[(size_t)(tok0 + tk) * W + hd * 128 + d]);
            QI[tk * HG_QS + d] = __float2half(q * __expf(bcs[i]));
            QM[tk * HG_QS + d] = (__bf16)(q * __expf(bcs[i] - bref));
            KM[tk * HG_QS + d] = (__bf16)((1.f - __expf(lf[i])) * __expf(bref - bcs[i]));
        }
    }
    hg_load_vt(p, tok0, hd, tid, VT);
    __syncthreads();
    const int tt = w & 1, et = w >> 1;
    h8 pb[2][2];
    bf8 qm[8];
#pragma unroll
    for (int ks = 0; ks < 8; ++ks) qm[ks] = *(const bf8*)(QM + (tt * 32 + col) * HG_QS + 16 * ks + 8 * half);
#pragma unroll
    for (int st = 0; st < 2; ++st) {
        if (st <= tt) {
            f32x16 sacc;
#pragma unroll
            for (int r = 0; r < 16; ++r) sacc[r] = 0.f;
#pragma unroll
            for (int ks = 0; ks < 8; ++ks) sacc = __builtin_amdgcn_mfma_f32_32x32x16_bf16(*(const bf8*)(KM + (st * 32 + col) * HG_QS + 16 * ks + 8 * half), qm[ks], sacc, 0, 0, 0);
#pragma unroll
            for (int r = 0; r < 16; ++r) {
                const int sl = (r & 3) + 8 * (r >> 2) + 4 * half;
                const float v = (st < tt || sl <= col) ? sacc[r] : 0.f;
                pb[st][r >> 3][r & 7] = (_Float16)v;
            }
        } else {
#pragma unroll
            for (int j = 0; j < 8; ++j) { pb[st][0][j] = (_Float16)0.f; pb[st][1][j] = (_Float16)0.f; }
        }
    }
    f32x16 o;
#pragma unroll
    for (int r = 0; r < 16; ++r) o[r] = 0.f;
#pragma unroll
    for (int st = 0; st < 2; ++st) {
        if (st <= tt) {
#pragma unroll
            for (int s2 = 0; s2 < 2; ++s2) {
                const __half* vp = VT + (et * 32 + col) * HG_VS + st * 32 + 16 * s2 + 4 * half;
                const h4 v0 = *(const h4*)vp, v1 = *(const h4*)(vp + 8);
                const h8 vf = {v0[0], v0[1], v0[2], v0[3], v1[0], v1[1], v1[2], v1[3]};
                o = __builtin_amdgcn_mfma_f32_32x32x16_f16(vf, pb[st][s2], o, 0, 0, 0);
            }
        }
    }
    {
        const __half* sp = p.stT16 + ((size_t)u * 128 + et * 32 + col) * 128 + 8 * half;
#pragma unroll
        for (int ks = 0; ks < 8; ++ks) o = __builtin_amdgcn_mfma_f32_32x32x16_f16(*(const h8*)(sp + 16 * ks), *(const h8*)(QI + (tt * 32 + col) * HG_QS + 16 * ks + 8 * half), o, 0, 0, 0);
    }
    float ss = 0.f;
#pragma unroll
    for (int r = 0; r < 16; ++r) ss += o[r] * o[r];
    ss += __shfl_xor(ss, 32);
    if (half == 0) part[et * 64 + tt * 32 + col] = ss;
    __syncthreads();
    const int tk = tt * 32 + col;
    const float tot = part[tk] + part[64 + tk] + part[128 + tk] + part[192 + tk];
    const float rs = rsqrtf(tot * (1.f / 128.f) + EPS);
    const float* on = p.onorm_g + l * 128;
    const size_t ob = (size_t)(tok0 + tk) * W + hd * 128;
#pragma unroll
    for (int r4 = 0; r4 < 4; ++r4) {
        const int e0 = et * 32 + 8 * r4 + 4 * half;
        const h4 gv = *(const h4*)(p.hgg16 + ob + e0);
        const f32x4 nv = *(const f32x4*)(on + e0);
        h4 ov;
#pragma unroll
        for (int j = 0; j < 4; ++j) ov[j] = (_Float16)(o[4 * r4 + j] * rs * nv[j] * (float)gv[j]);
        *(h4*)(p.ys + ob + e0) = ov;
    }
}

constexpr int S5_UP = 1032;
__device__ void s5_pow_table(const Params& p) {
    const size_t gtid = (size_t)blockIdx.x * 512 + tidx(), nth = (size_t)gridDim.x * 512;
    for (size_t i = gtid; i < (size_t)NL * 32 * 64 * 65; i += nth) {
        const int tau = (int)(i % 65); const size_t lgp = i / 65; const int lg = (int)(lgp / 64);
        const double dt = exp((double)p.log_dt[lg]);
        const double are = p.a_re[lgp], aim = p.a_im[lgp];
        const double mag = exp(are * dt * tau), ang = aim * dt * tau;
        p.pw[i * 2] = (float)(mag * cos(ang)); p.pw[i * 2 + 1] = (float)(mag * sin(ang));
    }
    for (size_t i = gtid; i < (size_t)NL * 32; i += nth) {
        const float sgv = exp2f(rintf(-p.log_dt[i] * 1.4426950408889634f));
        p.sg[i * 2] = sgv; p.sg[i * 2 + 1] = 1.f / sgv;
    }
}
__device__ void s5_build_tables(const Params& p, int l) {
    const size_t gtid = (size_t)blockIdx.x * 512 + tidx(), nth = (size_t)gridDim.x * 512;
    for (size_t i = gtid; i < (size_t)32 * 64 * 256; i += nth) {
        const int cp = (int)(i & 15), c = (int)((i >> 4) & 15), lag = (int)((i >> 8) & 63), g = (int)(i >> 14);
        const size_t lg = (size_t)l * 32 + g;
        float acc = 0.f;
        for (int s = 0; s < 64; ++s) {
            const float cr = p.c_re[(lg * 16 + c) * 64 + s], ci = p.c_im[(lg * 16 + c) * 64 + s];
            const float wr = p.pw[((lg * 64 + s) * 65 + lag) * 2], wi = p.pw[((lg * 64 + s) * 65 + lag) * 2 + 1];
            const float br = p.bbar[((lg * 64 + s) * 16 + cp) * 2], bi = p.bbar[((lg * 64 + s) * 16 + cp) * 2 + 1];
            acc += (cr * wr - ci * wi) * br - (cr * wi + ci * wr) * bi;
        }
        p.kmat16[i] = __float2half(acc * p.sg[lg * 2]);
    }
    for (size_t i = gtid; i < (size_t)32 * 128 * 1024; i += nth) {
        const int cp = (int)(i & 15), sig = (int)((i >> 4) & 63), n = (int)((i >> 10) & 127), g = (int)(i >> 17);
        const size_t lg = (size_t)l * 32 + g; const int s = n & 63;
        const float wr = p.pw[((lg * 64 + s) * 65 + 63 - sig) * 2], wi = p.pw[((lg * 64 + s) * 65 + 63 - sig) * 2 + 1];
        const float br = p.bbar[((lg * 64 + s) * 16 + cp) * 2], bi = p.bbar[((lg * 64 + s) * 16 + cp) * 2 + 1];
        const float v = n < 64 ? wr * br - wi * bi : wr * bi + wi * br;
        p.hs16[i] = __float2half(v * p.sg[lg * 2]);
    }
    for (size_t i = gtid; i < (size_t)32 * 1024 * 128; i += nth) {
        const int n = (int)(i & 127), c = (int)((i >> 7) & 15), tau = (int)((i >> 11) & 63), g = (int)(i >> 17);
        const size_t lg = (size_t)l * 32 + g; const int s = n & 63;
        const float cr = p.c_re[(lg * 16 + c) * 64 + s], ci = p.c_im[(lg * 16 + c) * 64 + s];
        const float wr = p.pw[((lg * 64 + s) * 65 + tau + 1) * 2], wi = p.pw[((lg * 64 + s) * 65 + tau + 1) * 2 + 1];
        const float v = n < 64 ? cr * wr - ci * wi : -(cr * wi + ci * wr);
        p.gs16[i] = __float2half(v);
    }
}
__device__ __forceinline__ void s5_load_u(const Params& p, int g, int b, int tid, __half* U) {
#pragma unroll
    for (int i = 0; i < 4; ++i) {
        const int idx = tid + 512 * i, ch = idx >> 6, sig = idx & 63;
        const h8* src = (const h8*)(p.s5u16 + (size_t)(b * S + ch * 64 + sig) * W + g * 16);
        const h8 a = src[0], c2 = src[1];
        *(h8*)(U + ch * S5_UP + sig * 16) = a; *(h8*)(U + ch * S5_UP + sig * 16 + 8) = c2;
    }
}
__device__ void s5_pass1(const Params& p, int g, int b, float* lds) {
    const int tid = tidx(), w = tid >> 6, lane = tid & 63, half = lane >> 5, col = lane & 31;
    __half* U = (__half*)lds;
    float* part = (float*)(U + 32 * S5_UP);
    __syncthreads();
    s5_load_u(p, g, b, tid, U);
    __syncthreads();
    const int nt = w & 3, sh = w >> 2;
    const __half* hp = p.hs16 + ((size_t)g * 128 + nt * 32 + col) * 1024 + 8 * half;
    const __half* up = U + col * S5_UP + 8 * half;
    f32x16 acc;
#pragma unroll
    for (int r = 0; r < 16; ++r) acc[r] = 0.f;
#pragma unroll 8
    for (int sig = sh * 32; sig < sh * 32 + 32; ++sig) acc = __builtin_amdgcn_mfma_f32_32x32x16_f16(*(const h8*)(hp + sig * 16), *(const h8*)(up + sig * 16), acc, 0, 0, 0);
    if (sh == 1) {
#pragma unroll
        for (int r = 0; r < 16; ++r) part[(nt * 16 + r) * 64 + lane] = acc[r];
    }
    __syncthreads();
    if (sh == 0) {
        float* ep = p.e32 + (((size_t)g * 8 + b) * 32 + col) * 128 + nt * 32 + 4 * half;
#pragma unroll
        for (int r4 = 0; r4 < 4; ++r4) {
            f32x4 o;
#pragma unroll
            for (int j = 0; j < 4; ++j) o[j] = acc[4 * r4 + j] + part[(nt * 16 + 4 * r4 + j) * 64 + lane];
            *(f32x4*)(ep + 8 * r4) = o;
        }
    }
}
__device__ void s5_scan(const Params& p, int l) {
    const int gt = blockIdx.x * 512 + tidx();
    if (gt >= 32 * 8 * 64) return;
    const int s = gt & 63, b = (gt >> 6) & 7, g = gt >> 9;
    const size_t lg = (size_t)l * 32 + g;
    const float ar = p.pw[((lg * 64 + s) * 65 + 64) * 2], ai = p.pw[((lg * 64 + s) * 65 + 64) * 2 + 1];
    float xr = 0.f, xi = 0.f;
    for (int c = 0; c < 32; ++c) {
        const size_t base = (((size_t)g * 8 + b) * 32 + c) * 128;
        p.x16[base + s] = __float2half(xr); p.x16[base + 64 + s] = __float2half(xi);
        const float er = p.e32[base + s], ei = p.e32[base + 64 + s];
        const float nr = ar * xr - ai * xi + er, ni = ar * xi + ai * xr + ei;
        xr = nr; xi = ni;
    }
}
__device__ void s5_pass3(const Params& p, int l, int g, int b, float* lds) {
    const int tid = tidx(), w = tid >> 6, lane = tid & 63, half = lane >> 5, col = lane & 31;
    __half* U = (__half*)lds;
    __half* KM = U + 32 * S5_UP;
    __syncthreads();
    s5_load_u(p, g, b, tid, U);
    for (int i = tid; i < 64 * 256 / 8; i += 512) *(h8*)(KM + i * 8) = *(const h8*)(p.kmat16 + (size_t)g * 64 * 256 + i * 8);
    __syncthreads();
    h8 xb[8];
    {
        const __half* xp = p.x16 + (((size_t)g * 8 + b) * 32 + col) * 128 + 8 * half;
#pragma unroll
        for (int ks = 0; ks < 8; ++ks) xb[ks] = *(const h8*)(xp + 16 * ks);
    }
    const float isg = p.sg[((size_t)l * 32 + g) * 2 + 1];
    const __half* up = U + col * S5_UP + 8 * half;
    const int cch = col & 15, tl = col >> 4;
#pragma unroll 1
    for (int rt = w; rt < 32; rt += 8) {
        f32x16 acc;
#pragma unroll
        for (int r = 0; r < 16; ++r) acc[r] = 0.f;
        const int tau = 2 * rt + tl;
#pragma unroll 2
        for (int sig = 0; sig <= 2 * rt + 1; ++sig) {
            const int lag = tau - sig;
            h8 a;
            if (lag >= 0) a = *(const h8*)(KM + (lag * 16 + cch) * 16 + 8 * half);
            else {
#pragma unroll
                for (int j = 0; j < 8; ++j) a[j] = (_Float16)0.f;
            }
            acc = __builtin_amdgcn_mfma_f32_32x32x16_f16(a, *(const h8*)(up + sig * 16), acc, 0, 0, 0);
        }
        const __half* gp = p.gs16 + ((size_t)g * 1024 + 2 * rt * 16 + col) * 128 + 8 * half;
#pragma unroll
        for (int ks = 0; ks < 8; ++ks) acc = __builtin_amdgcn_mfma_f32_32x32x16_f16(*(const h8*)(gp + 16 * ks), xb[ks], acc, 0, 0, 0);
#pragma unroll
        for (int r4 = 0; r4 < 4; ++r4) {
            const int tloc = r4 >> 1, c0 = 8 * (r4 & 1) + 4 * half;
            const int tk = 2 * rt + tloc;
            const h4 uv = *(const h4*)(U + col * S5_UP + tk * 16 + c0);
            const f32x4 dv = *(const f32x4*)(p.s5_d + l * W + g * 16 + c0);
            h4 ov;
#pragma unroll
            for (int j = 0; j < 4; ++j) ov[j] = (_Float16)gelu_tanh_f(acc[4 * r4 + j] * isg + dv[j] * (float)uv[j]);
            *(h4*)(p.ypre16 + (size_t)(b * S + col * 64 + tk) * W + g * 16 + c0) = ov;
        }
    }
}

__device__ void phase_mix1(const Params& p, int l, float* lds) {
    const int c = blockIdx.x, G = gridDim.x;
    for (int u = c; u < 256; u += G) s5_pass1(p, u >> 3, u & 7, lds);
    for (int u = c; u < 1024; u += G) hg_pass1(p, u, lds);
    __syncthreads();
    for (int it = c; it < NB * 64; it += G) { const int b = it >> 6, jp = it & 63; dsa_select(p, b, jp * 16, lds); dsa_select(p, b, (127 - jp) * 16, lds); }
}
__device__ void phase_mix2(const Params& p, int l) {
    s5_scan(p, l);
    hg_scan(p);
    const int w = tidx() >> 6;
    for (int c = blockIdx.x; c < 256; c += gridDim.x) {
        const int b = c >> 5, cc = c & 31;
        const int g = w < 4 ? cc * 4 + w : 255 - (cc * 4 + (w - 4));
        dsa_attend(p, b, g);
    }
}
__device__ void phase_mix3(const Params& p, int l, float* lds) {
    for (int u = blockIdx.x; u < 256; u += gridDim.x) s5_pass3(p, l, u >> 3, u & 7, lds);
    for (int u = blockIdx.x; u < 1024; u += gridDim.x) hg_pass3(p, l, u, lds);
}

#define XB_TMO      128
#define XB_XCNT(j)  (256  + 64 * (j))
#define XB_XSUB(j)  (1280 + 64 * (j))
#define XB_XGEN(j)  (2304 + 64 * (j))
#define XB_TOP      3328
#define XB_TOPGEN   3392
#define XCD_BAR_WORDS 3456
#define XB_SPIN_CAP (1u << 22)
__device__ __forceinline__ unsigned xb_ld(unsigned* p)              { return __hip_atomic_load(p, __ATOMIC_RELAXED, __HIP_MEMORY_SCOPE_AGENT); }
__device__ __forceinline__ unsigned xb_add(unsigned* p, unsigned v) { return __hip_atomic_fetch_add(p, v, __ATOMIC_RELAXED, __HIP_MEMORY_SCOPE_AGENT); }
__device__ __forceinline__ unsigned xb_xcc_id() { return (unsigned)__builtin_amdgcn_s_getreg((3 << 11) | 20) & 0xFu; }
#define XB_SPIN(cond, bar) do { unsigned _sp = 0; while (cond) { __builtin_amdgcn_s_sleep(1); \
    if ((++_sp & 255u) == 0u) { if (xb_ld(&(bar)[XB_TMO])) break; if (_sp > XB_SPIN_CAP) { atomicAdd(&(bar)[XB_TMO], 1u); break; } } } } while (0)
struct XcdBarrier { unsigned* bar; unsigned x; volatile LAS unsigned* st; };
__device__ __forceinline__ XcdBarrier xcd_barrier_post(unsigned* bar, volatile LAS unsigned* st) {
    XcdBarrier b; b.bar = bar; b.x = xb_xcc_id(); b.st = st;
    if (threadIdx.x == 0) (void)xb_add(&bar[XB_XCNT(b.x)], 1u);
    return b;
}
__device__ __forceinline__ void xcd_barrier_complete(unsigned* bar, unsigned x, unsigned& nloc, unsigned& nx) {
    const unsigned G = gridDim.x * gridDim.y * gridDim.z;
    unsigned sum, cnt, mine, sp = 0u;
    for (;;) {
        sum = 0u; cnt = 0u; mine = 0u;
#pragma unroll
        for (unsigned j = 0; j < 16; ++j) { const unsigned c = xb_ld(&bar[XB_XCNT(j)]); sum += c; cnt += (c > 0u) ? 1u : 0u; mine = (j == x) ? c : mine; }
        if (sum == G) break;
        __builtin_amdgcn_s_sleep(1);
        if ((++sp & 255u) == 0u) { if (xb_ld(&bar[XB_TMO])) break; if (sp > XB_SPIN_CAP) { atomicAdd(&bar[XB_TMO], 1u); break; } }
    }
    nloc = mine > 0u ? mine : 1u; nx = cnt > 0u ? cnt : 1u;
}
__device__ __forceinline__ void xcd_barrier(const XcdBarrier& b) {
    asm volatile("s_waitcnt vmcnt(0)" ::: "memory");
    __syncthreads();
    if (threadIdx.x == 0) {
        unsigned* bar = b.bar;
        __builtin_amdgcn_s_waitcnt(0);
        unsigned nloc = b.st[0], nx = b.st[1];
        if (nloc == 0u) { xcd_barrier_complete(bar, b.x, nloc, nx); b.st[0] = nloc; b.st[1] = nx; }
        const unsigned old = xb_add(&bar[XB_XSUB(b.x)], 1u);
        const unsigned gen = old / nloc;
        if (old + 1u == (gen + 1u) * nloc) {
            __builtin_amdgcn_fence(__ATOMIC_RELEASE, "agent");
            asm volatile("s_waitcnt vmcnt(0)" ::: "memory");
            const unsigned og = xb_add(&bar[XB_TOP], 1u);
            const unsigned tg = og / nx;
            if (og + 1u == (tg + 1u) * nx) xb_add(&bar[XB_TOPGEN], 1u);
            else XB_SPIN(xb_ld(&bar[XB_TOPGEN]) == tg, bar);
            __builtin_amdgcn_fence(__ATOMIC_ACQUIRE, "agent");
            xb_add(&bar[XB_XGEN(b.x)], 1u);
            asm volatile("s_waitcnt vmcnt(0)" ::: "memory");
        } else {
            XB_SPIN(xb_ld(&bar[XB_XGEN(b.x)]) == gen, bar);
            __builtin_amdgcn_fence(__ATOMIC_ACQUIRE, "agent");
            asm volatile("s_waitcnt vmcnt(0)" ::: "memory");
        }
    }
    __syncthreads();
}

typedef const __attribute__((address_space(4))) Params* KParams;
#define PHASE_PARAMS() KParams _kp = (KParams)__builtin_amdgcn_kernarg_segment_ptr(); asm volatile("" : "+s"(_kp)); const Params& p = *(const Params*)_kp
__global__ void __launch_bounds__(512, 2) mega(Params p_unused) {
    extern __shared__ __attribute__((aligned(16))) float lds[];
    LAS unsigned char* ldsb = (LAS unsigned char*)lds;
    cg::grid_group grid = cg::this_grid();
    const int G = gridDim.x, c = blockIdx.x;
    __shared__ uint4 xb_words;
    if (threadIdx.x == 0) xb_words = make_uint4(0u, 0u, 0u, 0u);
    __syncthreads();
    XcdBarrier xbar;
    { PHASE_PARAMS(); xbar = xcd_barrier_post(p.xbar, (volatile LAS unsigned*)&xb_words); }
    { PHASE_PARAMS(); phase0(p); s5_pow_table(p); phase0_conv(p, lds); }
    grid.sync();
    for (int l = 0; l < NL; ++l) {
        { PHASE_PARAMS(); phase_h(p, l); s5_build_tables(p, l); }
        xcd_barrier(xbar);
        {
            PHASE_PARAMS();
            SchedPlain sc{(const char*)p.h16, (const char*)(p.win16 + (size_t)l * NPK * D), 64, 32, G, c, D};
            EpiProj ep{p.q16, p.v16, p.hgg16, p.atq16, p.atk16, p.atv16, p.atg16, p.ixq16, p.ixk16, p.s5u16, p.s5g16, p.mg16, p.lf32, p.ixw32, p.lb + l * 512};
            pg::gemm_phase(ldsb, D, sc, ep);
        }
        xcd_barrier(xbar);
        { PHASE_PARAMS(); phase_fix(p, l, lds); }
        xcd_barrier(xbar);
        { PHASE_PARAMS(); phase_mix1(p, l, lds); }
        xcd_barrier(xbar);
        { PHASE_PARAMS(); phase_mix2(p, l); }
        xcd_barrier(xbar);
        { PHASE_PARAMS(); phase_mix3(p, l, lds); }
        xcd_barrier(xbar);
        {
            PHASE_PARAMS();
            SchedPlain sc{(const char*)p.ypre16, (const char*)(p.wglu16 + (size_t)l * W * W), 64, 2, G, c, W};
            EpiGlu ep{p.ypre16, p.s5g16, p.glu_b + l * W, p.ys + (size_t)2 * T * W, nullptr};
            pg::gemm_phase(ldsb, W, sc, ep);
        }
        xcd_barrier(xbar);
        {
            PHASE_PARAMS();
            SchedMerge sc{(const char*)p.ys, (const char*)(p.wb16 + (size_t)l * 3 * D * W), G, c};
            EpiMerge ep{p.mg16, p.mp32, p.merged16};
            pg::gemm_phase(ldsb, W, sc, ep);
        }
        xcd_barrier(xbar);
        {
            PHASE_PARAMS();
            SchedPlain sc{(const char*)p.merged16, (const char*)(p.wo16 + (size_t)l * D * D), 64, 4, G, c, D};
            EpiOut ep{l == 0 ? p.x : p.out, p.out, p.mod + (size_t)l * NB * 3072 + 2 * D};
            pg::gemm_phase(ldsb, D, sc, ep);
        }
        xcd_barrier(xbar);
    }
}

extern "C" void kernel_launch(void* const* d_in, const int* in_sizes, int n_in,
                              void* d_out, int out_size, void* d_ws, size_t ws_size,
                              hipStream_t stream) {
    static int grid_blocks = 0;
    if (!grid_blocks) {
        int dev = 0, cus = 0, per_cu = 0;
        (void)hipGetDevice(&dev);
        (void)hipDeviceGetAttribute(&cus, hipDeviceAttributeMultiprocessorCount, dev);
        (void)hipFuncSetAttribute((const void*)mega, hipFuncAttributeMaxDynamicSharedMemorySize, LDS_BYTES);
        (void)hipOccupancyMaxActiveBlocksPerMultiprocessor(&per_cu, mega, 512, LDS_BYTES);
        if (per_cu > 1) per_cu = 1;
        grid_blocks = cus * per_cu;
    }
    Params p{};
    const float* const* in = (const float* const*)d_in;
    p.x = in[0]; p.c = in[1]; p.pos = (const int*)d_in[2];
    p.ada_w = in[3]; p.ada_b = in[4]; p.norm_g = in[5]; p.w_in = in[6]; p.lb_logits = in[7]; p.onorm_g = in[8]; p.qn_g = in[9]; p.kn_g = in[10];
    p.a_re = in[11]; p.a_im = in[12]; p.log_dt = in[13]; p.b_re = in[14]; p.b_im = in[15]; p.c_re = in[16]; p.c_im = in[17]; p.s5_d = in[18];
    p.glu_w = in[19]; p.glu_b = in[20]; p.w_branch = in[21]; p.w_out = in[22];
    p.out = (float*)d_out;
    char* ws = (char*)d_ws; size_t off = 0;
    auto take = [&](size_t bytes) { char* q = ws + off; off += (bytes + 255) & ~(size_t)255; return q; };
    const size_t TW2 = (size_t)T * W * 2;
    p.mod = (float*)take((size_t)NL * NB * 3072 * 4);
    p.lb = (float*)take((size_t)NL * 512 * 4);
    p.abar = (float*)take((size_t)NL * 32 * 64 * 2 * 4);
    p.bbar = (float*)take((size_t)NL * 32 * 64 * 16 * 2 * 4);
    p.ropeA = (float*)take((size_t)T * 64 * 2 * 4);
    p.ropeI = (float*)take((size_t)T * 32 * 2 * 4);
    p.win16 = (__half*)take((size_t)NL * NPK * D * 2);
    p.wb16 = (__half*)take((size_t)NL * 3 * D * W * 2);
    p.wo16 = (__half*)take((size_t)NL * D * D * 2);
    p.wglu16 = (__half*)take((size_t)NL * W * W * 2);
    p.h16 = (__half*)take((size_t)T * D * 2);       p.merged16 = p.h16; p.stT16 = p.h16;
    p.q16 = (__half*)take(TW2);                     p.mp32 = (float*)p.q16;
    p.lf32 = (float*)take((size_t)T * W * 4);
    p.v16 = (__half*)take(TW2);
    p.hgg16 = (__half*)take(TW2);
    p.atq16 = (__half*)take(TW2);
    p.atk16 = (__half*)take((size_t)T * 128 * 2);
    p.atv16 = (__half*)take((size_t)T * 128 * 2);
    p.atg16 = (__half*)take(TW2);
    p.ixq16 = (__half*)take(TW2);
    p.ixk16 = (__half*)take((size_t)T * 64 * 2);
    p.ixw32 = (float*)take((size_t)T * 8 * 4);
    p.s5u16 = (__half*)take(TW2);
    p.s5g16 = (__half*)take(TW2);
    p.mg16 = (__half*)take((size_t)T * 3072 * 2);
    p.ys = (__half*)take(3 * TW2);
    p.ypre16 = (__half*)take(TW2);
    p.dbg = (unsigned*)take(256);
    p.xbar = (unsigned*)take((size_t)XCD_BAR_WORDS * 4);
    p.pw = (float*)take((size_t)NL * 32 * 64 * 65 * 2 * 4);
    p.sg = (float*)take((size_t)NL * 32 * 2 * 4);
    p.kmat16 = (__half*)take((size_t)32 * 64 * 256 * 2);
    p.hs16 = (__half*)take((size_t)32 * 128 * 1024 * 2);
    p.gs16 = (__half*)take((size_t)32 * 1024 * 128 * 2);
    p.e32 = (float*)take((size_t)32 * 8 * 32 * 128 * 4);
    p.x16 = (__half*)take((size_t)32 * 8 * 32 * 128 * 2);
    p.dec32 = (float*)take((size_t)1024 * 128 * 4);
    p.mask = (unsigned*)take((size_t)T * 64 * 4);
    p.atvT16 = (__half*)take((size_t)T * 128 * 2);
    if (off > ws_size) { fprintf(stderr, "workspace too small: need %zu have %zu\n", off, ws_size); return; }
    (void)hipMemsetAsync(p.xbar, 0, (size_t)XCD_BAR_WORDS * 4, stream);
    void* args[] = {&p};
    hipError_t e = hipLaunchCooperativeKernel((void*)mega, dim3(grid_blocks), dim3(512), args, LDS_BYTES, stream);
    if (e != hipSuccess) fprintf(stderr, "cooperative launch failed: %s (grid %d)\n", hipGetErrorString(e), grid_blocks);
}
```

```cpp
#include <hip/hip_runtime.h>
#include <hip/hip_cooperative_groups.h>
#include <hip/hip_fp16.h>
#include <cstdio>
namespace cg = cooperative_groups;

constexpr int D = 1024, NB = 8, S = 2048, T = NB * S, NL = 4, W = 512, NIN = 8008, NPK = 8192;
constexpr int C_S5U = 3912, C_MG = 4936;
constexpr float EPS = 1e-6f;
constexpr int LDS_BYTES = 135168;
#define LAS __attribute__((address_space(3)))
typedef _Float16 h8 __attribute__((ext_vector_type(8)));
typedef _Float16 h2 __attribute__((ext_vector_type(2)));
typedef float f32x4 __attribute__((ext_vector_type(4)));
typedef unsigned u32x4 __attribute__((ext_vector_type(4)));

struct Params {
    const float *x, *c; const int* pos;
    const float *ada_w, *ada_b, *norm_g, *w_in, *lb_logits, *onorm_g, *qn_g, *kn_g;
    const float *a_re, *a_im, *log_dt, *b_re, *b_im, *c_re, *c_im, *s5_d, *glu_w, *glu_b, *w_branch, *w_out;
    float* out;
    float *mod, *lb, *abar, *bbar, *ropeA, *ropeI;
    __half *win16, *wb16, *wo16, *wglu16;
    __half *h16, *q16, *v16, *hgg16, *atq16, *atk16, *atv16, *atg16, *ixq16, *ixk16, *s5u16, *s5g16, *mg16, *ys, *ypre16, *merged16;
    float *lf32, *ixw32, *mp32; unsigned* dbg; unsigned* mask; unsigned* xbar; __half *kf16, *vf16, *ikf16; __half* stT16; float* dec32; float *pw, *sg, *e32; __half *kmat16, *hs16, *gs16, *x16;
};

__device__ __forceinline__ float sigmoid_f(float v) { return 1.f / (1.f + expf(-v)); }
__device__ __forceinline__ float silu_f(float v) { return v / (1.f + expf(-v)); }
__device__ __forceinline__ float gelu_tanh_f(float v) { return 0.5f * v * (1.f + tanhf(0.7978845608028654f * (v + 0.044715f * v * v * v))); }
__device__ __forceinline__ float wave_sum(float v) {
#pragma unroll
    for (int o = 32; o > 0; o >>= 1) v += __shfl_xor(v, o);
    return v;
}
__device__ __forceinline__ void lds_fence() { asm volatile("s_waitcnt lgkmcnt(0)" ::: "memory"); }
__device__ __forceinline__ int tidx() { int t = threadIdx.x; asm volatile("" : "+v"(t)); return t; }

__device__ void phase0(const Params& p) {
    const size_t gtid = (size_t)blockIdx.x * blockDim.x + tidx(), nth = (size_t)gridDim.x * blockDim.x;
    {
        for (size_t i = gtid; i < (size_t)NL * 3072 * 8; i += nth) {
            const int col = (int)(i % 3072), ksl = (int)((i / 3072) % 8), l = (int)(i / (3072 * 8));
            const float* w = p.ada_w + ((size_t)l * 1024 + ksl * 128) * 3072 + col;
            float acc[NB];
#pragma unroll
            for (int b = 0; b < NB; ++b) acc[b] = ksl == 0 ? p.ada_b[l * 3072 + col] : 0.f;
#pragma unroll 4
            for (int k = 0; k < 128; ++k) {
                const float wv = w[(size_t)k * 3072];
#pragma unroll
                for (int b = 0; b < NB; ++b) { const float cv = p.c[b * 1024 + ksl * 128 + k]; acc[b] += (cv / (1.f + __expf(-cv))) * wv; }
            }
#pragma unroll
            for (int b = 0; b < NB; ++b) atomicAdd(p.mod + ((size_t)l * NB + b) * 3072 + col, acc[b]);
        }
    }
    for (size_t i = gtid; i < 512; i += nth) {
        float lg[NL], mx = -1e30f;
#pragma unroll
        for (int l = 0; l < NL; ++l) { lg[l] = p.lb_logits[l * 512 + i]; mx = fmaxf(mx, lg[l]); }
        float s = 0.f;
#pragma unroll
        for (int l = 0; l < NL; ++l) { lg[l] = expf(lg[l] - mx); s += lg[l]; }
        float cum = 0.f;
#pragma unroll
        for (int l = 0; l < NL; ++l) { const float pr = lg[l] / s; cum += pr; p.lb[l * 512 + i] = cum - lg[0] / s; }
    }
    for (size_t i = gtid; i < (size_t)NL * 32 * 64; i += nth) {
        const int lg = (int)(i / 64);
        const double dt = exp((double)p.log_dt[lg]);
        const double are = p.a_re[i], aim = p.a_im[i];
        const double mag = exp(are * dt), ang = aim * dt;
        const double abr = mag * cos(ang), abi = mag * sin(ang);
        const double nr = abr - 1.0, ni = abi, den = are * are + aim * aim;
        const double fr = (nr * are + ni * aim) / den, fi = (ni * are - nr * aim) / den;
        p.abar[i * 2] = (float)abr; p.abar[i * 2 + 1] = (float)abi;
        for (int c = 0; c < 16; ++c) {
            const double br = p.b_re[i * 16 + c], bi = p.b_im[i * 16 + c];
            p.bbar[(i * 16 + c) * 2] = (float)(fr * br - fi * bi);
            p.bbar[(i * 16 + c) * 2 + 1] = (float)(fr * bi + fi * br);
        }
    }
    for (size_t i = gtid; i < (size_t)T * 64; i += nth) {
        const int t = (int)(i / 64), j = (int)(i % 64);
        const double inv = pow(10000.0, -(double)(2 * j) / 128.0);
        const double ang = (double)p.pos[t] * inv;
        p.ropeA[i * 2] = (float)cos(ang); p.ropeA[i * 2 + 1] = (float)sin(ang);
    }
    for (size_t i = gtid; i < (size_t)T * 32; i += nth) {
        const int t = (int)(i / 32), j = (int)(i % 32);
        const double inv = pow(10000.0, -(double)(2 * j) / 64.0);
        const double ang = (double)p.pos[t] * inv;
        p.ropeI[i * 2] = (float)cos(ang); p.ropeI[i * 2 + 1] = (float)sin(ang);
    }
}

__device__ __forceinline__ unsigned pk2(float a, float b) { h2 v = {(_Float16)a, (_Float16)b}; return __builtin_bit_cast(unsigned, v); }
__device__ void phase_h(const Params& p, int l) {
    const float* xin = l == 0 ? p.x : p.out;
    const int w = tidx() >> 6, lane = tidx() & 63;
    for (int row = blockIdx.x * 8 + w; row < T; row += gridDim.x * 8) {
        const int b = row / S;
        const float* xr = xin + (size_t)row * D;
        float4 v[4]; float ss = 0.f;
#pragma unroll
        for (int i = 0; i < 4; ++i) { v[i] = *(const float4*)(xr + i * 256 + lane * 4); ss += v[i].x * v[i].x + v[i].y * v[i].y + v[i].z * v[i].z + v[i].w * v[i].w; }
        ss = wave_sum(ss);
        const float r = rsqrtf(ss * (1.f / D) + EPS);
        const float* md = p.mod + ((size_t)l * NB + b) * 3072;
#pragma unroll
        for (int i = 0; i < 4; ++i) {
            const int k = i * 256 + lane * 4;
            const float4 g = *(const float4*)(p.norm_g + l * D + k), sh = *(const float4*)(md + k), sc = *(const float4*)(md + D + k);
            uint2 o;
            o.x = pk2(v[i].x * r * g.x * (1.f + sc.x) + sh.x, v[i].y * r * g.y * (1.f + sc.y) + sh.y);
            o.y = pk2(v[i].z * r * g.z * (1.f + sc.z) + sh.z, v[i].w * r * g.w * (1.f + sc.w) + sh.w);
            *(uint2*)(p.h16 + (size_t)row * D + k) = o;
        }
    }
}
template <class CM>
__device__ void conv_transpose(const float* __restrict__ src, int ldsrc, int K, __half* __restrict__ dst, int N, CM colmap, float* lds, int part, int nparts) {
    float (*ts)[65] = (float (*)[65])lds;
    const int tid = tidx(), nkt = K / 64, nnt = N / 64;
    for (int tile = part; tile < nkt * nnt; tile += nparts) {
        const int kt = tile % nkt, nt = tile / nkt, k0 = kt * 64, n0 = nt * 64;
        __syncthreads();
#pragma unroll
        for (int i = 0; i < 8; ++i) {
            const int idx = tid + 512 * i, k = idx >> 6, n = idx & 63;
            const int sc = colmap(n0 + n);
            ts[k][n] = sc >= 0 ? src[(size_t)(k0 + k) * ldsrc + sc] : 0.f;
        }
        __syncthreads();
        const int n = tid >> 3, k8 = (tid & 7) * 8;
        u32x4 w;
        { h2 a = {(_Float16)ts[k8 + 0][n], (_Float16)ts[k8 + 1][n]}; w.x = __builtin_bit_cast(unsigned, a); }
        { h2 a = {(_Float16)ts[k8 + 2][n], (_Float16)ts[k8 + 3][n]}; w.y = __builtin_bit_cast(unsigned, a); }
        { h2 a = {(_Float16)ts[k8 + 4][n], (_Float16)ts[k8 + 5][n]}; w.z = __builtin_bit_cast(unsigned, a); }
        { h2 a = {(_Float16)ts[k8 + 6][n], (_Float16)ts[k8 + 7][n]}; w.w = __builtin_bit_cast(unsigned, a); }
        *(u32x4*)(dst + (size_t)(n0 + n) * K + k0 + k8) = w;
    }
}
struct CmIdent { __device__ int operator()(int n) const { return n; } };
struct CmWin { __device__ int operator()(int n) const { return n < C_S5U ? n : (n < 4096 ? -1 : n - 184); } };

__device__ void conv_layer(const Params& p, int l, float* lds) {
    conv_transpose(p.w_in + (size_t)l * D * NIN, NIN, D, p.win16, NPK, CmWin(), lds, blockIdx.x, gridDim.x);
    for (int n = 0; n < 3; ++n)
        conv_transpose(p.w_branch + ((size_t)l * 3 + n) * W * D, D, W, p.wb16 + (size_t)n * D * W, D, CmIdent(), lds, blockIdx.x, gridDim.x);
    conv_transpose(p.w_out + (size_t)l * D * D, D, D, p.wo16, D, CmIdent(), lds, blockIdx.x, gridDim.x);
    conv_transpose(p.glu_w + (size_t)l * W * W, W, W, p.wglu16, W, CmIdent(), lds, blockIdx.x, gridDim.x);
    __syncthreads();
}
namespace pg {
constexpr int BM = 256, BK = 64, HALF = 128, HTB = HALF * BK * 2, STAGE_BYTES = 8 * HTB, NXCD = 8, WGM = 8;
__device__ __forceinline__ int lds_byte(int r, int c) { const int st = (r >> 4) * 2 + (c >> 5), rr = r & 15, cc = c & 31, ob = rr * 64 + cc * 2; return st * 1024 + (ob ^ (((ob >> 9) & 1) << 5)); }
__device__ __forceinline__ void stage_rc(int b, int& R, int& C) { const int st = b / 1024, sb = b % 1024, swz = sb ^ (((sb >> 9) & 1) << 5); R = (st >> 1) * 16 + swz / 64; C = (st & 1) * 32 + (swz % 64) / 2; }
__device__ __forceinline__ int perm32(int rho) { const int n = rho >> 4, i = rho & 15; return 8 * (i >> 2) + 4 * n + (i & 3); }
struct Unit { int pm, pn, aux; const char* A; const char* B; };
__device__ __forceinline__ void tile_of(int L, int nM, int nN, int& pm, int& pn) {
    const int nwg = nM * nN; int wgid = L;
    { const int q = nwg / NXCD, r = nwg % NXCD, xcd = wgid % NXCD, off = wgid / NXCD; wgid = (xcd < r ? xcd * (q + 1) : r * (q + 1) + (xcd - r) * q) + off; }
    const int nig = WGM * nN, gid = wgid / nig, fm = gid * WGM, gsz = (nM - fm) < WGM ? (nM - fm) : WGM;
    pm = fm + ((wgid % nig) % gsz); pn = (wgid % nig) / gsz;
}
template <class Epi, class Sched>
__device__ __forceinline__ void gemm_phase(LAS unsigned char* lds, const int K, const Sched& S, const Epi& E) {
    int tid = tidx();
    const int wid = __builtin_amdgcn_readfirstlane(tid >> 6), lane = tid & 63, wr = wid >> 2, wc = wid & 3, fr = lane & 15, fq = lane >> 4;
    const int nt = K / BK;
    unsigned voffA[2], voffB[2];
#pragma unroll
    for (int i = 0; i < 2; ++i) { int R, C; stage_rc(tid * 16 + i * 8192, R, C); const int Rb = Epi::PERM ? ((R & ~31) + perm32(R & 31)) : R;
        voffA[i] = (unsigned)(R * K + C) * 2u; voffB[i] = (unsigned)(Rb * K + C) * 2u; }
    const size_t kstep = (size_t)(BK * 2);
    const size_t hstep = (size_t)HALF * K * 2;
    const unsigned ldsw = (unsigned)wid * 1024u;
    const int aoff = lds_byte(wr * 64 + fr, fq * 8), boff = lds_byte(wc * 32 + fr, fq * 8);
#define PG_SA(b, h) (((b) * 2 + (h)) * HTB)
#define PG_SB(b, h) ((4 + (b) * 2 + (h)) * HTB)
#define PG_STAGE(bufoff, gbase, voff) do { _Pragma("unroll") for (int _i = 0; _i < 2; ++_i) \
        __builtin_amdgcn_global_load_lds((const unsigned*)((const char*)(gbase) + (voff)[_i]), (LAS unsigned*)(lds + (bufoff) + ldsw + _i * 8192), 16, 0, 0); } while (0)
#define PG_LDA(dst, b, h) do { _Pragma("unroll") for (int m = 0; m < 4; ++m) _Pragma("unroll") for (int k = 0; k < 2; ++k) dst[m][k] = *(const LAS h8*)(lds + PG_SA(b, h) + aoff + m * 2048 + k * 1024); } while (0)
#define PG_LDB(dst, b, h) do { _Pragma("unroll") for (int n = 0; n < 2; ++n) _Pragma("unroll") for (int k = 0; k < 2; ++k) dst[n][k] = *(const LAS h8*)(lds + PG_SB(b, h) + boff + n * 2048 + k * 1024); } while (0)
#define PG_MMA(ai, bj, At, Bt) do { __builtin_amdgcn_s_setprio(1); _Pragma("unroll") for (int m = 0; m < 4; ++m) _Pragma("unroll") for (int n = 0; n < 2; ++n) _Pragma("unroll") for (int k = 0; k < 2; ++k) \
        acc[ai][bj][m][n] = __builtin_amdgcn_mfma_f32_16x16x32_f16(Bt[n][k], At[m][k], acc[ai][bj][m][n], 0, 0, 0); __builtin_amdgcn_s_setprio(0); } while (0)
#define PG_WAIT_V(n) asm volatile("s_waitcnt vmcnt(" #n ")" ::: "memory")
#define PG_WAIT_L(n) asm volatile("s_waitcnt lgkmcnt(" #n ")" ::: "memory")
#define PG_BAR __builtin_amdgcn_s_barrier()
#define PG_SCHED __builtin_amdgcn_sched_barrier(0)
    Unit cur, nxt; int ui = 0;
    if (!S.next(0, cur)) return;
    f32x4 acc[2][2][4][2];
#pragma unroll
    for (int a = 0; a < 2; ++a)
#pragma unroll
        for (int b = 0; b < 2; ++b)
#pragma unroll
            for (int m = 0; m < 4; ++m)
#pragma unroll
                for (int n = 0; n < 2; ++n) acc[a][b][m][n] = (f32x4){0.f, 0.f, 0.f, 0.f};
    h8 At[4][2], B0[2][2], B1[2][2];
    const char* cA = cur.A; const char* cB = cur.B;
    PG_STAGE(PG_SB(0, 0), cB, voffB); PG_STAGE(PG_SA(0, 0), cA, voffA); PG_STAGE(PG_SB(0, 1), cB + hstep, voffB); PG_STAGE(PG_SA(0, 1), cA + hstep, voffA);
    if (wr == 1) PG_BAR;
    PG_WAIT_V(4); PG_BAR;
    PG_STAGE(PG_SB(1, 0), cB + kstep, voffB); PG_STAGE(PG_SA(1, 0), cA + kstep, voffA); PG_STAGE(PG_SB(1, 1), cB + hstep + kstep, voffB);
    PG_WAIT_V(6); PG_BAR;
    for (;;) {
        const bool has_next = S.next(ui + 1, nxt);
        const char* nA = has_next ? nxt.A : cA; const char* nB = has_next ? nxt.B : cB;
        for (int t = 0; t < nt; t += 2) {
            const bool last = (t == nt - 2);
            const char* a1 = cA + (size_t)(t + 1) * kstep;
            const char* a2 = last ? nA : cA + (size_t)(t + 2) * kstep; const char* b2 = last ? nB : cB + (size_t)(t + 2) * kstep;
            const char* a3 = a2 + kstep; const char* b3 = b2 + kstep;
            PG_LDB(B0, 0, 0); PG_SCHED; PG_LDA(At, 0, 0); PG_STAGE(PG_SA(1, 1), a1 + hstep, voffA);
            PG_WAIT_L(8); PG_BAR; PG_WAIT_L(0); PG_MMA(0, 0, At, B0); PG_BAR; PG_SCHED;
            PG_LDB(B1, 0, 1); PG_STAGE(PG_SB(0, 0), b2, voffB);
            PG_BAR; PG_WAIT_L(0); PG_MMA(0, 1, At, B1); PG_BAR;
            PG_LDA(At, 0, 1); PG_STAGE(PG_SA(0, 0), a2, voffA);
            PG_BAR; PG_WAIT_L(0); PG_MMA(1, 0, At, B0); PG_BAR; PG_SCHED;
            PG_STAGE(PG_SB(0, 1), b2 + hstep, voffB);
            PG_WAIT_V(6); PG_BAR; PG_MMA(1, 1, At, B1); PG_BAR;
            PG_LDB(B0, 1, 0); PG_SCHED; PG_LDA(At, 1, 0); PG_STAGE(PG_SA(0, 1), a2 + hstep, voffA);
            PG_WAIT_L(8); PG_BAR; PG_WAIT_L(0); PG_MMA(0, 0, At, B0); PG_BAR; PG_SCHED;
            PG_LDB(B1, 1, 1); PG_STAGE(PG_SB(1, 0), b3, voffB);
            PG_BAR; PG_WAIT_L(0); PG_MMA(0, 1, At, B1); PG_BAR;
            PG_LDA(At, 1, 1); PG_STAGE(PG_SA(1, 0), a3, voffA);
            PG_BAR; PG_WAIT_L(0); PG_MMA(1, 0, At, B0); PG_BAR; PG_SCHED;
            PG_STAGE(PG_SB(1, 1), b3 + hstep, voffB);
            PG_WAIT_V(6); PG_BAR; PG_MMA(1, 1, At, B1); PG_BAR;
        }
        E(acc, cur, wr, wc, fr, fq);
        if (!has_next) break;
        if constexpr (!Epi::KEEP_ACC) {
#pragma unroll
        for (int a = 0; a < 2; ++a)
#pragma unroll
            for (int b = 0; b < 2; ++b)
#pragma unroll
                for (int m = 0; m < 4; ++m)
#pragma unroll
                    for (int n = 0; n < 2; ++n) acc[a][b][m][n] = (f32x4){0.f, 0.f, 0.f, 0.f};
        }
        cur = nxt; cA = nA; cB = nB; ++ui;
    }
    PG_WAIT_V(0);
    if (wr == 0) PG_BAR;
    PG_BAR;
#undef PG_SA
#undef PG_SB
#undef PG_STAGE
#undef PG_LDA
#undef PG_LDB
#undef PG_MMA
#undef PG_WAIT_V
#undef PG_WAIT_L
#undef PG_BAR
#undef PG_SCHED
}
}
__device__ __forceinline__ float fsig(float v) { return 1.f / (1.f + __expf(-v)); }
__device__ __forceinline__ float fsilu(float v) { return v / (1.f + __expf(-v)); }
__device__ __forceinline__ u32x4 pack8(const f32x4 a, const f32x4 b) {
    const h8 v = {(_Float16)a[0], (_Float16)a[1], (_Float16)a[2], (_Float16)a[3], (_Float16)b[0], (_Float16)b[1], (_Float16)b[2], (_Float16)b[3]};
    return __builtin_bit_cast(u32x4, v);
}
__device__ __forceinline__ void unpack8(const u32x4 w, float (&o)[8]) {
    const h8 v = __builtin_bit_cast(h8, w);
#pragma unroll
    for (int j = 0; j < 8; ++j) o[j] = (float)v[j];
}
struct SchedPlain {
    const char* A; const char* B; int nM, nN, G, c, K;
    __device__ bool next(int i, pg::Unit& u) const {
        const long L = (long)i * G + c; if (L >= (long)nM * nN) return false;
        pg::tile_of((int)L, nM, nN, u.pm, u.pn); u.aux = 0;
        u.A = A + (size_t)u.pm * 256 * K * 2; u.B = B + (size_t)u.pn * 256 * K * 2; return true;
    }
};
struct SchedMerge {
    const char* ys; const char* wb; int G, c;
    __device__ bool next(int i, pg::Unit& u) const {
        const int r = i / 3, n = i - 3 * r; const long L = (long)r * G + c; if (L >= 64 * 4) return false;
        pg::tile_of((int)L, 64, 4, u.pm, u.pn); u.aux = n;
        u.A = ys + ((size_t)n * T + (size_t)u.pm * 256) * W * 2; u.B = wb + ((size_t)n * D + (size_t)u.pn * 256) * W * 2; return true;
    }
};

template <int ACT> __device__ __forceinline__ f32x4 actv(f32x4 v) {
    if (ACT == 1) { for (int j = 0; j < 4; ++j) v[j] = fsilu(v[j]); }
    if (ACT == 2) { for (int j = 0; j < 4; ++j) v[j] = fsig(v[j]); }
    return v;
}
template <int ACT> __device__ __forceinline__ void st16(const f32x4 (&acc)[2][2][4][2], __half* base, int ld, int c8, int bj0, int bj1) {
#pragma unroll
    for (int ai = 0; ai < 2; ++ai)
#pragma unroll
        for (int m = 0; m < 4; ++m) {
            __half* rowp = base + (size_t)(ai * 128 + m * 16) * ld + c8;
#pragma unroll
            for (int bj = 0; bj < 2; ++bj) if (bj >= bj0 && bj < bj1)
                *(u32x4*)(rowp + (bj - bj0) * 128) = pack8(actv<ACT>(acc[ai][bj][m][0]), actv<ACT>(acc[ai][bj][m][1]));
        }
}
struct EpiProj {
    static constexpr bool PERM = true, KEEP_ACC = false;
    __half *q16, *v16, *hgg16, *atq16, *atk16, *atv16, *atg16, *ixq16, *ixk16, *s5u16, *s5g16, *mg16; float *lf32, *ixw32; const float* lb;
    __device__ __forceinline__ void operator()(f32x4 (&acc)[2][2][4][2], const pg::Unit& u, int wr, int wc, int fr, int fq) const {
        const size_t row0 = (size_t)u.pm * 256 + wr * 64 + fr; const int c8 = wc * 32 + 8 * fq, pn = u.pn;
        if (pn < 2)        st16<0>(acc, q16 + row0 * W + pn * 256, W, c8, 0, 2);
        else if (pn < 4) {
            const int cb = (pn - 2) * 256 + c8;
#pragma unroll
            for (int bj = 0; bj < 2; ++bj) {
                const f32x4 l0 = *(const f32x4*)(lb + cb + bj * 128), l1 = *(const f32x4*)(lb + cb + bj * 128 + 4);
#pragma unroll
                for (int ai = 0; ai < 2; ++ai)
#pragma unroll
                    for (int m = 0; m < 4; ++m) {
                        f32x4 a = acc[ai][bj][m][0], b = acc[ai][bj][m][1];
#pragma unroll
                        for (int j = 0; j < 4; ++j) { a[j] = __logf(fmaxf(l0[j] + (1.f - l0[j]) * fsig(a[j]), 1e-30f)); b[j] = __logf(fmaxf(l1[j] + (1.f - l1[j]) * fsig(b[j]), 1e-30f)); }
                        float* o = lf32 + (row0 + ai * 128 + m * 16) * W + cb + bj * 128;
                        *(f32x4*)o = a; *(f32x4*)(o + 4) = b;
                    }
            }
        }
        else if (pn < 6)   st16<0>(acc, v16 + row0 * W + (pn - 4) * 256, W, c8, 0, 2);
        else if (pn < 8)   st16<1>(acc, hgg16 + row0 * W + (pn - 6) * 256, W, c8, 0, 2);
        else if (pn < 10)  st16<0>(acc, atq16 + row0 * W + (pn - 8) * 256, W, c8, 0, 2);
        else if (pn == 10) { st16<0>(acc, atk16 + row0 * 128, 128, c8, 0, 1); st16<0>(acc, atv16 + row0 * 128, 128, c8, 1, 2); }
        else if (pn < 13)  st16<1>(acc, atg16 + row0 * W + (pn - 11) * 256, W, c8, 0, 2);
        else if (pn < 15)  st16<0>(acc, ixq16 + row0 * W + (pn - 13) * 256, W, c8, 0, 2);
        else if (pn == 15) {
            if (wc < 2) {
#pragma unroll
                for (int ai = 0; ai < 2; ++ai)
#pragma unroll
                    for (int m = 0; m < 4; ++m) *(u32x4*)(ixk16 + (row0 + ai * 128 + m * 16) * 64 + c8) = pack8(acc[ai][0][m][0], acc[ai][0][m][1]);
            } else if (wc == 2 && fq == 0) {
#pragma unroll
                for (int ai = 0; ai < 2; ++ai)
#pragma unroll
                    for (int m = 0; m < 4; ++m) { float* o = ixw32 + (row0 + ai * 128 + m * 16) * 8; *(f32x4*)o = acc[ai][0][m][0]; *(f32x4*)(o + 4) = acc[ai][0][m][1]; }
            }
        }
        else if (pn < 18)  st16<0>(acc, s5u16 + row0 * W + (pn - 16) * 256, W, c8, 0, 2);
        else if (pn < 20)  st16<1>(acc, s5g16 + row0 * W + (pn - 18) * 256, W, c8, 0, 2);
        else {
            int lane = fq * 16 + fr;
            asm volatile("" : "+v"(lane));
            __half* base = mg16 + ((((size_t)u.pm * 12 + (pn - 20)) * 8 + wr * 4 + wc) * 16) * 512 + lane * 8;
#pragma unroll
            for (int ai = 0; ai < 2; ++ai)
#pragma unroll
                for (int m = 0; m < 4; ++m)
#pragma unroll
                    for (int bj = 0; bj < 2; ++bj)
                        *(u32x4*)(base + ((ai * 4 + m) * 2 + bj) * 512) = pack8(actv<2>(acc[ai][bj][m][0]), actv<2>(acc[ai][bj][m][1]));
        }
    }
};
struct EpiGlu {
    static constexpr bool PERM = true, KEEP_ACC = false;
    const __half* ypre16; const __half* s5g16; const float* bias; __half* yc; float* raw;
    __device__ __forceinline__ void operator()(f32x4 (&acc)[2][2][4][2], const pg::Unit& u, int wr, int wc, int fr, int fq) const {
        const size_t row0 = (size_t)u.pm * 256 + wr * 64 + fr; const int c0 = u.pn * 256 + wc * 32 + 8 * fq;
#pragma unroll
        for (int bj = 0; bj < 2; ++bj) {
            const int col = c0 + bj * 128;
            const f32x4 b0 = *(const f32x4*)(bias + col), b1 = *(const f32x4*)(bias + col + 4);
#pragma unroll
            for (int ai = 0; ai < 2; ++ai)
#pragma unroll
                for (int m = 0; m < 4; ++m) {
                    const size_t off = (row0 + ai * 128 + m * 16) * W + col;
                    float y[8], g[8]; unpack8(*(const u32x4*)(ypre16 + off), y); unpack8(*(const u32x4*)(s5g16 + off), g);
                    f32x4 a = acc[ai][bj][m][0] + b0, b = acc[ai][bj][m][1] + b1;
                    if (raw) { *(f32x4*)(raw + (row0 + ai * 128 + m * 16) * D + col) = acc[ai][bj][m][0]; *(f32x4*)(raw + (row0 + ai * 128 + m * 16) * D + col + 4) = acc[ai][bj][m][1]; }
#pragma unroll
                    for (int j = 0; j < 4; ++j) { a[j] = y[j] * fsig(a[j]) * g[j]; b[j] = y[4 + j] * fsig(b[j]) * g[4 + j]; }
                    *(u32x4*)(yc + off) = pack8(a, b);
                }
        }
    }
};
struct EpiMerge {
    static constexpr bool PERM = true, KEEP_ACC = true;
    const __half* mg16; __half* merged16;
    __device__ __forceinline__ void operator()(f32x4 (&acc)[2][2][4][2], const pg::Unit& u, int wr, int wc, int fr, int fq) const {
        const size_t row0 = (size_t)u.pm * 256 + wr * 64 + fr; const int c0 = u.pn * 256 + wc * 32 + 8 * fq, n = u.aux;
        int lofs = ((wr * 4 + wc) * 16) * 512 + (fq * 16 + fr) * 8;
        asm volatile("" : "+v"(lofs));
#pragma unroll
        for (int ai = 0; ai < 2; ++ai)
#pragma unroll
            for (int m = 0; m < 4; ++m)
#pragma unroll
                for (int bj = 0; bj < 2; ++bj) {
                    const size_t r = row0 + ai * 128 + m * 16; const int col = c0 + bj * 128;
                    const size_t goff = (size_t)lofs + ((ai * 4 + m) * 2 + bj) * 512;
                    float g[8]; unpack8(*(const u32x4*)(mg16 + ((size_t)u.pm * 12 + n * 4 + u.pn) * 16 * 8 * 512 + goff), g);
#pragma unroll
                    for (int j = 0; j < 8; ++j) g[j] = fmaxf(g[j], 1e-4f);
                    f32x4 a = acc[ai][bj][m][0], b = acc[ai][bj][m][1];
                    if (n < 2) {
                        float gn[8]; unpack8(*(const u32x4*)(mg16 + ((size_t)u.pm * 12 + (n + 1) * 4 + u.pn) * 16 * 8 * 512 + goff), gn);
#pragma unroll
                        for (int j = 0; j < 4; ++j) { a[j] *= g[j] * __builtin_amdgcn_rcpf(fmaxf(gn[j], 1e-4f)); b[j] *= g[4 + j] * __builtin_amdgcn_rcpf(fmaxf(gn[4 + j], 1e-4f)); }
                        acc[ai][bj][m][0] = a; acc[ai][bj][m][1] = b;
                    } else {
#pragma unroll
                        for (int j = 0; j < 4; ++j) { a[j] *= g[j]; b[j] *= g[4 + j]; }
                        *(u32x4*)(merged16 + r * D + col) = pack8(a, b);
                        acc[ai][bj][m][0] = (f32x4){0.f, 0.f, 0.f, 0.f}; acc[ai][bj][m][1] = (f32x4){0.f, 0.f, 0.f, 0.f};
                    }
                }
    }
};
struct EpiOut {
    static constexpr bool PERM = false, KEEP_ACC = false;
    const float* xin; float* out; const float* gate;
    __device__ __forceinline__ void operator()(f32x4 (&acc)[2][2][4][2], const pg::Unit& u, int wr, int wc, int fr, int fq) const {
        const size_t row0 = (size_t)u.pm * 256 + wr * 64 + fr; const int c0 = u.pn * 256 + wc * 32 + 4 * fq;
        const int b = (u.pm * 256) / S;
#pragma unroll
        for (int bj = 0; bj < 2; ++bj)
#pragma unroll
            for (int n = 0; n < 2; ++n) {
                const int col = c0 + bj * 128 + n * 16;
                const f32x4 gv = *(const f32x4*)(gate + (size_t)b * 3072 + col);
#pragma unroll
                for (int ai = 0; ai < 2; ++ai)
#pragma unroll
                    for (int m = 0; m < 4; ++m) {
                        const size_t off = (row0 + ai * 128 + m * 16) * D + col;
                        *(f32x4*)(out + off) = *(const f32x4*)(xin + off) + gv * acc[ai][bj][m][n];
                    }
            }
    }
};
constexpr float QSCALE = 0.08838834764831845f * 1.4426950408889634f;
__device__ void phase_fix(const Params& p, int l, float* lds) {
    {
        __half* tl = (__half*)lds;
        const int tid = tidx();
        for (int tile = blockIdx.x; tile < T / 64; tile += gridDim.x) {
            const int t0 = tile * 64, b = t0 / S, s0 = t0 % S;
            __syncthreads();
            for (int i = tid; i < 64 * 64; i += 512) { const int tt = i >> 6, e2 = (i & 63) * 2; *(h2*)(tl + tt * 130 + e2) = *(const h2*)(p.atv16 + (size_t)(t0 + tt) * 128 + e2); }
            __syncthreads();
#pragma unroll
            for (int rep = 0; rep < 2; ++rep) {
                const int ch = tid + 512 * rep;
                const int ln = ch & 63, s2 = (ch >> 6) & 1, et = (ch >> 7) & 3, ktl = ch >> 9, colv = ln & 31, hf = ln >> 5;
                h8 v;
#pragma unroll
                for (int j = 0; j < 8; ++j) v[j] = __builtin_bit_cast(_Float16, tl[(ktl * 32 + 16 * s2 + 8 * (j >> 2) + 4 * hf + (j & 3)) * 130 + 32 * et + colv]);
                *(h8*)(p.vf16 + ((((size_t)(b * 64 + (s0 >> 5) + ktl) * 4 + et) * 2 + s2) * 64 + ln) * 8) = v;
            }
        }
        __syncthreads();
    }
    const int w = tidx() >> 6, lane = tidx() & 63;
    __half* wl = (__half*)lds + w * 192;
    for (int t = blockIdx.x * 8 + w; t < T; t += gridDim.x * 8) {
        const int b = t / S, s = t % S, kt = s >> 5, colk = s & 31;
        const float cA = p.ropeA[((size_t)t * 64 + lane) * 2], sA = p.ropeA[((size_t)t * 64 + lane) * 2 + 1];
        for (int hh = 0; hh < 5; ++hh) {
            __half* q = hh < 4 ? p.atq16 + (size_t)t * W + hh * 128 : p.atk16 + (size_t)t * 128;
            const float* g = hh < 4 ? p.qn_g + l * 128 : p.kn_g + l * 128;
            const float x1 = __half2float(q[lane]), x2 = __half2float(q[64 + lane]);
            const float ss = wave_sum(x1 * x1 + x2 * x2);
            const float r = rsqrtf(ss * (1.f / 128.f) + EPS) * (hh < 4 ? QSCALE : 1.f);
            const float a = x1 * r * g[lane], b2 = x2 * r * g[64 + lane];
            const __half o1 = __float2half(a * cA - b2 * sA), o2 = __float2half(b2 * cA + a * sA);
            if (hh < 4) { q[lane] = o1; q[64 + lane] = o2; } else { wl[lane] = o1; wl[64 + lane] = o2; }
        }
        if (lane < 32) {
            const __half* q = p.ixk16 + (size_t)t * 64;
            const float cI = p.ropeI[((size_t)t * 32 + lane) * 2], sI = p.ropeI[((size_t)t * 32 + lane) * 2 + 1];
            const float x1 = __half2float(q[lane]), x2 = __half2float(q[32 + lane]);
            wl[128 + lane] = __float2half(x1 * cI - x2 * sI); wl[160 + lane] = __float2half(x2 * cI + x1 * sI);
        }
        for (int i = 0; i < 4; ++i) {
            const int idx = lane + 64 * i, hh = idx >> 5, j = idx & 31;
            __half* q = p.ixq16 + (size_t)t * W + hh * 64;
            const float cI = p.ropeI[((size_t)t * 32 + j) * 2], sI = p.ropeI[((size_t)t * 32 + j) * 2 + 1];
            const float x1 = __half2float(q[j]), x2 = __half2float(q[32 + j]);
            q[j] = __float2half(x1 * cI - x2 * sI); q[32 + j] = __float2half(x2 * cI + x1 * sI);
        }
        lds_fence();
        if (lane < 16) {
            const h8 v = *(const h8*)(wl + lane * 8);
            *(h8*)(p.kf16 + ((((size_t)(b * 64 + kt) * 8 + (lane >> 1)) * 64) + (lane & 1) * 32 + colk) * 8) = v;
        } else if (lane < 24) {
            const int c2 = lane - 16;
            const h8 v = *(const h8*)(wl + 128 + c2 * 8);
            *(h8*)(p.ikf16 + ((((size_t)(b * 64 + kt) * 4 + (c2 >> 1)) * 64) + (c2 & 1) * 32 + colk) * 8) = v;
        }
        lds_fence();
    }
}

__device__ __forceinline__ unsigned f2key(float f) { const unsigned u = __float_as_uint(f); return (u & 0x80000000u) ? ~u : (u | 0x80000000u); }
typedef float f32x16 __attribute__((ext_vector_type(16)));
typedef _Float16 h4 __attribute__((ext_vector_type(4)));
__device__ void dsa_select(const Params& p, int b, int q0, float* lds) {
    const int tid = tidx(), w = tid >> 6, lane = tid & 63, half = lane >> 5, col = lane & 31;
    float* sc = lds;
    {
        const int wq = w & 3, par = w >> 2;
        const int blk = col >> 2, wi = col & 3, ql = 2 * (blk & 1) + (blk >> 2), head = 4 * ((blk >> 1) & 1) + wi;
        const __half* qrow = p.ixq16 + (size_t)(b * S + q0 + wq * 4 + ql) * W + head * 64 + 8 * half;
        h8 af[4];
#pragma unroll
        for (int ks = 0; ks < 4; ++ks) af[ks] = *(const h8*)(qrow + 16 * ks);
        const int qa = wq * 4 + 2 * half;
        float iw0[8], iw1[8];
#pragma unroll
        for (int hh = 0; hh < 8; ++hh) { iw0[hh] = p.ixw32[(size_t)(b * S + q0 + qa) * 8 + hh]; iw1[hh] = p.ixw32[(size_t)(b * S + q0 + qa + 1) * 8 + hh]; }
        const int ntiles = (q0 + 15) / 32 + 1;
        const __half* ikb = p.ikf16 + (size_t)b * 64 * 4 * 512 + lane * 8;
        h8 bc[4];
        if (par < ntiles) {
#pragma unroll
            for (int ks = 0; ks < 4; ++ks) bc[ks] = *(const h8*)(ikb + ((size_t)par * 4 + ks) * 512);
        }
        for (int kt = par; kt < ntiles; kt += 2) {
            const int key = kt * 32 + col;
            const int ktn = kt + 2 < ntiles ? kt + 2 : kt;
            h8 bn[4];
#pragma unroll
            for (int ks = 0; ks < 4; ++ks) bn[ks] = *(const h8*)(ikb + ((size_t)ktn * 4 + ks) * 512);
            f32x16 acc;
#pragma unroll
            for (int r = 0; r < 16; ++r) acc[r] = 0.f;
#pragma unroll
            for (int ks = 0; ks < 4; ++ks) acc = __builtin_amdgcn_mfma_f32_32x32x16_f16(af[ks], bc[ks], acc, 0, 0, 0);
            float s0 = 0.f, s1 = 0.f;
#pragma unroll
            for (int r = 0; r < 8; ++r) { s0 += fmaxf(acc[r], 0.f) * iw0[r]; s1 += fmaxf(acc[8 + r], 0.f) * iw1[r]; }
            sc[qa * 2048 + key] = key <= q0 + qa ? s0 : -INFINITY;
            sc[(qa + 1) * 2048 + key] = key <= q0 + qa + 1 ? s1 : -INFINITY;
#pragma unroll
            for (int ks = 0; ks < 4; ++ks) bc[ks] = bn[ks];
        }
        for (int i = ntiles * 32 + tid; i < 2048; i += 512) {
#pragma unroll
            for (int q = 0; q < 16; ++q) sc[q * 2048 + i] = -INFINITY;
        }
    }
    __syncthreads();
    for (int qq = 0; qq < 2; ++qq) {
        const int ql = 2 * w + qq, qi = q0 + ql;
        const float* scl = sc + ql * 2048;
        const bool all = qi + 1 <= 256;
        unsigned key[32];
#pragma unroll
        for (int i = 0; i < 32; ++i) key[i] = f2key(scl[lane + 64 * i]);
        unsigned tge = 0x00800000u;
        int rrem = 0; bool split = false;
        if (!all) {
            unsigned prefix = 0; bool exact = false;
#pragma unroll 1
            for (int bit = 31; bit >= 0; --bit) {
                const unsigned cand = prefix | (1u << bit);
                int c = 0, cl = 0;
#pragma unroll
                for (int i = 0; i < 12; ++i) c += __popcll(__ballot(key[i] >= cand));
#pragma unroll
                for (int i = 12; i < 32; ++i) cl += (key[i] >= cand) ? 1 : 0;
#pragma unroll
                for (int bb = 0; bb < 5; ++bb) c += __popcll(__ballot((cl >> bb) & 1)) << bb;
                if (c >= 256) prefix = cand;
                if (c == 256) { exact = true; break; }
            }
            tge = prefix;
            if (!exact) {
                int cge = 0, cgt = 0;
#pragma unroll
                for (int i = 0; i < 32; ++i) { cge += __popcll(__ballot(key[i] >= prefix)); cgt += __popcll(__ballot(key[i] > prefix)); }
                if (cge > 256) { split = true; tge = prefix + 1u; rrem = 256 - cgt; }
            }
        }
        const unsigned long long lt = (1ull << lane) - 1ull;
        unsigned mylo = 0, myhi = 0;
        if (!split) {
#pragma unroll
            for (int i = 0; i < 32; ++i) {
                const unsigned long long m2 = __ballot(key[i] >= tge);
                if (lane == i) { mylo = (unsigned)m2; myhi = (unsigned)(m2 >> 32); }
            }
        } else {
#pragma unroll 1
            for (int i = 0; i < 32; ++i) {
                const unsigned k = f2key(scl[lane + 64 * i]);
                const bool eq = k == tge - 1u;
                const unsigned long long m = __ballot(eq);
                const bool sl = (k >= tge) || (eq && __popcll(m & lt) < rrem);
                rrem -= __popcll(m); if (rrem < 0) rrem = 0;
                const unsigned long long m2 = __ballot(sl);
                if (lane == i) { mylo = (unsigned)m2; myhi = (unsigned)(m2 >> 32); }
            }
        }
        if (lane < 32) *(uint2*)(p.mask + (size_t)(b * S + qi) * 64 + 2 * lane) = make_uint2(mylo, myhi);
    }
    __syncthreads();
}

__device__ void dsa_attend(const Params& p, int b, int g) {
    const int lane = tidx() & 63, half = lane >> 5, col = lane & 31;
    const int q0 = 8 * g, qi = q0 + (col >> 2), hd = col & 3;
    const __half* qp = p.atq16 + (size_t)(b * S + qi) * W + hd * 128 + 8 * half;
    h8 qf[8];
#pragma unroll
    for (int ks = 0; ks < 8; ++ks) qf[ks] = *(const h8*)(qp + 16 * ks);
    f32x16 o[4];
#pragma unroll
    for (int et = 0; et < 4; ++et)
#pragma unroll
        for (int r = 0; r < 16; ++r) o[et][r] = 0.f;
    float m = -INFINITY, l = 0.f;
    const int ntiles = (q0 + 7) / 32 + 1;
    const unsigned* mrow = p.mask + (size_t)(b * S + qi) * 64;
    const __half* kfb = p.kf16 + (size_t)b * 64 * 8 * 512 + lane * 8;
    const __half* vfb = p.vf16 + (size_t)b * 64 * 8 * 512 + lane * 8;
    h8 kA[8], kB[8];
#pragma unroll
    for (int ks = 0; ks < 8; ++ks) kA[ks] = *(const h8*)(kfb + (size_t)ks * 512);
#define DSA_TILE(kcur, knext, KT) do { \
        const int _kt = (KT), _ktn = _kt + 1 < ntiles ? _kt + 1 : _kt; \
        _Pragma("unroll") for (int ks = 0; ks < 8; ++ks) knext[ks] = *(const h8*)(kfb + ((size_t)_ktn * 8 + ks) * 512); \
        const unsigned mws = mrow[_kt] >> (4 * half); \
        f32x16 s; \
        _Pragma("unroll") for (int r = 0; r < 16; ++r) s[r] = 0.f; \
        _Pragma("unroll") for (int ks = 0; ks < 8; ++ks) s = __builtin_amdgcn_mfma_f32_32x32x16_f16(kcur[ks], qf[ks], s, 0, 0, 0); \
        h8 vf[8]; \
        _Pragma("unroll") for (int i = 0; i < 8; ++i) vf[i] = *(const h8*)(vfb + ((size_t)_kt * 8 + i) * 512); \
        float tmax = -INFINITY; \
        _Pragma("unroll") for (int r = 0; r < 16; ++r) { s[r] = (mws & (1u << ((r & 3) + 8 * (r >> 2)))) ? s[r] : -INFINITY; tmax = fmaxf(tmax, s[r]); } \
        tmax = fmaxf(tmax, __shfl_xor(tmax, 32)); \
        if (__any(tmax > m + 11.5f)) {          \
            const float mn = fmaxf(m, tmax), msf = mn == -INFINITY ? 0.f : mn; \
            const float cs = __builtin_amdgcn_exp2f(m - msf); \
            l *= cs; m = mn; \
            _Pragma("unroll") for (int et = 0; et < 4; ++et) _Pragma("unroll") for (int r = 0; r < 16; ++r) o[et][r] *= cs; \
        } \
        const float ms2 = m == -INFINITY ? 0.f : m; \
        float ps = 0.f; \
        _Pragma("unroll") for (int r = 0; r < 16; ++r) { s[r] = __builtin_amdgcn_exp2f(s[r] - ms2); ps += s[r]; } \
        l += ps; \
        h8 pb[2]; \
        _Pragma("unroll") for (int s2 = 0; s2 < 2; ++s2) _Pragma("unroll") for (int j = 0; j < 8; ++j) pb[s2][j] = (_Float16)s[8 * s2 + j]; \
        _Pragma("unroll") for (int et = 0; et < 4; ++et) _Pragma("unroll") for (int s2 = 0; s2 < 2; ++s2) \
            o[et] = __builtin_amdgcn_mfma_f32_32x32x16_f16(vf[et * 2 + s2], pb[s2], o[et], 0, 0, 0); \
    } while (0)
    int kt = 0;
#pragma unroll 1
    for (; kt + 1 < ntiles; kt += 2) { DSA_TILE(kA, kB, kt); DSA_TILE(kB, kA, kt + 1); }
    if (kt < ntiles) DSA_TILE(kA, kB, kt);
#undef DSA_TILE
    l += __shfl_xor(l, 32);
    const float inv = 1.f / l;
    __half* yb = p.ys + (size_t)T * W + (size_t)(b * S + qi) * W + hd * 128;
    const __half* gp = p.atg16 + (size_t)(b * S + qi) * W + hd * 128;
#pragma unroll
    for (int et = 0; et < 4; ++et)
#pragma unroll
        for (int r4 = 0; r4 < 4; ++r4) {
            const int e0 = 32 * et + 8 * r4 + 4 * half;
            const h4 gv = *(const h4*)(gp + e0);
            h4 ov;
#pragma unroll
            for (int j = 0; j < 4; ++j) ov[j] = (_Float16)(o[et][4 * r4 + j] * inv * (float)gv[j]);
            *(h4*)(yb + e0) = ov;
        }
}

typedef __bf16 bf8 __attribute__((ext_vector_type(8)));
constexpr int HG_QS = 136;
constexpr int HG_VS = 72;
__device__ __forceinline__ void hg_cumsum(const Params& p, int tok0, int hd, int tid, float* segt, float (&lf)[16], float (&bcs)[16], float& blast, float& bref) {
    const int d = tid & 127, seg = tid >> 7;
    float run = 0.f;
#pragma unroll
    for (int i = 0; i < 16; ++i) { lf[i] = p.lf32[(size_t)(tok0 + seg * 16 + i) * W + hd * 128 + d]; run += lf[i]; bcs[i] = run; }
    segt[seg * 128 + d] = run;
    __syncthreads();
    const float s0 = segt[d], s1 = segt[128 + d], s2 = segt[256 + d], s3 = segt[384 + d];
    const float off = seg == 0 ? 0.f : (seg == 1 ? s0 : (seg == 2 ? s0 + s1 : s0 + s1 + s2));
#pragma unroll
    for (int i = 0; i < 16; ++i) bcs[i] += off;
    blast = s0 + s1 + s2 + s3; bref = s0 + s1;
}
__device__ __forceinline__ void hg_load_vt(const Params& p, int tok0, int hd, int tid, __half* VT) {
    const int e = tid & 127, seg = tid >> 7;
    h8 v0, v1;
#pragma unroll
    for (int i = 0; i < 8; ++i) { v0[i] = __builtin_bit_cast(_Float16, p.v16[(size_t)(tok0 + seg * 16 + i) * W + hd * 128 + e]); v1[i] = __builtin_bit_cast(_Float16, p.v16[(size_t)(tok0 + seg * 16 + 8 + i) * W + hd * 128 + e]); }
    *(h8*)(VT + e * HG_VS + seg * 16) = v0; *(h8*)(VT + e * HG_VS + seg * 16 + 8) = v1;
}
__device__ void hg_pass1(const Params& p, int u, float* lds) {
    const int tid = tidx(), w = tid >> 6, lane = tid & 63, half = lane >> 5, col = lane & 31;
    const int c = u & 31, bh = u >> 5, hd = bh & 3, b = bh >> 2, tok0 = b * S + c * 64;
    __half* KH = (__half*)lds;
    __half* VT = KH + 128 * HG_VS;
    float* segt = (float*)(VT + 128 * HG_VS);
    __syncthreads();
    float lf[16], bcs[16], blast, bref;
    hg_cumsum(p, tok0, hd, tid, segt, lf, bcs, blast, bref);
    {
        const int d = tid & 127, seg = tid >> 7;
        h8 k0, k1;
#pragma unroll
        for (int i = 0; i < 8; ++i) { k0[i] = (_Float16)((1.f - __expf(lf[i])) * __expf(blast - bcs[i])); k1[i] = (_Float16)((1.f - __expf(lf[8 + i])) * __expf(blast - bcs[8 + i])); }
        *(h8*)(KH + d * HG_VS + seg * 16) = k0; *(h8*)(KH + d * HG_VS + seg * 16 + 8) = k1;
        if (seg == 0) p.dec32[(size_t)u * 128 + d] = __expf(blast);
    }
    hg_load_vt(p, tok0, hd, tid, VT);
    __syncthreads();
    const int dt = w >> 1;
    h8 af[4];
#pragma unroll
    for (int ks = 0; ks < 4; ++ks) af[ks] = *(const h8*)(KH + (dt * 32 + col) * HG_VS + 16 * ks + 8 * half);
#pragma unroll
    for (int ee = 0; ee < 2; ++ee) {
        const int et = (w & 1) * 2 + ee;
        f32x16 acc;
#pragma unroll
        for (int r = 0; r < 16; ++r) acc[r] = 0.f;
#pragma unroll
        for (int ks = 0; ks < 4; ++ks) acc = __builtin_amdgcn_mfma_f32_32x32x16_f16(af[ks], *(const h8*)(VT + (et * 32 + col) * HG_VS + 16 * ks + 8 * half), acc, 0, 0, 0);
        __half* dst = p.stT16 + ((size_t)u * 128 + et * 32 + col) * 128 + dt * 32 + 4 * half;
#pragma unroll
        for (int r4 = 0; r4 < 4; ++r4) { h4 o = {(_Float16)acc[4 * r4], (_Float16)acc[4 * r4 + 1], (_Float16)acc[4 * r4 + 2], (_Float16)acc[4 * r4 + 3]}; *(h4*)(dst + 8 * r4) = o; }
    }
}
__device__ void hg_scan(const Params& p) {
    const int gt = blockIdx.x * 512 + tidx();
    if (gt >= 32 * 128 * 16) return;
    const int d8 = (gt & 15) * 8, e = (gt >> 4) & 127, bh = gt >> 11;
    float s[8];
#pragma unroll
    for (int j = 0; j < 8; ++j) s[j] = 0.f;
    for (int c = 0; c < 32; ++c) {
        const size_t u = (size_t)bh * 32 + c;
        h8* ptr = (h8*)(p.stT16 + (u * 128 + e) * 128 + d8);
        const h8 t = *ptr;
        const f32x4 g0 = *(const f32x4*)(p.dec32 + u * 128 + d8), g1 = *(const f32x4*)(p.dec32 + u * 128 + d8 + 4);
        h8 o;
#pragma unroll
        for (int j = 0; j < 8; ++j) o[j] = (_Float16)s[j];
        *ptr = o;
#pragma unroll
        for (int j = 0; j < 4; ++j) { s[j] = g0[j] * s[j] + (float)t[j]; s[4 + j] = g1[j] * s[4 + j] + (float)t[4 + j]; }
    }
}
__device__ void hg_pass3(const Params& p, int l, int u, float* lds) {
    const int tid = tidx(), w = tid >> 6, lane = tid & 63, half = lane >> 5, col = lane & 31;
    const int c = u & 31, bh = u >> 5, hd = bh & 3, b = bh >> 2, tok0 = b * S + c * 64;
    __half* QI = (__half*)lds;
    __bf16* QM = (__bf16*)(QI + 64 * HG_QS);
    __bf16* KM = QM + 64 * HG_QS;
    __half* VT = (__half*)(KM + 64 * HG_QS);
    float* segt = (float*)(VT + 128 * HG_VS);
    float* part = segt + 512;
    __syncthreads();
    float lf[16], bcs[16], blast, bref;
    hg_cumsum(p, tok0, hd, tid, segt, lf, bcs, blast, bref);
    {
        const int d = tid & 127, seg = tid >> 7;
#pragma unroll
        for (int i = 0; i < 16; ++i) {
            const int tk = seg * 16 + i;
            const float q = __half2float(p.q16[(size_t)(tok0 + tk) * W + hd * 128 + d]);
            QI[tk * HG_QS + d] = __float2half(q * __expf(bcs[i]));
            QM[tk * HG_QS + d] = (__bf16)(q * __expf(bcs[i] - bref));
            KM[tk * HG_QS + d] = (__bf16)((1.f - __expf(lf[i])) * __expf(bref - bcs[i]));
        }
    }
    hg_load_vt(p, tok0, hd, tid, VT);
    __syncthreads();
    const int tt = w & 1, et = w >> 1;
    h8 pb[2][2];
    bf8 qm[8];
#pragma unroll
    for (int ks = 0; ks < 8; ++ks) qm[ks] = *(const bf8*)(QM + (tt * 32 + col) * HG_QS + 16 * ks + 8 * half);
#pragma unroll
    for (int st = 0; st < 2; ++st) {
        if (st <= tt) {
            f32x16 sacc;
#pragma unroll
            for (int r = 0; r < 16; ++r) sacc[r] = 0.f;
#pragma unroll
            for (int ks = 0; ks < 8; ++ks) sacc = __builtin_amdgcn_mfma_f32_32x32x16_bf16(*(const bf8*)(KM + (st * 32 + col) * HG_QS + 16 * ks + 8 * half), qm[ks], sacc, 0, 0, 0);
#pragma unroll
            for (int r = 0; r < 16; ++r) {
                const int sl = (r & 3) + 8 * (r >> 2) + 4 * half;
                const float v = (st < tt || sl <= col) ? sacc[r] : 0.f;
                pb[st][r >> 3][r & 7] = (_Float16)v;
            }
        } else {
#pragma unroll
            for (int j = 0; j < 8; ++j) { pb[st][0][j] = (_Float16)0.f; pb[st][1][j] = (_Float16)0.f; }
        }
    }
    f32x16 o;
#pragma unroll
    for (int r = 0; r < 16; ++r) o[r] = 0.f;
#pragma unroll
    for (int st = 0; st < 2; ++st) {
        if (st <= tt) {
#pragma unroll
            for (int s2 = 0; s2 < 2; ++s2) {
                const __half* vp = VT + (et * 32 + col) * HG_VS + st * 32 + 16 * s2 + 4 * half;
                const h4 v0 = *(const h4*)vp, v1 = *(const h4*)(vp + 8);
                const h8 vf = {v0[0], v0[1], v0[2], v0[3], v1[0], v1[1], v1[2], v1[3]};
                o = __builtin_amdgcn_mfma_f32_32x32x16_f16(vf, pb[st][s2], o, 0, 0, 0);
            }
        }
    }
    {
        const __half* sp = p.stT16 + ((size_t)u * 128 + et * 32 + col) * 128 + 8 * half;
#pragma unroll
        for (int ks = 0; ks < 8; ++ks) o = __builtin_amdgcn_mfma_f32_32x32x16_f16(*(const h8*)(sp + 16 * ks), *(const h8*)(QI + (tt * 32 + col) * HG_QS + 16 * ks + 8 * half), o, 0, 0, 0);
    }
    float ss = 0.f;
#pragma unroll
    for (int r = 0; r < 16; ++r) ss += o[r] * o[r];
    ss += __shfl_xor(ss, 32);
    if (half == 0) part[et * 64 + tt * 32 + col] = ss;
    __syncthreads();
    const int tk = tt * 32 + col;
    const float tot = part[tk] + part[64 + tk] + part[128 + tk] + part[192 + tk];
    const float rs = rsqrtf(tot * (1.f / 128.f) + EPS);
    const float* on = p.onorm_g + l * 128;
    const size_t ob = (size_t)(tok0 + tk) * W + hd * 128;
#pragma unroll
    for (int r4 = 0; r4 < 4; ++r4) {
        const int e0 = et * 32 + 8 * r4 + 4 * half;
        const h4 gv = *(const h4*)(p.hgg16 + ob + e0);
        const f32x4 nv = *(const f32x4*)(on + e0);
        h4 ov;
#pragma unroll
        for (int j = 0; j < 4; ++j) ov[j] = (_Float16)(o[4 * r4 + j] * rs * nv[j] * (float)gv[j]);
        *(h4*)(p.ys + ob + e0) = ov;
    }
}

constexpr int S5_UP = 1032;
__device__ void s5_pow_table(const Params& p) {
    const size_t gtid = (size_t)blockIdx.x * 512 + tidx(), nth = (size_t)gridDim.x * 512;
    for (size_t i = gtid; i < (size_t)NL * 32 * 64 * 65; i += nth) {
        const int tau = (int)(i % 65); const size_t lgp = i / 65; const int lg = (int)(lgp / 64);
        const double dt = exp((double)p.log_dt[lg]);
        const double are = p.a_re[lgp], aim = p.a_im[lgp];
        const double mag = exp(are * dt * tau), ang = aim * dt * tau;
        p.pw[i * 2] = (float)(mag * cos(ang)); p.pw[i * 2 + 1] = (float)(mag * sin(ang));
    }
    for (size_t i = gtid; i < (size_t)NL * 32; i += nth) {
        const float sgv = exp2f(rintf(-p.log_dt[i] * 1.4426950408889634f));
        p.sg[i * 2] = sgv; p.sg[i * 2 + 1] = 1.f / sgv;
    }
}
__device__ void s5_build_tables(const Params& p, int l, float* lds) {
    const size_t gtid = (size_t)blockIdx.x * 512 + tidx(), nth = (size_t)gridDim.x * 512;
    {
        float* Cr = lds; float* Ci = Cr + 16 * 65; float* Br = Ci + 16 * 65; float* Bi = Br + 64 * 17; float* Wr = Bi + 64 * 17; float* Wi = Wr + 16 * 64;
        const int tid = tidx();
        for (int item = blockIdx.x; item < 128; item += gridDim.x) {
            const int g = item >> 2, lq = item & 3; const size_t lg = (size_t)l * 32 + g;
            __syncthreads();
            for (int i = tid; i < 1024; i += 512) {
                const int c = i >> 6, s = i & 63; Cr[c * 65 + s] = p.c_re[(lg * 16 + c) * 64 + s]; Ci[c * 65 + s] = p.c_im[(lg * 16 + c) * 64 + s];
                const int s2 = i >> 4, cp = i & 15; Br[s2 * 17 + cp] = p.bbar[((lg * 64 + s2) * 16 + cp) * 2]; Bi[s2 * 17 + cp] = p.bbar[((lg * 64 + s2) * 16 + cp) * 2 + 1];
                const int ll = i >> 6; Wr[ll * 64 + s] = p.pw[((lg * 64 + s) * 65 + lq * 16 + ll) * 2]; Wi[ll * 64 + s] = p.pw[((lg * 64 + s) * 65 + lq * 16 + ll) * 2 + 1];
            }
            __syncthreads();
            const float sgv = p.sg[lg * 2];
#pragma unroll 1
            for (int k = 0; k < 8; ++k) {
                const int o = tid + 512 * k, cp = o & 15, c = (o >> 4) & 15, ll = o >> 8;
                float acc = 0.f;
#pragma unroll 8
                for (int s = 0; s < 64; ++s) {
                    const float cr = Cr[c * 65 + s], ci = Ci[c * 65 + s], wr = Wr[ll * 64 + s], wi = Wi[ll * 64 + s];
                    acc += (cr * wr - ci * wi) * Br[s * 17 + cp] - (cr * wi + ci * wr) * Bi[s * 17 + cp];
                }
                p.kmat16[(((size_t)g * 64 + lq * 16 + ll) * 16 + c) * 16 + cp] = __float2half(acc * sgv);
            }
        }
        __syncthreads();
    }
    for (size_t i8 = gtid; i8 < (size_t)32 * 128 * 1024 / 8; i8 += nth) {
        const size_t i = i8 * 8;
        const int cp0 = (int)(i & 15), sig = (int)((i >> 4) & 63), n = (int)((i >> 10) & 127), g = (int)(i >> 17);
        const size_t lg = (size_t)l * 32 + g; const int s = n & 63;
        const float wr = p.pw[((lg * 64 + s) * 65 + 63 - sig) * 2], wi = p.pw[((lg * 64 + s) * 65 + 63 - sig) * 2 + 1], sgv = p.sg[lg * 2];
        const float* bb = p.bbar + ((lg * 64 + s) * 16 + cp0) * 2;
        h8 o;
#pragma unroll
        for (int j = 0; j < 8; ++j) { const float br = bb[2 * j], bi = bb[2 * j + 1]; o[j] = (_Float16)((n < 64 ? wr * br - wi * bi : wr * bi + wi * br) * sgv); }
        *(h8*)(p.hs16 + i) = o;
    }
    for (size_t i8 = gtid; i8 < (size_t)32 * 1024 * 128 / 8; i8 += nth) {
        const size_t i = i8 * 8;
        const int n0 = (int)(i & 127), c = (int)((i >> 7) & 15), tau = (int)((i >> 11) & 63), g = (int)(i >> 17);
        const size_t lg = (size_t)l * 32 + g; const int s0 = n0 & 63;
        h8 o;
#pragma unroll
        for (int j = 0; j < 8; ++j) {
            const int s = s0 + j;
            const float cr = p.c_re[(lg * 16 + c) * 64 + s], ci = p.c_im[(lg * 16 + c) * 64 + s];
            const float wr = p.pw[((lg * 64 + s) * 65 + tau + 1) * 2], wi = p.pw[((lg * 64 + s) * 65 + tau + 1) * 2 + 1];
            o[j] = (_Float16)(n0 < 64 ? cr * wr - ci * wi : -(cr * wi + ci * wr));
        }
        *(h8*)(p.gs16 + i) = o;
    }
}
__device__ __forceinline__ void s5_load_u(const Params& p, int g, int b, int tid, __half* U) {
#pragma unroll
    for (int i = 0; i < 4; ++i) {
        const int idx = tid + 512 * i, ch = idx >> 6, sig = idx & 63;
        const h8* src = (const h8*)(p.s5u16 + (size_t)(b * S + ch * 64 + sig) * W + g * 16);
        const h8 a = src[0], c2 = src[1];
        *(h8*)(U + ch * S5_UP + sig * 16) = a; *(h8*)(U + ch * S5_UP + sig * 16 + 8) = c2;
    }
}
__device__ void s5_pass1(const Params& p, int g, int b, float* lds) {
    const int tid = tidx(), w = tid >> 6, lane = tid & 63, half = lane >> 5, col = lane & 31;
    __half* U = (__half*)lds;
    float* part = (float*)(U + 32 * S5_UP);
    __syncthreads();
    s5_load_u(p, g, b, tid, U);
    __syncthreads();
    const int nt = w & 3, sh = w >> 2;
    const __half* hp = p.hs16 + ((size_t)g * 128 + nt * 32 + col) * 1024 + 8 * half;
    const __half* up = U + col * S5_UP + 8 * half;
    f32x16 acc;
#pragma unroll
    for (int r = 0; r < 16; ++r) acc[r] = 0.f;
#pragma unroll 8
    for (int sig = sh * 32; sig < sh * 32 + 32; ++sig) acc = __builtin_amdgcn_mfma_f32_32x32x16_f16(*(const h8*)(hp + sig * 16), *(const h8*)(up + sig * 16), acc, 0, 0, 0);
    if (sh == 1) {
#pragma unroll
        for (int r = 0; r < 16; ++r) part[(nt * 16 + r) * 64 + lane] = acc[r];
    }
    __syncthreads();
    if (sh == 0) {
        float* ep = p.e32 + (((size_t)g * 8 + b) * 32 + col) * 128 + nt * 32 + 4 * half;
#pragma unroll
        for (int r4 = 0; r4 < 4; ++r4) {
            f32x4 o;
#pragma unroll
            for (int j = 0; j < 4; ++j) o[j] = acc[4 * r4 + j] + part[(nt * 16 + 4 * r4 + j) * 64 + lane];
            *(f32x4*)(ep + 8 * r4) = o;
        }
    }
}
__device__ void s5_scan(const Params& p, int l) {
    const int gt = blockIdx.x * 512 + tidx();
    if (gt >= 32 * 8 * 64) return;
    const int s = gt & 63, b = (gt >> 6) & 7, g = gt >> 9;
    const size_t lg = (size_t)l * 32 + g;
    const float ar = p.pw[((lg * 64 + s) * 65 + 64) * 2], ai = p.pw[((lg * 64 + s) * 65 + 64) * 2 + 1];
    float xr = 0.f, xi = 0.f;
    for (int c = 0; c < 32; ++c) {
        const size_t base = (((size_t)g * 8 + b) * 32 + c) * 128;
        p.x16[base + s] = __float2half(xr); p.x16[base + 64 + s] = __float2half(xi);
        const float er = p.e32[base + s], ei = p.e32[base + 64 + s];
        const float nr = ar * xr - ai * xi + er, ni = ar * xi + ai * xr + ei;
        xr = nr; xi = ni;
    }
}
__device__ void s5_pass3(const Params& p, int l, int g, int b, float* lds) {
    const int tid = tidx(), w = tid >> 6, lane = tid & 63, half = lane >> 5, col = lane & 31;
    __half* U = (__half*)lds;
    __half* KM = U + 32 * S5_UP;
    __syncthreads();
    s5_load_u(p, g, b, tid, U);
    for (int i = tid; i < 64 * 256 / 8; i += 512) *(h8*)(KM + i * 8) = *(const h8*)(p.kmat16 + (size_t)g * 64 * 256 + i * 8);
    __syncthreads();
    h8 xb[8];
    {
        const __half* xp = p.x16 + (((size_t)g * 8 + b) * 32 + col) * 128 + 8 * half;
#pragma unroll
        for (int ks = 0; ks < 8; ++ks) xb[ks] = *(const h8*)(xp + 16 * ks);
    }
    const float isg = p.sg[((size_t)l * 32 + g) * 2 + 1];
    const __half* up = U + col * S5_UP + 8 * half;
    const int cch = col & 15, tl = col >> 4;
#pragma unroll 1
    for (int rt = w; rt < 32; rt += 8) {
        f32x16 acc;
#pragma unroll
        for (int r = 0; r < 16; ++r) acc[r] = 0.f;
        const int tau = 2 * rt + tl;
#pragma unroll 2
        for (int sig = 0; sig <= 2 * rt + 1; ++sig) {
            const int lag = tau - sig;
            h8 a;
            if (lag >= 0) a = *(const h8*)(KM + (lag * 16 + cch) * 16 + 8 * half);
            else {
#pragma unroll
                for (int j = 0; j < 8; ++j) a[j] = (_Float16)0.f;
            }
            acc = __builtin_amdgcn_mfma_f32_32x32x16_f16(a, *(const h8*)(up + sig * 16), acc, 0, 0, 0);
        }
        const __half* gp = p.gs16 + ((size_t)g * 1024 + 2 * rt * 16 + col) * 128 + 8 * half;
#pragma unroll
        for (int ks = 0; ks < 8; ++ks) acc = __builtin_amdgcn_mfma_f32_32x32x16_f16(*(const h8*)(gp + 16 * ks), xb[ks], acc, 0, 0, 0);
#pragma unroll
        for (int r4 = 0; r4 < 4; ++r4) {
            const int tloc = r4 >> 1, c0 = 8 * (r4 & 1) + 4 * half;
            const int tk = 2 * rt + tloc;
            const h4 uv = *(const h4*)(U + col * S5_UP + tk * 16 + c0);
            const f32x4 dv = *(const f32x4*)(p.s5_d + l * W + g * 16 + c0);
            h4 ov;
#pragma unroll
            for (int j = 0; j < 4; ++j) ov[j] = (_Float16)gelu_tanh_f(acc[4 * r4 + j] * isg + dv[j] * (float)uv[j]);
            *(h4*)(p.ypre16 + (size_t)(b * S + col * 64 + tk) * W + g * 16 + c0) = ov;
        }
    }
}

__device__ void phase_mix1(const Params& p, int l, float* lds) {
    const int c = blockIdx.x, G = gridDim.x;
    phase_fix(p, l, lds);
    for (int u = c; u < 256; u += G) s5_pass1(p, u >> 3, u & 7, lds);
    for (int u = c; u < 1024; u += G) hg_pass1(p, u, lds);
}
__device__ void phase_mix2(const Params& p, int l, float* lds) {
    const int c = blockIdx.x, G = gridDim.x;
    s5_scan(p, l);
    hg_scan(p);
    __syncthreads();
    for (int it = c; it < NB * 64; it += G) { const int b = it >> 6, jp = it & 63; dsa_select(p, b, jp * 16, lds); dsa_select(p, b, (127 - jp) * 16, lds); }
}
__device__ void phase_mix3(const Params& p, int l, float* lds) {
    const int w = tidx() >> 6;
    for (int c = blockIdx.x; c < 256; c += gridDim.x) {
        const int b = c >> 5, cc = c & 31;
        const int g = w < 4 ? cc * 4 + w : 255 - (cc * 4 + (w - 4));
        dsa_attend(p, b, g);
    }
    for (int u = blockIdx.x; u < 256; u += gridDim.x) s5_pass3(p, l, u >> 3, u & 7, lds);
    for (int u = blockIdx.x; u < 1024; u += gridDim.x) hg_pass3(p, l, u, lds);
}

#define XB_TMO      128
#define XB_XCNT(j)  (256  + 64 * (j))
#define XB_XSUB(j)  (1280 + 64 * (j))
#define XB_XGEN(j)  (2304 + 64 * (j))
#define XB_TOP      3328
#define XB_TOPGEN   3392
#define XCD_BAR_WORDS 3456
#define XB_SPIN_CAP (1u << 22)
__device__ __forceinline__ unsigned xb_ld(unsigned* p)              { return __hip_atomic_load(p, __ATOMIC_RELAXED, __HIP_MEMORY_SCOPE_AGENT); }
__device__ __forceinline__ unsigned xb_add(unsigned* p, unsigned v) { return __hip_atomic_fetch_add(p, v, __ATOMIC_RELAXED, __HIP_MEMORY_SCOPE_AGENT); }
__device__ __forceinline__ unsigned xb_xcc_id() { return (unsigned)__builtin_amdgcn_s_getreg((3 << 11) | 20) & 0xFu; }
#define XB_SPIN(cond, bar) do { unsigned _sp = 0; while (cond) { __builtin_amdgcn_s_sleep(1); \
    if ((++_sp & 255u) == 0u) { if (xb_ld(&(bar)[XB_TMO])) break; if (_sp > XB_SPIN_CAP) { atomicAdd(&(bar)[XB_TMO], 1u); break; } } } } while (0)
struct XcdBarrier { unsigned* bar; unsigned x; volatile LAS unsigned* st; };
__device__ __forceinline__ XcdBarrier xcd_barrier_post(unsigned* bar, volatile LAS unsigned* st) {
    XcdBarrier b; b.bar = bar; b.x = xb_xcc_id(); b.st = st;
    if (threadIdx.x == 0) (void)xb_add(&bar[XB_XCNT(b.x)], 1u);
    return b;
}
__device__ __forceinline__ void xcd_barrier_complete(unsigned* bar, unsigned x, unsigned& nloc, unsigned& nx) {
    const unsigned G = gridDim.x * gridDim.y * gridDim.z;
    unsigned sum, cnt, mine, sp = 0u;
    for (;;) {
        sum = 0u; cnt = 0u; mine = 0u;
#pragma unroll
        for (unsigned j = 0; j < 16; ++j) { const unsigned c = xb_ld(&bar[XB_XCNT(j)]); sum += c; cnt += (c > 0u) ? 1u : 0u; mine = (j == x) ? c : mine; }
        if (sum == G) break;
        __builtin_amdgcn_s_sleep(1);
        if ((++sp & 255u) == 0u) { if (xb_ld(&bar[XB_TMO])) break; if (sp > XB_SPIN_CAP) { atomicAdd(&bar[XB_TMO], 1u); break; } }
    }
    nloc = mine > 0u ? mine : 1u; nx = cnt > 0u ? cnt : 1u;
}
__device__ __forceinline__ void xcd_barrier(const XcdBarrier& b) {
    asm volatile("s_waitcnt vmcnt(0)" ::: "memory");
    __syncthreads();
    if (threadIdx.x == 0) {
        unsigned* bar = b.bar;
        __builtin_amdgcn_s_waitcnt(0);
        unsigned nloc = b.st[0], nx = b.st[1];
        if (nloc == 0u) { xcd_barrier_complete(bar, b.x, nloc, nx); b.st[0] = nloc; b.st[1] = nx; }
        const unsigned old = xb_add(&bar[XB_XSUB(b.x)], 1u);
        const unsigned gen = old / nloc;
        if (old + 1u == (gen + 1u) * nloc) {
            __builtin_amdgcn_fence(__ATOMIC_RELEASE, "agent");
            asm volatile("s_waitcnt vmcnt(0)" ::: "memory");
            const unsigned og = xb_add(&bar[XB_TOP], 1u);
            const unsigned tg = og / nx;
            if (og + 1u == (tg + 1u) * nx) xb_add(&bar[XB_TOPGEN], 1u);
            else XB_SPIN(xb_ld(&bar[XB_TOPGEN]) == tg, bar);
            __builtin_amdgcn_fence(__ATOMIC_ACQUIRE, "agent");
            xb_add(&bar[XB_XGEN(b.x)], 1u);
            asm volatile("s_waitcnt vmcnt(0)" ::: "memory");
        } else {
            XB_SPIN(xb_ld(&bar[XB_XGEN(b.x)]) == gen, bar);
            __builtin_amdgcn_fence(__ATOMIC_ACQUIRE, "agent");
            asm volatile("s_waitcnt vmcnt(0)" ::: "memory");
        }
    }
    __syncthreads();
}

typedef const __attribute__((address_space(4))) Params* KParams;
#define PHASE_PARAMS() KParams _kp = (KParams)__builtin_amdgcn_kernarg_segment_ptr(); asm volatile("" : "+s"(_kp)); const Params& p = *(const Params*)_kp
__global__ void __launch_bounds__(512, 2) mega(Params p_unused) {
    extern __shared__ __attribute__((aligned(16))) float lds[];
    LAS unsigned char* ldsb = (LAS unsigned char*)lds;
    cg::grid_group grid = cg::this_grid();
    const int G = gridDim.x, c = blockIdx.x;
    __shared__ uint4 xb_words;
    if (threadIdx.x == 0) xb_words = make_uint4(0u, 0u, 0u, 0u);
    __syncthreads();
    XcdBarrier xbar;
    { PHASE_PARAMS(); xbar = xcd_barrier_post(p.xbar, (volatile LAS unsigned*)&xb_words); }
    { PHASE_PARAMS(); phase0(p); s5_pow_table(p); }
    grid.sync();
    for (int l = 0; l < NL; ++l) {
        { PHASE_PARAMS(); conv_layer(p, l, lds); phase_h(p, l); s5_build_tables(p, l, lds); }
        xcd_barrier(xbar);
        {
            PHASE_PARAMS();
            SchedPlain sc{(const char*)p.h16, (const char*)p.win16, 64, 32, G, c, D};
            EpiProj ep{p.q16, p.v16, p.hgg16, p.atq16, p.atk16, p.atv16, p.atg16, p.ixq16, p.ixk16, p.s5u16, p.s5g16, p.mg16, p.lf32, p.ixw32, p.lb + l * 512};
            pg::gemm_phase(ldsb, D, sc, ep);
        }
        xcd_barrier(xbar);
        { PHASE_PARAMS(); phase_mix1(p, l, lds); }
        xcd_barrier(xbar);
        { PHASE_PARAMS(); phase_mix2(p, l, lds); }
        xcd_barrier(xbar);
        { PHASE_PARAMS(); phase_mix3(p, l, lds); }
        xcd_barrier(xbar);
        {
            PHASE_PARAMS();
            SchedPlain sc{(const char*)p.ypre16, (const char*)p.wglu16, 64, 2, G, c, W};
            EpiGlu ep{p.ypre16, p.s5g16, p.glu_b + l * W, p.ys + (size_t)2 * T * W, nullptr};
            pg::gemm_phase(ldsb, W, sc, ep);
        }
        xcd_barrier(xbar);
        {
            PHASE_PARAMS();
            SchedMerge sc{(const char*)p.ys, (const char*)p.wb16, G, c};
            EpiMerge ep{p.mg16, p.merged16};
            pg::gemm_phase(ldsb, W, sc, ep);
        }
        xcd_barrier(xbar);
        {
            PHASE_PARAMS();
            SchedPlain sc{(const char*)p.merged16, (const char*)p.wo16, 64, 4, G, c, D};
            EpiOut ep{l == 0 ? p.x : p.out, p.out, p.mod + (size_t)l * NB * 3072 + 2 * D};
            pg::gemm_phase(ldsb, D, sc, ep);
        }
        xcd_barrier(xbar);
    }
}

extern "C" void kernel_launch(void* const* d_in, const int* in_sizes, int n_in,
                              void* d_out, int out_size, void* d_ws, size_t ws_size,
                              hipStream_t stream) {
    static int grid_blocks = 0;
    if (!grid_blocks) {
        int dev = 0, cus = 0, per_cu = 0;
        (void)hipGetDevice(&dev);
        (void)hipDeviceGetAttribute(&cus, hipDeviceAttributeMultiprocessorCount, dev);
        (void)hipFuncSetAttribute((const void*)mega, hipFuncAttributeMaxDynamicSharedMemorySize, LDS_BYTES);
        (void)hipOccupancyMaxActiveBlocksPerMultiprocessor(&per_cu, mega, 512, LDS_BYTES);
        if (per_cu > 1) per_cu = 1;
        grid_blocks = cus * per_cu;
    }
    Params p{};
    const float* const* in = (const float* const*)d_in;
    p.x = in[0]; p.c = in[1]; p.pos = (const int*)d_in[2];
    p.ada_w = in[3]; p.ada_b = in[4]; p.norm_g = in[5]; p.w_in = in[6]; p.lb_logits = in[7]; p.onorm_g = in[8]; p.qn_g = in[9]; p.kn_g = in[10];
    p.a_re = in[11]; p.a_im = in[12]; p.log_dt = in[13]; p.b_re = in[14]; p.b_im = in[15]; p.c_re = in[16]; p.c_im = in[17]; p.s5_d = in[18];
    p.glu_w = in[19]; p.glu_b = in[20]; p.w_branch = in[21]; p.w_out = in[22];
    p.out = (float*)d_out;
    char* ws = (char*)d_ws; size_t off = 0;
    auto take = [&](size_t bytes) { char* q = ws + off; off += (bytes + 255) & ~(size_t)255; return q; };
    const size_t TW2 = (size_t)T * W * 2;
    p.mod = (float*)take((size_t)NL * NB * 3072 * 4);
    p.lb = (float*)take((size_t)NL * 512 * 4);
    p.abar = (float*)take((size_t)NL * 32 * 64 * 2 * 4);
    p.bbar = (float*)take((size_t)NL * 32 * 64 * 16 * 2 * 4);
    p.ropeA = (float*)take((size_t)T * 64 * 2 * 4);
    p.ropeI = (float*)take((size_t)T * 32 * 2 * 4);
    p.win16 = (__half*)take((size_t)NPK * D * 2);
    p.wb16 = (__half*)take((size_t)3 * D * W * 2);
    p.wo16 = (__half*)take((size_t)D * D * 2);
    p.wglu16 = (__half*)take((size_t)W * W * 2);
    p.h16 = (__half*)take((size_t)T * D * 2);       p.merged16 = p.h16; p.stT16 = p.h16;
    p.q16 = (__half*)take(TW2);                     p.mp32 = (float*)p.q16;
    p.lf32 = (float*)take((size_t)T * W * 4);
    p.v16 = (__half*)take(TW2);
    p.hgg16 = (__half*)take(TW2);
    p.atq16 = (__half*)take(TW2);
    p.atk16 = (__half*)take((size_t)T * 128 * 2);
    p.atv16 = (__half*)take((size_t)T * 128 * 2);
    p.atg16 = (__half*)take(TW2);
    p.ixq16 = (__half*)take(TW2);
    p.ixk16 = (__half*)take((size_t)T * 64 * 2);
    p.ixw32 = (float*)take((size_t)T * 8 * 4);
    p.s5u16 = (__half*)take(TW2);
    p.s5g16 = (__half*)take(TW2);
    p.mg16 = (__half*)take((size_t)T * 3072 * 2);
    p.ys = (__half*)take(3 * TW2);
    p.ypre16 = (__half*)take(TW2);
    p.dbg = (unsigned*)take(256);
    p.xbar = (unsigned*)take((size_t)XCD_BAR_WORDS * 4);
    p.pw = (float*)take((size_t)NL * 32 * 64 * 65 * 2 * 4);
    p.sg = (float*)take((size_t)NL * 32 * 2 * 4);
    p.kmat16 = (__half*)take((size_t)32 * 64 * 256 * 2);
    p.hs16 = (__half*)take((size_t)32 * 128 * 1024 * 2);
    p.gs16 = (__half*)take((size_t)32 * 1024 * 128 * 2);
    p.e32 = (float*)take((size_t)32 * 8 * 32 * 128 * 4);
    p.x16 = (__half*)take((size_t)32 * 8 * 32 * 128 * 2);
    p.dec32 = (float*)take((size_t)1024 * 128 * 4);
    p.mask = (unsigned*)take((size_t)T * 64 * 4);
    p.kf16 = (__half*)take((size_t)T * 128 * 2);
    p.vf16 = (__half*)take((size_t)T * 128 * 2);
    p.ikf16 = (__half*)take((size_t)T * 64 * 2);
    if (off > ws_size) { fprintf(stderr, "workspace too small: need %zu have %zu\n", off, ws_size); return; }
    (void)hipMemsetAsync(p.xbar, 0, (size_t)XCD_BAR_WORDS * 4, stream);
    (void)hipMemsetAsync(p.mod, 0, (size_t)NL * NB * 3072 * 4, stream);
    void* args[] = {&p};
    hipError_t e = hipLaunchCooperativeKernel((void*)mega, dim3(grid_blocks), dim3(512), args, LDS_BYTES, stream);
    if (e != hipSuccess) fprintf(stderr, "cooperative launch failed: %s (grid %d)\n", hipGetErrorString(e), grid_blocks);
}
```

```cpp
#include <hip/hip_runtime.h>
#include <hip/hip_cooperative_groups.h>
#include <hip/hip_fp16.h>
#include <cstdio>
namespace cg = cooperative_groups;

constexpr int D = 1024, NB = 8, S = 2048, T = NB * S, NL = 4, W = 512, NIN = 8008, NPK = 8192;
constexpr int C_S5U = 3912, C_MG = 4936;
constexpr float EPS = 1e-6f;
constexpr int LDS_BYTES = 135168;
#define LAS __attribute__((address_space(3)))
typedef _Float16 h8 __attribute__((ext_vector_type(8)));
typedef _Float16 h2 __attribute__((ext_vector_type(2)));
typedef float f32x4 __attribute__((ext_vector_type(4)));
typedef unsigned u32x4 __attribute__((ext_vector_type(4)));

struct Params {
    const float *x, *c; const int* pos;
    const float *ada_w, *ada_b, *norm_g, *w_in, *lb_logits, *onorm_g, *qn_g, *kn_g;
    const float *a_re, *a_im, *log_dt, *b_re, *b_im, *c_re, *c_im, *s5_d, *glu_w, *glu_b, *w_branch, *w_out;
    float* out;
    float *mod, *lb, *abar, *bbar, *ropeA, *ropeI;
    __half *win16, *wb16, *wo16, *wglu16;
    __half *h16, *q16, *v16, *hgg16, *atq16, *atk16, *atv16, *atg16, *ixq16, *ixk16, *s5u16, *s5g16, *mg16, *ys, *ypre16, *merged16;
    float *lf32, *ixw32, *mp32; unsigned* dbg; unsigned* mask; unsigned* xbar; __half *kf16, *vf16, *ikf16; __half* stT16; float* dec32; float *pw, *sg, *e32; __half *kmat16, *hs16, *gs16, *x16;
};

__device__ __forceinline__ float sigmoid_f(float v) { return 1.f / (1.f + expf(-v)); }
__device__ __forceinline__ float silu_f(float v) { return v / (1.f + expf(-v)); }
__device__ __forceinline__ float gelu_tanh_f(float v) { const float u = 0.7978845608028654f * (v + 0.044715f * v * v * v); return v * __builtin_amdgcn_rcpf(1.f + __builtin_amdgcn_exp2f(-2.885390081777927f * u)); }
__device__ __forceinline__ float wave_sum(float v) {
#pragma unroll
    for (int o = 32; o > 0; o >>= 1) v += __shfl_xor(v, o);
    return v;
}
__device__ __forceinline__ void lds_fence() { asm volatile("s_waitcnt lgkmcnt(0)" ::: "memory"); }
#define BAR_LDS() do { asm volatile("s_waitcnt lgkmcnt(0)" ::: "memory"); __builtin_amdgcn_s_barrier(); asm volatile("" ::: "memory"); } while (0)
__device__ __forceinline__ int tidx() { int t = threadIdx.x; asm volatile("" : "+v"(t)); return t; }

__device__ void phase0(const Params& p) {
    const size_t gtid = (size_t)blockIdx.x * blockDim.x + tidx(), nth = (size_t)gridDim.x * blockDim.x;
    {
        for (size_t i = gtid; i < (size_t)NL * 3072 * 8; i += nth) {
            const int col = (int)(i % 3072), ksl = (int)((i / 3072) % 8), l = (int)(i / (3072 * 8));
            const float* w = p.ada_w + ((size_t)l * 1024 + ksl * 128) * 3072 + col;
            float acc[NB];
#pragma unroll
            for (int b = 0; b < NB; ++b) acc[b] = ksl == 0 ? p.ada_b[l * 3072 + col] : 0.f;
#pragma unroll 4
            for (int k = 0; k < 128; ++k) {
                const float wv = w[(size_t)k * 3072];
#pragma unroll
                for (int b = 0; b < NB; ++b) { const float cv = p.c[b * 1024 + ksl * 128 + k]; acc[b] += cv * __builtin_amdgcn_rcpf(1.f + __builtin_amdgcn_exp2f(-1.4426950408889634f * cv)) * wv; }
            }
#pragma unroll
            for (int b = 0; b < NB; ++b) atomicAdd(p.mod + ((size_t)l * NB + b) * 3072 + col, acc[b]);
        }
    }
    for (size_t i = gtid; i < 512; i += nth) {
        float lg[NL], mx = -1e30f;
#pragma unroll
        for (int l = 0; l < NL; ++l) { lg[l] = p.lb_logits[l * 512 + i]; mx = fmaxf(mx, lg[l]); }
        float s = 0.f;
#pragma unroll
        for (int l = 0; l < NL; ++l) { lg[l] = expf(lg[l] - mx); s += lg[l]; }
        float cum = 0.f;
#pragma unroll
        for (int l = 0; l < NL; ++l) { const float pr = lg[l] / s; cum += pr; p.lb[l * 512 + i] = cum - lg[0] / s; }
    }
    for (size_t i = gtid; i < (size_t)NL * 32 * 64; i += nth) {
        const int lg = (int)(i / 64);
        const double dt = exp((double)p.log_dt[lg]);
        const double are = p.a_re[i], aim = p.a_im[i];
        const double mag = exp(are * dt), ang = aim * dt;
        const double abr = mag * cos(ang), abi = mag * sin(ang);
        const double nr = abr - 1.0, ni = abi, den = are * are + aim * aim;
        const double fr = (nr * are + ni * aim) / den, fi = (ni * are - nr * aim) / den;
        p.abar[i * 2] = (float)abr; p.abar[i * 2 + 1] = (float)abi;
        for (int c = 0; c < 16; ++c) {
            const double br = p.b_re[i * 16 + c], bi = p.b_im[i * 16 + c];
            p.bbar[(i * 16 + c) * 2] = (float)(fr * br - fi * bi);
            p.bbar[(i * 16 + c) * 2 + 1] = (float)(fr * bi + fi * br);
        }
    }
    for (size_t i = gtid; i < (size_t)T * 64; i += nth) {
        const int t = (int)(i / 64), j = (int)(i % 64);
        const double inv = pow(10000.0, -(double)(2 * j) / 128.0);
        const double ang = (double)p.pos[t] * inv;
        p.ropeA[i * 2] = (float)cos(ang); p.ropeA[i * 2 + 1] = (float)sin(ang);
    }
    for (size_t i = gtid; i < (size_t)T * 32; i += nth) {
        const int t = (int)(i / 32), j = (int)(i % 32);
        const double inv = pow(10000.0, -(double)(2 * j) / 64.0);
        const double ang = (double)p.pos[t] * inv;
        p.ropeI[i * 2] = (float)cos(ang); p.ropeI[i * 2 + 1] = (float)sin(ang);
    }
}

__device__ __forceinline__ unsigned pk2(float a, float b) { h2 v = {(_Float16)a, (_Float16)b}; return __builtin_bit_cast(unsigned, v); }
__device__ void phase_h(const Params& p, int l) {
    const float* xin = l == 0 ? p.x : p.out;
    const int w = tidx() >> 6, lane = tidx() & 63;
    for (int row = blockIdx.x * 8 + w; row < T; row += gridDim.x * 8) {
        const int b = row / S;
        const float* xr = xin + (size_t)row * D;
        float4 v[4]; float ss = 0.f;
#pragma unroll
        for (int i = 0; i < 4; ++i) { v[i] = *(const float4*)(xr + i * 256 + lane * 4); ss += v[i].x * v[i].x + v[i].y * v[i].y + v[i].z * v[i].z + v[i].w * v[i].w; }
        ss = wave_sum(ss);
        const float r = rsqrtf(ss * (1.f / D) + EPS);
        const float* md = p.mod + ((size_t)l * NB + b) * 3072;
#pragma unroll
        for (int i = 0; i < 4; ++i) {
            const int k = i * 256 + lane * 4;
            const float4 g = *(const float4*)(p.norm_g + l * D + k), sh = *(const float4*)(md + k), sc = *(const float4*)(md + D + k);
            uint2 o;
            o.x = pk2(v[i].x * r * g.x * (1.f + sc.x) + sh.x, v[i].y * r * g.y * (1.f + sc.y) + sh.y);
            o.y = pk2(v[i].z * r * g.z * (1.f + sc.z) + sh.z, v[i].w * r * g.w * (1.f + sc.w) + sh.w);
            *(uint2*)(p.h16 + (size_t)row * D + k) = o;
        }
    }
}
template <class CM>
__device__ void conv_transpose(const float* __restrict__ src, int ldsrc, int K, __half* __restrict__ dst, int N, CM colmap, float* lds, int part, int nparts) {
    float (*ts)[65] = (float (*)[65])lds;
    const int tid = tidx(), nkt = K / 64, nnt = N / 64;
    for (int tile = part; tile < nkt * nnt; tile += nparts) {
        const int kt = tile % nkt, nt = tile / nkt, k0 = kt * 64, n0 = nt * 64;
        __syncthreads();
#pragma unroll
        for (int i = 0; i < 8; ++i) {
            const int idx = tid + 512 * i, k = idx >> 6, n = idx & 63;
            const int sc = colmap(n0 + n);
            ts[k][n] = sc >= 0 ? src[(size_t)(k0 + k) * ldsrc + sc] : 0.f;
        }
        __syncthreads();
        const int n = tid >> 3, k8 = (tid & 7) * 8;
        u32x4 w;
        { h2 a = {(_Float16)ts[k8 + 0][n], (_Float16)ts[k8 + 1][n]}; w.x = __builtin_bit_cast(unsigned, a); }
        { h2 a = {(_Float16)ts[k8 + 2][n], (_Float16)ts[k8 + 3][n]}; w.y = __builtin_bit_cast(unsigned, a); }
        { h2 a = {(_Float16)ts[k8 + 4][n], (_Float16)ts[k8 + 5][n]}; w.z = __builtin_bit_cast(unsigned, a); }
        { h2 a = {(_Float16)ts[k8 + 6][n], (_Float16)ts[k8 + 7][n]}; w.w = __builtin_bit_cast(unsigned, a); }
        *(u32x4*)(dst + (size_t)(n0 + n) * K + k0 + k8) = w;
    }
}
struct CmIdent { __device__ int operator()(int n) const { return n; } };
struct CmWin { __device__ int operator()(int n) const { return n < C_S5U ? n : (n < 4096 ? -1 : n - 184); } };

__device__ void conv_layer(const Params& p, int l, float* lds) {
    conv_transpose(p.w_in + (size_t)l * D * NIN, NIN, D, p.win16, NPK, CmWin(), lds, blockIdx.x, gridDim.x);
    for (int n = 0; n < 3; ++n)
        conv_transpose(p.w_branch + ((size_t)l * 3 + n) * W * D, D, W, p.wb16 + (size_t)n * D * W, D, CmIdent(), lds, blockIdx.x, gridDim.x);
    conv_transpose(p.w_out + (size_t)l * D * D, D, D, p.wo16, D, CmIdent(), lds, blockIdx.x, gridDim.x);
    conv_transpose(p.glu_w + (size_t)l * W * W, W, W, p.wglu16, W, CmIdent(), lds, blockIdx.x, gridDim.x);
    __syncthreads();
}
namespace pg {
constexpr int BM = 256, BK = 64, HALF = 128, HTB = HALF * BK * 2, STAGE_BYTES = 8 * HTB, NXCD = 8, WGM = 8;
__device__ __forceinline__ int lds_byte(int r, int c) { const int st = (r >> 4) * 2 + (c >> 5), rr = r & 15, cc = c & 31, ob = rr * 64 + cc * 2; return st * 1024 + (ob ^ (((ob >> 9) & 1) << 5)); }
__device__ __forceinline__ void stage_rc(int b, int& R, int& C) { const int st = b / 1024, sb = b % 1024, swz = sb ^ (((sb >> 9) & 1) << 5); R = (st >> 1) * 16 + swz / 64; C = (st & 1) * 32 + (swz % 64) / 2; }
__device__ __forceinline__ int perm32(int rho) { const int n = rho >> 4, i = rho & 15; return 8 * (i >> 2) + 4 * n + (i & 3); }
struct Unit { int pm, pn, aux; const char* A; const char* B; };
__device__ __forceinline__ void tile_of(int L, int nM, int nN, int& pm, int& pn) {
    const int nwg = nM * nN; int wgid = L;
    { const int q = nwg / NXCD, r = nwg % NXCD, xcd = wgid % NXCD, off = wgid / NXCD; wgid = (xcd < r ? xcd * (q + 1) : r * (q + 1) + (xcd - r) * q) + off; }
    const int nig = WGM * nN, gid = wgid / nig, fm = gid * WGM, gsz = (nM - fm) < WGM ? (nM - fm) : WGM;
    pm = fm + ((wgid % nig) % gsz); pn = (wgid % nig) / gsz;
}
template <class Epi, class Sched>
__device__ __forceinline__ void gemm_phase(LAS unsigned char* lds, const int K, const Sched& S, const Epi& E) {
    int tid = tidx();
    const int wid = __builtin_amdgcn_readfirstlane(tid >> 6), lane = tid & 63, wr = wid >> 2, wc = wid & 3, fr = lane & 15, fq = lane >> 4;
    const int nt = K / BK;
    unsigned voffA[2], voffB[2];
#pragma unroll
    for (int i = 0; i < 2; ++i) { int R, C; stage_rc(tid * 16 + i * 8192, R, C); const int Rb = Epi::PERM ? ((R & ~31) + perm32(R & 31)) : R;
        voffA[i] = (unsigned)(R * K + C) * 2u; voffB[i] = (unsigned)(Rb * K + C) * 2u; }
    const size_t kstep = (size_t)(BK * 2);
    const size_t hstep = (size_t)HALF * K * 2;
    const unsigned ldsw = (unsigned)wid * 1024u;
    const int aoff = lds_byte(wr * 64 + fr, fq * 8), boff = lds_byte(wc * 32 + fr, fq * 8);
#define PG_SA(b, h) (((b) * 2 + (h)) * HTB)
#define PG_SB(b, h) ((4 + (b) * 2 + (h)) * HTB)
#define PG_STAGE(bufoff, gbase, voff) do { _Pragma("unroll") for (int _i = 0; _i < 2; ++_i) \
        __builtin_amdgcn_global_load_lds((const unsigned*)((const char*)(gbase) + (voff)[_i]), (LAS unsigned*)(lds + (bufoff) + ldsw + _i * 8192), 16, 0, 0); } while (0)
#define PG_LDA(dst, b, h) do { _Pragma("unroll") for (int m = 0; m < 4; ++m) _Pragma("unroll") for (int k = 0; k < 2; ++k) dst[m][k] = *(const LAS h8*)(lds + PG_SA(b, h) + aoff + m * 2048 + k * 1024); } while (0)
#define PG_LDB(dst, b, h) do { _Pragma("unroll") for (int n = 0; n < 2; ++n) _Pragma("unroll") for (int k = 0; k < 2; ++k) dst[n][k] = *(const LAS h8*)(lds + PG_SB(b, h) + boff + n * 2048 + k * 1024); } while (0)
#define PG_MMA(ai, bj, At, Bt) do { __builtin_amdgcn_s_setprio(1); _Pragma("unroll") for (int m = 0; m < 4; ++m) _Pragma("unroll") for (int n = 0; n < 2; ++n) _Pragma("unroll") for (int k = 0; k < 2; ++k) \
        acc[ai][bj][m][n] = __builtin_amdgcn_mfma_f32_16x16x32_f16(Bt[n][k], At[m][k], acc[ai][bj][m][n], 0, 0, 0); __builtin_amdgcn_s_setprio(0); } while (0)
#define PG_WAIT_V(n) asm volatile("s_waitcnt vmcnt(" #n ")" ::: "memory")
#define PG_WAIT_L(n) asm volatile("s_waitcnt lgkmcnt(" #n ")" ::: "memory")
#define PG_BAR __builtin_amdgcn_s_barrier()
#define PG_SCHED __builtin_amdgcn_sched_barrier(0)
    Unit cur, nxt; int ui = 0;
    if (!S.next(0, cur)) return;
    f32x4 acc[2][2][4][2];
#pragma unroll
    for (int a = 0; a < 2; ++a)
#pragma unroll
        for (int b = 0; b < 2; ++b)
#pragma unroll
            for (int m = 0; m < 4; ++m)
#pragma unroll
                for (int n = 0; n < 2; ++n) acc[a][b][m][n] = (f32x4){0.f, 0.f, 0.f, 0.f};
    h8 At[4][2], B0[2][2], B1[2][2];
    const char* cA = cur.A; const char* cB = cur.B;
    PG_STAGE(PG_SB(0, 0), cB, voffB); PG_STAGE(PG_SA(0, 0), cA, voffA); PG_STAGE(PG_SB(0, 1), cB + hstep, voffB); PG_STAGE(PG_SA(0, 1), cA + hstep, voffA);
    if (wr == 1) PG_BAR;
    PG_WAIT_V(4); PG_BAR;
    PG_STAGE(PG_SB(1, 0), cB + kstep, voffB); PG_STAGE(PG_SA(1, 0), cA + kstep, voffA); PG_STAGE(PG_SB(1, 1), cB + hstep + kstep, voffB);
    PG_WAIT_V(6); PG_BAR;
    for (;;) {
        const bool has_next = S.next(ui + 1, nxt);
        const char* nA = has_next ? nxt.A : cA; const char* nB = has_next ? nxt.B : cB;
        for (int t = 0; t < nt; t += 2) {
            const bool last = (t == nt - 2);
            const char* a1 = cA + (size_t)(t + 1) * kstep;
            const char* a2 = last ? nA : cA + (size_t)(t + 2) * kstep; const char* b2 = last ? nB : cB + (size_t)(t + 2) * kstep;
            const char* a3 = a2 + kstep; const char* b3 = b2 + kstep;
            PG_LDB(B0, 0, 0); PG_SCHED; PG_LDA(At, 0, 0); PG_STAGE(PG_SA(1, 1), a1 + hstep, voffA);
            PG_WAIT_L(8); PG_BAR; PG_WAIT_L(0); PG_MMA(0, 0, At, B0); PG_BAR; PG_SCHED;
            PG_LDB(B1, 0, 1); PG_STAGE(PG_SB(0, 0), b2, voffB);
            PG_BAR; PG_WAIT_L(0); PG_MMA(0, 1, At, B1); PG_BAR;
            PG_LDA(At, 0, 1); PG_STAGE(PG_SA(0, 0), a2, voffA);
            PG_BAR; PG_WAIT_L(0); PG_MMA(1, 0, At, B0); PG_BAR; PG_SCHED;
            PG_STAGE(PG_SB(0, 1), b2 + hstep, voffB);
            PG_WAIT_V(6); PG_BAR; PG_MMA(1, 1, At, B1); PG_BAR;
            PG_LDB(B0, 1, 0); PG_SCHED; PG_LDA(At, 1, 0); PG_STAGE(PG_SA(0, 1), a2 + hstep, voffA);
            PG_WAIT_L(8); PG_BAR; PG_WAIT_L(0); PG_MMA(0, 0, At, B0); PG_BAR; PG_SCHED;
            PG_LDB(B1, 1, 1); PG_STAGE(PG_SB(1, 0), b3, voffB);
            PG_BAR; PG_WAIT_L(0); PG_MMA(0, 1, At, B1); PG_BAR;
            PG_LDA(At, 1, 1); PG_STAGE(PG_SA(1, 0), a3, voffA);
            PG_BAR; PG_WAIT_L(0); PG_MMA(1, 0, At, B0); PG_BAR; PG_SCHED;
            PG_STAGE(PG_SB(1, 1), b3 + hstep, voffB);
            PG_WAIT_V(6); PG_BAR; PG_MMA(1, 1, At, B1); PG_BAR;
        }
        E(acc, cur, wr, wc, fr, fq);
        if (!has_next) break;
        if constexpr (!Epi::KEEP_ACC) {
#pragma unroll
        for (int a = 0; a < 2; ++a)
#pragma unroll
            for (int b = 0; b < 2; ++b)
#pragma unroll
                for (int m = 0; m < 4; ++m)
#pragma unroll
                    for (int n = 0; n < 2; ++n) acc[a][b][m][n] = (f32x4){0.f, 0.f, 0.f, 0.f};
        }
        cur = nxt; cA = nA; cB = nB; ++ui;
    }
    PG_WAIT_V(0);
    if (wr == 0) PG_BAR;
    PG_BAR;
#undef PG_SA
#undef PG_SB
#undef PG_STAGE
#undef PG_LDA
#undef PG_LDB
#undef PG_MMA
#undef PG_WAIT_V
#undef PG_WAIT_L
#undef PG_BAR
#undef PG_SCHED
}
}
__device__ __forceinline__ float fsig(float v) { return __builtin_amdgcn_rcpf(1.f + __builtin_amdgcn_exp2f(-1.4426950408889634f * v)); }
__device__ __forceinline__ float fsilu(float v) { return v * fsig(v); }
__device__ __forceinline__ u32x4 pack8(const f32x4 a, const f32x4 b) {
    const h8 v = {(_Float16)a[0], (_Float16)a[1], (_Float16)a[2], (_Float16)a[3], (_Float16)b[0], (_Float16)b[1], (_Float16)b[2], (_Float16)b[3]};
    return __builtin_bit_cast(u32x4, v);
}
__device__ __forceinline__ void unpack8(const u32x4 w, float (&o)[8]) {
    const h8 v = __builtin_bit_cast(h8, w);
#pragma unroll
    for (int j = 0; j < 8; ++j) o[j] = (float)v[j];
}
struct SchedPlain {
    const char* A; const char* B; int nM, nN, G, c, K;
    __device__ bool next(int i, pg::Unit& u) const {
        const long L = (long)i * G + c; if (L >= (long)nM * nN) return false;
        pg::tile_of((int)L, nM, nN, u.pm, u.pn); u.aux = 0;
        u.A = A + (size_t)u.pm * 256 * K * 2; u.B = B + (size_t)u.pn * 256 * K * 2; return true;
    }
};
struct SchedMerge {
    const char* ys; const char* wb; int G, c;
    __device__ bool next(int i, pg::Unit& u) const {
        const int r = i / 3, n = i - 3 * r; const long L = (long)r * G + c; if (L >= 64 * 4) return false;
        pg::tile_of((int)L, 64, 4, u.pm, u.pn); u.aux = n;
        u.A = ys + ((size_t)n * T + (size_t)u.pm * 256) * W * 2; u.B = wb + ((size_t)n * D + (size_t)u.pn * 256) * W * 2; return true;
    }
};

template <int ACT> __device__ __forceinline__ f32x4 actv(f32x4 v) {
    if (ACT == 1) { for (int j = 0; j < 4; ++j) v[j] = fsilu(v[j]); }
    if (ACT == 2) { for (int j = 0; j < 4; ++j) v[j] = fsig(v[j]); }
    return v;
}
template <int ACT> __device__ __forceinline__ void st16(const f32x4 (&acc)[2][2][4][2], __half* base, int ld, int c8, int bj0, int bj1) {
#pragma unroll
    for (int ai = 0; ai < 2; ++ai)
#pragma unroll
        for (int m = 0; m < 4; ++m) {
            __half* rowp = base + (size_t)(ai * 128 + m * 16) * ld + c8;
#pragma unroll
            for (int bj = 0; bj < 2; ++bj) if (bj >= bj0 && bj < bj1)
                *(u32x4*)(rowp + (bj - bj0) * 128) = pack8(actv<ACT>(acc[ai][bj][m][0]), actv<ACT>(acc[ai][bj][m][1]));
        }
}
struct EpiProj {
    static constexpr bool PERM = true, KEEP_ACC = false;
    __half *q16, *v16, *hgg16, *atq16, *atk16, *atv16, *atg16, *ixq16, *ixk16, *s5u16, *s5g16, *mg16; float *lf32, *ixw32; const float* lb;
    __device__ __forceinline__ void operator()(f32x4 (&acc)[2][2][4][2], const pg::Unit& u, int wr, int wc, int fr, int fq) const {
        const size_t row0 = (size_t)u.pm * 256 + wr * 64 + fr; const int c8 = wc * 32 + 8 * fq, pn = u.pn;
        if (pn < 2)        st16<0>(acc, q16 + row0 * W + pn * 256, W, c8, 0, 2);
        else if (pn < 4) {
            const int cb = (pn - 2) * 256 + c8;
#pragma unroll
            for (int bj = 0; bj < 2; ++bj) {
                const f32x4 l0 = *(const f32x4*)(lb + cb + bj * 128), l1 = *(const f32x4*)(lb + cb + bj * 128 + 4);
#pragma unroll
                for (int ai = 0; ai < 2; ++ai)
#pragma unroll
                    for (int m = 0; m < 4; ++m) {
                        f32x4 a = acc[ai][bj][m][0], b = acc[ai][bj][m][1];
#pragma unroll
                        for (int j = 0; j < 4; ++j) { a[j] = 0.6931471805599453f * __builtin_amdgcn_logf(fmaxf(l0[j] + (1.f - l0[j]) * fsig(a[j]), 1e-30f)); b[j] = 0.6931471805599453f * __builtin_amdgcn_logf(fmaxf(l1[j] + (1.f - l1[j]) * fsig(b[j]), 1e-30f)); }
                        float* o = lf32 + (row0 + ai * 128 + m * 16) * W + cb + bj * 128;
                        *(f32x4*)o = a; *(f32x4*)(o + 4) = b;
                    }
            }
        }
        else if (pn < 6)   st16<0>(acc, v16 + row0 * W + (pn - 4) * 256, W, c8, 0, 2);
        else if (pn < 8)   st16<1>(acc, hgg16 + row0 * W + (pn - 6) * 256, W, c8, 0, 2);
        else if (pn < 10)  st16<0>(acc, atq16 + row0 * W + (pn - 8) * 256, W, c8, 0, 2);
        else if (pn == 10) { st16<0>(acc, atk16 + row0 * 128, 128, c8, 0, 1); st16<0>(acc, atv16 + row0 * 128, 128, c8, 1, 2); }
        else if (pn < 13)  st16<1>(acc, atg16 + row0 * W + (pn - 11) * 256, W, c8, 0, 2);
        else if (pn < 15)  st16<0>(acc, ixq16 + row0 * W + (pn - 13) * 256, W, c8, 0, 2);
        else if (pn == 15) {
            if (wc < 2) {
#pragma unroll
                for (int ai = 0; ai < 2; ++ai)
#pragma unroll
                    for (int m = 0; m < 4; ++m) *(u32x4*)(ixk16 + (row0 + ai * 128 + m * 16) * 64 + c8) = pack8(acc[ai][0][m][0], acc[ai][0][m][1]);
            } else if (wc == 2 && fq == 0) {
#pragma unroll
                for (int ai = 0; ai < 2; ++ai)
#pragma unroll
                    for (int m = 0; m < 4; ++m) { float* o = ixw32 + (row0 + ai * 128 + m * 16) * 8; *(f32x4*)o = acc[ai][0][m][0]; *(f32x4*)(o + 4) = acc[ai][0][m][1]; }
            }
        }
        else if (pn < 18)  st16<0>(acc, s5u16 + row0 * W + (pn - 16) * 256, W, c8, 0, 2);
        else if (pn < 20)  st16<1>(acc, s5g16 + row0 * W + (pn - 18) * 256, W, c8, 0, 2);
        else {
            int lane = fq * 16 + fr;
            asm volatile("" : "+v"(lane));
            unsigned char* base = (unsigned char*)mg16 + ((((size_t)u.pm * 12 + (pn - 20)) * 8 + wr * 4 + wc) * 16) * 512 + lane * 8;
#pragma unroll
            for (int ai = 0; ai < 2; ++ai)
#pragma unroll
                for (int m = 0; m < 4; ++m)
#pragma unroll
                    for (int bj = 0; bj < 2; ++bj) {
                        const f32x4 a = actv<2>(acc[ai][bj][m][0]), b = actv<2>(acc[ai][bj][m][1]);
                        unsigned lo = 0, hi = 0;
#pragma unroll
                        for (int j = 0; j < 4; ++j) {
                            lo |= (unsigned)max(1, (int)__builtin_rintf(a[j] * 255.f)) << (8 * j);
                            hi |= (unsigned)max(1, (int)__builtin_rintf(b[j] * 255.f)) << (8 * j);
                        }
                        *(uint2*)(base + ((ai * 4 + m) * 2 + bj) * 512) = make_uint2(lo, hi);
                    }
        }
    }
};
struct EpiGlu {
    static constexpr bool PERM = true, KEEP_ACC = false;
    const __half* ypre16; const __half* s5g16; const float* bias; __half* yc; float* raw;
    __device__ __forceinline__ void operator()(f32x4 (&acc)[2][2][4][2], const pg::Unit& u, int wr, int wc, int fr, int fq) const {
        const size_t row0 = (size_t)u.pm * 256 + wr * 64 + fr; const int c0 = u.pn * 256 + wc * 32 + 8 * fq;
#pragma unroll
        for (int bj = 0; bj < 2; ++bj) {
            const int col = c0 + bj * 128;
            const f32x4 b0 = *(const f32x4*)(bias + col), b1 = *(const f32x4*)(bias + col + 4);
#pragma unroll
            for (int ai = 0; ai < 2; ++ai)
#pragma unroll
                for (int m = 0; m < 4; ++m) {
                    const size_t off = (row0 + ai * 128 + m * 16) * W + col;
                    float y[8], g[8]; unpack8(*(const u32x4*)(ypre16 + off), y); unpack8(*(const u32x4*)(s5g16 + off), g);
                    f32x4 a = acc[ai][bj][m][0] + b0, b = acc[ai][bj][m][1] + b1;
                    if (raw) { *(f32x4*)(raw + (row0 + ai * 128 + m * 16) * D + col) = acc[ai][bj][m][0]; *(f32x4*)(raw + (row0 + ai * 128 + m * 16) * D + col + 4) = acc[ai][bj][m][1]; }
#pragma unroll
                    for (int j = 0; j < 4; ++j) { a[j] = y[j] * fsig(a[j]) * g[j]; b[j] = y[4 + j] * fsig(b[j]) * g[4 + j]; }
                    *(u32x4*)(yc + off) = pack8(a, b);
                }
        }
    }
};
struct EpiMerge {
    static constexpr bool PERM = true, KEEP_ACC = true;
    const unsigned char* mg8; __half* merged16;
    static __device__ __forceinline__ void dec8(const uint2 w, float (&g)[8]) {
#pragma unroll
        for (int j = 0; j < 4; ++j) { g[j] = (float)((w.x >> (8 * j)) & 255u); g[4 + j] = (float)((w.y >> (8 * j)) & 255u); }
    }
    __device__ __forceinline__ void operator()(f32x4 (&acc)[2][2][4][2], const pg::Unit& u, int wr, int wc, int fr, int fq) const {
        const size_t row0 = (size_t)u.pm * 256 + wr * 64 + fr; const int c0 = u.pn * 256 + wc * 32 + 8 * fq, n = u.aux;
        int lofs = ((wr * 4 + wc) * 16) * 512 + (fq * 16 + fr) * 8;
        asm volatile("" : "+v"(lofs));
#pragma unroll
        for (int ai = 0; ai < 2; ++ai)
#pragma unroll
            for (int m = 0; m < 4; ++m)
#pragma unroll
                for (int bj = 0; bj < 2; ++bj) {
                    const size_t r = row0 + ai * 128 + m * 16; const int col = c0 + bj * 128;
                    const size_t goff = (size_t)lofs + ((ai * 4 + m) * 2 + bj) * 512;
                    float g[8]; dec8(*(const uint2*)(mg8 + ((size_t)u.pm * 12 + n * 4 + u.pn) * 16 * 8 * 512 + goff), g);
                    f32x4 a = acc[ai][bj][m][0], b = acc[ai][bj][m][1];
                    if (n < 2) {
                        float gn[8]; dec8(*(const uint2*)(mg8 + ((size_t)u.pm * 12 + (n + 1) * 4 + u.pn) * 16 * 8 * 512 + goff), gn);
#pragma unroll
                        for (int j = 0; j < 4; ++j) { a[j] *= g[j] * __builtin_amdgcn_rcpf(gn[j]); b[j] *= g[4 + j] * __builtin_amdgcn_rcpf(gn[4 + j]); }
                        acc[ai][bj][m][0] = a; acc[ai][bj][m][1] = b;
                    } else {
#pragma unroll
                        for (int j = 0; j < 4; ++j) { a[j] *= g[j] * (1.f / 255.f); b[j] *= g[4 + j] * (1.f / 255.f); }
                        *(u32x4*)(merged16 + r * D + col) = pack8(a, b);
                        acc[ai][bj][m][0] = (f32x4){0.f, 0.f, 0.f, 0.f}; acc[ai][bj][m][1] = (f32x4){0.f, 0.f, 0.f, 0.f};
                    }
                }
    }
};
struct EpiOut {
    static constexpr bool PERM = false, KEEP_ACC = false;
    const float* xin; float* out; const float* gate;
    __device__ __forceinline__ void operator()(f32x4 (&acc)[2][2][4][2], const pg::Unit& u, int wr, int wc, int fr, int fq) const {
        const size_t row0 = (size_t)u.pm * 256 + wr * 64 + fr; const int c0 = u.pn * 256 + wc * 32 + 4 * fq;
        const int b = (u.pm * 256) / S;
#pragma unroll
        for (int bj = 0; bj < 2; ++bj)
#pragma unroll
            for (int n = 0; n < 2; ++n) {
                const int col = c0 + bj * 128 + n * 16;
                const f32x4 gv = *(const f32x4*)(gate + (size_t)b * 3072 + col);
#pragma unroll
                for (int ai = 0; ai < 2; ++ai)
#pragma unroll
                    for (int m = 0; m < 4; ++m) {
                        const size_t off = (row0 + ai * 128 + m * 16) * D + col;
                        *(f32x4*)(out + off) = *(const f32x4*)(xin + off) + gv * acc[ai][bj][m][n];
                    }
            }
    }
};
constexpr float QSCALE = 0.08838834764831845f * 1.4426950408889634f;
__device__ void phase_fix(const Params& p, int l, float* lds) {
    {
        __half* tl = (__half*)lds;
        const int tid = tidx();
        for (int tile = blockIdx.x; tile < T / 64; tile += gridDim.x) {
            const int t0 = tile * 64, b = t0 / S, s0 = t0 % S;
            __syncthreads();
            for (int i = tid; i < 64 * 64; i += 512) { const int tt = i >> 6, e2 = (i & 63) * 2; *(h2*)(tl + tt * 130 + e2) = *(const h2*)(p.atv16 + (size_t)(t0 + tt) * 128 + e2); }
            __syncthreads();
#pragma unroll
            for (int rep = 0; rep < 2; ++rep) {
                const int ch = tid + 512 * rep;
                const int ln = ch & 63, s2 = (ch >> 6) & 1, et = (ch >> 7) & 3, ktl = ch >> 9, colv = ln & 31, hf = ln >> 5;
                h8 v;
#pragma unroll
                for (int j = 0; j < 8; ++j) v[j] = __builtin_bit_cast(_Float16, tl[(ktl * 32 + 16 * s2 + 8 * (j >> 2) + 4 * hf + (j & 3)) * 130 + 32 * et + colv]);
                *(h8*)(p.vf16 + ((((size_t)(b * 64 + (s0 >> 5) + ktl) * 4 + et) * 2 + s2) * 64 + ln) * 8) = v;
            }
        }
        __syncthreads();
    }
    const int w = tidx() >> 6, lane = tidx() & 63;
    __half* wl = (__half*)lds + w * 192;
    for (int t = blockIdx.x * 8 + w; t < T; t += gridDim.x * 8) {
        const int b = t / S, s = t % S, kt = s >> 5, colk = s & 31;
        const float cA = p.ropeA[((size_t)t * 64 + lane) * 2], sA = p.ropeA[((size_t)t * 64 + lane) * 2 + 1];
        for (int hh = 0; hh < 5; ++hh) {
            __half* q = hh < 4 ? p.atq16 + (size_t)t * W + hh * 128 : p.atk16 + (size_t)t * 128;
            const float* g = hh < 4 ? p.qn_g + l * 128 : p.kn_g + l * 128;
            const float x1 = __half2float(q[lane]), x2 = __half2float(q[64 + lane]);
            const float ss = wave_sum(x1 * x1 + x2 * x2);
            const float r = rsqrtf(ss * (1.f / 128.f) + EPS) * (hh < 4 ? QSCALE : 1.f);
            const float a = x1 * r * g[lane], b2 = x2 * r * g[64 + lane];
            const __half o1 = __float2half(a * cA - b2 * sA), o2 = __float2half(b2 * cA + a * sA);
            if (hh < 4) { q[lane] = o1; q[64 + lane] = o2; } else { wl[lane] = o1; wl[64 + lane] = o2; }
        }
        if (lane < 32) {
            const __half* q = p.ixk16 + (size_t)t * 64;
            const float cI = p.ropeI[((size_t)t * 32 + lane) * 2], sI = p.ropeI[((size_t)t * 32 + lane) * 2 + 1];
            const float x1 = __half2float(q[lane]), x2 = __half2float(q[32 + lane]);
            wl[128 + lane] = __float2half(x1 * cI - x2 * sI); wl[160 + lane] = __float2half(x2 * cI + x1 * sI);
        }
        for (int i = 0; i < 4; ++i) {
            const int idx = lane + 64 * i, hh = idx >> 5, j = idx & 31;
            __half* q = p.ixq16 + (size_t)t * W + hh * 64;
            const float cI = p.ropeI[((size_t)t * 32 + j) * 2], sI = p.ropeI[((size_t)t * 32 + j) * 2 + 1];
            const float x1 = __half2float(q[j]), x2 = __half2float(q[32 + j]);
            q[j] = __float2half(x1 * cI - x2 * sI); q[32 + j] = __float2half(x2 * cI + x1 * sI);
        }
        lds_fence();
        if (lane < 16) {
            const h8 v = *(const h8*)(wl + lane * 8);
            *(h8*)(p.kf16 + ((((size_t)(b * 64 + kt) * 8 + (lane >> 1)) * 64) + (lane & 1) * 32 + colk) * 8) = v;
        } else if (lane < 24) {
            const int c2 = lane - 16;
            const h8 v = *(const h8*)(wl + 128 + c2 * 8);
            *(h8*)(p.ikf16 + ((((size_t)(b * 64 + kt) * 4 + (c2 >> 1)) * 64) + (c2 & 1) * 32 + colk) * 8) = v;
        }
        lds_fence();
    }
}

__device__ __forceinline__ unsigned f2key(float f) { const unsigned u = __float_as_uint(f); return (u & 0x80000000u) ? ~u : (u | 0x80000000u); }
typedef float f32x16 __attribute__((ext_vector_type(16)));
typedef _Float16 h4 __attribute__((ext_vector_type(4)));
__device__ void dsa_select(const Params& p, int b, int q0, float* lds) {
    const int tid = tidx(), w = tid >> 6, lane = tid & 63, half = lane >> 5, col = lane & 31;
    float* sc = lds;
    {
        const int wq = w & 3, par = w >> 2;
        const int blk = col >> 2, wi = col & 3, ql = 2 * (blk & 1) + (blk >> 2), head = 4 * ((blk >> 1) & 1) + wi;
        const __half* qrow = p.ixq16 + (size_t)(b * S + q0 + wq * 4 + ql) * W + head * 64 + 8 * half;
        h8 af[4];
#pragma unroll
        for (int ks = 0; ks < 4; ++ks) af[ks] = *(const h8*)(qrow + 16 * ks);
        const int qa = wq * 4 + 2 * half;
        float iw0[8], iw1[8];
#pragma unroll
        for (int hh = 0; hh < 8; ++hh) { iw0[hh] = p.ixw32[(size_t)(b * S + q0 + qa) * 8 + hh]; iw1[hh] = p.ixw32[(size_t)(b * S + q0 + qa + 1) * 8 + hh]; }
        const int ntiles = (q0 + 15) / 32 + 1;
        const __half* ikb = p.ikf16 + (size_t)b * 64 * 4 * 512 + lane * 8;
        h8 bc[4];
        if (par < ntiles) {
#pragma unroll
            for (int ks = 0; ks < 4; ++ks) bc[ks] = *(const h8*)(ikb + ((size_t)par * 4 + ks) * 512);
        }
        for (int kt = par; kt < ntiles; kt += 2) {
            const int key = kt * 32 + col;
            const int ktn = kt + 2 < ntiles ? kt + 2 : kt;
            h8 bn[4];
#pragma unroll
            for (int ks = 0; ks < 4; ++ks) bn[ks] = *(const h8*)(ikb + ((size_t)ktn * 4 + ks) * 512);
            f32x16 acc;
#pragma unroll
            for (int r = 0; r < 16; ++r) acc[r] = 0.f;
#pragma unroll
            for (int ks = 0; ks < 4; ++ks) acc = __builtin_amdgcn_mfma_f32_32x32x16_f16(af[ks], bc[ks], acc, 0, 0, 0);
            float s0 = 0.f, s1 = 0.f;
#pragma unroll
            for (int r = 0; r < 8; ++r) { s0 += fmaxf(acc[r], 0.f) * iw0[r]; s1 += fmaxf(acc[8 + r], 0.f) * iw1[r]; }
            sc[qa * 2048 + key] = key <= q0 + qa ? s0 : -INFINITY;
            sc[(qa + 1) * 2048 + key] = key <= q0 + qa + 1 ? s1 : -INFINITY;
#pragma unroll
            for (int ks = 0; ks < 4; ++ks) bc[ks] = bn[ks];
        }
        for (int i = ntiles * 32 + tid; i < 2048; i += 512) {
#pragma unroll
            for (int q = 0; q < 16; ++q) sc[q * 2048 + i] = -INFINITY;
        }
    }
    __syncthreads();
    for (int qq = 0; qq < 2; ++qq) {
        const int ql = 2 * w + qq, qi = q0 + ql;
        const float* scl = sc + ql * 2048;
        const bool all = qi + 1 <= 256;
        unsigned key[32];
#pragma unroll
        for (int i = 0; i < 32; ++i) key[i] = f2key(scl[lane + 64 * i]);
        unsigned tge = 0x00800000u;
        int rrem = 0; bool split = false;
        if (!all) {
            unsigned prefix = 0; bool exact = false;
#pragma unroll 1
            for (int bit = 31; bit >= 0; --bit) {
                const unsigned cand = prefix | (1u << bit);
                int c = 0, cl = 0;
#pragma unroll
                for (int i = 0; i < 12; ++i) c += __popcll(__ballot(key[i] >= cand));
#pragma unroll
                for (int i = 12; i < 32; ++i) cl += (key[i] >= cand) ? 1 : 0;
#pragma unroll
                for (int bb = 0; bb < 5; ++bb) c += __popcll(__ballot((cl >> bb) & 1)) << bb;
                if (c >= 256) prefix = cand;
                if (c == 256) { exact = true; break; }
            }
            tge = prefix;
            if (!exact) {
                int cge = 0, cgt = 0;
#pragma unroll
                for (int i = 0; i < 32; ++i) { cge += __popcll(__ballot(key[i] >= prefix)); cgt += __popcll(__ballot(key[i] > prefix)); }
                if (cge > 256) { split = true; tge = prefix + 1u; rrem = 256 - cgt; }
            }
        }
        const unsigned long long lt = (1ull << lane) - 1ull;
        unsigned mylo = 0, myhi = 0;
        if (!split) {
#pragma unroll
            for (int i = 0; i < 32; ++i) {
                const unsigned long long m2 = __ballot(key[i] >= tge);
                if (lane == i) { mylo = (unsigned)m2; myhi = (unsigned)(m2 >> 32); }
            }
        } else {
#pragma unroll 1
            for (int i = 0; i < 32; ++i) {
                const unsigned k = f2key(scl[lane + 64 * i]);
                const bool eq = k == tge - 1u;
                const unsigned long long m = __ballot(eq);
                const bool sl = (k >= tge) || (eq && __popcll(m & lt) < rrem);
                rrem -= __popcll(m); if (rrem < 0) rrem = 0;
                const unsigned long long m2 = __ballot(sl);
                if (lane == i) { mylo = (unsigned)m2; myhi = (unsigned)(m2 >> 32); }
            }
        }
        if (lane < 32) *(uint2*)(p.mask + (size_t)(b * S + qi) * 64 + 2 * lane) = make_uint2(mylo, myhi);
    }
    __syncthreads();
}

__device__ void dsa_attend(const Params& p, int b, int g) {
    const int lane = tidx() & 63, half = lane >> 5, col = lane & 31;
    const int q0 = 8 * g, qi = q0 + (col >> 2), hd = col & 3;
    const __half* qp = p.atq16 + (size_t)(b * S + qi) * W + hd * 128 + 8 * half;
    h8 qf[8];
#pragma unroll
    for (int ks = 0; ks < 8; ++ks) qf[ks] = *(const h8*)(qp + 16 * ks);
    f32x16 o[4];
#pragma unroll
    for (int et = 0; et < 4; ++et)
#pragma unroll
        for (int r = 0; r < 16; ++r) o[et][r] = 0.f;
    float m = -INFINITY, l = 0.f;
    const int ntiles = (q0 + 7) / 32 + 1;
    const unsigned* mrow = p.mask + (size_t)(b * S + qi) * 64;
    const __half* kfb = p.kf16 + (size_t)b * 64 * 8 * 512 + lane * 8;
    const __half* vfb = p.vf16 + (size_t)b * 64 * 8 * 512 + lane * 8;
    h8 kA[8], kB[8];
#pragma unroll
    for (int ks = 0; ks < 8; ++ks) kA[ks] = *(const h8*)(kfb + (size_t)ks * 512);
#define DSA_TILE(kcur, knext, KT) do { \
        const int _kt = (KT), _ktn = _kt + 1 < ntiles ? _kt + 1 : _kt; \
        _Pragma("unroll") for (int ks = 0; ks < 8; ++ks) knext[ks] = *(const h8*)(kfb + ((size_t)_ktn * 8 + ks) * 512); \
        const unsigned mws = mrow[_kt] >> (4 * half); \
        f32x16 s; \
        _Pragma("unroll") for (int r = 0; r < 16; ++r) s[r] = 0.f; \
        _Pragma("unroll") for (int ks = 0; ks < 8; ++ks) s = __builtin_amdgcn_mfma_f32_32x32x16_f16(kcur[ks], qf[ks], s, 0, 0, 0); \
        h8 vf[8]; \
        _Pragma("unroll") for (int i = 0; i < 8; ++i) vf[i] = *(const h8*)(vfb + ((size_t)_kt * 8 + i) * 512); \
        float tmax = -INFINITY; \
        _Pragma("unroll") for (int r = 0; r < 16; ++r) { s[r] = (mws & (1u << ((r & 3) + 8 * (r >> 2)))) ? s[r] : -INFINITY; tmax = fmaxf(tmax, s[r]); } \
        tmax = fmaxf(tmax, __shfl_xor(tmax, 32)); \
        if (__any(tmax > m + 11.5f)) {          \
            const float mn = fmaxf(m, tmax), msf = mn == -INFINITY ? 0.f : mn; \
            const float cs = __builtin_amdgcn_exp2f(m - msf); \
            l *= cs; m = mn; \
            _Pragma("unroll") for (int et = 0; et < 4; ++et) _Pragma("unroll") for (int r = 0; r < 16; ++r) o[et][r] *= cs; \
        } \
        const float ms2 = m == -INFINITY ? 0.f : m; \
        float ps = 0.f; \
        _Pragma("unroll") for (int r = 0; r < 16; ++r) { s[r] = __builtin_amdgcn_exp2f(s[r] - ms2); ps += s[r]; } \
        l += ps; \
        h8 pb[2]; \
        _Pragma("unroll") for (int s2 = 0; s2 < 2; ++s2) _Pragma("unroll") for (int j = 0; j < 8; ++j) pb[s2][j] = (_Float16)s[8 * s2 + j]; \
        _Pragma("unroll") for (int et = 0; et < 4; ++et) _Pragma("unroll") for (int s2 = 0; s2 < 2; ++s2) \
            o[et] = __builtin_amdgcn_mfma_f32_32x32x16_f16(vf[et * 2 + s2], pb[s2], o[et], 0, 0, 0); \
    } while (0)
    int kt = 0;
#pragma unroll 1
    for (; kt + 1 < ntiles; kt += 2) { DSA_TILE(kA, kB, kt); DSA_TILE(kB, kA, kt + 1); }
    if (kt < ntiles) DSA_TILE(kA, kB, kt);
#undef DSA_TILE
    l += __shfl_xor(l, 32);
    const float inv = 1.f / l;
    __half* yb = p.ys + (size_t)T * W + (size_t)(b * S + qi) * W + hd * 128;
    const __half* gp = p.atg16 + (size_t)(b * S + qi) * W + hd * 128;
#pragma unroll
    for (int et = 0; et < 4; ++et)
#pragma unroll
        for (int r4 = 0; r4 < 4; ++r4) {
            const int e0 = 32 * et + 8 * r4 + 4 * half;
            const h4 gv = *(const h4*)(gp + e0);
            h4 ov;
#pragma unroll
            for (int j = 0; j < 4; ++j) ov[j] = (_Float16)(o[et][4 * r4 + j] * inv * (float)gv[j]);
            *(h4*)(yb + e0) = ov;
        }
}

__device__ __forceinline__ void dsa_attend_block(const Params& p, int b, int jq, float* lds) {
    const int tid = tidx(), w = tid >> 6, lane = tid & 63, half = lane >> 5, col = lane & 31;
    const int grp = w & 3, hf = w >> 2, th = tid & 255;
    const int q0 = 32 * jq + 8 * grp, qi = q0 + (col >> 2), hd = col & 3;
    const int Tt = jq + 1, Th = (Tt + 1) >> 1;
    const int t0 = hf ? Th : 0, nt = hf ? Tt - Th : Th;
    __half* stg = (__half*)lds;
    const __half* qp = p.atq16 + (size_t)(b * S + qi) * W + hd * 128 + 8 * half;
    h8 qf[8];
#pragma unroll
    for (int ks = 0; ks < 8; ++ks) qf[ks] = *(const h8*)(qp + 16 * ks);
    f32x16 o[4];
#pragma unroll
    for (int et = 0; et < 4; ++et)
#pragma unroll
        for (int r = 0; r < 16; ++r) o[et][r] = 0.f;
    float m = -INFINITY, l = 0.f;
    const unsigned* mrow = p.mask + (size_t)(b * S + qi) * 64;
    const __half* kfb = p.kf16 + (size_t)b * 64 * 4096;
    const __half* vfb = p.vf16 + (size_t)b * 64 * 4096;
    h8 sr[4];
    __syncthreads();
    if (nt > 0) {
        sr[0] = *(const h8*)(kfb + (size_t)t0 * 4096 + th * 8); sr[1] = *(const h8*)(kfb + (size_t)t0 * 4096 + (th + 256) * 8);
        sr[2] = *(const h8*)(vfb + (size_t)t0 * 4096 + th * 8); sr[3] = *(const h8*)(vfb + (size_t)t0 * 4096 + (th + 256) * 8);
        __half* d = stg + (size_t)hf * 8192;
        *(h8*)(d + th * 8) = sr[0]; *(h8*)(d + (th + 256) * 8) = sr[1]; *(h8*)(d + 4096 + th * 8) = sr[2]; *(h8*)(d + 4096 + (th + 256) * 8) = sr[3];
    }
    unsigned mw = nt > 0 ? mrow[t0] : 0u;
    __syncthreads();
#pragma unroll 1
    for (int r = 0; r < Th; ++r) {
        const bool act = r < nt, nxt = r + 1 < nt;
        unsigned mwn = 0u;
        if (nxt) {
            const size_t tn = (size_t)(t0 + r + 1) * 4096;
            sr[0] = *(const h8*)(kfb + tn + th * 8); sr[1] = *(const h8*)(kfb + tn + (th + 256) * 8);
            sr[2] = *(const h8*)(vfb + tn + th * 8); sr[3] = *(const h8*)(vfb + tn + (th + 256) * 8);
            mwn = mrow[t0 + r + 1];
        }
        if (act) {
            const __half* st = stg + (size_t)((r & 1) * 2 + hf) * 8192 + lane * 8;
            const unsigned mws = mw >> (4 * half);
            f32x16 s;
#pragma unroll
            for (int i = 0; i < 16; ++i) s[i] = 0.f;
            h8 kf[8];
#pragma unroll
            for (int ks = 0; ks < 8; ++ks) kf[ks] = *(const h8*)(st + ks * 512);
#pragma unroll
            for (int ks = 0; ks < 8; ++ks) s = __builtin_amdgcn_mfma_f32_32x32x16_f16(kf[ks], qf[ks], s, 0, 0, 0);
            h8 vf[8];
#pragma unroll
            for (int i = 0; i < 8; ++i) vf[i] = *(const h8*)(st + 4096 + i * 512);
            float tmax = -INFINITY;
#pragma unroll
            for (int i = 0; i < 16; ++i) { s[i] = (mws & (1u << ((i & 3) + 8 * (i >> 2)))) ? s[i] : -INFINITY; tmax = fmaxf(tmax, s[i]); }
            { const auto sw = __builtin_amdgcn_permlane32_swap(__float_as_uint(tmax), __float_as_uint(tmax), false, false); tmax = fmaxf(__uint_as_float(sw[0]), __uint_as_float(sw[1])); }
            if (__any(tmax > m + 11.5f)) {
                const float mn = fmaxf(m, tmax), msf = mn == -INFINITY ? 0.f : mn;
                const float cs = __builtin_amdgcn_exp2f(m - msf);
                l *= cs; m = mn;
#pragma unroll
                for (int et = 0; et < 4; ++et)
#pragma unroll
                    for (int i = 0; i < 16; ++i) o[et][i] *= cs;
            }
            const float ms2 = m == -INFINITY ? 0.f : m;
            float ps = 0.f;
#pragma unroll
            for (int i = 0; i < 16; ++i) { s[i] = __builtin_amdgcn_exp2f(s[i] - ms2); ps += s[i]; }
            l += ps;
            h8 pb[2];
#pragma unroll
            for (int s2 = 0; s2 < 2; ++s2)
#pragma unroll
                for (int j = 0; j < 8; ++j) pb[s2][j] = (_Float16)s[8 * s2 + j];
#pragma unroll
            for (int et = 0; et < 4; ++et)
#pragma unroll
                for (int s2 = 0; s2 < 2; ++s2) o[et] = __builtin_amdgcn_mfma_f32_32x32x16_f16(vf[et * 2 + s2], pb[s2], o[et], 0, 0, 0);
        }
        if (nxt) {
            __half* d = stg + (size_t)(((r + 1) & 1) * 2 + hf) * 8192;
            *(h8*)(d + th * 8) = sr[0]; *(h8*)(d + (th + 256) * 8) = sr[1]; *(h8*)(d + 4096 + th * 8) = sr[2]; *(h8*)(d + 4096 + (th + 256) * 8) = sr[3];
        }
        mw = mwn;
        __syncthreads();
    }
    l += __shfl_xor(l, 32);
    float* mg = lds;
    if (hf == 1) {
        float* d = mg + (size_t)grp * 66 * 64 + lane;
#pragma unroll
        for (int et = 0; et < 4; ++et)
#pragma unroll
            for (int i = 0; i < 16; ++i) d[(et * 16 + i) * 64] = o[et][i];
        d[64 * 64] = m; d[65 * 64] = l;
    }
    __syncthreads();
    if (hf == 0) {
        const float* d = mg + (size_t)grp * 66 * 64 + lane;
        const float m2 = d[64 * 64], l2 = d[65 * 64];
        const float mn = fmaxf(m, m2), msf = mn == -INFINITY ? 0.f : mn;
        const float a1 = __builtin_amdgcn_exp2f(m - msf), a2 = __builtin_amdgcn_exp2f(m2 - msf);
        const float inv = 1.f / (l * a1 + l2 * a2);
        __half* yb = p.ys + (size_t)T * W + (size_t)(b * S + qi) * W + hd * 128;
        const __half* gp = p.atg16 + (size_t)(b * S + qi) * W + hd * 128;
#pragma unroll
        for (int et = 0; et < 4; ++et)
#pragma unroll
            for (int r4 = 0; r4 < 4; ++r4) {
                const int e0 = 32 * et + 8 * r4 + 4 * half;
                const h4 gv = *(const h4*)(gp + e0);
                h4 ov;
#pragma unroll
                for (int j = 0; j < 4; ++j) ov[j] = (_Float16)((o[et][4 * r4 + j] * a1 + d[(et * 16 + 4 * r4 + j) * 64] * a2) * inv * (float)gv[j]);
                *(h4*)(yb + e0) = ov;
            }
    }
    __syncthreads();
}

typedef __bf16 bf8 __attribute__((ext_vector_type(8)));
constexpr int HG_QS = 136;
constexpr int HG_VS = 72;
struct HgIn { float lf[16]; h8 q0, q1, v0, v1; };
__device__ __forceinline__ void hg_issue_loads(const Params& p, int tok0, int hd, int tid, bool need_q, HgIn& in) {
    const int d = tid & 127, seg = tid >> 7;
    const size_t base = (size_t)(tok0 + seg * 16) * W + hd * 128 + d;
#pragma unroll
    for (int i = 0; i < 16; ++i) in.lf[i] = p.lf32[base + (size_t)i * W];
#pragma unroll
    for (int i = 0; i < 8; ++i) { in.v0[i] = __builtin_bit_cast(_Float16, p.v16[base + (size_t)i * W]); in.v1[i] = __builtin_bit_cast(_Float16, p.v16[base + (size_t)(8 + i) * W]); }
    if (need_q) {
#pragma unroll
        for (int i = 0; i < 8; ++i) { in.q0[i] = __builtin_bit_cast(_Float16, p.q16[base + (size_t)i * W]); in.q1[i] = __builtin_bit_cast(_Float16, p.q16[base + (size_t)(8 + i) * W]); }
    }
}
__device__ __forceinline__ void hg_cumsum(int tid, float* segt, const float (&lf)[16], float (&bcs)[16], float& blast, float& bref) {
    const int d = tid & 127, seg = tid >> 7;
    float run = 0.f;
#pragma unroll
    for (int i = 0; i < 16; ++i) { run += lf[i]; bcs[i] = run; }
    segt[seg * 128 + d] = run;
    BAR_LDS();
    const float s0 = segt[d], s1 = segt[128 + d], s2 = segt[256 + d], s3 = segt[384 + d];
    const float off = seg == 0 ? 0.f : (seg == 1 ? s0 : (seg == 2 ? s0 + s1 : s0 + s1 + s2));
#pragma unroll
    for (int i = 0; i < 16; ++i) bcs[i] += off;
    blast = s0 + s1 + s2 + s3; bref = s0 + s1;
}
__device__ __forceinline__ void hg_pass1(const Params& p, int u, float* lds, const HgIn& in) {
    const int tid = tidx(), w = tid >> 6, lane = tid & 63, half = lane >> 5, col = lane & 31;
    const int c = u & 31, bh = u >> 5, hd = bh & 3, b = bh >> 2, tok0 = b * S + c * 64;
    __half* KH = (__half*)lds;
    __half* VT = KH + 128 * HG_VS;
    float* segt = (float*)(VT + 128 * HG_VS);
    BAR_LDS();
    float bcs[16], blast, bref;
    hg_cumsum(tid, segt, in.lf, bcs, blast, bref);
    {
        const int d = tid & 127, seg = tid >> 7;
        h8 k0, k1;
#pragma unroll
        for (int i = 0; i < 8; ++i) { k0[i] = (_Float16)((1.f - __expf(in.lf[i])) * __expf(blast - bcs[i])); k1[i] = (_Float16)((1.f - __expf(in.lf[8 + i])) * __expf(blast - bcs[8 + i])); }
        *(h8*)(KH + d * HG_VS + seg * 16) = k0; *(h8*)(KH + d * HG_VS + seg * 16 + 8) = k1;
        if (seg == 0) p.dec32[(size_t)u * 128 + d] = __expf(blast);
        *(h8*)(VT + d * HG_VS + seg * 16) = in.v0; *(h8*)(VT + d * HG_VS + seg * 16 + 8) = in.v1;
    }
    BAR_LDS();
    const int dt = w >> 1;
    h8 af[4];
#pragma unroll
    for (int ks = 0; ks < 4; ++ks) af[ks] = *(const h8*)(KH + (dt * 32 + col) * HG_VS + 16 * ks + 8 * half);
#pragma unroll
    for (int ee = 0; ee < 2; ++ee) {
        const int et = (w & 1) * 2 + ee;
        f32x16 acc;
#pragma unroll
        for (int r = 0; r < 16; ++r) acc[r] = 0.f;
#pragma unroll
        for (int ks = 0; ks < 4; ++ks) acc = __builtin_amdgcn_mfma_f32_32x32x16_f16(af[ks], *(const h8*)(VT + (et * 32 + col) * HG_VS + 16 * ks + 8 * half), acc, 0, 0, 0);
        __half* dst = p.stT16 + ((size_t)u * 128 + et * 32 + col) * 128 + dt * 32 + 4 * half;
#pragma unroll
        for (int r4 = 0; r4 < 4; ++r4) { h4 o = {(_Float16)acc[4 * r4], (_Float16)acc[4 * r4 + 1], (_Float16)acc[4 * r4 + 2], (_Float16)acc[4 * r4 + 3]}; *(h4*)(dst + 8 * r4) = o; }
    }
}
__device__ void hg_scan(const Params& p) {
    const int t = tidx();
    if (t >= 256) return;
    for (int gt = blockIdx.x * 256 + t; gt < 32 * 128 * 16; gt += gridDim.x * 256) {
    const int d8 = (gt & 15) * 8, e = (gt >> 4) & 127, bh = gt >> 11;
    float s[8];
#pragma unroll
    for (int j = 0; j < 8; ++j) s[j] = 0.f;
    for (int c = 0; c < 32; ++c) {
        const size_t u = (size_t)bh * 32 + c;
        h8* ptr = (h8*)(p.stT16 + (u * 128 + e) * 128 + d8);
        const h8 tv = *ptr;
        const f32x4 g0 = *(const f32x4*)(p.dec32 + u * 128 + d8), g1 = *(const f32x4*)(p.dec32 + u * 128 + d8 + 4);
        h8 o;
#pragma unroll
        for (int j = 0; j < 8; ++j) o[j] = (_Float16)s[j];
        *ptr = o;
#pragma unroll
        for (int j = 0; j < 4; ++j) { s[j] = g0[j] * s[j] + (float)tv[j]; s[4 + j] = g1[j] * s[4 + j] + (float)tv[4 + j]; }
    }
    }
}
__device__ __forceinline__ void hg_pass3(const Params& p, int l, int u, float* lds, const HgIn& in) {
    const int tid = tidx(), w = tid >> 6, lane = tid & 63, half = lane >> 5, col = lane & 31;
    const int c = u & 31, bh = u >> 5, hd = bh & 3, b = bh >> 2, tok0 = b * S + c * 64;
    __half* QI = (__half*)lds;
    __bf16* QM = (__bf16*)(QI + 64 * HG_QS);
    __bf16* KM = QM + 64 * HG_QS;
    __half* VT = (__half*)(KM + 64 * HG_QS);
    float* segt = (float*)(VT + 128 * HG_VS);
    float* part = segt + 512;
    const int tt = w & 1, et = w >> 1;
    h8 sf[8];
    {
        const __half* sp = p.stT16 + ((size_t)u * 128 + et * 32 + col) * 128 + 8 * half;
#pragma unroll
        for (int ks = 0; ks < 8; ++ks) sf[ks] = *(const h8*)(sp + 16 * ks);
    }
    const size_t ob = (size_t)(tok0 + tt * 32 + col) * W + hd * 128;
    h4 gv[4];
#pragma unroll
    for (int r4 = 0; r4 < 4; ++r4) gv[r4] = *(const h4*)(p.hgg16 + ob + et * 32 + 8 * r4 + 4 * half);
    BAR_LDS();
    float bcs[16], blast, bref;
    hg_cumsum(tid, segt, in.lf, bcs, blast, bref);
    {
        const int d = tid & 127, seg = tid >> 7;
#pragma unroll
        for (int i = 0; i < 16; ++i) {
            const int tk = seg * 16 + i;
            const float q = (float)(i < 8 ? in.q0[i & 7] : in.q1[i & 7]);
            QI[tk * HG_QS + d] = __float2half(q * __expf(bcs[i]));
            QM[tk * HG_QS + d] = (__bf16)(q * __expf(bcs[i] - bref));
            KM[tk * HG_QS + d] = (__bf16)((1.f - __expf(in.lf[i])) * __expf(bref - bcs[i]));
        }
        *(h8*)(VT + d * HG_VS + seg * 16) = in.v0; *(h8*)(VT + d * HG_VS + seg * 16 + 8) = in.v1;
    }
    BAR_LDS();
    h8 pb[2][2];
    bf8 qm[8];
#pragma unroll
    for (int ks = 0; ks < 8; ++ks) qm[ks] = *(const bf8*)(QM + (tt * 32 + col) * HG_QS + 16 * ks + 8 * half);
#pragma unroll
    for (int st = 0; st < 2; ++st) {
        if (st <= tt) {
            f32x16 sacc;
#pragma unroll
            for (int r = 0; r < 16; ++r) sacc[r] = 0.f;
#pragma unroll
            for (int ks = 0; ks < 8; ++ks) sacc = __builtin_amdgcn_mfma_f32_32x32x16_bf16(*(const bf8*)(KM + (st * 32 + col) * HG_QS + 16 * ks + 8 * half), qm[ks], sacc, 0, 0, 0);
#pragma unroll
            for (int r = 0; r < 16; ++r) {
                const int sl = (r & 3) + 8 * (r >> 2) + 4 * half;
                const float v = (st < tt || sl <= col) ? sacc[r] : 0.f;
                pb[st][r >> 3][r & 7] = (_Float16)v;
            }
        } else {
#pragma unroll
            for (int j = 0; j < 8; ++j) { pb[st][0][j] = (_Float16)0.f; pb[st][1][j] = (_Float16)0.f; }
        }
    }
    f32x16 o;
#pragma unroll
    for (int r = 0; r < 16; ++r) o[r] = 0.f;
#pragma unroll
    for (int st = 0; st < 2; ++st) {
        if (st <= tt) {
#pragma unroll
            for (int s2 = 0; s2 < 2; ++s2) {
                const __half* vp = VT + (et * 32 + col) * HG_VS + st * 32 + 16 * s2 + 4 * half;
                const h4 v0 = *(const h4*)vp, v1 = *(const h4*)(vp + 8);
                const h8 vf = {v0[0], v0[1], v0[2], v0[3], v1[0], v1[1], v1[2], v1[3]};
                o = __builtin_amdgcn_mfma_f32_32x32x16_f16(vf, pb[st][s2], o, 0, 0, 0);
            }
        }
    }
    {
#pragma unroll
        for (int ks = 0; ks < 8; ++ks) o = __builtin_amdgcn_mfma_f32_32x32x16_f16(sf[ks], *(const h8*)(QI + (tt * 32 + col) * HG_QS + 16 * ks + 8 * half), o, 0, 0, 0);
    }
    float ss = 0.f;
#pragma unroll
    for (int r = 0; r < 16; ++r) ss += o[r] * o[r];
    ss += __shfl_xor(ss, 32);
    if (half == 0) part[et * 64 + tt * 32 + col] = ss;
    BAR_LDS();
    const int tk = tt * 32 + col;
    const float tot = part[tk] + part[64 + tk] + part[128 + tk] + part[192 + tk];
    const float rs = rsqrtf(tot * (1.f / 128.f) + EPS);
    const float* on = p.onorm_g + l * 128;
#pragma unroll
    for (int r4 = 0; r4 < 4; ++r4) {
        const int e0 = et * 32 + 8 * r4 + 4 * half;
        const f32x4 nv = *(const f32x4*)(on + e0);
        h4 ov;
#pragma unroll
        for (int j = 0; j < 4; ++j) ov[j] = (_Float16)(o[4 * r4 + j] * rs * nv[j] * (float)gv[r4][j]);
        *(h4*)(p.ys + ob + e0) = ov;
    }
}

constexpr int S5_UP = 1032;
__device__ void s5_pow_table(const Params& p) {
    const size_t gtid = (size_t)blockIdx.x * 512 + tidx(), nth = (size_t)gridDim.x * 512;
    for (size_t i = gtid; i < (size_t)NL * 32 * 64 * 65; i += nth) {
        const int tau = (int)(i % 65); const size_t lgp = i / 65; const int lg = (int)(lgp / 64);
        const double dt = exp((double)p.log_dt[lg]);
        const double are = p.a_re[lgp], aim = p.a_im[lgp];
        const double mag = exp(are * dt * tau), ang = aim * dt * tau;
        p.pw[i * 2] = (float)(mag * cos(ang)); p.pw[i * 2 + 1] = (float)(mag * sin(ang));
    }
    for (size_t i = gtid; i < (size_t)NL * 32; i += nth) {
        const float sgv = exp2f(rintf(-p.log_dt[i] * 1.4426950408889634f));
        p.sg[i * 2] = sgv; p.sg[i * 2 + 1] = 1.f / sgv;
    }
}
__device__ void s5_build_tables(const Params& p, int l, float* lds) {
    const size_t gtid = (size_t)blockIdx.x * 512 + tidx(), nth = (size_t)gridDim.x * 512;
    {
        float* Cr = lds; float* Ci = Cr + 16 * 65; float* Br = Ci + 16 * 65; float* Bi = Br + 64 * 17; float* Wr = Bi + 64 * 17; float* Wi = Wr + 16 * 64;
        const int tid = tidx();
        for (int item = blockIdx.x; item < 128; item += gridDim.x) {
            const int g = item >> 2, lq = item & 3; const size_t lg = (size_t)l * 32 + g;
            __syncthreads();
            for (int i = tid; i < 1024; i += 512) {
                const int c = i >> 6, s = i & 63; Cr[c * 65 + s] = p.c_re[(lg * 16 + c) * 64 + s]; Ci[c * 65 + s] = p.c_im[(lg * 16 + c) * 64 + s];
                const int s2 = i >> 4, cp = i & 15; Br[s2 * 17 + cp] = p.bbar[((lg * 64 + s2) * 16 + cp) * 2]; Bi[s2 * 17 + cp] = p.bbar[((lg * 64 + s2) * 16 + cp) * 2 + 1];
                const int ll = i >> 6; Wr[ll * 64 + s] = p.pw[((lg * 64 + s) * 65 + lq * 16 + ll) * 2]; Wi[ll * 64 + s] = p.pw[((lg * 64 + s) * 65 + lq * 16 + ll) * 2 + 1];
            }
            __syncthreads();
            const float sgv = p.sg[lg * 2];
#pragma unroll 1
            for (int k = 0; k < 8; ++k) {
                const int o = tid + 512 * k, cp = o & 15, c = (o >> 4) & 15, ll = o >> 8;
                float acc = 0.f;
#pragma unroll 8
                for (int s = 0; s < 64; ++s) {
                    const float cr = Cr[c * 65 + s], ci = Ci[c * 65 + s], wr = Wr[ll * 64 + s], wi = Wi[ll * 64 + s];
                    acc += (cr * wr - ci * wi) * Br[s * 17 + cp] - (cr * wi + ci * wr) * Bi[s * 17 + cp];
                }
                p.kmat16[(((size_t)g * 64 + lq * 16 + ll) * 16 + c) * 16 + cp] = __float2half(acc * sgv);
            }
        }
        __syncthreads();
    }
    for (size_t i8 = gtid; i8 < (size_t)32 * 128 * 1024 / 8; i8 += nth) {
        const size_t i = i8 * 8;
        const int cp0 = (int)(i & 15), sig = (int)((i >> 4) & 63), n = (int)((i >> 10) & 127), g = (int)(i >> 17);
        const size_t lg = (size_t)l * 32 + g; const int s = n & 63;
        const float wr = p.pw[((lg * 64 + s) * 65 + 63 - sig) * 2], wi = p.pw[((lg * 64 + s) * 65 + 63 - sig) * 2 + 1], sgv = p.sg[lg * 2];
        const float* bb = p.bbar + ((lg * 64 + s) * 16 + cp0) * 2;
        h8 o;
#pragma unroll
        for (int j = 0; j < 8; ++j) { const float br = bb[2 * j], bi = bb[2 * j + 1]; o[j] = (_Float16)((n < 64 ? wr * br - wi * bi : wr * bi + wi * br) * sgv); }
        *(h8*)(p.hs16 + i) = o;
    }
    for (size_t i8 = gtid; i8 < (size_t)32 * 1024 * 128 / 8; i8 += nth) {
        const size_t i = i8 * 8;
        const int n0 = (int)(i & 127), c = (int)((i >> 7) & 15), tau = (int)((i >> 11) & 63), g = (int)(i >> 17);
        const size_t lg = (size_t)l * 32 + g; const int s0 = n0 & 63;
        h8 o;
#pragma unroll
        for (int j = 0; j < 8; ++j) {
            const int s = s0 + j;
            const float cr = p.c_re[(lg * 16 + c) * 64 + s], ci = p.c_im[(lg * 16 + c) * 64 + s];
            const float wr = p.pw[((lg * 64 + s) * 65 + tau + 1) * 2], wi = p.pw[((lg * 64 + s) * 65 + tau + 1) * 2 + 1];
            o[j] = (_Float16)(n0 < 64 ? cr * wr - ci * wi : -(cr * wi + ci * wr));
        }
        *(h8*)(p.gs16 + i) = o;
    }
}
__device__ __forceinline__ void s5_load_u(const Params& p, int g, int b, int tid, __half* U) {
#pragma unroll
    for (int i = 0; i < 4; ++i) {
        const int idx = tid + 512 * i, ch = idx >> 6, sig = idx & 63;
        const h8* src = (const h8*)(p.s5u16 + (size_t)(b * S + ch * 64 + sig) * W + g * 16);
        const h8 a = src[0], c2 = src[1];
        *(h8*)(U + ch * S5_UP + sig * 16) = a; *(h8*)(U + ch * S5_UP + sig * 16 + 8) = c2;
    }
}
__device__ void s5_pass1(const Params& p, int g, int b, float* lds) {
    const int tid = tidx(), w = tid >> 6, lane = tid & 63, half = lane >> 5, col = lane & 31;
    __half* U = (__half*)lds;
    float* part = (float*)(U + 32 * S5_UP);
    __syncthreads();
    s5_load_u(p, g, b, tid, U);
    __syncthreads();
    const int nt = w & 3, sh = w >> 2;
    const __half* hp = p.hs16 + ((size_t)g * 128 + nt * 32 + col) * 1024 + 8 * half;
    const __half* up = U + col * S5_UP + 8 * half;
    f32x16 acc;
#pragma unroll
    for (int r = 0; r < 16; ++r) acc[r] = 0.f;
#pragma unroll 8
    for (int sig = sh * 32; sig < sh * 32 + 32; ++sig) acc = __builtin_amdgcn_mfma_f32_32x32x16_f16(*(const h8*)(hp + sig * 16), *(const h8*)(up + sig * 16), acc, 0, 0, 0);
    if (sh == 1) {
#pragma unroll
        for (int r = 0; r < 16; ++r) part[(nt * 16 + r) * 64 + lane] = acc[r];
    }
    __syncthreads();
    if (sh == 0) {
        float* ep = p.e32 + (((size_t)g * 8 + b) * 32 + col) * 128 + nt * 32 + 4 * half;
#pragma unroll
        for (int r4 = 0; r4 < 4; ++r4) {
            f32x4 o;
#pragma unroll
            for (int j = 0; j < 4; ++j) o[j] = acc[4 * r4 + j] + part[(nt * 16 + 4 * r4 + j) * 64 + lane];
            *(f32x4*)(ep + 8 * r4) = o;
        }
    }
}
__device__ void s5_scan(const Params& p, int l) {
    const int t = tidx();
    if (t < 256 || t >= 320) return;
    for (int gt = blockIdx.x * 64 + (t - 256); gt < 32 * 8 * 64; gt += gridDim.x * 64) {
    const int s = gt & 63, b = (gt >> 6) & 7, g = gt >> 9;
    const size_t lg = (size_t)l * 32 + g;
    const float ar = p.pw[((lg * 64 + s) * 65 + 64) * 2], ai = p.pw[((lg * 64 + s) * 65 + 64) * 2 + 1];
    float xr = 0.f, xi = 0.f;
    for (int c = 0; c < 32; ++c) {
        const size_t base = (((size_t)g * 8 + b) * 32 + c) * 128;
        p.x16[base + s] = __float2half(xr); p.x16[base + 64 + s] = __float2half(xi);
        const float er = p.e32[base + s], ei = p.e32[base + 64 + s];
        const float nr = ar * xr - ai * xi + er, ni = ar * xi + ai * xr + ei;
        xr = nr; xi = ni;
    }
    }
}
__device__ void s5_pass3(const Params& p, int l, int g, int b, float* lds) {
    const int tid = tidx(), w = tid >> 6, lane = tid & 63, half = lane >> 5, col = lane & 31;
    __half* U = (__half*)lds;
    __half* KM = U + 32 * S5_UP;
    __syncthreads();
    s5_load_u(p, g, b, tid, U);
    for (int i = tid; i < 64 * 256 / 8; i += 512) *(h8*)(KM + i * 8) = *(const h8*)(p.kmat16 + (size_t)g * 64 * 256 + i * 8);
    __syncthreads();
    h8 xb[8];
    {
        const __half* xp = p.x16 + (((size_t)g * 8 + b) * 32 + col) * 128 + 8 * half;
#pragma unroll
        for (int ks = 0; ks < 8; ++ks) xb[ks] = *(const h8*)(xp + 16 * ks);
    }
    const float isg = p.sg[((size_t)l * 32 + g) * 2 + 1];
    const __half* up = U + col * S5_UP + 8 * half;
    const int cch = col & 15, tl = col >> 4;
#pragma unroll 1
    for (int rt = w; rt < 32; rt += 8) {
        f32x16 acc;
#pragma unroll
        for (int r = 0; r < 16; ++r) acc[r] = 0.f;
        const int tau = 2 * rt + tl;
#pragma unroll 2
        for (int sig = 0; sig <= 2 * rt + 1; ++sig) {
            const int lag = tau - sig;
            h8 a;
            if (lag >= 0) a = *(const h8*)(KM + (lag * 16 + cch) * 16 + 8 * half);
            else {
#pragma unroll
                for (int j = 0; j < 8; ++j) a[j] = (_Float16)0.f;
            }
            acc = __builtin_amdgcn_mfma_f32_32x32x16_f16(a, *(const h8*)(up + sig * 16), acc, 0, 0, 0);
        }
        const __half* gp = p.gs16 + ((size_t)g * 1024 + 2 * rt * 16 + col) * 128 + 8 * half;
#pragma unroll
        for (int ks = 0; ks < 8; ++ks) acc = __builtin_amdgcn_mfma_f32_32x32x16_f16(*(const h8*)(gp + 16 * ks), xb[ks], acc, 0, 0, 0);
#pragma unroll
        for (int r4 = 0; r4 < 4; ++r4) {
            const int tloc = r4 >> 1, c0 = 8 * (r4 & 1) + 4 * half;
            const int tk = 2 * rt + tloc;
            const h4 uv = *(const h4*)(U + col * S5_UP + tk * 16 + c0);
            const f32x4 dv = *(const f32x4*)(p.s5_d + l * W + g * 16 + c0);
            h4 ov;
#pragma unroll
            for (int j = 0; j < 4; ++j) ov[j] = (_Float16)gelu_tanh_f(acc[4 * r4 + j] * isg + dv[j] * (float)uv[j]);
            *(h4*)(p.ypre16 + (size_t)(b * S + col * 64 + tk) * W + g * 16 + c0) = ov;
        }
    }
}

__device__ void phase_mix1(const Params& p, int l, float* lds) {
    const int c = blockIdx.x, G = gridDim.x;
    phase_fix(p, l, lds);
    for (int u = c; u < 256; u += G) s5_pass1(p, u >> 3, u & 7, lds);
#pragma unroll 1
    for (int u = c; u < 1024; u += G) {
        HgIn cur; const int bh = u >> 5;
        hg_issue_loads(p, (bh >> 2) * S + (u & 31) * 64, bh & 3, tidx(), false, cur);
        hg_pass1(p, u, lds, cur);
    }
    __syncthreads();
}
__device__ void phase_mix2(const Params& p, int l, float* lds) {
    const int c = blockIdx.x, G = gridDim.x;
    s5_scan(p, l);
    hg_scan(p);
    __syncthreads();
    for (int cb = c; cb < 256; cb += G) {
        const int b = cb >> 5, cc = cb & 31, k = cc & 15;
#pragma unroll 1
        for (int i = 0; i < 4; ++i) {
            const int j = cc < 16 ? (i == 0 ? k : (i == 1 ? 80 + k : (i == 2 ? 111 - k : 112 + k)))
                                  : (i == 0 ? 16 + k : (i == 1 ? 47 - k : (i == 2 ? 48 + k : 79 - k)));
            dsa_select(p, b, j * 16, lds);
        }
    }
}
__device__ void phase_mix3(const Params& p, int l, float* lds) {
    for (int c = blockIdx.x; c < 256; c += gridDim.x) {
        const int b = c >> 5, cc = c & 31;
#pragma unroll 1
        for (int k = 0; k < 2; ++k) dsa_attend_block(p, b, k ? 63 - cc : cc, lds);
    }
    for (int u = blockIdx.x; u < 256; u += gridDim.x) s5_pass3(p, l, u >> 3, u & 7, lds);
#pragma unroll 1
    for (int u = blockIdx.x; u < 1024; u += gridDim.x) {
        HgIn cur; const int bh = u >> 5;
        hg_issue_loads(p, (bh >> 2) * S + (u & 31) * 64, bh & 3, tidx(), true, cur);
        hg_pass3(p, l, u, lds, cur);
    }
    __syncthreads();
}

#define XB_TMO      128
#define XB_XCNT(j)  (256  + 64 * (j))
#define XB_XSUB(j)  (1280 + 64 * (j))
#define XB_XGEN(j)  (2304 + 64 * (j))
#define XB_TOP      3328
#define XB_TOPGEN   3392
#define XCD_BAR_WORDS 3456
#define XB_SPIN_CAP (1u << 22)
__device__ __forceinline__ unsigned xb_ld(unsigned* p)              { return __hip_atomic_load(p, __ATOMIC_RELAXED, __HIP_MEMORY_SCOPE_AGENT); }
__device__ __forceinline__ unsigned xb_add(unsigned* p, unsigned v) { return __hip_atomic_fetch_add(p, v, __ATOMIC_RELAXED, __HIP_MEMORY_SCOPE_AGENT); }
__device__ __forceinline__ unsigned xb_xcc_id() { return (unsigned)__builtin_amdgcn_s_getreg((3 << 11) | 20) & 0xFu; }
#define XB_SPIN(cond, bar) do { unsigned _sp = 0; while (cond) { __builtin_amdgcn_s_sleep(1); \
    if ((++_sp & 255u) == 0u) { if (xb_ld(&(bar)[XB_TMO])) break; if (_sp > XB_SPIN_CAP) { atomicAdd(&(bar)[XB_TMO], 1u); break; } } } } while (0)
struct XcdBarrier { unsigned* bar; unsigned x; volatile LAS unsigned* st; };
__device__ __forceinline__ XcdBarrier xcd_barrier_post(unsigned* bar, volatile LAS unsigned* st) {
    XcdBarrier b; b.bar = bar; b.x = xb_xcc_id(); b.st = st;
    if (threadIdx.x == 0) (void)xb_add(&bar[XB_XCNT(b.x)], 1u);
    return b;
}
__device__ __forceinline__ void xcd_barrier_complete(unsigned* bar, unsigned x, unsigned& nloc, unsigned& nx) {
    const unsigned G = gridDim.x * gridDim.y * gridDim.z;
    unsigned sum, cnt, mine, sp = 0u;
    for (;;) {
        sum = 0u; cnt = 0u; mine = 0u;
#pragma unroll
        for (unsigned j = 0; j < 16; ++j) { const unsigned c = xb_ld(&bar[XB_XCNT(j)]); sum += c; cnt += (c > 0u) ? 1u : 0u; mine = (j == x) ? c : mine; }
        if (sum == G) break;
        __builtin_amdgcn_s_sleep(1);
        if ((++sp & 255u) == 0u) { if (xb_ld(&bar[XB_TMO])) break; if (sp > XB_SPIN_CAP) { atomicAdd(&bar[XB_TMO], 1u); break; } }
    }
    nloc = mine > 0u ? mine : 1u; nx = cnt > 0u ? cnt : 1u;
}
__device__ __forceinline__ void xcd_barrier(const XcdBarrier& b) {
    asm volatile("s_waitcnt vmcnt(0)" ::: "memory");
    __syncthreads();
    if (threadIdx.x == 0) {
        unsigned* bar = b.bar;
        __builtin_amdgcn_s_waitcnt(0);
        unsigned nloc = b.st[0], nx = b.st[1];
        if (nloc == 0u) { xcd_barrier_complete(bar, b.x, nloc, nx); b.st[0] = nloc; b.st[1] = nx; }
        const unsigned old = xb_add(&bar[XB_XSUB(b.x)], 1u);
        const unsigned gen = old / nloc;
        if (old + 1u == (gen + 1u) * nloc) {
            __builtin_amdgcn_fence(__ATOMIC_RELEASE, "agent");
            asm volatile("s_waitcnt vmcnt(0)" ::: "memory");
            const unsigned og = xb_add(&bar[XB_TOP], 1u);
            const unsigned tg = og / nx;
            if (og + 1u == (tg + 1u) * nx) xb_add(&bar[XB_TOPGEN], 1u);
            else XB_SPIN(xb_ld(&bar[XB_TOPGEN]) == tg, bar);
            __builtin_amdgcn_fence(__ATOMIC_ACQUIRE, "agent");
            xb_add(&bar[XB_XGEN(b.x)], 1u);
            asm volatile("s_waitcnt vmcnt(0)" ::: "memory");
        } else {
            XB_SPIN(xb_ld(&bar[XB_XGEN(b.x)]) == gen, bar);
            __builtin_amdgcn_fence(__ATOMIC_ACQUIRE, "agent");
            asm volatile("s_waitcnt vmcnt(0)" ::: "memory");
        }
    }
    __syncthreads();
}

typedef const __attribute__((address_space(4))) Params* KParams;
#define PHASE_PARAMS() KParams _kp = (KParams)__builtin_amdgcn_kernarg_segment_ptr(); asm volatile("" : "+s"(_kp)); const Params& p = *(const Params*)_kp
__global__ void __launch_bounds__(512, 2) mega(Params p_unused) {
    extern __shared__ __attribute__((aligned(16))) float lds[];
    LAS unsigned char* ldsb = (LAS unsigned char*)lds;
    cg::grid_group grid = cg::this_grid();
    const int G = gridDim.x, c = blockIdx.x;
    __shared__ uint4 xb_words;
    if (threadIdx.x == 0) xb_words = make_uint4(0u, 0u, 0u, 0u);
    __syncthreads();
    XcdBarrier xbar;
    { PHASE_PARAMS(); xbar = xcd_barrier_post(p.xbar, (volatile LAS unsigned*)&xb_words); }
    { PHASE_PARAMS(); phase0(p); s5_pow_table(p); }
    grid.sync();
    for (int l = 0; l < NL; ++l) {
        { PHASE_PARAMS(); conv_layer(p, l, lds); phase_h(p, l); s5_build_tables(p, l, lds); }
        xcd_barrier(xbar);
        {
            PHASE_PARAMS();
            SchedPlain sc{(const char*)p.h16, (const char*)p.win16, 64, 32, G, c, D};
            EpiProj ep{p.q16, p.v16, p.hgg16, p.atq16, p.atk16, p.atv16, p.atg16, p.ixq16, p.ixk16, p.s5u16, p.s5g16, p.mg16, p.lf32, p.ixw32, p.lb + l * 512};
            pg::gemm_phase(ldsb, D, sc, ep);
        }
        xcd_barrier(xbar);
        { PHASE_PARAMS(); phase_mix1(p, l, lds); }
        xcd_barrier(xbar);
        { PHASE_PARAMS(); phase_mix2(p, l, lds); }
        xcd_barrier(xbar);
        { PHASE_PARAMS(); phase_mix3(p, l, lds); }
        xcd_barrier(xbar);
        {
            PHASE_PARAMS();
            SchedPlain sc{(const char*)p.ypre16, (const char*)p.wglu16, 64, 2, G, c, W};
            EpiGlu ep{p.ypre16, p.s5g16, p.glu_b + l * W, p.ys + (size_t)2 * T * W, nullptr};
            pg::gemm_phase(ldsb, W, sc, ep);
        }
        xcd_barrier(xbar);
        {
            PHASE_PARAMS();
            SchedMerge sc{(const char*)p.ys, (const char*)p.wb16, G, c};
            EpiMerge ep{(const unsigned char*)p.mg16, p.merged16};
            pg::gemm_phase(ldsb, W, sc, ep);
        }
        xcd_barrier(xbar);
        {
            PHASE_PARAMS();
            SchedPlain sc{(const char*)p.merged16, (const char*)p.wo16, 64, 4, G, c, D};
            EpiOut ep{l == 0 ? p.x : p.out, p.out, p.mod + (size_t)l * NB * 3072 + 2 * D};
            pg::gemm_phase(ldsb, D, sc, ep);
        }
        xcd_barrier(xbar);
    }
}

extern "C" void kernel_launch(void* const* d_in, const int* in_sizes, int n_in,
                              void* d_out, int out_size, void* d_ws, size_t ws_size,
                              hipStream_t stream) {
    static int grid_blocks = 0;
    if (!grid_blocks) {
        int dev = 0, cus = 0, per_cu = 0;
        (void)hipGetDevice(&dev);
        (void)hipDeviceGetAttribute(&cus, hipDeviceAttributeMultiprocessorCount, dev);
        (void)hipFuncSetAttribute((const void*)mega, hipFuncAttributeMaxDynamicSharedMemorySize, LDS_BYTES);
        (void)hipOccupancyMaxActiveBlocksPerMultiprocessor(&per_cu, mega, 512, LDS_BYTES);
        if (per_cu > 1) per_cu = 1;
        grid_blocks = cus * per_cu;
    }
    Params p{};
    const float* const* in = (const float* const*)d_in;
    p.x = in[0]; p.c = in[1]; p.pos = (const int*)d_in[2];
    p.ada_w = in[3]; p.ada_b = in[4]; p.norm_g = in[5]; p.w_in = in[6]; p.lb_logits = in[7]; p.onorm_g = in[8]; p.qn_g = in[9]; p.kn_g = in[10];
    p.a_re = in[11]; p.a_im = in[12]; p.log_dt = in[13]; p.b_re = in[14]; p.b_im = in[15]; p.c_re = in[16]; p.c_im = in[17]; p.s5_d = in[18];
    p.glu_w = in[19]; p.glu_b = in[20]; p.w_branch = in[21]; p.w_out = in[22];
    p.out = (float*)d_out;
    char* ws = (char*)d_ws; size_t off = 0;
    auto take = [&](size_t bytes) { char* q = ws + off; off += (bytes + 255) & ~(size_t)255; return q; };
    const size_t TW2 = (size_t)T * W * 2;
    p.mod = (float*)take((size_t)NL * NB * 3072 * 4);
    p.lb = (float*)take((size_t)NL * 512 * 4);
    p.abar = (float*)take((size_t)NL * 32 * 64 * 2 * 4);
    p.bbar = (float*)take((size_t)NL * 32 * 64 * 16 * 2 * 4);
    p.ropeA = (float*)take((size_t)T * 64 * 2 * 4);
    p.ropeI = (float*)take((size_t)T * 32 * 2 * 4);
    p.win16 = (__half*)take((size_t)NPK * D * 2);
    p.wb16 = (__half*)take((size_t)3 * D * W * 2);
    p.wo16 = (__half*)take((size_t)D * D * 2);
    p.wglu16 = (__half*)take((size_t)W * W * 2);
    p.h16 = (__half*)take((size_t)T * D * 2);       p.merged16 = p.h16; p.stT16 = p.h16;
    p.q16 = (__half*)take(TW2);                     p.mp32 = (float*)p.q16;
    p.lf32 = (float*)take((size_t)T * W * 4);
    p.v16 = (__half*)take(TW2);
    p.hgg16 = (__half*)take(TW2);
    p.atq16 = (__half*)take(TW2);
    p.atk16 = (__half*)take((size_t)T * 128 * 2);
    p.atv16 = (__half*)take((size_t)T * 128 * 2);
    p.atg16 = (__half*)take(TW2);
    p.ixq16 = (__half*)take(TW2);
    p.ixk16 = (__half*)take((size_t)T * 64 * 2);
    p.ixw32 = (float*)take((size_t)T * 8 * 4);
    p.s5u16 = (__half*)take(TW2);
    p.s5g16 = (__half*)take(TW2);
    p.mg16 = (__half*)take((size_t)T * 3072 * 2);
    p.ys = (__half*)take(3 * TW2);
    p.ypre16 = (__half*)take(TW2);
    p.dbg = (unsigned*)take(256);
    p.xbar = (unsigned*)take((size_t)XCD_BAR_WORDS * 4);
    p.pw = (float*)take((size_t)NL * 32 * 64 * 65 * 2 * 4);
    p.sg = (float*)take((size_t)NL * 32 * 2 * 4);
    p.kmat16 = (__half*)take((size_t)32 * 64 * 256 * 2);
    p.hs16 = (__half*)take((size_t)32 * 128 * 1024 * 2);
    p.gs16 = (__half*)take((size_t)32 * 1024 * 128 * 2);
    p.e32 = (float*)take((size_t)32 * 8 * 32 * 128 * 4);
    p.x16 = (__half*)take((size_t)32 * 8 * 32 * 128 * 2);
    p.dec32 = (float*)take((size_t)1024 * 128 * 4);
    p.mask = (unsigned*)take((size_t)T * 64 * 4);
    p.kf16 = (__half*)take((size_t)T * 128 * 2);
    p.vf16 = (__half*)take((size_t)T * 128 * 2);
    p.ikf16 = (__half*)take((size_t)T * 64 * 2);
    if (off > ws_size) { fprintf(stderr, "workspace too small: need %zu have %zu\n", off, ws_size); return; }
    (void)hipMemsetAsync(p.xbar, 0, (size_t)XCD_BAR_WORDS * 4, stream);
    (void)hipMemsetAsync(p.mod, 0, (size_t)NL * NB * 3072 * 4, stream);
    void* args[] = {&p};
    hipError_t e = hipLaunchCooperativeKernel((void*)mega, dim3(grid_blocks), dim3(512), args, LDS_BYTES, stream);
    if (e != hipSuccess) fprintf(stderr, "cooperative launch failed: %s (grid %d)\n", hipGetErrorString(e), grid_blocks);
}
```

```cpp
#include <hip/hip_runtime.h>
#include <hip/hip_cooperative_groups.h>
#include <hip/hip_fp16.h>
#include <cstdio>
namespace cg = cooperative_groups;

constexpr int D = 1024, NB = 8, S = 2048, T = NB * S, NL = 4, W = 512, NIN = 8008, NPK = 8192;
constexpr int C_S5U = 3912, C_MG = 4936;
constexpr float EPS = 1e-6f;
constexpr int LDS_BYTES = 135168;
#define LAS __attribute__((address_space(3)))
typedef _Float16 h8 __attribute__((ext_vector_type(8)));
typedef _Float16 h2 __attribute__((ext_vector_type(2)));
typedef float f32x4 __attribute__((ext_vector_type(4)));
typedef unsigned u32x4 __attribute__((ext_vector_type(4)));

struct Params {
    const float *x, *c; const int* pos;
    const float *ada_w, *ada_b, *norm_g, *w_in, *lb_logits, *onorm_g, *qn_g, *kn_g;
    const float *a_re, *a_im, *log_dt, *b_re, *b_im, *c_re, *c_im, *s5_d, *glu_w, *glu_b, *w_branch, *w_out;
    float* out;
    float *mod, *lb, *abar, *bbar, *ropeA, *ropeI;
    __half *win16, *wb16, *wo16, *wglu16;
    __half *h16, *q16, *v16, *hgg16, *atq16, *atk16, *atv16, *atg16, *ixq16, *ixk16, *s5u16, *s5g16, *mg16, *ys, *ypre16, *merged16;
    float *lf32, *ixw32, *mp32; unsigned* dbg; unsigned* mask; unsigned* xbar; __half *kf16, *vf16, *ikf16; __half* stT16; float* dec32; float *pw, *sg, *e32; __half *kmat16, *hs16, *gs16, *x16;
};

__device__ __forceinline__ float sigmoid_f(float v) { return 1.f / (1.f + expf(-v)); }
__device__ __forceinline__ float silu_f(float v) { return v / (1.f + expf(-v)); }
__device__ __forceinline__ float gelu_tanh_f(float v) { const float u = 0.7978845608028654f * (v + 0.044715f * v * v * v); return v * __builtin_amdgcn_rcpf(1.f + __builtin_amdgcn_exp2f(-2.885390081777927f * u)); }
__device__ __forceinline__ float wave_sum(float v) {
#pragma unroll
    for (int o = 32; o > 0; o >>= 1) v += __shfl_xor(v, o);
    return v;
}
__device__ __forceinline__ void lds_fence() { asm volatile("s_waitcnt lgkmcnt(0)" ::: "memory"); }
#define BAR_LDS() do { asm volatile("s_waitcnt lgkmcnt(0)" ::: "memory"); __builtin_amdgcn_s_barrier(); asm volatile("" ::: "memory"); } while (0)
__device__ __forceinline__ int tidx() { int t = threadIdx.x; asm volatile("" : "+v"(t)); return t; }

__device__ void phase0(const Params& p) {
    const size_t gtid = (size_t)blockIdx.x * blockDim.x + tidx(), nth = (size_t)gridDim.x * blockDim.x;
    {
        for (size_t i = gtid; i < (size_t)NL * 3072 * 8; i += nth) {
            const int col = (int)(i % 3072), ksl = (int)((i / 3072) % 8), l = (int)(i / (3072 * 8));
            const float* w = p.ada_w + ((size_t)l * 1024 + ksl * 128) * 3072 + col;
            float acc[NB];
#pragma unroll
            for (int b = 0; b < NB; ++b) acc[b] = ksl == 0 ? p.ada_b[l * 3072 + col] : 0.f;
#pragma unroll 4
            for (int k = 0; k < 128; ++k) {
                const float wv = w[(size_t)k * 3072];
#pragma unroll
                for (int b = 0; b < NB; ++b) { const float cv = p.c[b * 1024 + ksl * 128 + k]; acc[b] += cv * __builtin_amdgcn_rcpf(1.f + __builtin_amdgcn_exp2f(-1.4426950408889634f * cv)) * wv; }
            }
#pragma unroll
            for (int b = 0; b < NB; ++b) atomicAdd(p.mod + ((size_t)l * NB + b) * 3072 + col, acc[b]);
        }
    }
    for (size_t i = gtid; i < 512; i += nth) {
        float lg[NL], mx = -1e30f;
#pragma unroll
        for (int l = 0; l < NL; ++l) { lg[l] = p.lb_logits[l * 512 + i]; mx = fmaxf(mx, lg[l]); }
        float s = 0.f;
#pragma unroll
        for (int l = 0; l < NL; ++l) { lg[l] = expf(lg[l] - mx); s += lg[l]; }
        float cum = 0.f;
#pragma unroll
        for (int l = 0; l < NL; ++l) { const float pr = lg[l] / s; cum += pr; p.lb[l * 512 + i] = cum - lg[0] / s; }
    }
    for (size_t i = gtid; i < (size_t)NL * 32 * 64; i += nth) {
        const int lg = (int)(i / 64);
        const double dt = exp((double)p.log_dt[lg]);
        const double are = p.a_re[i], aim = p.a_im[i];
        const double mag = exp(are * dt), ang = aim * dt;
        const double abr = mag * cos(ang), abi = mag * sin(ang);
        const double nr = abr - 1.0, ni = abi, den = are * are + aim * aim;
        const double fr = (nr * are + ni * aim) / den, fi = (ni * are - nr * aim) / den;
        p.abar[i * 2] = (float)abr; p.abar[i * 2 + 1] = (float)abi;
        for (int c = 0; c < 16; ++c) {
            const double br = p.b_re[i * 16 + c], bi = p.b_im[i * 16 + c];
            p.bbar[(i * 16 + c) * 2] = (float)(fr * br - fi * bi);
            p.bbar[(i * 16 + c) * 2 + 1] = (float)(fr * bi + fi * br);
        }
    }
    for (size_t i = gtid; i < (size_t)T * 64; i += nth) {
        const int t = (int)(i / 64), j = (int)(i % 64);
        const double inv = pow(10000.0, -(double)(2 * j) / 128.0);
        const double ang = (double)p.pos[t] * inv;
        p.ropeA[i * 2] = (float)cos(ang); p.ropeA[i * 2 + 1] = (float)sin(ang);
    }
    for (size_t i = gtid; i < (size_t)T * 32; i += nth) {
        const int t = (int)(i / 32), j = (int)(i % 32);
        const double inv = pow(10000.0, -(double)(2 * j) / 64.0);
        const double ang = (double)p.pos[t] * inv;
        p.ropeI[i * 2] = (float)cos(ang); p.ropeI[i * 2 + 1] = (float)sin(ang);
    }
}

__device__ __forceinline__ unsigned pk2(float a, float b) { h2 v = {(_Float16)a, (_Float16)b}; return __builtin_bit_cast(unsigned, v); }
__device__ void phase_h(const Params& p, int l) {
    const float* xin = l == 0 ? p.x : p.out;
    const int w = tidx() >> 6, lane = tidx() & 63;
    for (int row = blockIdx.x * 8 + w; row < T; row += gridDim.x * 8) {
        const int b = row / S;
        const float* xr = xin + (size_t)row * D;
        float4 v[4]; float ss = 0.f;
#pragma unroll
        for (int i = 0; i < 4; ++i) { v[i] = *(const float4*)(xr + i * 256 + lane * 4); ss += v[i].x * v[i].x + v[i].y * v[i].y + v[i].z * v[i].z + v[i].w * v[i].w; }
        ss = wave_sum(ss);
        const float r = rsqrtf(ss * (1.f / D) + EPS);
        const float* md = p.mod + ((size_t)l * NB + b) * 3072;
#pragma unroll
        for (int i = 0; i < 4; ++i) {
            const int k = i * 256 + lane * 4;
            const float4 g = *(const float4*)(p.norm_g + l * D + k), sh = *(const float4*)(md + k), sc = *(const float4*)(md + D + k);
            uint2 o;
            o.x = pk2(v[i].x * r * g.x * (1.f + sc.x) + sh.x, v[i].y * r * g.y * (1.f + sc.y) + sh.y);
            o.y = pk2(v[i].z * r * g.z * (1.f + sc.z) + sh.z, v[i].w * r * g.w * (1.f + sc.w) + sh.w);
            *(uint2*)(p.h16 + (size_t)row * D + k) = o;
        }
    }
}
template <class CM>
__device__ void conv_transpose(const float* __restrict__ src, int ldsrc, int K, __half* __restrict__ dst, int N, CM colmap, float* lds, int part, int nparts) {
    float (*ts)[65] = (float (*)[65])lds;
    const int tid = tidx(), nkt = K / 64, nnt = N / 64;
    for (int tile = part; tile < nkt * nnt; tile += nparts) {
        const int kt = tile % nkt, nt = tile / nkt, k0 = kt * 64, n0 = nt * 64;
        __syncthreads();
#pragma unroll
        for (int i = 0; i < 8; ++i) {
            const int idx = tid + 512 * i, k = idx >> 6, n = idx & 63;
            const int sc = colmap(n0 + n);
            ts[k][n] = sc >= 0 ? src[(size_t)(k0 + k) * ldsrc + sc] : 0.f;
        }
        __syncthreads();
        const int n = tid >> 3, k8 = (tid & 7) * 8;
        u32x4 w;
        { h2 a = {(_Float16)ts[k8 + 0][n], (_Float16)ts[k8 + 1][n]}; w.x = __builtin_bit_cast(unsigned, a); }
        { h2 a = {(_Float16)ts[k8 + 2][n], (_Float16)ts[k8 + 3][n]}; w.y = __builtin_bit_cast(unsigned, a); }
        { h2 a = {(_Float16)ts[k8 + 4][n], (_Float16)ts[k8 + 5][n]}; w.z = __builtin_bit_cast(unsigned, a); }
        { h2 a = {(_Float16)ts[k8 + 6][n], (_Float16)ts[k8 + 7][n]}; w.w = __builtin_bit_cast(unsigned, a); }
        *(u32x4*)(dst + (size_t)(n0 + n) * K + k0 + k8) = w;
    }
}
struct CmIdent { __device__ int operator()(int n) const { return n; } };
struct CmWin { __device__ int operator()(int n) const { return n < C_S5U ? n : (n < 4096 ? -1 : n - 184); } };

__device__ void conv_layer(const Params& p, int l, float* lds) {
    conv_transpose(p.w_in + (size_t)l * D * NIN, NIN, D, p.win16, NPK, CmWin(), lds, blockIdx.x, gridDim.x);
    for (int n = 0; n < 3; ++n)
        conv_transpose(p.w_branch + ((size_t)l * 3 + n) * W * D, D, W, p.wb16 + (size_t)n * D * W, D, CmIdent(), lds, blockIdx.x, gridDim.x);
    conv_transpose(p.w_out + (size_t)l * D * D, D, D, p.wo16, D, CmIdent(), lds, blockIdx.x, gridDim.x);
    conv_transpose(p.glu_w + (size_t)l * W * W, W, W, p.wglu16, W, CmIdent(), lds, blockIdx.x, gridDim.x);
    __syncthreads();
}
namespace pg {
constexpr int BM = 256, BK = 64, HALF = 128, HTB = HALF * BK * 2, STAGE_BYTES = 8 * HTB, NXCD = 8, WGM = 8;
__device__ __forceinline__ int lds_byte(int r, int c) { const int st = (r >> 4) * 2 + (c >> 5), rr = r & 15, cc = c & 31, ob = rr * 64 + cc * 2; return st * 1024 + (ob ^ (((ob >> 9) & 1) << 5)); }
__device__ __forceinline__ void stage_rc(int b, int& R, int& C) { const int st = b / 1024, sb = b % 1024, swz = sb ^ (((sb >> 9) & 1) << 5); R = (st >> 1) * 16 + swz / 64; C = (st & 1) * 32 + (swz % 64) / 2; }
__device__ __forceinline__ int perm32(int rho) { const int n = rho >> 4, i = rho & 15; return 8 * (i >> 2) + 4 * n + (i & 3); }
struct Unit { int pm, pn, aux; const char* A; const char* B; };
__device__ __forceinline__ void tile_of(int L, int nM, int nN, int& pm, int& pn) {
    const int nwg = nM * nN; int wgid = L;
    { const int q = nwg / NXCD, r = nwg % NXCD, xcd = wgid % NXCD, off = wgid / NXCD; wgid = (xcd < r ? xcd * (q + 1) : r * (q + 1) + (xcd - r) * q) + off; }
    const int nig = WGM * nN, gid = wgid / nig, fm = gid * WGM, gsz = (nM - fm) < WGM ? (nM - fm) : WGM;
    pm = fm + ((wgid % nig) % gsz); pn = (wgid % nig) / gsz;
}
template <class Epi, class Sched>
__device__ __forceinline__ void gemm_phase(LAS unsigned char* lds, const int K, const Sched& S, const Epi& E) {
    int tid = tidx();
    const int wid = __builtin_amdgcn_readfirstlane(tid >> 6), lane = tid & 63, wr = wid >> 2, wc = wid & 3, fr = lane & 15, fq = lane >> 4;
    const int nt = K / BK;
    unsigned voffA[2], voffB[2];
#pragma unroll
    for (int i = 0; i < 2; ++i) { int R, C; stage_rc(tid * 16 + i * 8192, R, C); const int Rb = Epi::PERM ? ((R & ~31) + perm32(R & 31)) : R;
        voffA[i] = (unsigned)(R * K + C) * 2u; voffB[i] = (unsigned)(Rb * K + C) * 2u; }
    const size_t kstep = (size_t)(BK * 2);
    const size_t hstep = (size_t)HALF * K * 2;
    const unsigned ldsw = (unsigned)wid * 1024u;
    const int aoff = lds_byte(wr * 64 + fr, fq * 8), boff = lds_byte(wc * 32 + fr, fq * 8);
#define PG_SA(b, h) (((b) * 2 + (h)) * HTB)
#define PG_SB(b, h) ((4 + (b) * 2 + (h)) * HTB)
#define PG_STAGE(bufoff, gbase, voff) do { _Pragma("unroll") for (int _i = 0; _i < 2; ++_i) \
        __builtin_amdgcn_global_load_lds((const unsigned*)((const char*)(gbase) + (voff)[_i]), (LAS unsigned*)(lds + (bufoff) + ldsw + _i * 8192), 16, 0, 0); } while (0)
#define PG_LDA(dst, b, h) do { _Pragma("unroll") for (int m = 0; m < 4; ++m) _Pragma("unroll") for (int k = 0; k < 2; ++k) dst[m][k] = *(const LAS h8*)(lds + PG_SA(b, h) + aoff + m * 2048 + k * 1024); } while (0)
#define PG_LDB(dst, b, h) do { _Pragma("unroll") for (int n = 0; n < 2; ++n) _Pragma("unroll") for (int k = 0; k < 2; ++k) dst[n][k] = *(const LAS h8*)(lds + PG_SB(b, h) + boff + n * 2048 + k * 1024); } while (0)
#define PG_MMA(ai, bj, At, Bt) do { __builtin_amdgcn_s_setprio(1); _Pragma("unroll") for (int m = 0; m < 4; ++m) _Pragma("unroll") for (int n = 0; n < 2; ++n) _Pragma("unroll") for (int k = 0; k < 2; ++k) \
        acc[ai][bj][m][n] = __builtin_amdgcn_mfma_f32_16x16x32_f16(Bt[n][k], At[m][k], acc[ai][bj][m][n], 0, 0, 0); __builtin_amdgcn_s_setprio(0); } while (0)
#define PG_WAIT_V(n) asm volatile("s_waitcnt vmcnt(" #n ")" ::: "memory")
#define PG_WAIT_L(n) asm volatile("s_waitcnt lgkmcnt(" #n ")" ::: "memory")
#define PG_BAR __builtin_amdgcn_s_barrier()
#define PG_SCHED __builtin_amdgcn_sched_barrier(0)
    Unit cur, nxt; int ui = 0;
    if (!S.next(0, cur)) return;
    f32x4 acc[2][2][4][2];
#pragma unroll
    for (int a = 0; a < 2; ++a)
#pragma unroll
        for (int b = 0; b < 2; ++b)
#pragma unroll
            for (int m = 0; m < 4; ++m)
#pragma unroll
                for (int n = 0; n < 2; ++n) acc[a][b][m][n] = (f32x4){0.f, 0.f, 0.f, 0.f};
    h8 At[4][2], B0[2][2], B1[2][2];
    const char* cA = cur.A; const char* cB = cur.B;
    PG_STAGE(PG_SB(0, 0), cB, voffB); PG_STAGE(PG_SA(0, 0), cA, voffA); PG_STAGE(PG_SB(0, 1), cB + hstep, voffB); PG_STAGE(PG_SA(0, 1), cA + hstep, voffA);
    if (wr == 1) PG_BAR;
    PG_WAIT_V(4); PG_BAR;
    PG_STAGE(PG_SB(1, 0), cB + kstep, voffB); PG_STAGE(PG_SA(1, 0), cA + kstep, voffA); PG_STAGE(PG_SB(1, 1), cB + hstep + kstep, voffB);
    PG_WAIT_V(6); PG_BAR;
    for (;;) {
        const bool has_next = S.next(ui + 1, nxt);
        const char* nA = has_next ? nxt.A : cA; const char* nB = has_next ? nxt.B : cB;
        for (int t = 0; t < nt; t += 2) {
            const bool last = (t == nt - 2);
            const char* a1 = cA + (size_t)(t + 1) * kstep;
            const char* a2 = last ? nA : cA + (size_t)(t + 2) * kstep; const char* b2 = last ? nB : cB + (size_t)(t + 2) * kstep;
            const char* a3 = a2 + kstep; const char* b3 = b2 + kstep;
            PG_LDB(B0, 0, 0); PG_SCHED; PG_LDA(At, 0, 0); PG_STAGE(PG_SA(1, 1), a1 + hstep, voffA);
            PG_WAIT_L(8); PG_BAR; PG_WAIT_L(0); PG_MMA(0, 0, At, B0); PG_BAR; PG_SCHED;
            PG_LDB(B1, 0, 1); PG_STAGE(PG_SB(0, 0), b2, voffB);
            PG_BAR; PG_WAIT_L(0); PG_MMA(0, 1, At, B1); PG_BAR;
            PG_LDA(At, 0, 1); PG_STAGE(PG_SA(0, 0), a2, voffA);
            PG_BAR; PG_WAIT_L(0); PG_MMA(1, 0, At, B0); PG_BAR; PG_SCHED;
            PG_STAGE(PG_SB(0, 1), b2 + hstep, voffB);
            PG_WAIT_V(6); PG_BAR; PG_MMA(1, 1, At, B1); PG_BAR;
            PG_LDB(B0, 1, 0); PG_SCHED; PG_LDA(At, 1, 0); PG_STAGE(PG_SA(0, 1), a2 + hstep, voffA);
            PG_WAIT_L(8); PG_BAR; PG_WAIT_L(0); PG_MMA(0, 0, At, B0); PG_BAR; PG_SCHED;
            PG_LDB(B1, 1, 1); PG_STAGE(PG_SB(1, 0), b3, voffB);
            PG_BAR; PG_WAIT_L(0); PG_MMA(0, 1, At, B1); PG_BAR;
            PG_LDA(At, 1, 1); PG_STAGE(PG_SA(1, 0), a3, voffA);
            PG_BAR; PG_WAIT_L(0); PG_MMA(1, 0, At, B0); PG_BAR; PG_SCHED;
            PG_STAGE(PG_SB(1, 1), b3 + hstep, voffB);
            PG_WAIT_V(6); PG_BAR; PG_MMA(1, 1, At, B1); PG_BAR;
        }
        E(acc, cur, wr, wc, fr, fq);
        if (!has_next) break;
        if constexpr (!Epi::KEEP_ACC) {
#pragma unroll
        for (int a = 0; a < 2; ++a)
#pragma unroll
            for (int b = 0; b < 2; ++b)
#pragma unroll
                for (int m = 0; m < 4; ++m)
#pragma unroll
                    for (int n = 0; n < 2; ++n) acc[a][b][m][n] = (f32x4){0.f, 0.f, 0.f, 0.f};
        }
        cur = nxt; cA = nA; cB = nB; ++ui;
    }
    PG_WAIT_V(0);
    if (wr == 0) PG_BAR;
    PG_BAR;
#undef PG_SA
#undef PG_SB
#undef PG_STAGE
#undef PG_LDA
#undef PG_LDB
#undef PG_MMA
#undef PG_WAIT_V
#undef PG_WAIT_L
#undef PG_BAR
#undef PG_SCHED
}
}
__device__ __forceinline__ float fsig(float v) { return __builtin_amdgcn_rcpf(1.f + __builtin_amdgcn_exp2f(-1.4426950408889634f * v)); }
__device__ __forceinline__ float fsilu(float v) { return v * fsig(v); }
__device__ __forceinline__ u32x4 pack8(const f32x4 a, const f32x4 b) {
    const h8 v = {(_Float16)a[0], (_Float16)a[1], (_Float16)a[2], (_Float16)a[3], (_Float16)b[0], (_Float16)b[1], (_Float16)b[2], (_Float16)b[3]};
    return __builtin_bit_cast(u32x4, v);
}
__device__ __forceinline__ void unpack8(const u32x4 w, float (&o)[8]) {
    const h8 v = __builtin_bit_cast(h8, w);
#pragma unroll
    for (int j = 0; j < 8; ++j) o[j] = (float)v[j];
}
struct SchedPlain {
    const char* A; const char* B; int nM, nN, G, c, K;
    __device__ bool next(int i, pg::Unit& u) const {
        const long L = (long)i * G + c; if (L >= (long)nM * nN) return false;
        pg::tile_of((int)L, nM, nN, u.pm, u.pn); u.aux = 0;
        u.A = A + (size_t)u.pm * 256 * K * 2; u.B = B + (size_t)u.pn * 256 * K * 2; return true;
    }
};
struct SchedMerge {
    const char* ys; const char* wb; int G, c;
    __device__ bool next(int i, pg::Unit& u) const {
        const int r = i / 3, n = i - 3 * r; const long L = (long)r * G + c; if (L >= 64 * 4) return false;
        pg::tile_of((int)L, 64, 4, u.pm, u.pn); u.aux = n;
        u.A = ys + ((size_t)n * T + (size_t)u.pm * 256) * W * 2; u.B = wb + ((size_t)n * D + (size_t)u.pn * 256) * W * 2; return true;
    }
};

template <int ACT> __device__ __forceinline__ f32x4 actv(f32x4 v) {
    if (ACT == 1) { for (int j = 0; j < 4; ++j) v[j] = fsilu(v[j]); }
    if (ACT == 2) { for (int j = 0; j < 4; ++j) v[j] = fsig(v[j]); }
    return v;
}
template <int ACT> __device__ __forceinline__ void st16(const f32x4 (&acc)[2][2][4][2], __half* base, int ld, int c8, int bj0, int bj1) {
#pragma unroll
    for (int ai = 0; ai < 2; ++ai)
#pragma unroll
        for (int m = 0; m < 4; ++m) {
            __half* rowp = base + (size_t)(ai * 128 + m * 16) * ld + c8;
#pragma unroll
            for (int bj = 0; bj < 2; ++bj) if (bj >= bj0 && bj < bj1)
                *(u32x4*)(rowp + (bj - bj0) * 128) = pack8(actv<ACT>(acc[ai][bj][m][0]), actv<ACT>(acc[ai][bj][m][1]));
        }
}
struct EpiProj {
    static constexpr bool PERM = true, KEEP_ACC = false;
    __half *q16, *v16, *hgg16, *atq16, *atk16, *atv16, *atg16, *ixq16, *ixk16, *s5u16, *s5g16, *mg16; float *lf32, *ixw32; const float* lb;
    __device__ __forceinline__ void operator()(f32x4 (&acc)[2][2][4][2], const pg::Unit& u, int wr, int wc, int fr, int fq) const {
        const size_t row0 = (size_t)u.pm * 256 + wr * 64 + fr; const int c8 = wc * 32 + 8 * fq, pn = u.pn;
        if (pn < 2)        st16<0>(acc, q16 + row0 * W + pn * 256, W, c8, 0, 2);
        else if (pn < 4) {
            const int cb = (pn - 2) * 256 + c8;
#pragma unroll
            for (int bj = 0; bj < 2; ++bj) {
                const f32x4 l0 = *(const f32x4*)(lb + cb + bj * 128), l1 = *(const f32x4*)(lb + cb + bj * 128 + 4);
#pragma unroll
                for (int ai = 0; ai < 2; ++ai)
#pragma unroll
                    for (int m = 0; m < 4; ++m) {
                        f32x4 a = acc[ai][bj][m][0], b = acc[ai][bj][m][1];
#pragma unroll
                        for (int j = 0; j < 4; ++j) { a[j] = 0.6931471805599453f * __builtin_amdgcn_logf(fmaxf(l0[j] + (1.f - l0[j]) * fsig(a[j]), 1e-30f)); b[j] = 0.6931471805599453f * __builtin_amdgcn_logf(fmaxf(l1[j] + (1.f - l1[j]) * fsig(b[j]), 1e-30f)); }
                        float* o = lf32 + (row0 + ai * 128 + m * 16) * W + cb + bj * 128;
                        *(f32x4*)o = a; *(f32x4*)(o + 4) = b;
                    }
            }
        }
        else if (pn < 6)   st16<0>(acc, v16 + row0 * W + (pn - 4) * 256, W, c8, 0, 2);
        else if (pn < 8)   st16<1>(acc, hgg16 + row0 * W + (pn - 6) * 256, W, c8, 0, 2);
        else if (pn < 10)  st16<0>(acc, atq16 + row0 * W + (pn - 8) * 256, W, c8, 0, 2);
        else if (pn == 10) { st16<0>(acc, atk16 + row0 * 128, 128, c8, 0, 1); st16<0>(acc, atv16 + row0 * 128, 128, c8, 1, 2); }
        else if (pn < 13)  st16<1>(acc, atg16 + row0 * W + (pn - 11) * 256, W, c8, 0, 2);
        else if (pn < 15)  st16<0>(acc, ixq16 + row0 * W + (pn - 13) * 256, W, c8, 0, 2);
        else if (pn == 15) {
            if (wc < 2) {
#pragma unroll
                for (int ai = 0; ai < 2; ++ai)
#pragma unroll
                    for (int m = 0; m < 4; ++m) *(u32x4*)(ixk16 + (row0 + ai * 128 + m * 16) * 64 + c8) = pack8(acc[ai][0][m][0], acc[ai][0][m][1]);
            } else if (wc == 2 && fq == 0) {
#pragma unroll
                for (int ai = 0; ai < 2; ++ai)
#pragma unroll
                    for (int m = 0; m < 4; ++m) { float* o = ixw32 + (row0 + ai * 128 + m * 16) * 8; *(f32x4*)o = acc[ai][0][m][0]; *(f32x4*)(o + 4) = acc[ai][0][m][1]; }
            }
        }
        else if (pn < 18)  st16<0>(acc, s5u16 + row0 * W + (pn - 16) * 256, W, c8, 0, 2);
        else if (pn < 20)  st16<1>(acc, s5g16 + row0 * W + (pn - 18) * 256, W, c8, 0, 2);
        else {
            int lane = fq * 16 + fr;
            asm volatile("" : "+v"(lane));
            unsigned char* base = (unsigned char*)mg16 + ((((size_t)u.pm * 12 + (pn - 20)) * 8 + wr * 4 + wc) * 16) * 512 + lane * 8;
#pragma unroll
            for (int ai = 0; ai < 2; ++ai)
#pragma unroll
                for (int m = 0; m < 4; ++m)
#pragma unroll
                    for (int bj = 0; bj < 2; ++bj) {
                        const f32x4 a = actv<2>(acc[ai][bj][m][0]), b = actv<2>(acc[ai][bj][m][1]);
                        unsigned lo = 0, hi = 0;
#pragma unroll
                        for (int j = 0; j < 4; ++j) {
                            lo |= (unsigned)max(1, (int)__builtin_rintf(a[j] * 255.f)) << (8 * j);
                            hi |= (unsigned)max(1, (int)__builtin_rintf(b[j] * 255.f)) << (8 * j);
                        }
                        *(uint2*)(base + ((ai * 4 + m) * 2 + bj) * 512) = make_uint2(lo, hi);
                    }
        }
    }
};
struct EpiGlu {
    static constexpr bool PERM = true, KEEP_ACC = false;
    const __half* ypre16; const __half* s5g16; const float* bias; __half* yc; float* raw;
    __device__ __forceinline__ void operator()(f32x4 (&acc)[2][2][4][2], const pg::Unit& u, int wr, int wc, int fr, int fq) const {
        size_t row0 = (size_t)u.pm * 256 + wr * 64 + fr; const int c0 = u.pn * 256 + wc * 32 + 8 * fq;
        asm volatile("" : "+v"(row0));
        f32x4 bv[2][2];
#pragma unroll
        for (int bj = 0; bj < 2; ++bj) { bv[bj][0] = *(const f32x4*)(bias + c0 + bj * 128); bv[bj][1] = *(const f32x4*)(bias + c0 + bj * 128 + 4); }
#pragma unroll
        for (int am = 0; am < 4; ++am) {
            u32x4 yv[2][2], gv[2][2];
#pragma unroll
            for (int mm = 0; mm < 2; ++mm)
#pragma unroll
                for (int bj = 0; bj < 2; ++bj) {
                    const size_t off = (row0 + (am >> 1) * 128 + ((am & 1) * 2 + mm) * 16) * W + c0 + bj * 128;
                    yv[mm][bj] = *(const u32x4*)(ypre16 + off); gv[mm][bj] = *(const u32x4*)(s5g16 + off);
                }
#pragma unroll
            for (int mm = 0; mm < 2; ++mm)
#pragma unroll
                for (int bj = 0; bj < 2; ++bj) {
                    const int ai = am >> 1, m = (am & 1) * 2 + mm;
                    const size_t off = (row0 + ai * 128 + m * 16) * W + c0 + bj * 128;
                    float y[8], g[8]; unpack8(yv[mm][bj], y); unpack8(gv[mm][bj], g);
                    f32x4 a = acc[ai][bj][m][0] + bv[bj][0], b = acc[ai][bj][m][1] + bv[bj][1];
#pragma unroll
                    for (int j = 0; j < 4; ++j) { a[j] = y[j] * fsig(a[j]) * g[j]; b[j] = y[4 + j] * fsig(b[j]) * g[4 + j]; }
                    *(u32x4*)(yc + off) = pack8(a, b);
                }
        }
    }
};
struct EpiMerge {
    static constexpr bool PERM = true, KEEP_ACC = true;
    const unsigned char* mg8; __half* merged16;
    static __device__ __forceinline__ void dec8(const uint2 w, float (&g)[8]) {
#pragma unroll
        for (int j = 0; j < 4; ++j) { g[j] = (float)((w.x >> (8 * j)) & 255u); g[4 + j] = (float)((w.y >> (8 * j)) & 255u); }
    }
    __device__ __forceinline__ void operator()(f32x4 (&acc)[2][2][4][2], const pg::Unit& u, int wr, int wc, int fr, int fq) const {
        const size_t row0 = (size_t)u.pm * 256 + wr * 64 + fr; const int c0 = u.pn * 256 + wc * 32 + 8 * fq, n = u.aux;
        int lofs = ((wr * 4 + wc) * 16) * 512 + (fq * 16 + fr) * 8;
        asm volatile("" : "+v"(lofs));
        const unsigned char* gp = mg8 + ((size_t)u.pm * 12 + n * 4 + u.pn) * 16 * 8 * 512 + lofs;
        uint2 gq[16], gnq[16];
#pragma unroll
        for (int k = 0; k < 16; ++k) gq[k] = *(const uint2*)(gp + k * 512);
        if (n < 2) {
#pragma unroll
            for (int k = 0; k < 16; ++k) gnq[k] = *(const uint2*)(gp + (size_t)4 * 16 * 8 * 512 + k * 512);
        }
#pragma unroll
        for (int ai = 0; ai < 2; ++ai)
#pragma unroll
            for (int m = 0; m < 4; ++m)
#pragma unroll
                for (int bj = 0; bj < 2; ++bj) {
                    const int k = (ai * 4 + m) * 2 + bj;
                    float g[8]; dec8(gq[k], g);
                    f32x4 a = acc[ai][bj][m][0], b = acc[ai][bj][m][1];
                    if (n < 2) {
                        float gn[8]; dec8(gnq[k], gn);
#pragma unroll
                        for (int j = 0; j < 4; ++j) { a[j] *= g[j] * __builtin_amdgcn_rcpf(gn[j]); b[j] *= g[4 + j] * __builtin_amdgcn_rcpf(gn[4 + j]); }
                        acc[ai][bj][m][0] = a; acc[ai][bj][m][1] = b;
                    } else {
#pragma unroll
                        for (int j = 0; j < 4; ++j) { a[j] *= g[j] * (1.f / 255.f); b[j] *= g[4 + j] * (1.f / 255.f); }
                        *(u32x4*)(merged16 + (row0 + ai * 128 + m * 16) * D + c0 + bj * 128) = pack8(a, b);
                        acc[ai][bj][m][0] = (f32x4){0.f, 0.f, 0.f, 0.f}; acc[ai][bj][m][1] = (f32x4){0.f, 0.f, 0.f, 0.f};
                    }
                }
    }
};
struct EpiOut {
    static constexpr bool PERM = false, KEEP_ACC = false;
    const float* xin; float* out; const float* gate;
    __device__ __forceinline__ void operator()(f32x4 (&acc)[2][2][4][2], const pg::Unit& u, int wr, int wc, int fr, int fq) const {
        size_t row0 = (size_t)u.pm * 256 + wr * 64 + fr; const int c0 = u.pn * 256 + wc * 32 + 4 * fq;
        asm volatile("" : "+v"(row0));
        const int b = (u.pm * 256) / S;
        f32x4 gv[2][2];
#pragma unroll
        for (int bj = 0; bj < 2; ++bj)
#pragma unroll
            for (int n = 0; n < 2; ++n) gv[bj][n] = *(const f32x4*)(gate + (size_t)b * 3072 + c0 + bj * 128 + n * 16);
#pragma unroll
        for (int am = 0; am < 4; ++am) {
            f32x4 xv[2][2][2];
#pragma unroll
            for (int mm = 0; mm < 2; ++mm)
#pragma unroll
                for (int bj = 0; bj < 2; ++bj)
#pragma unroll
                    for (int n = 0; n < 2; ++n) xv[mm][bj][n] = *(const f32x4*)(xin + (row0 + (am >> 1) * 128 + ((am & 1) * 2 + mm) * 16) * D + c0 + bj * 128 + n * 16);
#pragma unroll
            for (int mm = 0; mm < 2; ++mm)
#pragma unroll
                for (int bj = 0; bj < 2; ++bj)
#pragma unroll
                    for (int n = 0; n < 2; ++n)
                        *(f32x4*)(out + (row0 + (am >> 1) * 128 + ((am & 1) * 2 + mm) * 16) * D + c0 + bj * 128 + n * 16) = xv[mm][bj][n] + gv[bj][n] * acc[am >> 1][bj][(am & 1) * 2 + mm][n];
        }
    }
};
constexpr float QSCALE = 0.08838834764831845f * 1.4426950408889634f;
__device__ void phase_fix(const Params& p, int l, float* lds) {
    {
        __half* tl = (__half*)lds;
        const int tid = tidx();
        for (int tile = blockIdx.x; tile < T / 64; tile += gridDim.x) {
            const int t0 = tile * 64, b = t0 / S, s0 = t0 % S;
            __syncthreads();
            for (int i = tid; i < 64 * 64; i += 512) { const int tt = i >> 6, e2 = (i & 63) * 2; *(h2*)(tl + tt * 130 + e2) = *(const h2*)(p.atv16 + (size_t)(t0 + tt) * 128 + e2); }
            __syncthreads();
#pragma unroll
            for (int rep = 0; rep < 2; ++rep) {
                const int ch = tid + 512 * rep;
                const int ln = ch & 63, s2 = (ch >> 6) & 1, et = (ch >> 7) & 3, ktl = ch >> 9, colv = ln & 31, hf = ln >> 5;
                h8 v;
#pragma unroll
                for (int j = 0; j < 8; ++j) v[j] = __builtin_bit_cast(_Float16, tl[(ktl * 32 + 16 * s2 + 8 * (j >> 2) + 4 * hf + (j & 3)) * 130 + 32 * et + colv]);
                *(h8*)(p.vf16 + ((((size_t)(b * 64 + (s0 >> 5) + ktl) * 4 + et) * 2 + s2) * 64 + ln) * 8) = v;
            }
        }
        __syncthreads();
    }
    const int w = tidx() >> 6, lane = tidx() & 63;
    __half* wl = (__half*)lds + w * 192;
    for (int t = blockIdx.x * 8 + w; t < T; t += gridDim.x * 8) {
        const int b = t / S, s = t % S, kt = s >> 5, colk = s & 31;
        const float cA = p.ropeA[((size_t)t * 64 + lane) * 2], sA = p.ropeA[((size_t)t * 64 + lane) * 2 + 1];
        for (int hh = 0; hh < 5; ++hh) {
            __half* q = hh < 4 ? p.atq16 + (size_t)t * W + hh * 128 : p.atk16 + (size_t)t * 128;
            const float* g = hh < 4 ? p.qn_g + l * 128 : p.kn_g + l * 128;
            const float x1 = __half2float(q[lane]), x2 = __half2float(q[64 + lane]);
            const float ss = wave_sum(x1 * x1 + x2 * x2);
            const float r = rsqrtf(ss * (1.f / 128.f) + EPS) * (hh < 4 ? QSCALE : 1.f);
            const float a = x1 * r * g[lane], b2 = x2 * r * g[64 + lane];
            const __half o1 = __float2half(a * cA - b2 * sA), o2 = __float2half(b2 * cA + a * sA);
            if (hh < 4) { q[lane] = o1; q[64 + lane] = o2; } else { wl[lane] = o1; wl[64 + lane] = o2; }
        }
        if (lane < 32) {
            const __half* q = p.ixk16 + (size_t)t * 64;
            const float cI = p.ropeI[((size_t)t * 32 + lane) * 2], sI = p.ropeI[((size_t)t * 32 + lane) * 2 + 1];
            const float x1 = __half2float(q[lane]), x2 = __half2float(q[32 + lane]);
            wl[128 + lane] = __float2half(x1 * cI - x2 * sI); wl[160 + lane] = __float2half(x2 * cI + x1 * sI);
        }
        for (int i = 0; i < 4; ++i) {
            const int idx = lane + 64 * i, hh = idx >> 5, j = idx & 31;
            __half* q = p.ixq16 + (size_t)t * W + hh * 64;
            const float cI = p.ropeI[((size_t)t * 32 + j) * 2], sI = p.ropeI[((size_t)t * 32 + j) * 2 + 1];
            const float x1 = __half2float(q[j]), x2 = __half2float(q[32 + j]);
            q[j] = __float2half(x1 * cI - x2 * sI); q[32 + j] = __float2half(x2 * cI + x1 * sI);
        }
        lds_fence();
        if (lane < 16) {
            const h8 v = *(const h8*)(wl + lane * 8);
            *(h8*)(p.kf16 + ((((size_t)(b * 64 + kt) * 8 + (lane >> 1)) * 64) + (lane & 1) * 32 + colk) * 8) = v;
        } else if (lane < 24) {
            const int c2 = lane - 16;
            const h8 v = *(const h8*)(wl + 128 + c2 * 8);
            *(h8*)(p.ikf16 + ((((size_t)(b * 64 + kt) * 4 + (c2 >> 1)) * 64) + (c2 & 1) * 32 + colk) * 8) = v;
        }
        lds_fence();
    }
}

__device__ __forceinline__ unsigned f2key(float f) { const unsigned u = __float_as_uint(f); return (u & 0x80000000u) ? ~u : (u | 0x80000000u); }
typedef float f32x16 __attribute__((ext_vector_type(16)));
typedef _Float16 h4 __attribute__((ext_vector_type(4)));
__device__ void dsa_select(const Params& p, int b, int q0, float* lds) {
    const int tid = tidx(), w = tid >> 6, lane = tid & 63, half = lane >> 5, col = lane & 31;
    float* sc = lds;
    {
        const int wq = w & 3, par = w >> 2;
        const int blk = col >> 2, wi = col & 3, ql = 2 * (blk & 1) + (blk >> 2), head = 4 * ((blk >> 1) & 1) + wi;
        const __half* qrow = p.ixq16 + (size_t)(b * S + q0 + wq * 4 + ql) * W + head * 64 + 8 * half;
        h8 af[4];
#pragma unroll
        for (int ks = 0; ks < 4; ++ks) af[ks] = *(const h8*)(qrow + 16 * ks);
        const int qa = wq * 4 + 2 * half;
        float iw0[8], iw1[8];
#pragma unroll
        for (int hh = 0; hh < 8; ++hh) { iw0[hh] = p.ixw32[(size_t)(b * S + q0 + qa) * 8 + hh]; iw1[hh] = p.ixw32[(size_t)(b * S + q0 + qa + 1) * 8 + hh]; }
        const int ntiles = (q0 + 15) / 32 + 1;
        const __half* ikb = p.ikf16 + (size_t)b * 64 * 4 * 512 + lane * 8;
        h8 bc[4];
        if (par < ntiles) {
#pragma unroll
            for (int ks = 0; ks < 4; ++ks) bc[ks] = *(const h8*)(ikb + ((size_t)par * 4 + ks) * 512);
        }
        for (int kt = par; kt < ntiles; kt += 2) {
            const int key = kt * 32 + col;
            const int ktn = kt + 2 < ntiles ? kt + 2 : kt;
            h8 bn[4];
#pragma unroll
            for (int ks = 0; ks < 4; ++ks) bn[ks] = *(const h8*)(ikb + ((size_t)ktn * 4 + ks) * 512);
            f32x16 acc;
#pragma unroll
            for (int r = 0; r < 16; ++r) acc[r] = 0.f;
#pragma unroll
            for (int ks = 0; ks < 4; ++ks) acc = __builtin_amdgcn_mfma_f32_32x32x16_f16(af[ks], bc[ks], acc, 0, 0, 0);
            float s0 = 0.f, s1 = 0.f;
#pragma unroll
            for (int r = 0; r < 8; ++r) { s0 += fmaxf(acc[r], 0.f) * iw0[r]; s1 += fmaxf(acc[8 + r], 0.f) * iw1[r]; }
            sc[qa * 2048 + key] = key <= q0 + qa ? s0 : -INFINITY;
            sc[(qa + 1) * 2048 + key] = key <= q0 + qa + 1 ? s1 : -INFINITY;
#pragma unroll
            for (int ks = 0; ks < 4; ++ks) bc[ks] = bn[ks];
        }
        for (int i = ntiles * 32 + tid; i < 2048; i += 512) {
#pragma unroll
            for (int q = 0; q < 16; ++q) sc[q * 2048 + i] = -INFINITY;
        }
    }
    __syncthreads();
    for (int qq = 0; qq < 2; ++qq) {
        const int ql = 2 * w + qq, qi = q0 + ql;
        const float* scl = sc + ql * 2048;
        const bool all = qi + 1 <= 256;
        unsigned key[32];
#pragma unroll
        for (int i = 0; i < 32; ++i) key[i] = f2key(scl[lane + 64 * i]);
        unsigned tge = 0x00800000u;
        int rrem = 0; bool split = false;
        if (!all) {
            unsigned prefix = 0; bool exact = false;
#pragma unroll 1
            for (int bit = 31; bit >= 0; --bit) {
                const unsigned cand = prefix | (1u << bit);
                int c = 0, cl = 0;
#pragma unroll
                for (int i = 0; i < 12; ++i) c += __popcll(__ballot(key[i] >= cand));
#pragma unroll
                for (int i = 12; i < 32; ++i) cl += (key[i] >= cand) ? 1 : 0;
#pragma unroll
                for (int bb = 0; bb < 5; ++bb) c += __popcll(__ballot((cl >> bb) & 1)) << bb;
                if (c >= 256) prefix = cand;
                if (c == 256) { exact = true; break; }
            }
            tge = prefix;
            if (!exact) {
                int cge = 0, cgt = 0;
#pragma unroll
                for (int i = 0; i < 32; ++i) { cge += __popcll(__ballot(key[i] >= prefix)); cgt += __popcll(__ballot(key[i] > prefix)); }
                if (cge > 256) { split = true; tge = prefix + 1u; rrem = 256 - cgt; }
            }
        }
        const unsigned long long lt = (1ull << lane) - 1ull;
        unsigned mylo = 0, myhi = 0;
        if (!split) {
#pragma unroll
            for (int i = 0; i < 32; ++i) {
                const unsigned long long m2 = __ballot(key[i] >= tge);
                if (lane == i) { mylo = (unsigned)m2; myhi = (unsigned)(m2 >> 32); }
            }
        } else {
#pragma unroll 1
            for (int i = 0; i < 32; ++i) {
                const unsigned k = f2key(scl[lane + 64 * i]);
                const bool eq = k == tge - 1u;
                const unsigned long long m = __ballot(eq);
                const bool sl = (k >= tge) || (eq && __popcll(m & lt) < rrem);
                rrem -= __popcll(m); if (rrem < 0) rrem = 0;
                const unsigned long long m2 = __ballot(sl);
                if (lane == i) { mylo = (unsigned)m2; myhi = (unsigned)(m2 >> 32); }
            }
        }
        if (lane < 32) *(uint2*)(p.mask + (size_t)(b * S + qi) * 64 + 2 * lane) = make_uint2(mylo, myhi);
    }
    __syncthreads();
}

__device__ void dsa_attend(const Params& p, int b, int g) {
    const int lane = tidx() & 63, half = lane >> 5, col = lane & 31;
    const int q0 = 8 * g, qi = q0 + (col >> 2), hd = col & 3;
    const __half* qp = p.atq16 + (size_t)(b * S + qi) * W + hd * 128 + 8 * half;
    h8 qf[8];
#pragma unroll
    for (int ks = 0; ks < 8; ++ks) qf[ks] = *(const h8*)(qp + 16 * ks);
    f32x16 o[4];
#pragma unroll
    for (int et = 0; et < 4; ++et)
#pragma unroll
        for (int r = 0; r < 16; ++r) o[et][r] = 0.f;
    float m = -INFINITY, l = 0.f;
    const int ntiles = (q0 + 7) / 32 + 1;
    const unsigned* mrow = p.mask + (size_t)(b * S + qi) * 64;
    const __half* kfb = p.kf16 + (size_t)b * 64 * 8 * 512 + lane * 8;
    const __half* vfb = p.vf16 + (size_t)b * 64 * 8 * 512 + lane * 8;
    h8 kA[8], kB[8];
#pragma unroll
    for (int ks = 0; ks < 8; ++ks) kA[ks] = *(const h8*)(kfb + (size_t)ks * 512);
#define DSA_TILE(kcur, knext, KT) do { \
        const int _kt = (KT), _ktn = _kt + 1 < ntiles ? _kt + 1 : _kt; \
        _Pragma("unroll") for (int ks = 0; ks < 8; ++ks) knext[ks] = *(const h8*)(kfb + ((size_t)_ktn * 8 + ks) * 512); \
        const unsigned mws = mrow[_kt] >> (4 * half); \
        f32x16 s; \
        _Pragma("unroll") for (int r = 0; r < 16; ++r) s[r] = 0.f; \
        _Pragma("unroll") for (int ks = 0; ks < 8; ++ks) s = __builtin_amdgcn_mfma_f32_32x32x16_f16(kcur[ks], qf[ks], s, 0, 0, 0); \
        h8 vf[8]; \
        _Pragma("unroll") for (int i = 0; i < 8; ++i) vf[i] = *(const h8*)(vfb + ((size_t)_kt * 8 + i) * 512); \
        float tmax = -INFINITY; \
        _Pragma("unroll") for (int r = 0; r < 16; ++r) { s[r] = (mws & (1u << ((r & 3) + 8 * (r >> 2)))) ? s[r] : -INFINITY; tmax = fmaxf(tmax, s[r]); } \
        tmax = fmaxf(tmax, __shfl_xor(tmax, 32)); \
        if (__any(tmax > m + 11.5f)) {          \
            const float mn = fmaxf(m, tmax), msf = mn == -INFINITY ? 0.f : mn; \
            const float cs = __builtin_amdgcn_exp2f(m - msf); \
            l *= cs; m = mn; \
            _Pragma("unroll") for (int et = 0; et < 4; ++et) _Pragma("unroll") for (int r = 0; r < 16; ++r) o[et][r] *= cs; \
        } \
        const float ms2 = m == -INFINITY ? 0.f : m; \
        float ps = 0.f; \
        _Pragma("unroll") for (int r = 0; r < 16; ++r) { s[r] = __builtin_amdgcn_exp2f(s[r] - ms2); ps += s[r]; } \
        l += ps; \
        h8 pb[2]; \
        _Pragma("unroll") for (int s2 = 0; s2 < 2; ++s2) _Pragma("unroll") for (int j = 0; j < 8; ++j) pb[s2][j] = (_Float16)s[8 * s2 + j]; \
        _Pragma("unroll") for (int et = 0; et < 4; ++et) _Pragma("unroll") for (int s2 = 0; s2 < 2; ++s2) \
            o[et] = __builtin_amdgcn_mfma_f32_32x32x16_f16(vf[et * 2 + s2], pb[s2], o[et], 0, 0, 0); \
    } while (0)
    int kt = 0;
#pragma unroll 1
    for (; kt + 1 < ntiles; kt += 2) { DSA_TILE(kA, kB, kt); DSA_TILE(kB, kA, kt + 1); }
    if (kt < ntiles) DSA_TILE(kA, kB, kt);
#undef DSA_TILE
    l += __shfl_xor(l, 32);
    const float inv = 1.f / l;
    __half* yb = p.ys + (size_t)T * W + (size_t)(b * S + qi) * W + hd * 128;
    const __half* gp = p.atg16 + (size_t)(b * S + qi) * W + hd * 128;
#pragma unroll
    for (int et = 0; et < 4; ++et)
#pragma unroll
        for (int r4 = 0; r4 < 4; ++r4) {
            const int e0 = 32 * et + 8 * r4 + 4 * half;
            const h4 gv = *(const h4*)(gp + e0);
            h4 ov;
#pragma unroll
            for (int j = 0; j < 4; ++j) ov[j] = (_Float16)(o[et][4 * r4 + j] * inv * (float)gv[j]);
            *(h4*)(yb + e0) = ov;
        }
}

__device__ __forceinline__ void dsa_attend_block(const Params& p, int b, int jq, float* lds) {
    const int tid = tidx(), w = tid >> 6, lane = tid & 63, half = lane >> 5, col = lane & 31;
    const int grp = w & 3, hf = w >> 2, th = tid & 255;
    const int q0 = 32 * jq + 8 * grp, qi = q0 + (col >> 2), hd = col & 3;
    const int Tt = jq + 1, Th = (Tt + 1) >> 1;
    const int t0 = hf ? Th : 0, nt = hf ? Tt - Th : Th;
    __half* stg = (__half*)lds;
    const __half* qp = p.atq16 + (size_t)(b * S + qi) * W + hd * 128 + 8 * half;
    h8 qf[8];
#pragma unroll
    for (int ks = 0; ks < 8; ++ks) qf[ks] = *(const h8*)(qp + 16 * ks);
    f32x16 o[4];
#pragma unroll
    for (int et = 0; et < 4; ++et)
#pragma unroll
        for (int r = 0; r < 16; ++r) o[et][r] = 0.f;
    float m = -INFINITY, l = 0.f;
    const unsigned* mrow = p.mask + (size_t)(b * S + qi) * 64;
    const __half* kfb = p.kf16 + (size_t)b * 64 * 4096;
    const __half* vfb = p.vf16 + (size_t)b * 64 * 4096;
    h8 sr[4];
    __syncthreads();
    if (nt > 0) {
        sr[0] = *(const h8*)(kfb + (size_t)t0 * 4096 + th * 8); sr[1] = *(const h8*)(kfb + (size_t)t0 * 4096 + (th + 256) * 8);
        sr[2] = *(const h8*)(vfb + (size_t)t0 * 4096 + th * 8); sr[3] = *(const h8*)(vfb + (size_t)t0 * 4096 + (th + 256) * 8);
        __half* d = stg + (size_t)hf * 8192;
        *(h8*)(d + th * 8) = sr[0]; *(h8*)(d + (th + 256) * 8) = sr[1]; *(h8*)(d + 4096 + th * 8) = sr[2]; *(h8*)(d + 4096 + (th + 256) * 8) = sr[3];
    }
    unsigned mw = nt > 0 ? mrow[t0] : 0u;
    __syncthreads();
#pragma unroll 1
    for (int r = 0; r < Th; ++r) {
        const bool act = r < nt, nxt = r + 1 < nt;
        unsigned mwn = 0u;
        if (nxt) {
            const size_t tn = (size_t)(t0 + r + 1) * 4096;
            sr[0] = *(const h8*)(kfb + tn + th * 8); sr[1] = *(const h8*)(kfb + tn + (th + 256) * 8);
            sr[2] = *(const h8*)(vfb + tn + th * 8); sr[3] = *(const h8*)(vfb + tn + (th + 256) * 8);
            mwn = mrow[t0 + r + 1];
        }
        if (act) {
            const __half* st = stg + (size_t)((r & 1) * 2 + hf) * 8192 + lane * 8;
            const unsigned mws = mw >> (4 * half);
            f32x16 s;
#pragma unroll
            for (int i = 0; i < 16; ++i) s[i] = 0.f;
            h8 kf[8];
#pragma unroll
            for (int ks = 0; ks < 8; ++ks) kf[ks] = *(const h8*)(st + ks * 512);
#pragma unroll
            for (int ks = 0; ks < 8; ++ks) s = __builtin_amdgcn_mfma_f32_32x32x16_f16(kf[ks], qf[ks], s, 0, 0, 0);
            h8 vf[8];
#pragma unroll
            for (int i = 0; i < 8; ++i) vf[i] = *(const h8*)(st + 4096 + i * 512);
            float tmax = -INFINITY;
#pragma unroll
            for (int i = 0; i < 16; ++i) { s[i] = (mws & (1u << ((i & 3) + 8 * (i >> 2)))) ? s[i] : -INFINITY; tmax = fmaxf(tmax, s[i]); }
            { const auto sw = __builtin_amdgcn_permlane32_swap(__float_as_uint(tmax), __float_as_uint(tmax), false, false); tmax = fmaxf(__uint_as_float(sw[0]), __uint_as_float(sw[1])); }
            if (__any(tmax > m + 11.5f)) {
                const float mn = fmaxf(m, tmax), msf = mn == -INFINITY ? 0.f : mn;
                const float cs = __builtin_amdgcn_exp2f(m - msf);
                l *= cs; m = mn;
#pragma unroll
                for (int et = 0; et < 4; ++et)
#pragma unroll
                    for (int i = 0; i < 16; ++i) o[et][i] *= cs;
            }
            const float ms2 = m == -INFINITY ? 0.f : m;
            float ps = 0.f;
#pragma unroll
            for (int i = 0; i < 16; ++i) { s[i] = __builtin_amdgcn_exp2f(s[i] - ms2); ps += s[i]; }
            l += ps;
            h8 pb[2];
#pragma unroll
            for (int s2 = 0; s2 < 2; ++s2)
#pragma unroll
                for (int j = 0; j < 8; ++j) pb[s2][j] = (_Float16)s[8 * s2 + j];
#pragma unroll
            for (int et = 0; et < 4; ++et)
#pragma unroll
                for (int s2 = 0; s2 < 2; ++s2) o[et] = __builtin_amdgcn_mfma_f32_32x32x16_f16(vf[et * 2 + s2], pb[s2], o[et], 0, 0, 0);
        }
        if (nxt) {
            __half* d = stg + (size_t)(((r + 1) & 1) * 2 + hf) * 8192;
            *(h8*)(d + th * 8) = sr[0]; *(h8*)(d + (th + 256) * 8) = sr[1]; *(h8*)(d + 4096 + th * 8) = sr[2]; *(h8*)(d + 4096 + (th + 256) * 8) = sr[3];
        }
        mw = mwn;
        __syncthreads();
    }
    l += __shfl_xor(l, 32);
    float* mg = lds;
    if (hf == 1) {
        float* d = mg + (size_t)grp * 66 * 64 + lane;
#pragma unroll
        for (int et = 0; et < 4; ++et)
#pragma unroll
            for (int i = 0; i < 16; ++i) d[(et * 16 + i) * 64] = o[et][i];
        d[64 * 64] = m; d[65 * 64] = l;
    }
    __syncthreads();
    if (hf == 0) {
        const float* d = mg + (size_t)grp * 66 * 64 + lane;
        const float m2 = d[64 * 64], l2 = d[65 * 64];
        const float mn = fmaxf(m, m2), msf = mn == -INFINITY ? 0.f : mn;
        const float a1 = __builtin_amdgcn_exp2f(m - msf), a2 = __builtin_amdgcn_exp2f(m2 - msf);
        const float inv = 1.f / (l * a1 + l2 * a2);
        __half* yb = p.ys + (size_t)T * W + (size_t)(b * S + qi) * W + hd * 128;
        const __half* gp = p.atg16 + (size_t)(b * S + qi) * W + hd * 128;
#pragma unroll
        for (int et = 0; et < 4; ++et)
#pragma unroll
            for (int r4 = 0; r4 < 4; ++r4) {
                const int e0 = 32 * et + 8 * r4 + 4 * half;
                const h4 gv = *(const h4*)(gp + e0);
                h4 ov;
#pragma unroll
                for (int j = 0; j < 4; ++j) ov[j] = (_Float16)((o[et][4 * r4 + j] * a1 + d[(et * 16 + 4 * r4 + j) * 64] * a2) * inv * (float)gv[j]);
                *(h4*)(yb + e0) = ov;
            }
    }
    __syncthreads();
}

typedef __bf16 bf8 __attribute__((ext_vector_type(8)));
constexpr int HG_QS = 136;
constexpr int HG_VS = 72;
struct HgIn { float lf[16]; h8 q0, q1, v0, v1; };
__device__ __forceinline__ void hg_issue_loads(const Params& p, int tok0, int hd, int tid, bool need_q, HgIn& in) {
    const int d = tid & 127, seg = tid >> 7;
    const size_t base = (size_t)(tok0 + seg * 16) * W + hd * 128 + d;
#pragma unroll
    for (int i = 0; i < 16; ++i) in.lf[i] = p.lf32[base + (size_t)i * W];
#pragma unroll
    for (int i = 0; i < 8; ++i) { in.v0[i] = __builtin_bit_cast(_Float16, p.v16[base + (size_t)i * W]); in.v1[i] = __builtin_bit_cast(_Float16, p.v16[base + (size_t)(8 + i) * W]); }
    if (need_q) {
#pragma unroll
        for (int i = 0; i < 8; ++i) { in.q0[i] = __builtin_bit_cast(_Float16, p.q16[base + (size_t)i * W]); in.q1[i] = __builtin_bit_cast(_Float16, p.q16[base + (size_t)(8 + i) * W]); }
    }
}
__device__ __forceinline__ void hg_cumsum(int tid, float* segt, const float (&lf)[16], float (&bcs)[16], float& blast, float& bref) {
    const int d = tid & 127, seg = tid >> 7;
    float run = 0.f;
#pragma unroll
    for (int i = 0; i < 16; ++i) { run += lf[i]; bcs[i] = run; }
    segt[seg * 128 + d] = run;
    BAR_LDS();
    const float s0 = segt[d], s1 = segt[128 + d], s2 = segt[256 + d], s3 = segt[384 + d];
    const float off = seg == 0 ? 0.f : (seg == 1 ? s0 : (seg == 2 ? s0 + s1 : s0 + s1 + s2));
#pragma unroll
    for (int i = 0; i < 16; ++i) bcs[i] += off;
    blast = s0 + s1 + s2 + s3; bref = s0 + s1;
}
__device__ __forceinline__ void hg_pass1(const Params& p, int u, float* lds, const HgIn& in) {
    const int tid = tidx(), w = tid >> 6, lane = tid & 63, half = lane >> 5, col = lane & 31;
    const int c = u & 31, bh = u >> 5, hd = bh & 3, b = bh >> 2, tok0 = b * S + c * 64;
    __half* KH = (__half*)lds;
    __half* VT = KH + 128 * HG_VS;
    float* segt = (float*)(VT + 128 * HG_VS);
    BAR_LDS();
    float bcs[16], blast, bref;
    hg_cumsum(tid, segt, in.lf, bcs, blast, bref);
    {
        const int d = tid & 127, seg = tid >> 7;
        h8 k0, k1;
#pragma unroll
        for (int i = 0; i < 8; ++i) { k0[i] = (_Float16)((1.f - __expf(in.lf[i])) * __expf(blast - bcs[i])); k1[i] = (_Float16)((1.f - __expf(in.lf[8 + i])) * __expf(blast - bcs[8 + i])); }
        *(h8*)(KH + d * HG_VS + seg * 16) = k0; *(h8*)(KH + d * HG_VS + seg * 16 + 8) = k1;
        if (seg == 0) p.dec32[(size_t)u * 128 + d] = __expf(blast);
        *(h8*)(VT + d * HG_VS + seg * 16) = in.v0; *(h8*)(VT + d * HG_VS + seg * 16 + 8) = in.v1;
    }
    BAR_LDS();
    const int dt = w >> 1;
    h8 af[4];
#pragma unroll
    for (int ks = 0; ks < 4; ++ks) af[ks] = *(const h8*)(KH + (dt * 32 + col) * HG_VS + 16 * ks + 8 * half);
#pragma unroll
    for (int ee = 0; ee < 2; ++ee) {
        const int et = (w & 1) * 2 + ee;
        f32x16 acc;
#pragma unroll
        for (int r = 0; r < 16; ++r) acc[r] = 0.f;
#pragma unroll
        for (int ks = 0; ks < 4; ++ks) acc = __builtin_amdgcn_mfma_f32_32x32x16_f16(af[ks], *(const h8*)(VT + (et * 32 + col) * HG_VS + 16 * ks + 8 * half), acc, 0, 0, 0);
        __half* dst = p.stT16 + ((size_t)u * 128 + et * 32 + col) * 128 + dt * 32 + 4 * half;
#pragma unroll
        for (int r4 = 0; r4 < 4; ++r4) { h4 o = {(_Float16)acc[4 * r4], (_Float16)acc[4 * r4 + 1], (_Float16)acc[4 * r4 + 2], (_Float16)acc[4 * r4 + 3]}; *(h4*)(dst + 8 * r4) = o; }
    }
}
__device__ void hg_scan(const Params& p) {
    const int t = tidx();
    if (t >= 256) return;
    for (int gt = blockIdx.x * 256 + t; gt < 32 * 128 * 16; gt += gridDim.x * 256) {
    const int d8 = (gt & 15) * 8, e = (gt >> 4) & 127, bh = gt >> 11;
    float s[8];
#pragma unroll
    for (int j = 0; j < 8; ++j) s[j] = 0.f;
    for (int c = 0; c < 32; ++c) {
        const size_t u = (size_t)bh * 32 + c;
        h8* ptr = (h8*)(p.stT16 + (u * 128 + e) * 128 + d8);
        const h8 tv = *ptr;
        const f32x4 g0 = *(const f32x4*)(p.dec32 + u * 128 + d8), g1 = *(const f32x4*)(p.dec32 + u * 128 + d8 + 4);
        h8 o;
#pragma unroll
        for (int j = 0; j < 8; ++j) o[j] = (_Float16)s[j];
        *ptr = o;
#pragma unroll
        for (int j = 0; j < 4; ++j) { s[j] = g0[j] * s[j] + (float)tv[j]; s[4 + j] = g1[j] * s[4 + j] + (float)tv[4 + j]; }
    }
    }
}
__device__ __forceinline__ void hg_pass3(const Params& p, int l, int u, float* lds, const HgIn& in) {
    const int tid = tidx(), w = tid >> 6, lane = tid & 63, half = lane >> 5, col = lane & 31;
    const int c = u & 31, bh = u >> 5, hd = bh & 3, b = bh >> 2, tok0 = b * S + c * 64;
    __half* QI = (__half*)lds;
    __bf16* QM = (__bf16*)(QI + 64 * HG_QS);
    __bf16* KM = QM + 64 * HG_QS;
    __half* VT = (__half*)(KM + 64 * HG_QS);
    float* segt = (float*)(VT + 128 * HG_VS);
    float* part = segt + 512;
    const int tt = w & 1, et = w >> 1;
    h8 sf[8];
    {
        const __half* sp = p.stT16 + ((size_t)u * 128 + et * 32 + col) * 128 + 8 * half;
#pragma unroll
        for (int ks = 0; ks < 8; ++ks) sf[ks] = *(const h8*)(sp + 16 * ks);
    }
    const size_t ob = (size_t)(tok0 + tt * 32 + col) * W + hd * 128;
    h4 gv[4];
#pragma unroll
    for (int r4 = 0; r4 < 4; ++r4) gv[r4] = *(const h4*)(p.hgg16 + ob + et * 32 + 8 * r4 + 4 * half);
    BAR_LDS();
    float bcs[16], blast, bref;
    hg_cumsum(tid, segt, in.lf, bcs, blast, bref);
    {
        const int d = tid & 127, seg = tid >> 7;
#pragma unroll
        for (int i = 0; i < 16; ++i) {
            const int tk = seg * 16 + i;
            const float q = (float)(i < 8 ? in.q0[i & 7] : in.q1[i & 7]);
            QI[tk * HG_QS + d] = __float2half(q * __expf(bcs[i]));
            QM[tk * HG_QS + d] = (__bf16)(q * __expf(bcs[i] - bref));
            KM[tk * HG_QS + d] = (__bf16)((1.f - __expf(in.lf[i])) * __expf(bref - bcs[i]));
        }
        *(h8*)(VT + d * HG_VS + seg * 16) = in.v0; *(h8*)(VT + d * HG_VS + seg * 16 + 8) = in.v1;
    }
    BAR_LDS();
    h8 pb[2][2];
    bf8 qm[8];
#pragma unroll
    for (int ks = 0; ks < 8; ++ks) qm[ks] = *(const bf8*)(QM + (tt * 32 + col) * HG_QS + 16 * ks + 8 * half);
#pragma unroll
    for (int st = 0; st < 2; ++st) {
        if (st <= tt) {
            f32x16 sacc;
#pragma unroll
            for (int r = 0; r < 16; ++r) sacc[r] = 0.f;
#pragma unroll
            for (int ks = 0; ks < 8; ++ks) sacc = __builtin_amdgcn_mfma_f32_32x32x16_bf16(*(const bf8*)(KM + (st * 32 + col) * HG_QS + 16 * ks + 8 * half), qm[ks], sacc, 0, 0, 0);
#pragma unroll
            for (int r = 0; r < 16; ++r) {
                const int sl = (r & 3) + 8 * (r >> 2) + 4 * half;
                const float v = (st < tt || sl <= col) ? sacc[r] : 0.f;
                pb[st][r >> 3][r & 7] = (_Float16)v;
            }
        } else {
#pragma unroll
            for (int j = 0; j < 8; ++j) { pb[st][0][j] = (_Float16)0.f; pb[st][1][j] = (_Float16)0.f; }
        }
    }
    f32x16 o;
#pragma unroll
    for (int r = 0; r < 16; ++r) o[r] = 0.f;
#pragma unroll
    for (int st = 0; st < 2; ++st) {
        if (st <= tt) {
#pragma unroll
            for (int s2 = 0; s2 < 2; ++s2) {
                const __half* vp = VT + (et * 32 + col) * HG_VS + st * 32 + 16 * s2 + 4 * half;
                const h4 v0 = *(const h4*)vp, v1 = *(const h4*)(vp + 8);
                const h8 vf = {v0[0], v0[1], v0[2], v0[3], v1[0], v1[1], v1[2], v1[3]};
                o = __builtin_amdgcn_mfma_f32_32x32x16_f16(vf, pb[st][s2], o, 0, 0, 0);
            }
        }
    }
    {
#pragma unroll
        for (int ks = 0; ks < 8; ++ks) o = __builtin_amdgcn_mfma_f32_32x32x16_f16(sf[ks], *(const h8*)(QI + (tt * 32 + col) * HG_QS + 16 * ks + 8 * half), o, 0, 0, 0);
    }
    float ss = 0.f;
#pragma unroll
    for (int r = 0; r < 16; ++r) ss += o[r] * o[r];
    ss += __shfl_xor(ss, 32);
    if (half == 0) part[et * 64 + tt * 32 + col] = ss;
    BAR_LDS();
    const int tk = tt * 32 + col;
    const float tot = part[tk] + part[64 + tk] + part[128 + tk] + part[192 + tk];
    const float rs = rsqrtf(tot * (1.f / 128.f) + EPS);
    const float* on = p.onorm_g + l * 128;
#pragma unroll
    for (int r4 = 0; r4 < 4; ++r4) {
        const int e0 = et * 32 + 8 * r4 + 4 * half;
        const f32x4 nv = *(const f32x4*)(on + e0);
        h4 ov;
#pragma unroll
        for (int j = 0; j < 4; ++j) ov[j] = (_Float16)(o[4 * r4 + j] * rs * nv[j] * (float)gv[r4][j]);
        *(h4*)(p.ys + ob + e0) = ov;
    }
}

constexpr int S5_UP = 1032;
__device__ void s5_pow_table(const Params& p) {
    const size_t gtid = (size_t)blockIdx.x * 512 + tidx(), nth = (size_t)gridDim.x * 512;
    for (size_t i = gtid; i < (size_t)NL * 32 * 64 * 65; i += nth) {
        const int tau = (int)(i % 65); const size_t lgp = i / 65; const int lg = (int)(lgp / 64);
        const double dt = exp((double)p.log_dt[lg]);
        const double are = p.a_re[lgp], aim = p.a_im[lgp];
        const double mag = exp(are * dt * tau), ang = aim * dt * tau;
        p.pw[i * 2] = (float)(mag * cos(ang)); p.pw[i * 2 + 1] = (float)(mag * sin(ang));
    }
    for (size_t i = gtid; i < (size_t)NL * 32; i += nth) {
        const float sgv = exp2f(rintf(-p.log_dt[i] * 1.4426950408889634f));
        p.sg[i * 2] = sgv; p.sg[i * 2 + 1] = 1.f / sgv;
    }
}
__device__ void s5_build_tables(const Params& p, int l, float* lds) {
    const size_t gtid = (size_t)blockIdx.x * 512 + tidx(), nth = (size_t)gridDim.x * 512;
    {
        float* Cr = lds; float* Ci = Cr + 16 * 65; float* Br = Ci + 16 * 65; float* Bi = Br + 64 * 17; float* Wr = Bi + 64 * 17; float* Wi = Wr + 16 * 64;
        const int tid = tidx();
        for (int item = blockIdx.x; item < 128; item += gridDim.x) {
            const int g = item >> 2, lq = item & 3; const size_t lg = (size_t)l * 32 + g;
            __syncthreads();
            for (int i = tid; i < 1024; i += 512) {
                const int c = i >> 6, s = i & 63; Cr[c * 65 + s] = p.c_re[(lg * 16 + c) * 64 + s]; Ci[c * 65 + s] = p.c_im[(lg * 16 + c) * 64 + s];
                const int s2 = i >> 4, cp = i & 15; Br[s2 * 17 + cp] = p.bbar[((lg * 64 + s2) * 16 + cp) * 2]; Bi[s2 * 17 + cp] = p.bbar[((lg * 64 + s2) * 16 + cp) * 2 + 1];
                const int ll = i >> 6; Wr[ll * 64 + s] = p.pw[((lg * 64 + s) * 65 + lq * 16 + ll) * 2]; Wi[ll * 64 + s] = p.pw[((lg * 64 + s) * 65 + lq * 16 + ll) * 2 + 1];
            }
            __syncthreads();
            const float sgv = p.sg[lg * 2];
#pragma unroll 1
            for (int k = 0; k < 8; ++k) {
                const int o = tid + 512 * k, cp = o & 15, c = (o >> 4) & 15, ll = o >> 8;
                float acc = 0.f;
#pragma unroll 8
                for (int s = 0; s < 64; ++s) {
                    const float cr = Cr[c * 65 + s], ci = Ci[c * 65 + s], wr = Wr[ll * 64 + s], wi = Wi[ll * 64 + s];
                    acc += (cr * wr - ci * wi) * Br[s * 17 + cp] - (cr * wi + ci * wr) * Bi[s * 17 + cp];
                }
                p.kmat16[(((size_t)g * 64 + lq * 16 + ll) * 16 + c) * 16 + cp] = __float2half(acc * sgv);
            }
        }
        __syncthreads();
    }
    for (size_t i8 = gtid; i8 < (size_t)32 * 128 * 1024 / 8; i8 += nth) {
        const size_t i = i8 * 8;
        const int cp0 = (int)(i & 15), sig = (int)((i >> 4) & 63), n = (int)((i >> 10) & 127), g = (int)(i >> 17);
        const size_t lg = (size_t)l * 32 + g; const int s = n & 63;
        const float wr = p.pw[((lg * 64 + s) * 65 + 63 - sig) * 2], wi = p.pw[((lg * 64 + s) * 65 + 63 - sig) * 2 + 1], sgv = p.sg[lg * 2];
        const float* bb = p.bbar + ((lg * 64 + s) * 16 + cp0) * 2;
        h8 o;
#pragma unroll
        for (int j = 0; j < 8; ++j) { const float br = bb[2 * j], bi = bb[2 * j + 1]; o[j] = (_Float16)((n < 64 ? wr * br - wi * bi : wr * bi + wi * br) * sgv); }
        *(h8*)(p.hs16 + i) = o;
    }
    for (size_t i8 = gtid; i8 < (size_t)32 * 1024 * 128 / 8; i8 += nth) {
        const size_t i = i8 * 8;
        const int n0 = (int)(i & 127), c = (int)((i >> 7) & 15), tau = (int)((i >> 11) & 63), g = (int)(i >> 17);
        const size_t lg = (size_t)l * 32 + g; const int s0 = n0 & 63;
        h8 o;
#pragma unroll
        for (int j = 0; j < 8; ++j) {
            const int s = s0 + j;
            const float cr = p.c_re[(lg * 16 + c) * 64 + s], ci = p.c_im[(lg * 16 + c) * 64 + s];
            const float wr = p.pw[((lg * 64 + s) * 65 + tau + 1) * 2], wi = p.pw[((lg * 64 + s) * 65 + tau + 1) * 2 + 1];
            o[j] = (_Float16)(n0 < 64 ? cr * wr - ci * wi : -(cr * wi + ci * wr));
        }
        *(h8*)(p.gs16 + i) = o;
    }
}
__device__ __forceinline__ void s5_load_u(const Params& p, int g, int b, int tid, __half* U) {
#pragma unroll
    for (int i = 0; i < 4; ++i) {
        const int idx = tid + 512 * i, ch = idx >> 6, sig = idx & 63;
        const h8* src = (const h8*)(p.s5u16 + (size_t)(b * S + ch * 64 + sig) * W + g * 16);
        const h8 a = src[0], c2 = src[1];
        *(h8*)(U + ch * S5_UP + sig * 16) = a; *(h8*)(U + ch * S5_UP + sig * 16 + 8) = c2;
    }
}
__device__ void s5_pass1(const Params& p, int g, int b, float* lds) {
    const int tid = tidx(), w = tid >> 6, lane = tid & 63, half = lane >> 5, col = lane & 31;
    __half* U = (__half*)lds;
    float* part = (float*)(U + 32 * S5_UP);
    __syncthreads();
    s5_load_u(p, g, b, tid, U);
    __syncthreads();
    const int nt = w & 3, sh = w >> 2;
    const __half* hp = p.hs16 + ((size_t)g * 128 + nt * 32 + col) * 1024 + 8 * half;
    const __half* up = U + col * S5_UP + 8 * half;
    f32x16 acc;
#pragma unroll
    for (int r = 0; r < 16; ++r) acc[r] = 0.f;
#pragma unroll 8
    for (int sig = sh * 32; sig < sh * 32 + 32; ++sig) acc = __builtin_amdgcn_mfma_f32_32x32x16_f16(*(const h8*)(hp + sig * 16), *(const h8*)(up + sig * 16), acc, 0, 0, 0);
    if (sh == 1) {
#pragma unroll
        for (int r = 0; r < 16; ++r) part[(nt * 16 + r) * 64 + lane] = acc[r];
    }
    __syncthreads();
    if (sh == 0) {
        float* ep = p.e32 + (((size_t)g * 8 + b) * 32 + col) * 128 + nt * 32 + 4 * half;
#pragma unroll
        for (int r4 = 0; r4 < 4; ++r4) {
            f32x4 o;
#pragma unroll
            for (int j = 0; j < 4; ++j) o[j] = acc[4 * r4 + j] + part[(nt * 16 + 4 * r4 + j) * 64 + lane];
            *(f32x4*)(ep + 8 * r4) = o;
        }
    }
}
__device__ void s5_scan(const Params& p, int l) {
    const int t = tidx();
    if (t < 256 || t >= 320) return;
    for (int gt = blockIdx.x * 64 + (t - 256); gt < 32 * 8 * 64; gt += gridDim.x * 64) {
    const int s = gt & 63, b = (gt >> 6) & 7, g = gt >> 9;
    const size_t lg = (size_t)l * 32 + g;
    const float ar = p.pw[((lg * 64 + s) * 65 + 64) * 2], ai = p.pw[((lg * 64 + s) * 65 + 64) * 2 + 1];
    float xr = 0.f, xi = 0.f;
    for (int c = 0; c < 32; ++c) {
        const size_t base = (((size_t)g * 8 + b) * 32 + c) * 128;
        p.x16[base + s] = __float2half(xr); p.x16[base + 64 + s] = __float2half(xi);
        const float er = p.e32[base + s], ei = p.e32[base + 64 + s];
        const float nr = ar * xr - ai * xi + er, ni = ar * xi + ai * xr + ei;
        xr = nr; xi = ni;
    }
    }
}
__device__ void s5_pass3(const Params& p, int l, int g, int b, float* lds) {
    const int tid = tidx(), w = tid >> 6, lane = tid & 63, half = lane >> 5, col = lane & 31;
    __half* U = (__half*)lds;
    __half* KM = U + 32 * S5_UP;
    __syncthreads();
    s5_load_u(p, g, b, tid, U);
    for (int i = tid; i < 64 * 256 / 8; i += 512) *(h8*)(KM + i * 8) = *(const h8*)(p.kmat16 + (size_t)g * 64 * 256 + i * 8);
    __syncthreads();
    h8 xb[8];
    {
        const __half* xp = p.x16 + (((size_t)g * 8 + b) * 32 + col) * 128 + 8 * half;
#pragma unroll
        for (int ks = 0; ks < 8; ++ks) xb[ks] = *(const h8*)(xp + 16 * ks);
    }
    const float isg = p.sg[((size_t)l * 32 + g) * 2 + 1];
    const __half* up = U + col * S5_UP + 8 * half;
    const int cch = col & 15, tl = col >> 4;
#pragma unroll 1
    for (int rt = w; rt < 32; rt += 8) {
        f32x16 acc;
#pragma unroll
        for (int r = 0; r < 16; ++r) acc[r] = 0.f;
        const int tau = 2 * rt + tl;
#pragma unroll 2
        for (int sig = 0; sig <= 2 * rt + 1; ++sig) {
            const int lag = tau - sig;
            h8 a;
            if (lag >= 0) a = *(const h8*)(KM + (lag * 16 + cch) * 16 + 8 * half);
            else {
#pragma unroll
                for (int j = 0; j < 8; ++j) a[j] = (_Float16)0.f;
            }
            acc = __builtin_amdgcn_mfma_f32_32x32x16_f16(a, *(const h8*)(up + sig * 16), acc, 0, 0, 0);
        }
        const __half* gp = p.gs16 + ((size_t)g * 1024 + 2 * rt * 16 + col) * 128 + 8 * half;
#pragma unroll
        for (int ks = 0; ks < 8; ++ks) acc = __builtin_amdgcn_mfma_f32_32x32x16_f16(*(const h8*)(gp + 16 * ks), xb[ks], acc, 0, 0, 0);
#pragma unroll
        for (int r4 = 0; r4 < 4; ++r4) {
            const int tloc = r4 >> 1, c0 = 8 * (r4 & 1) + 4 * half;
            const int tk = 2 * rt + tloc;
            const h4 uv = *(const h4*)(U + col * S5_UP + tk * 16 + c0);
            const f32x4 dv = *(const f32x4*)(p.s5_d + l * W + g * 16 + c0);
            h4 ov;
#pragma unroll
            for (int j = 0; j < 4; ++j) ov[j] = (_Float16)gelu_tanh_f(acc[4 * r4 + j] * isg + dv[j] * (float)uv[j]);
            *(h4*)(p.ypre16 + (size_t)(b * S + col * 64 + tk) * W + g * 16 + c0) = ov;
        }
    }
}

__device__ void phase_mix1(const Params& p, int l, float* lds) {
    const int c = blockIdx.x, G = gridDim.x;
    phase_fix(p, l, lds);
    for (int u = c; u < 256; u += G) s5_pass1(p, u >> 3, u & 7, lds);
#pragma unroll 1
    for (int u = c; u < 1024; u += G) {
        HgIn cur; const int bh = u >> 5;
        hg_issue_loads(p, (bh >> 2) * S + (u & 31) * 64, bh & 3, tidx(), false, cur);
        hg_pass1(p, u, lds, cur);
    }
    __syncthreads();
}
__device__ void phase_mix2(const Params& p, int l, float* lds) {
    const int c = blockIdx.x, G = gridDim.x;
    s5_scan(p, l);
    hg_scan(p);
    __syncthreads();
    for (int cb = c; cb < 256; cb += G) {
        const int b = cb >> 5, cc = cb & 31, k = cc & 15;
#pragma unroll 1
        for (int i = 0; i < 4; ++i) {
            const int j = cc < 16 ? (i == 0 ? k : (i == 1 ? 80 + k : (i == 2 ? 111 - k : 112 + k)))
                                  : (i == 0 ? 16 + k : (i == 1 ? 47 - k : (i == 2 ? 48 + k : 79 - k)));
            dsa_select(p, b, j * 16, lds);
        }
    }
}
__device__ void phase_mix3(const Params& p, int l, float* lds) {
    for (int c = blockIdx.x; c < 256; c += gridDim.x) {
        const int b = c >> 5, cc = c & 31;
#pragma unroll 1
        for (int k = 0; k < 2; ++k) dsa_attend_block(p, b, k ? 63 - cc : cc, lds);
    }
    for (int u = blockIdx.x; u < 256; u += gridDim.x) s5_pass3(p, l, u >> 3, u & 7, lds);
#pragma unroll 1
    for (int u = blockIdx.x; u < 1024; u += gridDim.x) {
        HgIn cur; const int bh = u >> 5;
        hg_issue_loads(p, (bh >> 2) * S + (u & 31) * 64, bh & 3, tidx(), true, cur);
        hg_pass3(p, l, u, lds, cur);
    }
    __syncthreads();
}

#define XB_TMO      128
#define XB_XCNT(j)  (256  + 64 * (j))
#define XB_XSUB(j)  (1280 + 64 * (j))
#define XB_XGEN(j)  (2304 + 64 * (j))
#define XB_TOP      3328
#define XB_TOPGEN   3392
#define XCD_BAR_WORDS 3456
#define XB_SPIN_CAP (1u << 22)
__device__ __forceinline__ unsigned xb_ld(unsigned* p)              { return __hip_atomic_load(p, __ATOMIC_RELAXED, __HIP_MEMORY_SCOPE_AGENT); }
__device__ __forceinline__ unsigned xb_add(unsigned* p, unsigned v) { return __hip_atomic_fetch_add(p, v, __ATOMIC_RELAXED, __HIP_MEMORY_SCOPE_AGENT); }
__device__ __forceinline__ unsigned xb_xcc_id() { return (unsigned)__builtin_amdgcn_s_getreg((3 << 11) | 20) & 0xFu; }
#define XB_SPIN(cond, bar) do { unsigned _sp = 0; while (cond) { __builtin_amdgcn_s_sleep(1); \
    if ((++_sp & 255u) == 0u) { if (xb_ld(&(bar)[XB_TMO])) break; if (_sp > XB_SPIN_CAP) { atomicAdd(&(bar)[XB_TMO], 1u); break; } } } } while (0)
struct XcdBarrier { unsigned* bar; unsigned x; volatile LAS unsigned* st; };
__device__ __forceinline__ XcdBarrier xcd_barrier_post(unsigned* bar, volatile LAS unsigned* st) {
    XcdBarrier b; b.bar = bar; b.x = xb_xcc_id(); b.st = st;
    if (threadIdx.x == 0) (void)xb_add(&bar[XB_XCNT(b.x)], 1u);
    return b;
}
__device__ __forceinline__ void xcd_barrier_complete(unsigned* bar, unsigned x, unsigned& nloc, unsigned& nx) {
    const unsigned G = gridDim.x * gridDim.y * gridDim.z;
    unsigned sum, cnt, mine, sp = 0u;
    for (;;) {
        sum = 0u; cnt = 0u; mine = 0u;
#pragma unroll
        for (unsigned j = 0; j < 16; ++j) { const unsigned c = xb_ld(&bar[XB_XCNT(j)]); sum += c; cnt += (c > 0u) ? 1u : 0u; mine = (j == x) ? c : mine; }
        if (sum == G) break;
        __builtin_amdgcn_s_sleep(1);
        if ((++sp & 255u) == 0u) { if (xb_ld(&bar[XB_TMO])) break; if (sp > XB_SPIN_CAP) { atomicAdd(&bar[XB_TMO], 1u); break; } }
    }
    nloc = mine > 0u ? mine : 1u; nx = cnt > 0u ? cnt : 1u;
}
__device__ __forceinline__ void xcd_barrier(const XcdBarrier& b) {
    asm volatile("s_waitcnt vmcnt(0)" ::: "memory");
    __syncthreads();
    if (threadIdx.x == 0) {
        unsigned* bar = b.bar;
        __builtin_amdgcn_s_waitcnt(0);
        unsigned nloc = b.st[0], nx = b.st[1];
        if (nloc == 0u) { xcd_barrier_complete(bar, b.x, nloc, nx); b.st[0] = nloc; b.st[1] = nx; }
        const unsigned old = xb_add(&bar[XB_XSUB(b.x)], 1u);
        const unsigned gen = old / nloc;
        if (old + 1u == (gen + 1u) * nloc) {
            __builtin_amdgcn_fence(__ATOMIC_RELEASE, "agent");
            asm volatile("s_waitcnt vmcnt(0)" ::: "memory");
            const unsigned og = xb_add(&bar[XB_TOP], 1u);
            const unsigned tg = og / nx;
            if (og + 1u == (tg + 1u) * nx) xb_add(&bar[XB_TOPGEN], 1u);
            else XB_SPIN(xb_ld(&bar[XB_TOPGEN]) == tg, bar);
            __builtin_amdgcn_fence(__ATOMIC_ACQUIRE, "agent");
            xb_add(&bar[XB_XGEN(b.x)], 1u);
            asm volatile("s_waitcnt vmcnt(0)" ::: "memory");
        } else {
            XB_SPIN(xb_ld(&bar[XB_XGEN(b.x)]) == gen, bar);
            __builtin_amdgcn_fence(__ATOMIC_ACQUIRE, "agent");
            asm volatile("s_waitcnt vmcnt(0)" ::: "memory");
        }
    }
    __syncthreads();
}

typedef const __attribute__((address_space(4))) Params* KParams;
#define PHASE_PARAMS() KParams _kp = (KParams)__builtin_amdgcn_kernarg_segment_ptr(); asm volatile("" : "+s"(_kp)); const Params& p = *(const Params*)_kp
__global__ void __launch_bounds__(512, 2) mega(Params p_unused) {
    extern __shared__ __attribute__((aligned(16))) float lds[];
    LAS unsigned char* ldsb = (LAS unsigned char*)lds;
    cg::grid_group grid = cg::this_grid();
    const int G = gridDim.x, c = blockIdx.x;
    __shared__ uint4 xb_words;
    if (threadIdx.x == 0) xb_words = make_uint4(0u, 0u, 0u, 0u);
    __syncthreads();
    XcdBarrier xbar;
    { PHASE_PARAMS(); xbar = xcd_barrier_post(p.xbar, (volatile LAS unsigned*)&xb_words); }
    { PHASE_PARAMS(); phase0(p); s5_pow_table(p); }
    grid.sync();
    for (int l = 0; l < NL; ++l) {
        { PHASE_PARAMS(); conv_layer(p, l, lds); phase_h(p, l); s5_build_tables(p, l, lds); }
        xcd_barrier(xbar);
        {
            PHASE_PARAMS();
            SchedPlain sc{(const char*)p.h16, (const char*)p.win16, 64, 32, G, c, D};
            EpiProj ep{p.q16, p.v16, p.hgg16, p.atq16, p.atk16, p.atv16, p.atg16, p.ixq16, p.ixk16, p.s5u16, p.s5g16, p.mg16, p.lf32, p.ixw32, p.lb + l * 512};
            pg::gemm_phase(ldsb, D, sc, ep);
        }
        xcd_barrier(xbar);
        { PHASE_PARAMS(); phase_mix1(p, l, lds); }
        xcd_barrier(xbar);
        { PHASE_PARAMS(); phase_mix2(p, l, lds); }
        xcd_barrier(xbar);
        { PHASE_PARAMS(); phase_mix3(p, l, lds); }
        xcd_barrier(xbar);
        {
            PHASE_PARAMS();
            SchedPlain sc{(const char*)p.ypre16, (const char*)p.wglu16, 64, 2, G, c, W};
            EpiGlu ep{p.ypre16, p.s5g16, p.glu_b + l * W, p.ys + (size_t)2 * T * W, nullptr};
            pg::gemm_phase(ldsb, W, sc, ep);
        }
        xcd_barrier(xbar);
        {
            PHASE_PARAMS();
            SchedMerge sc{(const char*)p.ys, (const char*)p.wb16, G, c};
            EpiMerge ep{(const unsigned char*)p.mg16, p.merged16};
            pg::gemm_phase(ldsb, W, sc, ep);
        }
        xcd_barrier(xbar);
        {
            PHASE_PARAMS();
            SchedPlain sc{(const char*)p.merged16, (const char*)p.wo16, 64, 4, G, c, D};
            EpiOut ep{l == 0 ? p.x : p.out, p.out, p.mod + (size_t)l * NB * 3072 + 2 * D};
            pg::gemm_phase(ldsb, D, sc, ep);
        }
        xcd_barrier(xbar);
    }
}

extern "C" void kernel_launch(void* const* d_in, const int* in_sizes, int n_in,
                              void* d_out, int out_size, void* d_ws, size_t ws_size,
                              hipStream_t stream) {
    static int grid_blocks = 0;
    if (!grid_blocks) {
        int dev = 0, cus = 0, per_cu = 0;
        (void)hipGetDevice(&dev);
        (void)hipDeviceGetAttribute(&cus, hipDeviceAttributeMultiprocessorCount, dev);
        (void)hipFuncSetAttribute((const void*)mega, hipFuncAttributeMaxDynamicSharedMemorySize, LDS_BYTES);
        (void)hipOccupancyMaxActiveBlocksPerMultiprocessor(&per_cu, mega, 512, LDS_BYTES);
        if (per_cu > 1) per_cu = 1;
        grid_blocks = cus * per_cu;
    }
    Params p{};
    const float* const* in = (const float* const*)d_in;
    p.x = in[0]; p.c = in[1]; p.pos = (const int*)d_in[2];
    p.ada_w = in[3]; p.ada_b = in[4]; p.norm_g = in[5]; p.w_in = in[6]; p.lb_logits = in[7]; p.onorm_g = in[8]; p.qn_g = in[9]; p.kn_g = in[10];
    p.a_re = in[11]; p.a_im = in[12]; p.log_dt = in[13]; p.b_re = in[14]; p.b_im = in[15]; p.c_re = in[16]; p.c_im = in[17]; p.s5_d = in[18];
    p.glu_w = in[19]; p.glu_b = in[20]; p.w_branch = in[21]; p.w_out = in[22];
    p.out = (float*)d_out;
    char* ws = (char*)d_ws; size_t off = 0;
    auto take = [&](size_t bytes) { char* q = ws + off; off += (bytes + 255) & ~(size_t)255; return q; };
    const size_t TW2 = (size_t)T * W * 2;
    p.mod = (float*)take((size_t)NL * NB * 3072 * 4);
    p.lb = (float*)take((size_t)NL * 512 * 4);
    p.abar = (float*)take((size_t)NL * 32 * 64 * 2 * 4);
    p.bbar = (float*)take((size_t)NL * 32 * 64 * 16 * 2 * 4);
    p.ropeA = (float*)take((size_t)T * 64 * 2 * 4);
    p.ropeI = (float*)take((size_t)T * 32 * 2 * 4);
    p.win16 = (__half*)take((size_t)NPK * D * 2);
    p.wb16 = (__half*)take((size_t)3 * D * W * 2);
    p.wo16 = (__half*)take((size_t)D * D * 2);
    p.wglu16 = (__half*)take((size_t)W * W * 2);
    p.h16 = (__half*)take((size_t)T * D * 2);       p.merged16 = p.h16; p.stT16 = p.h16;
    p.q16 = (__half*)take(TW2);                     p.mp32 = (float*)p.q16;
    p.lf32 = (float*)take((size_t)T * W * 4);
    p.v16 = (__half*)take(TW2);
    p.hgg16 = (__half*)take(TW2);
    p.atq16 = (__half*)take(TW2);
    p.atk16 = (__half*)take((size_t)T * 128 * 2);
    p.atv16 = (__half*)take((size_t)T * 128 * 2);
    p.atg16 = (__half*)take(TW2);
    p.ixq16 = (__half*)take(TW2);
    p.ixk16 = (__half*)take((size_t)T * 64 * 2);
    p.ixw32 = (float*)take((size_t)T * 8 * 4);
    p.s5u16 = (__half*)take(TW2);
    p.s5g16 = (__half*)take(TW2);
    p.mg16 = (__half*)take((size_t)T * 3072 * 2);
    p.ys = (__half*)take(3 * TW2);
    p.ypre16 = (__half*)take(TW2);
    p.dbg = (unsigned*)take(256);
    p.xbar = (unsigned*)take((size_t)XCD_BAR_WORDS * 4);
    p.pw = (float*)take((size_t)NL * 32 * 64 * 65 * 2 * 4);
    p.sg = (float*)take((size_t)NL * 32 * 2 * 4);
    p.kmat16 = (__half*)take((size_t)32 * 64 * 256 * 2);
    p.hs16 = (__half*)take((size_t)32 * 128 * 1024 * 2);
    p.gs16 = (__half*)take((size_t)32 * 1024 * 128 * 2);
    p.e32 = (float*)take((size_t)32 * 8 * 32 * 128 * 4);
    p.x16 = (__half*)take((size_t)32 * 8 * 32 * 128 * 2);
    p.dec32 = (float*)take((size_t)1024 * 128 * 4);
    p.mask = (unsigned*)take((size_t)T * 64 * 4);
    p.kf16 = (__half*)take((size_t)T * 128 * 2);
    p.vf16 = (__half*)take((size_t)T * 128 * 2);
    p.ikf16 = (__half*)take((size_t)T * 64 * 2);
    if (off > ws_size) { fprintf(stderr, "workspace too small: need %zu have %zu\n", off, ws_size); return; }
    (void)hipMemsetAsync(p.xbar, 0, (size_t)XCD_BAR_WORDS * 4, stream);
    (void)hipMemsetAsync(p.mod, 0, (size_t)NL * NB * 3072 * 4, stream);
    void* args[] = {&p};
    hipError_t e = hipLaunchCooperativeKernel((void*)mega, dim3(grid_blocks), dim3(512), args, LDS_BYTES, stream);
    if (e != hipSuccess) fprintf(stderr, "cooperative launch failed: %s (grid %d)\n", hipGetErrorString(e), grid_blocks);
}
```

```cpp
#include <hip/hip_runtime.h>
#include <hip/hip_cooperative_groups.h>
#include <hip/hip_fp16.h>
#include <cstdio>
namespace cg = cooperative_groups;

constexpr int D = 1024, NB = 8, S = 2048, T = NB * S, NL = 4, W = 512, NIN = 8008, NPK = 8192;
constexpr int C_S5U = 3912, C_MG = 4936;
constexpr float EPS = 1e-6f;
constexpr int LDS_BYTES = 135168;
#define LAS __attribute__((address_space(3)))
typedef _Float16 h8 __attribute__((ext_vector_type(8)));
typedef _Float16 h2 __attribute__((ext_vector_type(2)));
typedef float f32x4 __attribute__((ext_vector_type(4)));
typedef unsigned u32x4 __attribute__((ext_vector_type(4)));

struct Params {
    const float *x, *c; const int* pos;
    const float *ada_w, *ada_b, *norm_g, *w_in, *lb_logits, *onorm_g, *qn_g, *kn_g;
    const float *a_re, *a_im, *log_dt, *b_re, *b_im, *c_re, *c_im, *s5_d, *glu_w, *glu_b, *w_branch, *w_out;
    float* out;
    float *mod, *lb, *abar, *bbar, *ropeA, *ropeI;
    __half *win16, *wb16, *wo16, *wglu16;
    __half *h16, *q16, *v16, *hgg16, *atq16, *atk16, *atv16, *atg16, *ixq16, *ixk16, *s5u16, *s5g16, *mg16, *ys, *ypre16, *merged16;
    float *lf32, *ixw32, *mp32; unsigned* dbg; unsigned* mask; unsigned* xbar; __half *kf16, *vf16, *ikf16; __half* stT16; float* dec32; float *pw, *sg, *e32; __half *kmat16, *hs16, *gs16, *x16;
};

__device__ __forceinline__ float sigmoid_f(float v) { return 1.f / (1.f + expf(-v)); }
__device__ __forceinline__ float silu_f(float v) { return v / (1.f + expf(-v)); }
__device__ __forceinline__ float gelu_tanh_f(float v) { const float u = 0.7978845608028654f * (v + 0.044715f * v * v * v); return v * __builtin_amdgcn_rcpf(1.f + __builtin_amdgcn_exp2f(-2.885390081777927f * u)); }
__device__ __forceinline__ float wave_sum(float v) {
#pragma unroll
    for (int o = 32; o > 0; o >>= 1) v += __shfl_xor(v, o);
    return v;
}
__device__ __forceinline__ void lds_fence() { asm volatile("s_waitcnt lgkmcnt(0)" ::: "memory"); }
#define BAR_LDS() do { asm volatile("s_waitcnt lgkmcnt(0)" ::: "memory"); __builtin_amdgcn_s_barrier(); asm volatile("" ::: "memory"); } while (0)
__device__ __forceinline__ int tidx() { int t = threadIdx.x; asm volatile("" : "+v"(t)); return t; }

__device__ void phase0(const Params& p) {
    const size_t gtid = (size_t)blockIdx.x * blockDim.x + tidx(), nth = (size_t)gridDim.x * blockDim.x;
    {
        for (size_t i = gtid; i < (size_t)NL * 3072 * 8; i += nth) {
            const int col = (int)(i % 3072), ksl = (int)((i / 3072) % 8), l = (int)(i / (3072 * 8));
            const float* w = p.ada_w + ((size_t)l * 1024 + ksl * 128) * 3072 + col;
            float acc[NB];
#pragma unroll
            for (int b = 0; b < NB; ++b) acc[b] = ksl == 0 ? p.ada_b[l * 3072 + col] : 0.f;
#pragma unroll 4
            for (int k = 0; k < 128; ++k) {
                const float wv = w[(size_t)k * 3072];
#pragma unroll
                for (int b = 0; b < NB; ++b) { const float cv = p.c[b * 1024 + ksl * 128 + k]; acc[b] += cv * __builtin_amdgcn_rcpf(1.f + __builtin_amdgcn_exp2f(-1.4426950408889634f * cv)) * wv; }
            }
#pragma unroll
            for (int b = 0; b < NB; ++b) atomicAdd(p.mod + ((size_t)l * NB + b) * 3072 + col, acc[b]);
        }
    }
    for (size_t i = gtid; i < 512; i += nth) {
        float lg[NL], mx = -1e30f;
#pragma unroll
        for (int l = 0; l < NL; ++l) { lg[l] = p.lb_logits[l * 512 + i]; mx = fmaxf(mx, lg[l]); }
        float s = 0.f;
#pragma unroll
        for (int l = 0; l < NL; ++l) { lg[l] = expf(lg[l] - mx); s += lg[l]; }
        float cum = 0.f;
#pragma unroll
        for (int l = 0; l < NL; ++l) { const float pr = lg[l] / s; cum += pr; p.lb[l * 512 + i] = cum - lg[0] / s; }
    }
    for (size_t i = gtid; i < (size_t)NL * 32 * 64; i += nth) {
        const int lg = (int)(i / 64);
        const double dt = exp((double)p.log_dt[lg]);
        const double are = p.a_re[i], aim = p.a_im[i];
        const double mag = exp(are * dt), ang = aim * dt;
        const double abr = mag * cos(ang), abi = mag * sin(ang);
        const double nr = abr - 1.0, ni = abi, den = are * are + aim * aim;
        const double fr = (nr * are + ni * aim) / den, fi = (ni * are - nr * aim) / den;
        p.abar[i * 2] = (float)abr; p.abar[i * 2 + 1] = (float)abi;
        for (int c = 0; c < 16; ++c) {
            const double br = p.b_re[i * 16 + c], bi = p.b_im[i * 16 + c];
            p.bbar[(i * 16 + c) * 2] = (float)(fr * br - fi * bi);
            p.bbar[(i * 16 + c) * 2 + 1] = (float)(fr * bi + fi * br);
        }
    }
    for (size_t i = gtid; i < (size_t)T * 64; i += nth) {
        const int t = (int)(i / 64), j = (int)(i % 64);
        const double inv = pow(10000.0, -(double)(2 * j) / 128.0);
        const double ang = (double)p.pos[t] * inv;
        p.ropeA[i * 2] = (float)cos(ang); p.ropeA[i * 2 + 1] = (float)sin(ang);
    }
    for (size_t i = gtid; i < (size_t)T * 32; i += nth) {
        const int t = (int)(i / 32), j = (int)(i % 32);
        const double inv = pow(10000.0, -(double)(2 * j) / 64.0);
        const double ang = (double)p.pos[t] * inv;
        p.ropeI[i * 2] = (float)cos(ang); p.ropeI[i * 2 + 1] = (float)sin(ang);
    }
}

__device__ __forceinline__ unsigned pk2(float a, float b) { h2 v = {(_Float16)a, (_Float16)b}; return __builtin_bit_cast(unsigned, v); }
__device__ void phase_h(const Params& p, int l) {
    const float* xin = l == 0 ? p.x : p.out;
    const int w = tidx() >> 6, lane = tidx() & 63;
    for (int row = blockIdx.x * 8 + w; row < T; row += gridDim.x * 8) {
        const int b = row / S;
        const float* xr = xin + (size_t)row * D;
        float4 v[4]; float ss = 0.f;
#pragma unroll
        for (int i = 0; i < 4; ++i) { v[i] = *(const float4*)(xr + i * 256 + lane * 4); ss += v[i].x * v[i].x + v[i].y * v[i].y + v[i].z * v[i].z + v[i].w * v[i].w; }
        ss = wave_sum(ss);
        const float r = rsqrtf(ss * (1.f / D) + EPS);
        const float* md = p.mod + ((size_t)l * NB + b) * 3072;
#pragma unroll
        for (int i = 0; i < 4; ++i) {
            const int k = i * 256 + lane * 4;
            const float4 g = *(const float4*)(p.norm_g + l * D + k), sh = *(const float4*)(md + k), sc = *(const float4*)(md + D + k);
            uint2 o;
            o.x = pk2(v[i].x * r * g.x * (1.f + sc.x) + sh.x, v[i].y * r * g.y * (1.f + sc.y) + sh.y);
            o.y = pk2(v[i].z * r * g.z * (1.f + sc.z) + sh.z, v[i].w * r * g.w * (1.f + sc.w) + sh.w);
            *(uint2*)(p.h16 + (size_t)row * D + k) = o;
        }
    }
}
template <class CM>
__device__ void conv_transpose(const float* __restrict__ src, int ldsrc, int K, __half* __restrict__ dst, int N, CM colmap, float* lds, int part, int nparts) {
    float (*ts)[65] = (float (*)[65])lds;
    const int tid = tidx(), nkt = K / 64, nnt = N / 64;
    for (int tile = part; tile < nkt * nnt; tile += nparts) {
        const int kt = tile % nkt, nt = tile / nkt, k0 = kt * 64, n0 = nt * 64;
        __syncthreads();
#pragma unroll
        for (int i = 0; i < 8; ++i) {
            const int idx = tid + 512 * i, k = idx >> 6, n = idx & 63;
            const int sc = colmap(n0 + n);
            ts[k][n] = sc >= 0 ? src[(size_t)(k0 + k) * ldsrc + sc] : 0.f;
        }
        __syncthreads();
        const int n = tid >> 3, k8 = (tid & 7) * 8;
        u32x4 w;
        { h2 a = {(_Float16)ts[k8 + 0][n], (_Float16)ts[k8 + 1][n]}; w.x = __builtin_bit_cast(unsigned, a); }
        { h2 a = {(_Float16)ts[k8 + 2][n], (_Float16)ts[k8 + 3][n]}; w.y = __builtin_bit_cast(unsigned, a); }
        { h2 a = {(_Float16)ts[k8 + 4][n], (_Float16)ts[k8 + 5][n]}; w.z = __builtin_bit_cast(unsigned, a); }
        { h2 a = {(_Float16)ts[k8 + 6][n], (_Float16)ts[k8 + 7][n]}; w.w = __builtin_bit_cast(unsigned, a); }
        *(u32x4*)(dst + (size_t)(n0 + n) * K + k0 + k8) = w;
    }
}
struct CmIdent { __device__ int operator()(int n) const { return n; } };
struct CmWin { __device__ int operator()(int n) const { return n < C_S5U ? n : (n < 4096 ? -1 : n - 184); } };

__device__ void conv_layer(const Params& p, int l, float* lds) {
    conv_transpose(p.w_in + (size_t)l * D * NIN, NIN, D, p.win16, NPK, CmWin(), lds, blockIdx.x, gridDim.x);
    for (int n = 0; n < 3; ++n)
        conv_transpose(p.w_branch + ((size_t)l * 3 + n) * W * D, D, W, p.wb16 + (size_t)n * D * W, D, CmIdent(), lds, blockIdx.x, gridDim.x);
    conv_transpose(p.w_out + (size_t)l * D * D, D, D, p.wo16, D, CmIdent(), lds, blockIdx.x, gridDim.x);
    conv_transpose(p.glu_w + (size_t)l * W * W, W, W, p.wglu16, W, CmIdent(), lds, blockIdx.x, gridDim.x);
    __syncthreads();
}
namespace pg {
constexpr int BM = 256, BK = 64, HALF = 128, HTB = HALF * BK * 2, STAGE_BYTES = 8 * HTB, NXCD = 8, WGM = 8;
__device__ __forceinline__ int lds_byte(int r, int c) { const int st = (r >> 4) * 2 + (c >> 5), rr = r & 15, cc = c & 31, ob = rr * 64 + cc * 2; return st * 1024 + (ob ^ (((ob >> 9) & 1) << 5)); }
__device__ __forceinline__ void stage_rc(int b, int& R, int& C) { const int st = b / 1024, sb = b % 1024, swz = sb ^ (((sb >> 9) & 1) << 5); R = (st >> 1) * 16 + swz / 64; C = (st & 1) * 32 + (swz % 64) / 2; }
__device__ __forceinline__ int perm32(int rho) { const int n = rho >> 4, i = rho & 15; return 8 * (i >> 2) + 4 * n + (i & 3); }
struct Unit { int pm, pn, aux; const char* A; const char* B; };
__device__ __forceinline__ void tile_of(int L, int nM, int nN, int& pm, int& pn) {
    const int nwg = nM * nN; int wgid = L;
    { const int q = nwg / NXCD, r = nwg % NXCD, xcd = wgid % NXCD, off = wgid / NXCD; wgid = (xcd < r ? xcd * (q + 1) : r * (q + 1) + (xcd - r) * q) + off; }
    const int nig = WGM * nN, gid = wgid / nig, fm = gid * WGM, gsz = (nM - fm) < WGM ? (nM - fm) : WGM;
    pm = fm + ((wgid % nig) % gsz); pn = (wgid % nig) / gsz;
}
template <class Epi, class Sched>
__device__ __forceinline__ void gemm_phase(LAS unsigned char* lds, const int K, const Sched& S, const Epi& E) {
    int tid = tidx();
    const int wid = __builtin_amdgcn_readfirstlane(tid >> 6), lane = tid & 63, wr = wid >> 2, wc = wid & 3, fr = lane & 15, fq = lane >> 4;
    const int nt = K / BK;
    unsigned voffA[2], voffB[2];
#pragma unroll
    for (int i = 0; i < 2; ++i) { int R, C; stage_rc(tid * 16 + i * 8192, R, C); const int Rb = Epi::PERM ? ((R & ~31) + perm32(R & 31)) : R;
        voffA[i] = (unsigned)(R * K + C) * 2u; voffB[i] = (unsigned)(Rb * K + C) * 2u; }
    const size_t kstep = (size_t)(BK * 2);
    const size_t hstep = (size_t)HALF * K * 2;
    const unsigned ldsw = (unsigned)wid * 1024u;
    const int aoff = lds_byte(wr * 64 + fr, fq * 8), boff = lds_byte(wc * 32 + fr, fq * 8);
#define PG_SA(b, h) (((b) * 2 + (h)) * HTB)
#define PG_SB(b, h) ((4 + (b) * 2 + (h)) * HTB)
#define PG_STAGE(bufoff, gbase, voff) do { _Pragma("unroll") for (int _i = 0; _i < 2; ++_i) \
        __builtin_amdgcn_global_load_lds((const unsigned*)((const char*)(gbase) + (voff)[_i]), (LAS unsigned*)(lds + (bufoff) + ldsw + _i * 8192), 16, 0, 0); } while (0)
#define PG_LDA(dst, b, h) do { _Pragma("unroll") for (int m = 0; m < 4; ++m) _Pragma("unroll") for (int k = 0; k < 2; ++k) dst[m][k] = *(const LAS h8*)(lds + PG_SA(b, h) + aoff + m * 2048 + k * 1024); } while (0)
#define PG_LDB(dst, b, h) do { _Pragma("unroll") for (int n = 0; n < 2; ++n) _Pragma("unroll") for (int k = 0; k < 2; ++k) dst[n][k] = *(const LAS h8*)(lds + PG_SB(b, h) + boff + n * 2048 + k * 1024); } while (0)
#define PG_MMA(ai, bj, At, Bt) do { __builtin_amdgcn_s_setprio(1); _Pragma("unroll") for (int m = 0; m < 4; ++m) _Pragma("unroll") for (int n = 0; n < 2; ++n) _Pragma("unroll") for (int k = 0; k < 2; ++k) \
        acc[ai][bj][m][n] = __builtin_amdgcn_mfma_f32_16x16x32_f16(Bt[n][k], At[m][k], acc[ai][bj][m][n], 0, 0, 0); __builtin_amdgcn_s_setprio(0); } while (0)
#define PG_WAIT_V(n) asm volatile("s_waitcnt vmcnt(" #n ")" ::: "memory")
#define PG_WAIT_L(n) asm volatile("s_waitcnt lgkmcnt(" #n ")" ::: "memory")
#define PG_BAR __builtin_amdgcn_s_barrier()
#define PG_SCHED __builtin_amdgcn_sched_barrier(0)
    Unit cur, nxt; int ui = 0;
    if (!S.next(0, cur)) return;
    f32x4 acc[2][2][4][2];
#pragma unroll
    for (int a = 0; a < 2; ++a)
#pragma unroll
        for (int b = 0; b < 2; ++b)
#pragma unroll
            for (int m = 0; m < 4; ++m)
#pragma unroll
                for (int n = 0; n < 2; ++n) acc[a][b][m][n] = (f32x4){0.f, 0.f, 0.f, 0.f};
    h8 At[4][2], B0[2][2], B1[2][2];
    const char* cA = cur.A; const char* cB = cur.B;
    PG_STAGE(PG_SB(0, 0), cB, voffB); PG_STAGE(PG_SA(0, 0), cA, voffA); PG_STAGE(PG_SB(0, 1), cB + hstep, voffB); PG_STAGE(PG_SA(0, 1), cA + hstep, voffA);
    if (wr == 1) PG_BAR;
    PG_WAIT_V(4); PG_BAR;
    PG_STAGE(PG_SB(1, 0), cB + kstep, voffB); PG_STAGE(PG_SA(1, 0), cA + kstep, voffA); PG_STAGE(PG_SB(1, 1), cB + hstep + kstep, voffB);
    PG_WAIT_V(6); PG_BAR;
    for (;;) {
        const bool has_next = S.next(ui + 1, nxt);
        const char* nA = has_next ? nxt.A : cA; const char* nB = has_next ? nxt.B : cB;
        for (int t = 0; t < nt; t += 2) {
            const bool last = (t == nt - 2);
            const char* a1 = cA + (size_t)(t + 1) * kstep;
            const char* a2 = last ? nA : cA + (size_t)(t + 2) * kstep; const char* b2 = last ? nB : cB + (size_t)(t + 2) * kstep;
            const char* a3 = a2 + kstep; const char* b3 = b2 + kstep;
            PG_LDB(B0, 0, 0); PG_SCHED; PG_LDA(At, 0, 0); PG_STAGE(PG_SA(1, 1), a1 + hstep, voffA);
            PG_WAIT_L(8); PG_BAR; PG_WAIT_L(0); PG_MMA(0, 0, At, B0); PG_BAR; PG_SCHED;
            PG_LDB(B1, 0, 1); PG_STAGE(PG_SB(0, 0), b2, voffB);
            PG_BAR; PG_WAIT_L(0); PG_MMA(0, 1, At, B1); PG_BAR;
            PG_LDA(At, 0, 1); PG_STAGE(PG_SA(0, 0), a2, voffA);
            PG_BAR; PG_WAIT_L(0); PG_MMA(1, 0, At, B0); PG_BAR; PG_SCHED;
            PG_STAGE(PG_SB(0, 1), b2 + hstep, voffB);
            PG_WAIT_V(6); PG_BAR; PG_MMA(1, 1, At, B1); PG_BAR;
            PG_LDB(B0, 1, 0); PG_SCHED; PG_LDA(At, 1, 0); PG_STAGE(PG_SA(0, 1), a2 + hstep, voffA);
            PG_WAIT_L(8); PG_BAR; PG_WAIT_L(0); PG_MMA(0, 0, At, B0); PG_BAR; PG_SCHED;
            PG_LDB(B1, 1, 1); PG_STAGE(PG_SB(1, 0), b3, voffB);
            PG_BAR; PG_WAIT_L(0); PG_MMA(0, 1, At, B1); PG_BAR;
            PG_LDA(At, 1, 1); PG_STAGE(PG_SA(1, 0), a3, voffA);
            PG_BAR; PG_WAIT_L(0); PG_MMA(1, 0, At, B0); PG_BAR; PG_SCHED;
            PG_STAGE(PG_SB(1, 1), b3 + hstep, voffB);
            PG_WAIT_V(6); PG_BAR; PG_MMA(1, 1, At, B1); PG_BAR;
        }
        E(acc, cur, wr, wc, fr, fq);
        if (!has_next) break;
        if constexpr (!Epi::KEEP_ACC) {
#pragma unroll
        for (int a = 0; a < 2; ++a)
#pragma unroll
            for (int b = 0; b < 2; ++b)
#pragma unroll
                for (int m = 0; m < 4; ++m)
#pragma unroll
                    for (int n = 0; n < 2; ++n) acc[a][b][m][n] = (f32x4){0.f, 0.f, 0.f, 0.f};
        }
        cur = nxt; cA = nA; cB = nB; ++ui;
    }
    PG_WAIT_V(0);
    if (wr == 0) PG_BAR;
    PG_BAR;
#undef PG_SA
#undef PG_SB
#undef PG_STAGE
#undef PG_LDA
#undef PG_LDB
#undef PG_MMA
#undef PG_WAIT_V
#undef PG_WAIT_L
#undef PG_BAR
#undef PG_SCHED
}
}
__device__ __forceinline__ float fsig(float v) { return __builtin_amdgcn_rcpf(1.f + __builtin_amdgcn_exp2f(-1.4426950408889634f * v)); }
__device__ __forceinline__ float fsilu(float v) { return v * fsig(v); }
__device__ __forceinline__ u32x4 pack8(const f32x4 a, const f32x4 b) {
    const h8 v = {(_Float16)a[0], (_Float16)a[1], (_Float16)a[2], (_Float16)a[3], (_Float16)b[0], (_Float16)b[1], (_Float16)b[2], (_Float16)b[3]};
    return __builtin_bit_cast(u32x4, v);
}
__device__ __forceinline__ void unpack8(const u32x4 w, float (&o)[8]) {
    const h8 v = __builtin_bit_cast(h8, w);
#pragma unroll
    for (int j = 0; j < 8; ++j) o[j] = (float)v[j];
}
struct SchedPlain {
    const char* A; const char* B; int nM, nN, G, c, K;
    __device__ bool next(int i, pg::Unit& u) const {
        const long L = (long)i * G + c; if (L >= (long)nM * nN) return false;
        pg::tile_of((int)L, nM, nN, u.pm, u.pn); u.aux = 0;
        u.A = A + (size_t)u.pm * 256 * K * 2; u.B = B + (size_t)u.pn * 256 * K * 2; return true;
    }
};
struct SchedMerge {
    const char* ys; const char* wb; int G, c;
    __device__ bool next(int i, pg::Unit& u) const {
        const int r = i / 3, n = i - 3 * r; const long L = (long)r * G + c; if (L >= 64 * 4) return false;
        pg::tile_of((int)L, 64, 4, u.pm, u.pn); u.aux = n;
        u.A = ys + ((size_t)n * T + (size_t)u.pm * 256) * W * 2; u.B = wb + ((size_t)n * D + (size_t)u.pn * 256) * W * 2; return true;
    }
};

template <int ACT> __device__ __forceinline__ f32x4 actv(f32x4 v) {
    if (ACT == 1) { for (int j = 0; j < 4; ++j) v[j] = fsilu(v[j]); }
    if (ACT == 2) { for (int j = 0; j < 4; ++j) v[j] = fsig(v[j]); }
    return v;
}
template <int ACT> __device__ __forceinline__ void st16(const f32x4 (&acc)[2][2][4][2], __half* base, int ld, int c8, int bj0, int bj1) {
#pragma unroll
    for (int ai = 0; ai < 2; ++ai)
#pragma unroll
        for (int m = 0; m < 4; ++m) {
            __half* rowp = base + (size_t)(ai * 128 + m * 16) * ld + c8;
#pragma unroll
            for (int bj = 0; bj < 2; ++bj) if (bj >= bj0 && bj < bj1)
                *(u32x4*)(rowp + (bj - bj0) * 128) = pack8(actv<ACT>(acc[ai][bj][m][0]), actv<ACT>(acc[ai][bj][m][1]));
        }
}
struct EpiProj {
    static constexpr bool PERM = true, KEEP_ACC = false;
    __half *q16, *v16, *hgg16, *atq16, *atk16, *atv16, *atg16, *ixq16, *ixk16, *s5u16, *s5g16, *mg16; float *lf32, *ixw32; const float* lb;
    __device__ __forceinline__ void operator()(f32x4 (&acc)[2][2][4][2], const pg::Unit& u, int wr, int wc, int fr, int fq) const {
        const size_t row0 = (size_t)u.pm * 256 + wr * 64 + fr; const int c8 = wc * 32 + 8 * fq, pn = u.pn;
        if (pn < 2)        st16<0>(acc, q16 + row0 * W + pn * 256, W, c8, 0, 2);
        else if (pn < 4) {
            const int cb = (pn - 2) * 256 + c8;
#pragma unroll
            for (int bj = 0; bj < 2; ++bj) {
                const f32x4 l0 = *(const f32x4*)(lb + cb + bj * 128), l1 = *(const f32x4*)(lb + cb + bj * 128 + 4);
#pragma unroll
                for (int ai = 0; ai < 2; ++ai)
#pragma unroll
                    for (int m = 0; m < 4; ++m) {
                        f32x4 a = acc[ai][bj][m][0], b = acc[ai][bj][m][1];
#pragma unroll
                        for (int j = 0; j < 4; ++j) { a[j] = 0.6931471805599453f * __builtin_amdgcn_logf(fmaxf(l0[j] + (1.f - l0[j]) * fsig(a[j]), 1e-30f)); b[j] = 0.6931471805599453f * __builtin_amdgcn_logf(fmaxf(l1[j] + (1.f - l1[j]) * fsig(b[j]), 1e-30f)); }
                        float* o = lf32 + (row0 + ai * 128 + m * 16) * W + cb + bj * 128;
                        *(f32x4*)o = a; *(f32x4*)(o + 4) = b;
                    }
            }
        }
        else if (pn < 6)   st16<0>(acc, v16 + row0 * W + (pn - 4) * 256, W, c8, 0, 2);
        else if (pn < 8)   st16<1>(acc, hgg16 + row0 * W + (pn - 6) * 256, W, c8, 0, 2);
        else if (pn < 10)  st16<0>(acc, atq16 + row0 * W + (pn - 8) * 256, W, c8, 0, 2);
        else if (pn == 10) { st16<0>(acc, atk16 + row0 * 128, 128, c8, 0, 1); st16<0>(acc, atv16 + row0 * 128, 128, c8, 1, 2); }
        else if (pn < 13)  st16<1>(acc, atg16 + row0 * W + (pn - 11) * 256, W, c8, 0, 2);
        else if (pn < 15)  st16<0>(acc, ixq16 + row0 * W + (pn - 13) * 256, W, c8, 0, 2);
        else if (pn == 15) {
            if (wc < 2) {
#pragma unroll
                for (int ai = 0; ai < 2; ++ai)
#pragma unroll
                    for (int m = 0; m < 4; ++m) *(u32x4*)(ixk16 + (row0 + ai * 128 + m * 16) * 64 + c8) = pack8(acc[ai][0][m][0], acc[ai][0][m][1]);
            } else if (wc == 2 && fq == 0) {
#pragma unroll
                for (int ai = 0; ai < 2; ++ai)
#pragma unroll
                    for (int m = 0; m < 4; ++m) { float* o = ixw32 + (row0 + ai * 128 + m * 16) * 8; *(f32x4*)o = acc[ai][0][m][0]; *(f32x4*)(o + 4) = acc[ai][0][m][1]; }
            }
        }
        else if (pn < 18)  st16<0>(acc, s5u16 + row0 * W + (pn - 16) * 256, W, c8, 0, 2);
        else if (pn < 20)  st16<1>(acc, s5g16 + row0 * W + (pn - 18) * 256, W, c8, 0, 2);
        else {
            int lane = fq * 16 + fr;
            asm volatile("" : "+v"(lane));
            unsigned char* base = (unsigned char*)mg16 + ((((size_t)u.pm * 12 + (pn - 20)) * 8 + wr * 4 + wc) * 16) * 512 + lane * 8;
#pragma unroll
            for (int ai = 0; ai < 2; ++ai)
#pragma unroll
                for (int m = 0; m < 4; ++m)
#pragma unroll
                    for (int bj = 0; bj < 2; ++bj) {
                        const f32x4 a = actv<2>(acc[ai][bj][m][0]), b = actv<2>(acc[ai][bj][m][1]);
                        unsigned lo = 0, hi = 0;
#pragma unroll
                        for (int j = 0; j < 4; ++j) {
                            lo |= (unsigned)max(1, (int)__builtin_rintf(a[j] * 255.f)) << (8 * j);
                            hi |= (unsigned)max(1, (int)__builtin_rintf(b[j] * 255.f)) << (8 * j);
                        }
                        *(uint2*)(base + ((ai * 4 + m) * 2 + bj) * 512) = make_uint2(lo, hi);
                    }
        }
    }
};
struct EpiGlu {
    static constexpr bool PERM = true, KEEP_ACC = false;
    const __half* ypre16; const __half* s5g16; const float* bias; __half* yc; float* raw;
    __device__ __forceinline__ void operator()(f32x4 (&acc)[2][2][4][2], const pg::Unit& u, int wr, int wc, int fr, int fq) const {
        size_t row0 = (size_t)u.pm * 256 + wr * 64 + fr; const int c0 = u.pn * 256 + wc * 32 + 8 * fq;
        asm volatile("" : "+v"(row0));
        f32x4 bv[2][2];
#pragma unroll
        for (int bj = 0; bj < 2; ++bj) { bv[bj][0] = *(const f32x4*)(bias + c0 + bj * 128); bv[bj][1] = *(const f32x4*)(bias + c0 + bj * 128 + 4); }
#pragma unroll
        for (int am = 0; am < 4; ++am) {
            u32x4 yv[2][2], gv[2][2];
#pragma unroll
            for (int mm = 0; mm < 2; ++mm)
#pragma unroll
                for (int bj = 0; bj < 2; ++bj) {
                    const size_t off = (row0 + (am >> 1) * 128 + ((am & 1) * 2 + mm) * 16) * W + c0 + bj * 128;
                    yv[mm][bj] = *(const u32x4*)(ypre16 + off); gv[mm][bj] = *(const u32x4*)(s5g16 + off);
                }
#pragma unroll
            for (int mm = 0; mm < 2; ++mm)
#pragma unroll
                for (int bj = 0; bj < 2; ++bj) {
                    const int ai = am >> 1, m = (am & 1) * 2 + mm;
                    const size_t off = (row0 + ai * 128 + m * 16) * W + c0 + bj * 128;
                    float y[8], g[8]; unpack8(yv[mm][bj], y); unpack8(gv[mm][bj], g);
                    f32x4 a = acc[ai][bj][m][0] + bv[bj][0], b = acc[ai][bj][m][1] + bv[bj][1];
#pragma unroll
                    for (int j = 0; j < 4; ++j) { a[j] = y[j] * fsig(a[j]) * g[j]; b[j] = y[4 + j] * fsig(b[j]) * g[4 + j]; }
                    *(u32x4*)(yc + off) = pack8(a, b);
                }
        }
    }
};
struct EpiMerge {
    static constexpr bool PERM = true, KEEP_ACC = true;
    const unsigned char* mg8; __half* merged16;
    static __device__ __forceinline__ void dec8(const uint2 w, float (&g)[8]) {
#pragma unroll
        for (int j = 0; j < 4; ++j) { g[j] = (float)((w.x >> (8 * j)) & 255u); g[4 + j] = (float)((w.y >> (8 * j)) & 255u); }
    }
    __device__ __forceinline__ void operator()(f32x4 (&acc)[2][2][4][2], const pg::Unit& u, int wr, int wc, int fr, int fq) const {
        const size_t row0 = (size_t)u.pm * 256 + wr * 64 + fr; const int c0 = u.pn * 256 + wc * 32 + 8 * fq, n = u.aux;
        int lofs = ((wr * 4 + wc) * 16) * 512 + (fq * 16 + fr) * 8;
        asm volatile("" : "+v"(lofs));
        const unsigned char* gp = mg8 + ((size_t)u.pm * 12 + n * 4 + u.pn) * 16 * 8 * 512 + lofs;
        uint2 gq[16], gnq[16];
#pragma unroll
        for (int k = 0; k < 16; ++k) gq[k] = *(const uint2*)(gp + k * 512);
        if (n < 2) {
#pragma unroll
            for (int k = 0; k < 16; ++k) gnq[k] = *(const uint2*)(gp + (size_t)4 * 16 * 8 * 512 + k * 512);
        }
#pragma unroll
        for (int ai = 0; ai < 2; ++ai)
#pragma unroll
            for (int m = 0; m < 4; ++m)
#pragma unroll
                for (int bj = 0; bj < 2; ++bj) {
                    const int k = (ai * 4 + m) * 2 + bj;
                    float g[8]; dec8(gq[k], g);
                    f32x4 a = acc[ai][bj][m][0], b = acc[ai][bj][m][1];
                    if (n < 2) {
                        float gn[8]; dec8(gnq[k], gn);
#pragma unroll
                        for (int j = 0; j < 4; ++j) { a[j] *= g[j] * __builtin_amdgcn_rcpf(gn[j]); b[j] *= g[4 + j] * __builtin_amdgcn_rcpf(gn[4 + j]); }
                        acc[ai][bj][m][0] = a; acc[ai][bj][m][1] = b;
                    } else {
#pragma unroll
                        for (int j = 0; j < 4; ++j) { a[j] *= g[j] * (1.f / 255.f); b[j] *= g[4 + j] * (1.f / 255.f); }
                        *(u32x4*)(merged16 + (row0 + ai * 128 + m * 16) * D + c0 + bj * 128) = pack8(a, b);
                        acc[ai][bj][m][0] = (f32x4){0.f, 0.f, 0.f, 0.f}; acc[ai][bj][m][1] = (f32x4){0.f, 0.f, 0.f, 0.f};
                    }
                }
    }
};
struct EpiOut {
    static constexpr bool PERM = false, KEEP_ACC = false;
    const float* xin; float* out; const float* gate;
    __device__ __forceinline__ void operator()(f32x4 (&acc)[2][2][4][2], const pg::Unit& u, int wr, int wc, int fr, int fq) const {
        size_t row0 = (size_t)u.pm * 256 + wr * 64 + fr; const int c0 = u.pn * 256 + wc * 32 + 4 * fq;
        asm volatile("" : "+v"(row0));
        const int b = (u.pm * 256) / S;
        f32x4 gv[2][2];
#pragma unroll
        for (int bj = 0; bj < 2; ++bj)
#pragma unroll
            for (int n = 0; n < 2; ++n) gv[bj][n] = *(const f32x4*)(gate + (size_t)b * 3072 + c0 + bj * 128 + n * 16);
#pragma unroll
        for (int am = 0; am < 4; ++am) {
            f32x4 xv[2][2][2];
#pragma unroll
            for (int mm = 0; mm < 2; ++mm)
#pragma unroll
                for (int bj = 0; bj < 2; ++bj)
#pragma unroll
                    for (int n = 0; n < 2; ++n) xv[mm][bj][n] = *(const f32x4*)(xin + (row0 + (am >> 1) * 128 + ((am & 1) * 2 + mm) * 16) * D + c0 + bj * 128 + n * 16);
#pragma unroll
            for (int mm = 0; mm < 2; ++mm)
#pragma unroll
                for (int bj = 0; bj < 2; ++bj)
#pragma unroll
                    for (int n = 0; n < 2; ++n)
                        *(f32x4*)(out + (row0 + (am >> 1) * 128 + ((am & 1) * 2 + mm) * 16) * D + c0 + bj * 128 + n * 16) = xv[mm][bj][n] + gv[bj][n] * acc[am >> 1][bj][(am & 1) * 2 + mm][n];
        }
    }
};
constexpr float QSCALE = 0.08838834764831845f * 1.4426950408889634f;
__device__ void phase_fix(const Params& p, int l, float* lds) {
    {
        __half* tl = (__half*)lds;
        const int tid = tidx();
        for (int tile = blockIdx.x; tile < T / 64; tile += gridDim.x) {
            const int t0 = tile * 64, b = t0 / S, s0 = t0 % S;
            __syncthreads();
            for (int i = tid; i < 64 * 64; i += 512) { const int tt = i >> 6, e2 = (i & 63) * 2; *(h2*)(tl + tt * 130 + e2) = *(const h2*)(p.atv16 + (size_t)(t0 + tt) * 128 + e2); }
            __syncthreads();
#pragma unroll
            for (int rep = 0; rep < 2; ++rep) {
                const int ch = tid + 512 * rep;
                const int ln = ch & 63, s2 = (ch >> 6) & 1, et = (ch >> 7) & 3, ktl = ch >> 9, colv = ln & 31, hf = ln >> 5;
                h8 v;
#pragma unroll
                for (int j = 0; j < 8; ++j) v[j] = __builtin_bit_cast(_Float16, tl[(ktl * 32 + 16 * s2 + 8 * (j >> 2) + 4 * hf + (j & 3)) * 130 + 32 * et + colv]);
                *(h8*)(p.vf16 + ((((size_t)(b * 64 + (s0 >> 5) + ktl) * 4 + et) * 2 + s2) * 64 + ln) * 8) = v;
            }
        }
        __syncthreads();
    }
    const int w = tidx() >> 6, lane = tidx() & 63;
    __half* wl = (__half*)lds + w * 192;
    const float gq0 = p.qn_g[l * 128 + lane], gq1 = p.qn_g[l * 128 + 64 + lane], gk0 = p.kn_g[l * 128 + lane], gk1 = p.kn_g[l * 128 + 64 + lane];
#pragma unroll 1
    for (int t = blockIdx.x * 8 + w; t < T; t += gridDim.x * 8) {
        const int b = t / S, s = t % S, kt = s >> 5, colk = s & 31;
        __half* qrow = p.atq16 + (size_t)t * W; const __half* krow = p.atk16 + (size_t)t * 128;
        __half* iqrow = p.ixq16 + (size_t)t * W; const __half* ikrow = p.ixk16 + (size_t)t * 64;
        float x1[5], x2[5];
#pragma unroll
        for (int hh = 0; hh < 4; ++hh) { x1[hh] = __half2float(qrow[hh * 128 + lane]); x2[hh] = __half2float(qrow[hh * 128 + 64 + lane]); }
        x1[4] = __half2float(krow[lane]); x2[4] = __half2float(krow[64 + lane]);
        const float2 csA = *(const float2*)(p.ropeA + ((size_t)t * 64 + lane) * 2);
        const float2 csI = *(const float2*)(p.ropeI + ((size_t)t * 32 + (lane & 31)) * 2);
        float y1[4], y2[4];
#pragma unroll
        for (int i = 0; i < 4; ++i) { const int hh = (lane >> 5) + 2 * i; y1[i] = __half2float(iqrow[hh * 64 + (lane & 31)]); y2[i] = __half2float(iqrow[hh * 64 + 32 + (lane & 31)]); }
        float z1 = 0.f, z2 = 0.f;
        if (lane < 32) { z1 = __half2float(ikrow[lane]); z2 = __half2float(ikrow[32 + lane]); }
        float ss[5];
#pragma unroll
        for (int hh = 0; hh < 5; ++hh) ss[hh] = x1[hh] * x1[hh] + x2[hh] * x2[hh];
#pragma unroll
        for (int o = 32; o > 0; o >>= 1) {
#pragma unroll
            for (int hh = 0; hh < 5; ++hh) ss[hh] += __shfl_xor(ss[hh], o);
        }
#pragma unroll
        for (int hh = 0; hh < 5; ++hh) {
            const float r = rsqrtf(ss[hh] * (1.f / 128.f) + EPS) * (hh < 4 ? QSCALE : 1.f);
            const float a = x1[hh] * r * (hh < 4 ? gq0 : gk0), b2 = x2[hh] * r * (hh < 4 ? gq1 : gk1);
            const __half o1 = __float2half(a * csA.x - b2 * csA.y), o2 = __float2half(b2 * csA.x + a * csA.y);
            if (hh < 4) { qrow[hh * 128 + lane] = o1; qrow[hh * 128 + 64 + lane] = o2; } else { wl[lane] = o1; wl[64 + lane] = o2; }
        }
#pragma unroll
        for (int i = 0; i < 4; ++i) {
            const int hh = (lane >> 5) + 2 * i;
            iqrow[hh * 64 + (lane & 31)] = __float2half(y1[i] * csI.x - y2[i] * csI.y); iqrow[hh * 64 + 32 + (lane & 31)] = __float2half(y2[i] * csI.x + y1[i] * csI.y);
        }
        if (lane < 32) { wl[128 + lane] = __float2half(z1 * csI.x - z2 * csI.y); wl[160 + lane] = __float2half(z2 * csI.x + z1 * csI.y); }
        lds_fence();
        if (lane < 16) {
            const h8 v = *(const h8*)(wl + lane * 8);
            *(h8*)(p.kf16 + ((((size_t)(b * 64 + kt) * 8 + (lane >> 1)) * 64) + (lane & 1) * 32 + colk) * 8) = v;
        } else if (lane < 24) {
            const int c2 = lane - 16;
            const h8 v = *(const h8*)(wl + 128 + c2 * 8);
            *(h8*)(p.ikf16 + ((((size_t)(b * 64 + kt) * 4 + (c2 >> 1)) * 64) + (c2 & 1) * 32 + colk) * 8) = v;
        }
        lds_fence();
    }
}

__device__ __forceinline__ unsigned f2key(float f) { const unsigned u = __float_as_uint(f); return (u & 0x80000000u) ? ~u : (u | 0x80000000u); }
typedef float f32x16 __attribute__((ext_vector_type(16)));
typedef _Float16 h4 __attribute__((ext_vector_type(4)));
__device__ void dsa_select(const Params& p, int b, int q0, float* lds) {
    const int tid = tidx(), w = tid >> 6, lane = tid & 63, half = lane >> 5, col = lane & 31;
    float* sc = lds;
    {
        const int wq = w & 3, par = w >> 2;
        const int blk = col >> 2, wi = col & 3, ql = 2 * (blk & 1) + (blk >> 2), head = 4 * ((blk >> 1) & 1) + wi;
        const __half* qrow = p.ixq16 + (size_t)(b * S + q0 + wq * 4 + ql) * W + head * 64 + 8 * half;
        h8 af[4];
#pragma unroll
        for (int ks = 0; ks < 4; ++ks) af[ks] = *(const h8*)(qrow + 16 * ks);
        const int qa = wq * 4 + 2 * half;
        float iw0[8], iw1[8];
#pragma unroll
        for (int hh = 0; hh < 8; ++hh) { iw0[hh] = p.ixw32[(size_t)(b * S + q0 + qa) * 8 + hh]; iw1[hh] = p.ixw32[(size_t)(b * S + q0 + qa + 1) * 8 + hh]; }
        const int ntiles = (q0 + 15) / 32 + 1;
        const __half* ikb = p.ikf16 + (size_t)b * 64 * 4 * 512 + lane * 8;
        h8 bc[4];
        if (par < ntiles) {
#pragma unroll
            for (int ks = 0; ks < 4; ++ks) bc[ks] = *(const h8*)(ikb + ((size_t)par * 4 + ks) * 512);
        }
        for (int kt = par; kt < ntiles; kt += 2) {
            const int key = kt * 32 + col;
            const int ktn = kt + 2 < ntiles ? kt + 2 : kt;
            h8 bn[4];
#pragma unroll
            for (int ks = 0; ks < 4; ++ks) bn[ks] = *(const h8*)(ikb + ((size_t)ktn * 4 + ks) * 512);
            f32x16 acc;
#pragma unroll
            for (int r = 0; r < 16; ++r) acc[r] = 0.f;
#pragma unroll
            for (int ks = 0; ks < 4; ++ks) acc = __builtin_amdgcn_mfma_f32_32x32x16_f16(af[ks], bc[ks], acc, 0, 0, 0);
            float s0 = 0.f, s1 = 0.f;
#pragma unroll
            for (int r = 0; r < 8; ++r) { s0 += fmaxf(acc[r], 0.f) * iw0[r]; s1 += fmaxf(acc[8 + r], 0.f) * iw1[r]; }
            sc[qa * 2048 + key] = key <= q0 + qa ? s0 : -INFINITY;
            sc[(qa + 1) * 2048 + key] = key <= q0 + qa + 1 ? s1 : -INFINITY;
#pragma unroll
            for (int ks = 0; ks < 4; ++ks) bc[ks] = bn[ks];
        }
        for (int i = ntiles * 32 + tid; i < 2048; i += 512) {
#pragma unroll
            for (int q = 0; q < 16; ++q) sc[q * 2048 + i] = -INFINITY;
        }
    }
    __syncthreads();
    for (int qq = 0; qq < 2; ++qq) {
        const int ql = 2 * w + qq, qi = q0 + ql;
        const float* scl = sc + ql * 2048;
        const bool all = qi + 1 <= 256;
        unsigned key[32];
#pragma unroll
        for (int i = 0; i < 32; ++i) key[i] = f2key(scl[lane + 64 * i]);
        unsigned tge = 0x00800000u;
        int rrem = 0; bool split = false;
        if (!all) {
            unsigned prefix = 0; bool exact = false;
#pragma unroll 1
            for (int bit = 31; bit >= 0; --bit) {
                const unsigned cand = prefix | (1u << bit);
                int c = 0, cl = 0;
#pragma unroll
                for (int i = 0; i < 12; ++i) c += __popcll(__ballot(key[i] >= cand));
#pragma unroll
                for (int i = 12; i < 32; ++i) cl += (key[i] >= cand) ? 1 : 0;
#pragma unroll
                for (int bb = 0; bb < 5; ++bb) c += __popcll(__ballot((cl >> bb) & 1)) << bb;
                if (c >= 256) prefix = cand;
                if (c == 256) { exact = true; break; }
            }
            tge = prefix;
            if (!exact) {
                int cge = 0, cgt = 0;
#pragma unroll
                for (int i = 0; i < 32; ++i) { cge += __popcll(__ballot(key[i] >= prefix)); cgt += __popcll(__ballot(key[i] > prefix)); }
                if (cge > 256) { split = true; tge = prefix + 1u; rrem = 256 - cgt; }
            }
        }
        const unsigned long long lt = (1ull << lane) - 1ull;
        unsigned mylo = 0, myhi = 0;
        if (!split) {
#pragma unroll
            for (int i = 0; i < 32; ++i) {
                const unsigned long long m2 = __ballot(key[i] >= tge);
                if (lane == i) { mylo = (unsigned)m2; myhi = (unsigned)(m2 >> 32); }
            }
        } else {
#pragma unroll 1
            for (int i = 0; i < 32; ++i) {
                const unsigned k = f2key(scl[lane + 64 * i]);
                const bool eq = k == tge - 1u;
                const unsigned long long m = __ballot(eq);
                const bool sl = (k >= tge) || (eq && __popcll(m & lt) < rrem);
                rrem -= __popcll(m); if (rrem < 0) rrem = 0;
                const unsigned long long m2 = __ballot(sl);
                if (lane == i) { mylo = (unsigned)m2; myhi = (unsigned)(m2 >> 32); }
            }
        }
        if (lane < 32) *(uint2*)(p.mask + (size_t)(b * S + qi) * 64 + 2 * lane) = make_uint2(mylo, myhi);
    }
    __syncthreads();
}

__device__ void dsa_attend(const Params& p, int b, int g) {
    const int lane = tidx() & 63, half = lane >> 5, col = lane & 31;
    const int q0 = 8 * g, qi = q0 + (col >> 2), hd = col & 3;
    const __half* qp = p.atq16 + (size_t)(b * S + qi) * W + hd * 128 + 8 * half;
    h8 qf[8];
#pragma unroll
    for (int ks = 0; ks < 8; ++ks) qf[ks] = *(const h8*)(qp + 16 * ks);
    f32x16 o[4];
#pragma unroll
    for (int et = 0; et < 4; ++et)
#pragma unroll
        for (int r = 0; r < 16; ++r) o[et][r] = 0.f;
    float m = -INFINITY, l = 0.f;
    const int ntiles = (q0 + 7) / 32 + 1;
    const unsigned* mrow = p.mask + (size_t)(b * S + qi) * 64;
    const __half* kfb = p.kf16 + (size_t)b * 64 * 8 * 512 + lane * 8;
    const __half* vfb = p.vf16 + (size_t)b * 64 * 8 * 512 + lane * 8;
    h8 kA[8], kB[8];
#pragma unroll
    for (int ks = 0; ks < 8; ++ks) kA[ks] = *(const h8*)(kfb + (size_t)ks * 512);
#define DSA_TILE(kcur, knext, KT) do { \
        const int _kt = (KT), _ktn = _kt + 1 < ntiles ? _kt + 1 : _kt; \
        _Pragma("unroll") for (int ks = 0; ks < 8; ++ks) knext[ks] = *(const h8*)(kfb + ((size_t)_ktn * 8 + ks) * 512); \
        const unsigned mws = mrow[_kt] >> (4 * half); \
        f32x16 s; \
        _Pragma("unroll") for (int r = 0; r < 16; ++r) s[r] = 0.f; \
        _Pragma("unroll") for (int ks = 0; ks < 8; ++ks) s = __builtin_amdgcn_mfma_f32_32x32x16_f16(kcur[ks], qf[ks], s, 0, 0, 0); \
        h8 vf[8]; \
        _Pragma("unroll") for (int i = 0; i < 8; ++i) vf[i] = *(const h8*)(vfb + ((size_t)_kt * 8 + i) * 512); \
        float tmax = -INFINITY; \
        _Pragma("unroll") for (int r = 0; r < 16; ++r) { s[r] = (mws & (1u << ((r & 3) + 8 * (r >> 2)))) ? s[r] : -INFINITY; tmax = fmaxf(tmax, s[r]); } \
        tmax = fmaxf(tmax, __shfl_xor(tmax, 32)); \
        if (__any(tmax > m + 11.5f)) {          \
            const float mn = fmaxf(m, tmax), msf = mn == -INFINITY ? 0.f : mn; \
            const float cs = __builtin_amdgcn_exp2f(m - msf); \
            l *= cs; m = mn; \
            _Pragma("unroll") for (int et = 0; et < 4; ++et) _Pragma("unroll") for (int r = 0; r < 16; ++r) o[et][r] *= cs; \
        } \
        const float ms2 = m == -INFINITY ? 0.f : m; \
        float ps = 0.f; \
        _Pragma("unroll") for (int r = 0; r < 16; ++r) { s[r] = __builtin_amdgcn_exp2f(s[r] - ms2); ps += s[r]; } \
        l += ps; \
        h8 pb[2]; \
        _Pragma("unroll") for (int s2 = 0; s2 < 2; ++s2) _Pragma("unroll") for (int j = 0; j < 8; ++j) pb[s2][j] = (_Float16)s[8 * s2 + j]; \
        _Pragma("unroll") for (int et = 0; et < 4; ++et) _Pragma("unroll") for (int s2 = 0; s2 < 2; ++s2) \
            o[et] = __builtin_amdgcn_mfma_f32_32x32x16_f16(vf[et * 2 + s2], pb[s2], o[et], 0, 0, 0); \
    } while (0)
    int kt = 0;
#pragma unroll 1
    for (; kt + 1 < ntiles; kt += 2) { DSA_TILE(kA, kB, kt); DSA_TILE(kB, kA, kt + 1); }
    if (kt < ntiles) DSA_TILE(kA, kB, kt);
#undef DSA_TILE
    l += __shfl_xor(l, 32);
    const float inv = 1.f / l;
    __half* yb = p.ys + (size_t)T * W + (size_t)(b * S + qi) * W + hd * 128;
    const __half* gp = p.atg16 + (size_t)(b * S + qi) * W + hd * 128;
#pragma unroll
    for (int et = 0; et < 4; ++et)
#pragma unroll
        for (int r4 = 0; r4 < 4; ++r4) {
            const int e0 = 32 * et + 8 * r4 + 4 * half;
            const h4 gv = *(const h4*)(gp + e0);
            h4 ov;
#pragma unroll
            for (int j = 0; j < 4; ++j) ov[j] = (_Float16)(o[et][4 * r4 + j] * inv * (float)gv[j]);
            *(h4*)(yb + e0) = ov;
        }
}

__device__ __forceinline__ void dsa_attend_block(const Params& p, int b, int jq, float* lds) {
    const int tid = tidx(), w = tid >> 6, lane = tid & 63, half = lane >> 5, col = lane & 31;
    const int grp = w & 3, hf = w >> 2, th = tid & 255;
    const int q0 = 32 * jq + 8 * grp, qi = q0 + (col >> 2), hd = col & 3;
    const int Tt = jq + 1, Th = (Tt + 1) >> 1;
    const int t0 = hf ? Th : 0, nt = hf ? Tt - Th : Th;
    __half* stg = (__half*)lds;
    const __half* qp = p.atq16 + (size_t)(b * S + qi) * W + hd * 128 + 8 * half;
    h8 qf[8];
#pragma unroll
    for (int ks = 0; ks < 8; ++ks) qf[ks] = *(const h8*)(qp + 16 * ks);
    f32x16 o[4];
#pragma unroll
    for (int et = 0; et < 4; ++et)
#pragma unroll
        for (int r = 0; r < 16; ++r) o[et][r] = 0.f;
    float m = -INFINITY, l = 0.f;
    const unsigned* mrow = p.mask + (size_t)(b * S + qi) * 64;
    const __half* kfb = p.kf16 + (size_t)b * 64 * 4096;
    const __half* vfb = p.vf16 + (size_t)b * 64 * 4096;
    h8 sr[4];
    __syncthreads();
    if (nt > 0) {
        sr[0] = *(const h8*)(kfb + (size_t)t0 * 4096 + th * 8); sr[1] = *(const h8*)(kfb + (size_t)t0 * 4096 + (th + 256) * 8);
        sr[2] = *(const h8*)(vfb + (size_t)t0 * 4096 + th * 8); sr[3] = *(const h8*)(vfb + (size_t)t0 * 4096 + (th + 256) * 8);
        __half* d = stg + (size_t)hf * 8192;
        *(h8*)(d + th * 8) = sr[0]; *(h8*)(d + (th + 256) * 8) = sr[1]; *(h8*)(d + 4096 + th * 8) = sr[2]; *(h8*)(d + 4096 + (th + 256) * 8) = sr[3];
    }
    unsigned mw = nt > 0 ? mrow[t0] : 0u;
    __syncthreads();
#pragma unroll 1
    for (int r = 0; r < Th; ++r) {
        const bool act = r < nt, nxt = r + 1 < nt;
        unsigned mwn = 0u;
        if (nxt) {
            const size_t tn = (size_t)(t0 + r + 1) * 4096;
            sr[0] = *(const h8*)(kfb + tn + th * 8); sr[1] = *(const h8*)(kfb + tn + (th + 256) * 8);
            sr[2] = *(const h8*)(vfb + tn + th * 8); sr[3] = *(const h8*)(vfb + tn + (th + 256) * 8);
            mwn = mrow[t0 + r + 1];
        }
        if (act) {
            const __half* st = stg + (size_t)((r & 1) * 2 + hf) * 8192 + lane * 8;
            const unsigned mws = mw >> (4 * half);
            f32x16 s;
#pragma unroll
            for (int i = 0; i < 16; ++i) s[i] = 0.f;
            h8 kf[8];
#pragma unroll
            for (int ks = 0; ks < 8; ++ks) kf[ks] = *(const h8*)(st + ks * 512);
#pragma unroll
            for (int ks = 0; ks < 8; ++ks) s = __builtin_amdgcn_mfma_f32_32x32x16_f16(kf[ks], qf[ks], s, 0, 0, 0);
            h8 vf[8];
#pragma unroll
            for (int i = 0; i < 8; ++i) vf[i] = *(const h8*)(st + 4096 + i * 512);
            float tmax = -INFINITY;
#pragma unroll
            for (int i = 0; i < 16; ++i) { s[i] = (mws & (1u << ((i & 3) + 8 * (i >> 2)))) ? s[i] : -INFINITY; tmax = fmaxf(tmax, s[i]); }
            { const auto sw = __builtin_amdgcn_permlane32_swap(__float_as_uint(tmax), __float_as_uint(tmax), false, false); tmax = fmaxf(__uint_as_float(sw[0]), __uint_as_float(sw[1])); }
            if (__any(tmax > m + 11.5f)) {
                const float mn = fmaxf(m, tmax), msf = mn == -INFINITY ? 0.f : mn;
                const float cs = __builtin_amdgcn_exp2f(m - msf);
                l *= cs; m = mn;
#pragma unroll
                for (int et = 0; et < 4; ++et)
#pragma unroll
                    for (int i = 0; i < 16; ++i) o[et][i] *= cs;
            }
            const float ms2 = m == -INFINITY ? 0.f : m;
            float ps = 0.f;
#pragma unroll
            for (int i = 0; i < 16; ++i) { s[i] = __builtin_amdgcn_exp2f(s[i] - ms2); ps += s[i]; }
            l += ps;
            h8 pb[2];
#pragma unroll
            for (int s2 = 0; s2 < 2; ++s2)
#pragma unroll
                for (int j = 0; j < 8; ++j) pb[s2][j] = (_Float16)s[8 * s2 + j];
#pragma unroll
            for (int et = 0; et < 4; ++et)
#pragma unroll
                for (int s2 = 0; s2 < 2; ++s2) o[et] = __builtin_amdgcn_mfma_f32_32x32x16_f16(vf[et * 2 + s2], pb[s2], o[et], 0, 0, 0);
        }
        if (nxt) {
            __half* d = stg + (size_t)(((r + 1) & 1) * 2 + hf) * 8192;
            *(h8*)(d + th * 8) = sr[0]; *(h8*)(d + (th + 256) * 8) = sr[1]; *(h8*)(d + 4096 + th * 8) = sr[2]; *(h8*)(d + 4096 + (th + 256) * 8) = sr[3];
        }
        mw = mwn;
        __syncthreads();
    }
    l += __shfl_xor(l, 32);
    float* mg = lds;
    if (hf == 1) {
        float* d = mg + (size_t)grp * 66 * 64 + lane;
#pragma unroll
        for (int et = 0; et < 4; ++et)
#pragma unroll
            for (int i = 0; i < 16; ++i) d[(et * 16 + i) * 64] = o[et][i];
        d[64 * 64] = m; d[65 * 64] = l;
    }
    __syncthreads();
    if (hf == 0) {
        const float* d = mg + (size_t)grp * 66 * 64 + lane;
        const float m2 = d[64 * 64], l2 = d[65 * 64];
        const float mn = fmaxf(m, m2), msf = mn == -INFINITY ? 0.f : mn;
        const float a1 = __builtin_amdgcn_exp2f(m - msf), a2 = __builtin_amdgcn_exp2f(m2 - msf);
        const float inv = 1.f / (l * a1 + l2 * a2);
        __half* yb = p.ys + (size_t)T * W + (size_t)(b * S + qi) * W + hd * 128;
        const __half* gp = p.atg16 + (size_t)(b * S + qi) * W + hd * 128;
#pragma unroll
        for (int et = 0; et < 4; ++et)
#pragma unroll
            for (int r4 = 0; r4 < 4; ++r4) {
                const int e0 = 32 * et + 8 * r4 + 4 * half;
                const h4 gv = *(const h4*)(gp + e0);
                h4 ov;
#pragma unroll
                for (int j = 0; j < 4; ++j) ov[j] = (_Float16)((o[et][4 * r4 + j] * a1 + d[(et * 16 + 4 * r4 + j) * 64] * a2) * inv * (float)gv[j]);
                *(h4*)(yb + e0) = ov;
            }
    }
    __syncthreads();
}

typedef __bf16 bf8 __attribute__((ext_vector_type(8)));
constexpr int HG_QS = 136;
constexpr int HG_VS = 72;
struct HgIn { float lf[16]; h8 q0, q1, v0, v1; };
__device__ __forceinline__ void hg_issue_loads(const Params& p, int tok0, int hd, int tid, bool need_q, HgIn& in) {
    const int d = tid & 127, seg = tid >> 7;
    const size_t base = (size_t)(tok0 + seg * 16) * W + hd * 128 + d;
#pragma unroll
    for (int i = 0; i < 16; ++i) in.lf[i] = p.lf32[base + (size_t)i * W];
#pragma unroll
    for (int i = 0; i < 8; ++i) { in.v0[i] = __builtin_bit_cast(_Float16, p.v16[base + (size_t)i * W]); in.v1[i] = __builtin_bit_cast(_Float16, p.v16[base + (size_t)(8 + i) * W]); }
    if (need_q) {
#pragma unroll
        for (int i = 0; i < 8; ++i) { in.q0[i] = __builtin_bit_cast(_Float16, p.q16[base + (size_t)i * W]); in.q1[i] = __builtin_bit_cast(_Float16, p.q16[base + (size_t)(8 + i) * W]); }
    }
}
__device__ __forceinline__ void hg_cumsum(int tid, float* segt, const float (&lf)[16], float (&bcs)[16], float& blast, float& bref) {
    const int d = tid & 127, seg = tid >> 7;
    float run = 0.f;
#pragma unroll
    for (int i = 0; i < 16; ++i) { run += lf[i]; bcs[i] = run; }
    segt[seg * 128 + d] = run;
    BAR_LDS();
    const float s0 = segt[d], s1 = segt[128 + d], s2 = segt[256 + d], s3 = segt[384 + d];
    const float off = seg == 0 ? 0.f : (seg == 1 ? s0 : (seg == 2 ? s0 + s1 : s0 + s1 + s2));
#pragma unroll
    for (int i = 0; i < 16; ++i) bcs[i] += off;
    blast = s0 + s1 + s2 + s3; bref = s0 + s1;
}
__device__ __forceinline__ void hg_pass1(const Params& p, int u, float* lds, const HgIn& in) {
    const int tid = tidx(), w = tid >> 6, lane = tid & 63, half = lane >> 5, col = lane & 31;
    const int c = u & 31, bh = u >> 5, hd = bh & 3, b = bh >> 2, tok0 = b * S + c * 64;
    __half* KH = (__half*)lds;
    __half* VT = KH + 128 * HG_VS;
    float* segt = (float*)(VT + 128 * HG_VS);
    BAR_LDS();
    float bcs[16], blast, bref;
    hg_cumsum(tid, segt, in.lf, bcs, blast, bref);
    {
        const int d = tid & 127, seg = tid >> 7;
        h8 k0, k1;
#pragma unroll
        for (int i = 0; i < 8; ++i) { k0[i] = (_Float16)((1.f - __expf(in.lf[i])) * __expf(blast - bcs[i])); k1[i] = (_Float16)((1.f - __expf(in.lf[8 + i])) * __expf(blast - bcs[8 + i])); }
        *(h8*)(KH + d * HG_VS + seg * 16) = k0; *(h8*)(KH + d * HG_VS + seg * 16 + 8) = k1;
        if (seg == 0) p.dec32[(size_t)u * 128 + d] = __expf(blast);
        *(h8*)(VT + d * HG_VS + seg * 16) = in.v0; *(h8*)(VT + d * HG_VS + seg * 16 + 8) = in.v1;
    }
    BAR_LDS();
    const int dt = w >> 1;
    h8 af[4];
#pragma unroll
    for (int ks = 0; ks < 4; ++ks) af[ks] = *(const h8*)(KH + (dt * 32 + col) * HG_VS + 16 * ks + 8 * half);
#pragma unroll
    for (int ee = 0; ee < 2; ++ee) {
        const int et = (w & 1) * 2 + ee;
        f32x16 acc;
#pragma unroll
        for (int r = 0; r < 16; ++r) acc[r] = 0.f;
#pragma unroll
        for (int ks = 0; ks < 4; ++ks) acc = __builtin_amdgcn_mfma_f32_32x32x16_f16(af[ks], *(const h8*)(VT + (et * 32 + col) * HG_VS + 16 * ks + 8 * half), acc, 0, 0, 0);
        __half* dst = p.stT16 + ((size_t)u * 128 + et * 32 + col) * 128 + dt * 32 + 4 * half;
#pragma unroll
        for (int r4 = 0; r4 < 4; ++r4) { h4 o = {(_Float16)acc[4 * r4], (_Float16)acc[4 * r4 + 1], (_Float16)acc[4 * r4 + 2], (_Float16)acc[4 * r4 + 3]}; *(h4*)(dst + 8 * r4) = o; }
    }
}
__device__ void hg_scan(const Params& p) {
    const int t = tidx();
    if (t >= 256) return;
    for (int gt = blockIdx.x * 256 + t; gt < 32 * 128 * 16; gt += gridDim.x * 256) {
    const int d8 = (gt & 15) * 8, e = (gt >> 4) & 127, bh = gt >> 11;
    float s[8];
#pragma unroll
    for (int j = 0; j < 8; ++j) s[j] = 0.f;
    for (int c = 0; c < 32; ++c) {
        const size_t u = (size_t)bh * 32 + c;
        h8* ptr = (h8*)(p.stT16 + (u * 128 + e) * 128 + d8);
        const h8 tv = *ptr;
        const f32x4 g0 = *(const f32x4*)(p.dec32 + u * 128 + d8), g1 = *(const f32x4*)(p.dec32 + u * 128 + d8 + 4);
        h8 o;
#pragma unroll
        for (int j = 0; j < 8; ++j) o[j] = (_Float16)s[j];
        *ptr = o;
#pragma unroll
        for (int j = 0; j < 4; ++j) { s[j] = g0[j] * s[j] + (float)tv[j]; s[4 + j] = g1[j] * s[4 + j] + (float)tv[4 + j]; }
    }
    }
}
__device__ __forceinline__ void hg_pass3(const Params& p, int l, int u, float* lds, const HgIn& in) {
    const int tid = tidx(), w = tid >> 6, lane = tid & 63, half = lane >> 5, col = lane & 31;
    const int c = u & 31, bh = u >> 5, hd = bh & 3, b = bh >> 2, tok0 = b * S + c * 64;
    __half* QI = (__half*)lds;
    __bf16* QM = (__bf16*)(QI + 64 * HG_QS);
    __bf16* KM = QM + 64 * HG_QS;
    __half* VT = (__half*)(KM + 64 * HG_QS);
    float* segt = (float*)(VT + 128 * HG_VS);
    float* part = segt + 512;
    const int tt = w & 1, et = w >> 1;
    h8 sf[8];
    {
        const __half* sp = p.stT16 + ((size_t)u * 128 + et * 32 + col) * 128 + 8 * half;
#pragma unroll
        for (int ks = 0; ks < 8; ++ks) sf[ks] = *(const h8*)(sp + 16 * ks);
    }
    const size_t ob = (size_t)(tok0 + tt * 32 + col) * W + hd * 128;
    h4 gv[4];
#pragma unroll
    for (int r4 = 0; r4 < 4; ++r4) gv[r4] = *(const h4*)(p.hgg16 + ob + et * 32 + 8 * r4 + 4 * half);
    BAR_LDS();
    float bcs[16], blast, bref;
    hg_cumsum(tid, segt, in.lf, bcs, blast, bref);
    {
        const int d = tid & 127, seg = tid >> 7;
#pragma unroll
        for (int i = 0; i < 16; ++i) {
            const int tk = seg * 16 + i;
            const float q = (float)(i < 8 ? in.q0[i & 7] : in.q1[i & 7]);
            QI[tk * HG_QS + d] = __float2half(q * __expf(bcs[i]));
            QM[tk * HG_QS + d] = (__bf16)(q * __expf(bcs[i] - bref));
            KM[tk * HG_QS + d] = (__bf16)((1.f - __expf(in.lf[i])) * __expf(bref - bcs[i]));
        }
        *(h8*)(VT + d * HG_VS + seg * 16) = in.v0; *(h8*)(VT + d * HG_VS + seg * 16 + 8) = in.v1;
    }
    BAR_LDS();
    h8 pb[2][2];
    bf8 qm[8];
#pragma unroll
    for (int ks = 0; ks < 8; ++ks) qm[ks] = *(const bf8*)(QM + (tt * 32 + col) * HG_QS + 16 * ks + 8 * half);
#pragma unroll
    for (int st = 0; st < 2; ++st) {
        if (st <= tt) {
            f32x16 sacc;
#pragma unroll
            for (int r = 0; r < 16; ++r) sacc[r] = 0.f;
#pragma unroll
            for (int ks = 0; ks < 8; ++ks) sacc = __builtin_amdgcn_mfma_f32_32x32x16_bf16(*(const bf8*)(KM + (st * 32 + col) * HG_QS + 16 * ks + 8 * half), qm[ks], sacc, 0, 0, 0);
#pragma unroll
            for (int r = 0; r < 16; ++r) {
                const int sl = (r & 3) + 8 * (r >> 2) + 4 * half;
                const float v = (st < tt || sl <= col) ? sacc[r] : 0.f;
                pb[st][r >> 3][r & 7] = (_Float16)v;
            }
        } else {
#pragma unroll
            for (int j = 0; j < 8; ++j) { pb[st][0][j] = (_Float16)0.f; pb[st][1][j] = (_Float16)0.f; }
        }
    }
    f32x16 o;
#pragma unroll
    for (int r = 0; r < 16; ++r) o[r] = 0.f;
#pragma unroll
    for (int st = 0; st < 2; ++st) {
        if (st <= tt) {
#pragma unroll
            for (int s2 = 0; s2 < 2; ++s2) {
                const __half* vp = VT + (et * 32 + col) * HG_VS + st * 32 + 16 * s2 + 4 * half;
                const h4 v0 = *(const h4*)vp, v1 = *(const h4*)(vp + 8);
                const h8 vf = {v0[0], v0[1], v0[2], v0[3], v1[0], v1[1], v1[2], v1[3]};
                o = __builtin_amdgcn_mfma_f32_32x32x16_f16(vf, pb[st][s2], o, 0, 0, 0);
            }
        }
    }
    {
#pragma unroll
        for (int ks = 0; ks < 8; ++ks) o = __builtin_amdgcn_mfma_f32_32x32x16_f16(sf[ks], *(const h8*)(QI + (tt * 32 + col) * HG_QS + 16 * ks + 8 * half), o, 0, 0, 0);
    }
    float ss = 0.f;
#pragma unroll
    for (int r = 0; r < 16; ++r) ss += o[r] * o[r];
    ss += __shfl_xor(ss, 32);
    if (half == 0) part[et * 64 + tt * 32 + col] = ss;
    BAR_LDS();
    const int tk = tt * 32 + col;
    const float tot = part[tk] + part[64 + tk] + part[128 + tk] + part[192 + tk];
    const float rs = rsqrtf(tot * (1.f / 128.f) + EPS);
    const float* on = p.onorm_g + l * 128;
#pragma unroll
    for (int r4 = 0; r4 < 4; ++r4) {
        const int e0 = et * 32 + 8 * r4 + 4 * half;
        const f32x4 nv = *(const f32x4*)(on + e0);
        h4 ov;
#pragma unroll
        for (int j = 0; j < 4; ++j) ov[j] = (_Float16)(o[4 * r4 + j] * rs * nv[j] * (float)gv[r4][j]);
        *(h4*)(p.ys + ob + e0) = ov;
    }
}

constexpr int S5_UP = 1032;
__device__ void s5_pow_table(const Params& p) {
    const size_t gtid = (size_t)blockIdx.x * 512 + tidx(), nth = (size_t)gridDim.x * 512;
    for (size_t i = gtid; i < (size_t)NL * 32 * 64 * 65; i += nth) {
        const int tau = (int)(i % 65); const size_t lgp = i / 65; const int lg = (int)(lgp / 64);
        const double dt = exp((double)p.log_dt[lg]);
        const double are = p.a_re[lgp], aim = p.a_im[lgp];
        const double mag = exp(are * dt * tau), ang = aim * dt * tau;
        p.pw[i * 2] = (float)(mag * cos(ang)); p.pw[i * 2 + 1] = (float)(mag * sin(ang));
    }
    for (size_t i = gtid; i < (size_t)NL * 32; i += nth) {
        const float sgv = exp2f(rintf(-p.log_dt[i] * 1.4426950408889634f));
        p.sg[i * 2] = sgv; p.sg[i * 2 + 1] = 1.f / sgv;
    }
}
constexpr size_t S5_KM_SZ = (size_t)32 * 64 * 256, S5_HG_SZ = (size_t)32 * 128 * 1024;
__device__ void s5_build_tables(const Params& p, int l, float* lds, int part, int nparts) {
    float* Cr = lds; float* Ci = Cr + 16 * 65; float* Br = Ci + 16 * 65; float* Bi = Br + 64 * 17; float* Wr = Bi + 64 * 17; float* Wi = Wr + 65 * 64;
    const int tid = tidx();
    __half* kmat16 = p.kmat16 + (size_t)(l & 1) * S5_KM_SZ; __half* hs16 = p.hs16 + (size_t)(l & 1) * S5_HG_SZ; __half* gs16 = p.gs16 + (size_t)(l & 1) * S5_HG_SZ;
    for (int item = part; item < 128; item += nparts) {
        const int g = item >> 2, q4 = item & 3; const size_t lg = (size_t)l * 32 + g;
        __syncthreads();
        for (int i = tid; i < 1024; i += 512) {
            const int c = i >> 6, s = i & 63; Cr[c * 65 + s] = p.c_re[(lg * 16 + c) * 64 + s]; Ci[c * 65 + s] = p.c_im[(lg * 16 + c) * 64 + s];
            const int s2 = i >> 4, cp = i & 15; Br[s2 * 17 + cp] = p.bbar[((lg * 64 + s2) * 16 + cp) * 2]; Bi[s2 * 17 + cp] = p.bbar[((lg * 64 + s2) * 16 + cp) * 2 + 1];
        }
        for (int i = tid; i < 64 * 65; i += 512) { const int s = i / 65, lag = i - 65 * s; Wr[lag * 64 + s] = p.pw[((lg * 64 + s) * 65 + lag) * 2]; Wi[lag * 64 + s] = p.pw[((lg * 64 + s) * 65 + lag) * 2 + 1]; }
        __syncthreads();
        const float sgv = p.sg[lg * 2];
#pragma unroll 1
        for (int k = 0; k < 8; ++k) {
            const int o = tid + 512 * k, cp = o & 15, c = (o >> 4) & 15, lag = q4 * 16 + (o >> 8);
            float acc = 0.f;
#pragma unroll 8
            for (int s = 0; s < 64; ++s) {
                const float cr = Cr[c * 65 + s], ci = Ci[c * 65 + s], wr = Wr[lag * 64 + s], wi = Wi[lag * 64 + s];
                acc += (cr * wr - ci * wi) * Br[s * 17 + cp] - (cr * wi + ci * wr) * Bi[s * 17 + cp];
            }
            kmat16[(((size_t)g * 64 + lag) * 16 + c) * 16 + cp] = __float2half(acc * sgv);
        }
#pragma unroll 1
        for (int k = 0; k < 8; ++k) {
            const int ch = tid + 512 * k, cp0 = (ch & 1) * 8, sig = (ch >> 1) & 63, n = q4 * 32 + (ch >> 7), s = n & 63;
            const float wr = Wr[(63 - sig) * 64 + s], wi = Wi[(63 - sig) * 64 + s];
            h8 o;
#pragma unroll
            for (int j = 0; j < 8; ++j) { const float br = Br[s * 17 + cp0 + j], bi = Bi[s * 17 + cp0 + j]; o[j] = (_Float16)((n < 64 ? wr * br - wi * bi : wr * bi + wi * br) * sgv); }
            *(h8*)(hs16 + ((size_t)g * 128 + n) * 1024 + sig * 16 + cp0) = o;
        }
#pragma unroll 1
        for (int k = 0; k < 8; ++k) {
            const int ch = tid + 512 * k, n0 = (ch & 15) * 8, c = (ch >> 4) & 15, tau = q4 * 16 + (ch >> 8), s0 = n0 & 63;
            h8 o;
#pragma unroll
            for (int j = 0; j < 8; ++j) {
                const float cr = Cr[c * 65 + s0 + j], ci = Ci[c * 65 + s0 + j], wr = Wr[(tau + 1) * 64 + s0 + j], wi = Wi[(tau + 1) * 64 + s0 + j];
                o[j] = (_Float16)(n0 < 64 ? cr * wr - ci * wi : -(cr * wi + ci * wr));
            }
            *(h8*)(gs16 + ((size_t)g * 1024 + tau * 16 + c) * 128 + n0) = o;
        }
    }
    __syncthreads();
}
__device__ __forceinline__ void s5_load_u(const Params& p, int g, int b, int tid, __half* U) {
#pragma unroll
    for (int i = 0; i < 4; ++i) {
        const int idx = tid + 512 * i, ch = idx >> 6, sig = idx & 63;
        const h8* src = (const h8*)(p.s5u16 + (size_t)(b * S + ch * 64 + sig) * W + g * 16);
        const h8 a = src[0], c2 = src[1];
        *(h8*)(U + ch * S5_UP + sig * 16) = a; *(h8*)(U + ch * S5_UP + sig * 16 + 8) = c2;
    }
}
__device__ void s5_pass1(const Params& p, int l, int g, int b, float* lds) {
    const int tid = tidx(), w = tid >> 6, lane = tid & 63, half = lane >> 5, col = lane & 31;
    __half* U = (__half*)lds;
    float* part = (float*)(U + 32 * S5_UP);
    __syncthreads();
    s5_load_u(p, g, b, tid, U);
    __syncthreads();
    const int nt = w & 3, sh = w >> 2;
    const __half* hp = p.hs16 + (size_t)(l & 1) * S5_HG_SZ + ((size_t)g * 128 + nt * 32 + col) * 1024 + 8 * half;
    const __half* up = U + col * S5_UP + 8 * half;
    f32x16 acc;
#pragma unroll
    for (int r = 0; r < 16; ++r) acc[r] = 0.f;
#pragma unroll 8
    for (int sig = sh * 32; sig < sh * 32 + 32; ++sig) acc = __builtin_amdgcn_mfma_f32_32x32x16_f16(*(const h8*)(hp + sig * 16), *(const h8*)(up + sig * 16), acc, 0, 0, 0);
    if (sh == 1) {
#pragma unroll
        for (int r = 0; r < 16; ++r) part[(nt * 16 + r) * 64 + lane] = acc[r];
    }
    __syncthreads();
    if (sh == 0) {
        float* ep = p.e32 + (((size_t)g * 8 + b) * 32 + col) * 128 + nt * 32 + 4 * half;
#pragma unroll
        for (int r4 = 0; r4 < 4; ++r4) {
            f32x4 o;
#pragma unroll
            for (int j = 0; j < 4; ++j) o[j] = acc[4 * r4 + j] + part[(nt * 16 + 4 * r4 + j) * 64 + lane];
            *(f32x4*)(ep + 8 * r4) = o;
        }
    }
}
__device__ void s5_scan(const Params& p, int l) {
    const int t = tidx();
    if (t < 256 || t >= 320) return;
    for (int gt = blockIdx.x * 64 + (t - 256); gt < 32 * 8 * 64; gt += gridDim.x * 64) {
    const int s = gt & 63, b = (gt >> 6) & 7, g = gt >> 9;
    const size_t lg = (size_t)l * 32 + g;
    const float ar = p.pw[((lg * 64 + s) * 65 + 64) * 2], ai = p.pw[((lg * 64 + s) * 65 + 64) * 2 + 1];
    float xr = 0.f, xi = 0.f;
    for (int c = 0; c < 32; ++c) {
        const size_t base = (((size_t)g * 8 + b) * 32 + c) * 128;
        p.x16[base + s] = __float2half(xr); p.x16[base + 64 + s] = __float2half(xi);
        const float er = p.e32[base + s], ei = p.e32[base + 64 + s];
        const float nr = ar * xr - ai * xi + er, ni = ar * xi + ai * xr + ei;
        xr = nr; xi = ni;
    }
    }
}
__device__ void s5_pass3(const Params& p, int l, int g, int b, float* lds) {
    const int tid = tidx(), w = tid >> 6, lane = tid & 63, half = lane >> 5, col = lane & 31;
    __half* U = (__half*)lds;
    __half* KM = U + 32 * S5_UP;
    __syncthreads();
    s5_load_u(p, g, b, tid, U);
    for (int i = tid; i < 64 * 256 / 8; i += 512) *(h8*)(KM + i * 8) = *(const h8*)(p.kmat16 + (size_t)(l & 1) * S5_KM_SZ + (size_t)g * 64 * 256 + i * 8);
    __syncthreads();
    h8 xb[8];
    {
        const __half* xp = p.x16 + (((size_t)g * 8 + b) * 32 + col) * 128 + 8 * half;
#pragma unroll
        for (int ks = 0; ks < 8; ++ks) xb[ks] = *(const h8*)(xp + 16 * ks);
    }
    const float isg = p.sg[((size_t)l * 32 + g) * 2 + 1];
    const __half* up = U + col * S5_UP + 8 * half;
    const int cch = col & 15, tl = col >> 4;
#pragma unroll 1
    for (int rt = w; rt < 32; rt += 8) {
        f32x16 acc;
#pragma unroll
        for (int r = 0; r < 16; ++r) acc[r] = 0.f;
        const int tau = 2 * rt + tl;
#pragma unroll 2
        for (int sig = 0; sig <= 2 * rt + 1; ++sig) {
            const int lag = tau - sig;
            h8 a;
            if (lag >= 0) a = *(const h8*)(KM + (lag * 16 + cch) * 16 + 8 * half);
            else {
#pragma unroll
                for (int j = 0; j < 8; ++j) a[j] = (_Float16)0.f;
            }
            acc = __builtin_amdgcn_mfma_f32_32x32x16_f16(a, *(const h8*)(up + sig * 16), acc, 0, 0, 0);
        }
        const __half* gp = p.gs16 + (size_t)(l & 1) * S5_HG_SZ + ((size_t)g * 1024 + 2 * rt * 16 + col) * 128 + 8 * half;
#pragma unroll
        for (int ks = 0; ks < 8; ++ks) acc = __builtin_amdgcn_mfma_f32_32x32x16_f16(*(const h8*)(gp + 16 * ks), xb[ks], acc, 0, 0, 0);
#pragma unroll
        for (int r4 = 0; r4 < 4; ++r4) {
            const int tloc = r4 >> 1, c0 = 8 * (r4 & 1) + 4 * half;
            const int tk = 2 * rt + tloc;
            const h4 uv = *(const h4*)(U + col * S5_UP + tk * 16 + c0);
            const f32x4 dv = *(const f32x4*)(p.s5_d + l * W + g * 16 + c0);
            h4 ov;
#pragma unroll
            for (int j = 0; j < 4; ++j) ov[j] = (_Float16)gelu_tanh_f(acc[4 * r4 + j] * isg + dv[j] * (float)uv[j]);
            *(h4*)(p.ypre16 + (size_t)(b * S + col * 64 + tk) * W + g * 16 + c0) = ov;
        }
    }
}

__device__ void phase_mix1(const Params& p, int l, float* lds) {
    const int c = blockIdx.x, G = gridDim.x;
    phase_fix(p, l, lds);
    for (int u = c; u < 256; u += G) s5_pass1(p, l, u >> 3, u & 7, lds);
#pragma unroll 1
    for (int u = c; u < 1024; u += G) {
        HgIn cur; const int bh = u >> 5;
        hg_issue_loads(p, (bh >> 2) * S + (u & 31) * 64, bh & 3, tidx(), false, cur);
        hg_pass1(p, u, lds, cur);
    }
    __syncthreads();
}
__device__ void phase_mix2(const Params& p, int l, float* lds) {
    const int c = blockIdx.x, G = gridDim.x;
    s5_scan(p, l);
    hg_scan(p);
    __syncthreads();
    for (int cb = c; cb < 256; cb += G) {
        const int b = cb >> 5, cc = cb & 31, k = cc & 15;
#pragma unroll 1
        for (int i = 0; i < 4; ++i) {
            const int j = cc < 16 ? (i == 0 ? k : (i == 1 ? 80 + k : (i == 2 ? 111 - k : 112 + k)))
                                  : (i == 0 ? 16 + k : (i == 1 ? 47 - k : (i == 2 ? 48 + k : 79 - k)));
            dsa_select(p, b, j * 16, lds);
        }
    }
}
__device__ void phase_mix3(const Params& p, int l, float* lds) {
    for (int c = blockIdx.x; c < 256; c += gridDim.x) {
        const int b = c >> 5, cc = c & 31;
#pragma unroll 1
        for (int k = 0; k < 2; ++k) dsa_attend_block(p, b, k ? 63 - cc : cc, lds);
    }
    for (int u = blockIdx.x; u < 256; u += gridDim.x) s5_pass3(p, l, u >> 3, u & 7, lds);
#pragma unroll 1
    for (int u = blockIdx.x; u < 1024; u += gridDim.x) {
        HgIn cur; const int bh = u >> 5;
        hg_issue_loads(p, (bh >> 2) * S + (u & 31) * 64, bh & 3, tidx(), true, cur);
        hg_pass3(p, l, u, lds, cur);
    }
    __syncthreads();
}

#define XB_TMO      128
#define XB_XCNT(j)  (256  + 64 * (j))
#define XB_XSUB(j)  (1280 + 64 * (j))
#define XB_XGEN(j)  (2304 + 64 * (j))
#define XB_TOP      3328
#define XB_TOPGEN   3392
#define XCD_BAR_WORDS 3456
#define XB_SPIN_CAP (1u << 22)
__device__ __forceinline__ unsigned xb_ld(unsigned* p)              { return __hip_atomic_load(p, __ATOMIC_RELAXED, __HIP_MEMORY_SCOPE_AGENT); }
__device__ __forceinline__ unsigned xb_add(unsigned* p, unsigned v) { return __hip_atomic_fetch_add(p, v, __ATOMIC_RELAXED, __HIP_MEMORY_SCOPE_AGENT); }
__device__ __forceinline__ unsigned xb_xcc_id() { return (unsigned)__builtin_amdgcn_s_getreg((3 << 11) | 20) & 0xFu; }
#define XB_SPIN(cond, bar) do { unsigned _sp = 0; while (cond) { __builtin_amdgcn_s_sleep(1); \
    if ((++_sp & 255u) == 0u) { if (xb_ld(&(bar)[XB_TMO])) break; if (_sp > XB_SPIN_CAP) { atomicAdd(&(bar)[XB_TMO], 1u); break; } } } } while (0)
struct XcdBarrier { unsigned* bar; unsigned x; volatile LAS unsigned* st; };
__device__ __forceinline__ XcdBarrier xcd_barrier_post(unsigned* bar, volatile LAS unsigned* st) {
    XcdBarrier b; b.bar = bar; b.x = xb_xcc_id(); b.st = st;
    if (threadIdx.x == 0) (void)xb_add(&bar[XB_XCNT(b.x)], 1u);
    return b;
}
__device__ __forceinline__ void xcd_barrier_complete(unsigned* bar, unsigned x, unsigned& nloc, unsigned& nx) {
    const unsigned G = gridDim.x * gridDim.y * gridDim.z;
    unsigned sum, cnt, mine, sp = 0u;
    for (;;) {
        sum = 0u; cnt = 0u; mine = 0u;
#pragma unroll
        for (unsigned j = 0; j < 16; ++j) { const unsigned c = xb_ld(&bar[XB_XCNT(j)]); sum += c; cnt += (c > 0u) ? 1u : 0u; mine = (j == x) ? c : mine; }
        if (sum == G) break;
        __builtin_amdgcn_s_sleep(1);
        if ((++sp & 255u) == 0u) { if (xb_ld(&bar[XB_TMO])) break; if (sp > XB_SPIN_CAP) { atomicAdd(&bar[XB_TMO], 1u); break; } }
    }
    nloc = mine > 0u ? mine : 1u; nx = cnt > 0u ? cnt : 1u;
}
__device__ __forceinline__ void xcd_barrier(const XcdBarrier& b) {
    asm volatile("s_waitcnt vmcnt(0)" ::: "memory");
    __syncthreads();
    if (threadIdx.x == 0) {
        unsigned* bar = b.bar;
        __builtin_amdgcn_s_waitcnt(0);
        unsigned nloc = b.st[0], nx = b.st[1];
        if (nloc == 0u) { xcd_barrier_complete(bar, b.x, nloc, nx); b.st[0] = nloc; b.st[1] = nx; }
        const unsigned old = xb_add(&bar[XB_XSUB(b.x)], 1u);
        const unsigned gen = old / nloc;
        if (old + 1u == (gen + 1u) * nloc) {
            __builtin_amdgcn_fence(__ATOMIC_RELEASE, "agent");
            asm volatile("s_waitcnt vmcnt(0)" ::: "memory");
            const unsigned og = xb_add(&bar[XB_TOP], 1u);
            const unsigned tg = og / nx;
            if (og + 1u == (tg + 1u) * nx) xb_add(&bar[XB_TOPGEN], 1u);
            else XB_SPIN(xb_ld(&bar[XB_TOPGEN]) == tg, bar);
            __builtin_amdgcn_fence(__ATOMIC_ACQUIRE, "agent");
            xb_add(&bar[XB_XGEN(b.x)], 1u);
            asm volatile("s_waitcnt vmcnt(0)" ::: "memory");
        } else {
            XB_SPIN(xb_ld(&bar[XB_XGEN(b.x)]) == gen, bar);
            __builtin_amdgcn_fence(__ATOMIC_ACQUIRE, "agent");
            asm volatile("s_waitcnt vmcnt(0)" ::: "memory");
        }
    }
    __syncthreads();
}

typedef const __attribute__((address_space(4))) Params* KParams;
#define PHASE_PARAMS() KParams _kp = (KParams)__builtin_amdgcn_kernarg_segment_ptr(); asm volatile("" : "+s"(_kp)); const Params& p = *(const Params*)_kp
__global__ void __launch_bounds__(512, 2) mega(Params p_unused) {
    extern __shared__ __attribute__((aligned(16))) float lds[];
    LAS unsigned char* ldsb = (LAS unsigned char*)lds;
    cg::grid_group grid = cg::this_grid();
    const int G = gridDim.x, c = blockIdx.x;
    __shared__ uint4 xb_words;
    if (threadIdx.x == 0) xb_words = make_uint4(0u, 0u, 0u, 0u);
    __syncthreads();
    XcdBarrier xbar;
    { PHASE_PARAMS(); xbar = xcd_barrier_post(p.xbar, (volatile LAS unsigned*)&xb_words); }
    { PHASE_PARAMS(); phase0(p); s5_pow_table(p); }
    grid.sync();
    for (int l = 0; l < NL; ++l) {
        { PHASE_PARAMS(); conv_layer(p, l, lds); phase_h(p, l); if (l == 0) s5_build_tables(p, 0, lds, c, G); }
        xcd_barrier(xbar);
        {
            PHASE_PARAMS();
            SchedPlain sc{(const char*)p.h16, (const char*)p.win16, 64, 32, G, c, D};
            EpiProj ep{p.q16, p.v16, p.hgg16, p.atq16, p.atk16, p.atv16, p.atg16, p.ixq16, p.ixk16, p.s5u16, p.s5g16, p.mg16, p.lf32, p.ixw32, p.lb + l * 512};
            pg::gemm_phase(ldsb, D, sc, ep);
        }
        xcd_barrier(xbar);
        { PHASE_PARAMS(); phase_mix1(p, l, lds); }
        xcd_barrier(xbar);
        { PHASE_PARAMS(); phase_mix2(p, l, lds); }
        xcd_barrier(xbar);
        { PHASE_PARAMS(); phase_mix3(p, l, lds); }
        xcd_barrier(xbar);
        {
            PHASE_PARAMS();
            SchedPlain sc{(const char*)p.ypre16, (const char*)p.wglu16, 64, 2, G, c, W};
            EpiGlu ep{p.ypre16, p.s5g16, p.glu_b + l * W, p.ys + (size_t)2 * T * W, nullptr};
            pg::gemm_phase(ldsb, W, sc, ep);
            if (c >= 128 && l + 1 < NL) s5_build_tables(p, l + 1, lds, c - 128, G - 128);
        }
        xcd_barrier(xbar);
        {
            PHASE_PARAMS();
            SchedMerge sc{(const char*)p.ys, (const char*)p.wb16, G, c};
            EpiMerge ep{(const unsigned char*)p.mg16, p.merged16};
            pg::gemm_phase(ldsb, W, sc, ep);
        }
        xcd_barrier(xbar);
        {
            PHASE_PARAMS();
            SchedPlain sc{(const char*)p.merged16, (const char*)p.wo16, 64, 4, G, c, D};
            EpiOut ep{l == 0 ? p.x : p.out, p.out, p.mod + (size_t)l * NB * 3072 + 2 * D};
            pg::gemm_phase(ldsb, D, sc, ep);
        }
        xcd_barrier(xbar);
    }
}

extern "C" void kernel_launch(void* const* d_in, const int* in_sizes, int n_in,
                              void* d_out, int out_size, void* d_ws, size_t ws_size,
                              hipStream_t stream) {
    static int grid_blocks = 0;
    if (!grid_blocks) {
        int dev = 0, cus = 0, per_cu = 0;
        (void)hipGetDevice(&dev);
        (void)hipDeviceGetAttribute(&cus, hipDeviceAttributeMultiprocessorCount, dev);
        (void)hipFuncSetAttribute((const void*)mega, hipFuncAttributeMaxDynamicSharedMemorySize, LDS_BYTES);
        (void)hipOccupancyMaxActiveBlocksPerMultiprocessor(&per_cu, mega, 512, LDS_BYTES);
        if (per_cu > 1) per_cu = 1;
        grid_blocks = cus * per_cu;
    }
    Params p{};
    const float* const* in = (const float* const*)d_in;
    p.x = in[0]; p.c = in[1]; p.pos = (const int*)d_in[2];
    p.ada_w = in[3]; p.ada_b = in[4]; p.norm_g = in[5]; p.w_in = in[6]; p.lb_logits = in[7]; p.onorm_g = in[8]; p.qn_g = in[9]; p.kn_g = in[10];
    p.a_re = in[11]; p.a_im = in[12]; p.log_dt = in[13]; p.b_re = in[14]; p.b_im = in[15]; p.c_re = in[16]; p.c_im = in[17]; p.s5_d = in[18];
    p.glu_w = in[19]; p.glu_b = in[20]; p.w_branch = in[21]; p.w_out = in[22];
    p.out = (float*)d_out;
    char* ws = (char*)d_ws; size_t off = 0;
    auto take = [&](size_t bytes) { char* q = ws + off; off += (bytes + 255) & ~(size_t)255; return q; };
    const size_t TW2 = (size_t)T * W * 2;
    p.mod = (float*)take((size_t)NL * NB * 3072 * 4);
    p.lb = (float*)take((size_t)NL * 512 * 4);
    p.abar = (float*)take((size_t)NL * 32 * 64 * 2 * 4);
    p.bbar = (float*)take((size_t)NL * 32 * 64 * 16 * 2 * 4);
    p.ropeA = (float*)take((size_t)T * 64 * 2 * 4);
    p.ropeI = (float*)take((size_t)T * 32 * 2 * 4);
    p.win16 = (__half*)take((size_t)NPK * D * 2);
    p.wb16 = (__half*)take((size_t)3 * D * W * 2);
    p.wo16 = (__half*)take((size_t)D * D * 2);
    p.wglu16 = (__half*)take((size_t)W * W * 2);
    p.h16 = (__half*)take((size_t)T * D * 2);       p.merged16 = p.h16; p.stT16 = p.h16;
    p.q16 = (__half*)take(TW2);                     p.mp32 = (float*)p.q16;
    p.lf32 = (float*)take((size_t)T * W * 4);
    p.v16 = (__half*)take(TW2);
    p.hgg16 = (__half*)take(TW2);
    p.atq16 = (__half*)take(TW2);
    p.atk16 = (__half*)take((size_t)T * 128 * 2);
    p.atv16 = (__half*)take((size_t)T * 128 * 2);
    p.atg16 = (__half*)take(TW2);
    p.ixq16 = (__half*)take(TW2);
    p.ixk16 = (__half*)take((size_t)T * 64 * 2);
    p.ixw32 = (float*)take((size_t)T * 8 * 4);
    p.s5u16 = (__half*)take(TW2);
    p.s5g16 = (__half*)take(TW2);
    p.mg16 = (__half*)take((size_t)T * 3072 * 2);
    p.ys = (__half*)take(3 * TW2);
    p.ypre16 = (__half*)take(TW2);
    p.dbg = (unsigned*)take(256);
    p.xbar = (unsigned*)take((size_t)XCD_BAR_WORDS * 4);
    p.pw = (float*)take((size_t)NL * 32 * 64 * 65 * 2 * 4);
    p.sg = (float*)take((size_t)NL * 32 * 2 * 4);
    p.kmat16 = (__half*)take((size_t)2 * 32 * 64 * 256 * 2);
    p.hs16 = (__half*)take((size_t)2 * 32 * 128 * 1024 * 2);
    p.gs16 = (__half*)take((size_t)2 * 32 * 1024 * 128 * 2);
    p.e32 = (float*)take((size_t)32 * 8 * 32 * 128 * 4);
    p.x16 = (__half*)take((size_t)32 * 8 * 32 * 128 * 2);
    p.dec32 = (float*)take((size_t)1024 * 128 * 4);
    p.mask = (unsigned*)take((size_t)T * 64 * 4);
    p.kf16 = (__half*)take((size_t)T * 128 * 2);
    p.vf16 = (__half*)take((size_t)T * 128 * 2);
    p.ikf16 = (__half*)take((size_t)T * 64 * 2);
    if (off > ws_size) { fprintf(stderr, "workspace too small: need %zu have %zu\n", off, ws_size); return; }
    (void)hipMemsetAsync(p.xbar, 0, (size_t)XCD_BAR_WORDS * 4, stream);
    (void)hipMemsetAsync(p.mod, 0, (size_t)NL * NB * 3072 * 4, stream);
    void* args[] = {&p};
    hipError_t e = hipLaunchCooperativeKernel((void*)mega, dim3(grid_blocks), dim3(512), args, LDS_BYTES, stream);
    if (e != hipSuccess) fprintf(stderr, "cooperative launch failed: %s (grid %d)\n", hipGetErrorString(e), grid_blocks);
}
```

```cpp
#include <hip/hip_runtime.h>
#include <hip/hip_cooperative_groups.h>
#include <hip/hip_fp16.h>
#include <cstdio>
namespace cg = cooperative_groups;

constexpr int D = 1024, NB = 8, S = 2048, T = NB * S, NL = 4, W = 512, NIN = 8008, NPK = 8192;
constexpr int C_S5U = 3912, C_MG = 4936;
constexpr float EPS = 1e-6f;
constexpr int LDS_BYTES = 135168;
#define LAS __attribute__((address_space(3)))
typedef _Float16 h8 __attribute__((ext_vector_type(8)));
typedef _Float16 h2 __attribute__((ext_vector_type(2)));
typedef float f32x4 __attribute__((ext_vector_type(4)));
typedef unsigned u32x4 __attribute__((ext_vector_type(4)));

struct Params {
    const float *x, *c; const int* pos;
    const float *ada_w, *ada_b, *norm_g, *w_in, *lb_logits, *onorm_g, *qn_g, *kn_g;
    const float *a_re, *a_im, *log_dt, *b_re, *b_im, *c_re, *c_im, *s5_d, *glu_w, *glu_b, *w_branch, *w_out;
    float* out;
    float *mod, *lb, *abar, *bbar, *ropeA, *ropeI;
    __half *win16, *wb16, *wo16, *wglu16;
    __half *h16, *q16, *v16, *hgg16, *atq16, *atk16, *atv16, *atg16, *ixq16, *ixk16, *s5u16, *s5g16, *mg16, *ys, *ypre16, *merged16;
    float *lf32, *ixw32, *mp32; unsigned* dbg; unsigned* mask; unsigned* xbar; __half *kf16, *vf16, *ikf16; __half* stT16; float* dec32; float *pw, *sg, *e32; __half *kmat16, *hs16, *gs16, *x16, *xr16;
};

__device__ __forceinline__ float sigmoid_f(float v) { return 1.f / (1.f + expf(-v)); }
__device__ __forceinline__ float silu_f(float v) { return v / (1.f + expf(-v)); }
__device__ __forceinline__ float gelu_tanh_f(float v) { const float u = 0.7978845608028654f * (v + 0.044715f * v * v * v); return v * __builtin_amdgcn_rcpf(1.f + __builtin_amdgcn_exp2f(-2.885390081777927f * u)); }
__device__ __forceinline__ float wave_sum(float v) {
#pragma unroll
    for (int o = 32; o > 0; o >>= 1) v += __shfl_xor(v, o);
    return v;
}
__device__ __forceinline__ void lds_fence() { asm volatile("s_waitcnt lgkmcnt(0)" ::: "memory"); }
#define BAR_LDS() do { asm volatile("s_waitcnt lgkmcnt(0)" ::: "memory"); __builtin_amdgcn_s_barrier(); asm volatile("" ::: "memory"); } while (0)
__device__ __forceinline__ int tidx() { int t = threadIdx.x; asm volatile("" : "+v"(t)); return t; }

__device__ void phase0(const Params& p) {
    const size_t gtid = (size_t)blockIdx.x * blockDim.x + tidx(), nth = (size_t)gridDim.x * blockDim.x;
    {
        for (size_t i = gtid; i < (size_t)NL * 3072 * 8; i += nth) {
            const int col = (int)(i % 3072), ksl = (int)((i / 3072) % 8), l = (int)(i / (3072 * 8));
            const float* w = p.ada_w + ((size_t)l * 1024 + ksl * 128) * 3072 + col;
            float acc[NB];
#pragma unroll
            for (int b = 0; b < NB; ++b) acc[b] = ksl == 0 ? p.ada_b[l * 3072 + col] : 0.f;
#pragma unroll 4
            for (int k = 0; k < 128; ++k) {
                const float wv = w[(size_t)k * 3072];
#pragma unroll
                for (int b = 0; b < NB; ++b) { const float cv = p.c[b * 1024 + ksl * 128 + k]; acc[b] += cv * __builtin_amdgcn_rcpf(1.f + __builtin_amdgcn_exp2f(-1.4426950408889634f * cv)) * wv; }
            }
#pragma unroll
            for (int b = 0; b < NB; ++b) atomicAdd(p.mod + ((size_t)l * NB + b) * 3072 + col, acc[b]);
        }
    }
    for (size_t i = gtid; i < 512; i += nth) {
        float lg[NL], mx = -1e30f;
#pragma unroll
        for (int l = 0; l < NL; ++l) { lg[l] = p.lb_logits[l * 512 + i]; mx = fmaxf(mx, lg[l]); }
        float s = 0.f;
#pragma unroll
        for (int l = 0; l < NL; ++l) { lg[l] = expf(lg[l] - mx); s += lg[l]; }
        float cum = 0.f;
#pragma unroll
        for (int l = 0; l < NL; ++l) { const float pr = lg[l] / s; cum += pr; p.lb[l * 512 + i] = cum - lg[0] / s; }
    }
    for (size_t i = gtid; i < (size_t)NL * 32 * 64; i += nth) {
        const int lg = (int)(i / 64);
        const double dt = exp((double)p.log_dt[lg]);
        const double are = p.a_re[i], aim = p.a_im[i];
        const double mag = exp(are * dt), ang = aim * dt;
        const double abr = mag * cos(ang), abi = mag * sin(ang);
        const double nr = abr - 1.0, ni = abi, den = are * are + aim * aim;
        const double fr = (nr * are + ni * aim) / den, fi = (ni * are - nr * aim) / den;
        p.abar[i * 2] = (float)abr; p.abar[i * 2 + 1] = (float)abi;
        for (int c = 0; c < 16; ++c) {
            const double br = p.b_re[i * 16 + c], bi = p.b_im[i * 16 + c];
            p.bbar[(i * 16 + c) * 2] = (float)(fr * br - fi * bi);
            p.bbar[(i * 16 + c) * 2 + 1] = (float)(fr * bi + fi * br);
        }
    }
    {
        const double invA = pow(10000.0, -(double)(2 * (int)(gtid % 64)) / 128.0), invI = pow(10000.0, -(double)(2 * (int)(gtid % 32)) / 64.0);
        const bool fixedj = (nth % 64) == 0;
        for (size_t i = gtid; i < (size_t)T * 64; i += nth) {
            const int t = (int)(i / 64), j = (int)(i % 64);
            const double inv = fixedj ? invA : pow(10000.0, -(double)(2 * j) / 128.0);
            double sn, cs; sincos((double)p.pos[t] * inv, &sn, &cs);
            p.ropeA[i * 2] = (float)cs; p.ropeA[i * 2 + 1] = (float)sn;
        }
        for (size_t i = gtid; i < (size_t)T * 32; i += nth) {
            const int t = (int)(i / 32), j = (int)(i % 32);
            const double inv = fixedj ? invI : pow(10000.0, -(double)(2 * j) / 64.0);
            double sn, cs; sincos((double)p.pos[t] * inv, &sn, &cs);
            p.ropeI[i * 2] = (float)cs; p.ropeI[i * 2 + 1] = (float)sn;
        }
    }
}

__device__ __forceinline__ unsigned pk2(float a, float b) { h2 v = {(_Float16)a, (_Float16)b}; return __builtin_bit_cast(unsigned, v); }
__device__ void phase_h(const Params& p, int l) {
    const int w = tidx() >> 6, lane = tidx() & 63;
    for (int ri = blockIdx.x * 8 + w; ri < T; ri += gridDim.x * 8) {
        const int row = (((ri >> 3) & 7) << 11) | (((ri >> 11) & 7) << 8) | (((ri >> 6) & 31) << 3) | (ri & 7);
        const int b = row / S;
        float v[16]; float ss = 0.f;
        if (l == 0) {
            const float* xr = p.x + (size_t)row * D + lane * 8;
#pragma unroll
            for (int i = 0; i < 2; ++i) {
                const float4 a = *(const float4*)(xr + i * 512), c = *(const float4*)(xr + i * 512 + 4);
                v[i * 8 + 0] = a.x; v[i * 8 + 1] = a.y; v[i * 8 + 2] = a.z; v[i * 8 + 3] = a.w; v[i * 8 + 4] = c.x; v[i * 8 + 5] = c.y; v[i * 8 + 6] = c.z; v[i * 8 + 7] = c.w;
            }
        } else {
            const __half* xr = p.xr16 + (size_t)row * D + lane * 8;
#pragma unroll
            for (int i = 0; i < 2; ++i) {
                const h8 a = *(const h8*)(xr + i * 512);
#pragma unroll
                for (int j = 0; j < 8; ++j) v[i * 8 + j] = (float)a[j];
            }
        }
#pragma unroll
        for (int j = 0; j < 16; ++j) ss += v[j] * v[j];
        ss = wave_sum(ss);
        const float r = rsqrtf(ss * (1.f / D) + EPS);
        const float* md = p.mod + ((size_t)l * NB + b) * 3072;
#pragma unroll
        for (int i = 0; i < 2; ++i) {
            const int k = i * 512 + lane * 8;
            uint4 o;
            {
                const float4 g = *(const float4*)(p.norm_g + l * D + k), sh = *(const float4*)(md + k), sc = *(const float4*)(md + D + k);
                o.x = pk2(v[i * 8 + 0] * r * g.x * (1.f + sc.x) + sh.x, v[i * 8 + 1] * r * g.y * (1.f + sc.y) + sh.y);
                o.y = pk2(v[i * 8 + 2] * r * g.z * (1.f + sc.z) + sh.z, v[i * 8 + 3] * r * g.w * (1.f + sc.w) + sh.w);
            }
            {
                const float4 g = *(const float4*)(p.norm_g + l * D + k + 4), sh = *(const float4*)(md + k + 4), sc = *(const float4*)(md + D + k + 4);
                o.z = pk2(v[i * 8 + 4] * r * g.x * (1.f + sc.x) + sh.x, v[i * 8 + 5] * r * g.y * (1.f + sc.y) + sh.y);
                o.w = pk2(v[i * 8 + 6] * r * g.z * (1.f + sc.z) + sh.z, v[i * 8 + 7] * r * g.w * (1.f + sc.w) + sh.w);
            }
            *(uint4*)(p.h16 + (size_t)row * D + k) = o;
        }
    }
}
template <class CM>
__device__ void conv_transpose(const float* __restrict__ src, int ldsrc, int K, __half* __restrict__ dst, int N, CM colmap, float* lds, int part, int nparts) {
    float (*ts)[65] = (float (*)[65])lds;
    const int tid = tidx(), nkt = K / 64, nnt = N / 64;
    for (int tile = part; tile < nkt * nnt; tile += nparts) {
        const int kt = tile % nkt, nt = tile / nkt, k0 = kt * 64, n0 = nt * 64;
        __syncthreads();
#pragma unroll
        for (int i = 0; i < 8; ++i) {
            const int idx = tid + 512 * i, k = idx >> 6, n = idx & 63;
            const int sc = colmap(n0 + n);
            ts[k][n] = sc >= 0 ? src[(size_t)(k0 + k) * ldsrc + sc] : 0.f;
        }
        __syncthreads();
        const int n = tid >> 3, k8 = (tid & 7) * 8;
        u32x4 w;
        { h2 a = {(_Float16)ts[k8 + 0][n], (_Float16)ts[k8 + 1][n]}; w.x = __builtin_bit_cast(unsigned, a); }
        { h2 a = {(_Float16)ts[k8 + 2][n], (_Float16)ts[k8 + 3][n]}; w.y = __builtin_bit_cast(unsigned, a); }
        { h2 a = {(_Float16)ts[k8 + 4][n], (_Float16)ts[k8 + 5][n]}; w.z = __builtin_bit_cast(unsigned, a); }
        { h2 a = {(_Float16)ts[k8 + 6][n], (_Float16)ts[k8 + 7][n]}; w.w = __builtin_bit_cast(unsigned, a); }
        *(u32x4*)(dst + (size_t)(n0 + n) * K + k0 + k8) = w;
    }
}
template <class CM>
__device__ void conv_transpose4(const float* __restrict__ src, int ldsrc, int K, __half* __restrict__ dst, int N, CM colmap, float* lds, int part, int nparts) {
    float (*ts)[64][65] = (float (*)[64][65])lds;
    const int tid = tidx(), nkt = K / 64, ntiles = nkt * (N / 64);
    for (int t0 = part * 4; t0 < ntiles; t0 += nparts * 4) {
        float v[4][8];
#pragma unroll
        for (int q = 0; q < 4; ++q) {
            const int tile = t0 + q, k0 = (tile % nkt) * 64, n0 = (tile / nkt) * 64;
#pragma unroll
            for (int i = 0; i < 8; ++i) {
                const int idx = tid + 512 * i, k = idx >> 6, n = idx & 63;
                const int sc = colmap(n0 + n);
                const float x = src[(size_t)(k0 + k) * ldsrc + (sc >= 0 ? sc : 0)];
                v[q][i] = sc >= 0 ? x : 0.f;
            }
        }
        __syncthreads();
#pragma unroll
        for (int q = 0; q < 4; ++q)
#pragma unroll
            for (int i = 0; i < 8; ++i) { const int idx = tid + 512 * i; ts[q][idx >> 6][idx & 63] = v[q][i]; }
        __syncthreads();
        const int n = tid >> 3, k8 = (tid & 7) * 8;
#pragma unroll
        for (int q = 0; q < 4; ++q) {
            const int tile = t0 + q, k0 = (tile % nkt) * 64, n0 = (tile / nkt) * 64;
            const h8 o = {(_Float16)ts[q][k8 + 0][n], (_Float16)ts[q][k8 + 1][n], (_Float16)ts[q][k8 + 2][n], (_Float16)ts[q][k8 + 3][n],
                          (_Float16)ts[q][k8 + 4][n], (_Float16)ts[q][k8 + 5][n], (_Float16)ts[q][k8 + 6][n], (_Float16)ts[q][k8 + 7][n]};
            *(h8*)(dst + (size_t)(n0 + n) * K + k0 + k8) = o;
        }
    }
}
struct CmIdent { __device__ int operator()(int n) const { return n; } };
struct CmWin { __device__ int operator()(int n) const { return n < C_S5U ? n : (n < 4096 ? -1 : n - 184); } };

__device__ void conv_in(const Params& p, int l, float* lds) {
    conv_transpose4(p.w_in + (size_t)l * D * NIN, NIN, D, p.win16, NPK, CmWin(), lds, blockIdx.x, gridDim.x);
    __syncthreads();
}
__device__ void conv_rest(const Params& p, int l, float* lds) {
    float (*ts)[64][65] = (float (*)[64][65])lds;
    const int tid = tidx(), G = gridDim.x;
    for (int t0 = blockIdx.x; t0 < 704; t0 += 3 * G) {
        float v[3][8];
        const float* srcq[3]; __half* dstq[3]; int ldq[3], Kq[3], k0q[3], n0q[3];
#pragma unroll
        for (int q = 0; q < 3; ++q) {
            int t = t0 + q * G; const bool ok = t < 704; if (!ok) t = t0;
            const float* s; __half* d; int ld, K, tile;
            if (t < 384) { const int n = t >> 7; tile = t & 127; s = p.w_branch + ((size_t)l * 3 + n) * W * D; ld = D; K = W; d = p.wb16 + (size_t)n * D * W; }
            else if (t < 640) { tile = t - 384; s = p.w_out + (size_t)l * D * D; ld = D; K = D; d = p.wo16; }
            else { tile = t - 640; s = p.glu_w + (size_t)l * W * W; ld = W; K = W; d = p.wglu16; }
            const int nkt = K >> 6, k0 = (tile % nkt) * 64, n0 = (tile / nkt) * 64;
            srcq[q] = s; dstq[q] = ok ? d : nullptr; ldq[q] = ld; Kq[q] = K; k0q[q] = k0; n0q[q] = n0;
#pragma unroll
            for (int i = 0; i < 8; ++i) { const int idx = tid + 512 * i, k = idx >> 6, n = idx & 63; v[q][i] = s[(size_t)(k0 + k) * ld + n0 + n]; }
        }
        __syncthreads();
#pragma unroll
        for (int q = 0; q < 3; ++q)
#pragma unroll
            for (int i = 0; i < 8; ++i) { const int idx = tid + 512 * i; ts[q][idx >> 6][idx & 63] = v[q][i]; }
        __syncthreads();
        const int n = tid >> 3, k8 = (tid & 7) * 8;
#pragma unroll
        for (int q = 0; q < 3; ++q) {
            if (dstq[q] != nullptr) {
                const h8 o = {(_Float16)ts[q][k8 + 0][n], (_Float16)ts[q][k8 + 1][n], (_Float16)ts[q][k8 + 2][n], (_Float16)ts[q][k8 + 3][n],
                              (_Float16)ts[q][k8 + 4][n], (_Float16)ts[q][k8 + 5][n], (_Float16)ts[q][k8 + 6][n], (_Float16)ts[q][k8 + 7][n]};
                *(h8*)(dstq[q] + (size_t)(n0q[q] + n) * Kq[q] + k0q[q] + k8) = o;
            }
        }
    }
    __syncthreads();
}
namespace pg {
constexpr int BM = 256, BK = 64, HALF = 128, HTB = HALF * BK * 2, STAGE_BYTES = 8 * HTB, NXCD = 8, WGM = 8;
__device__ __forceinline__ int lds_byte(int r, int c) { const int st = (r >> 4) * 2 + (c >> 5), rr = r & 15, cc = c & 31, ob = rr * 64 + cc * 2; return st * 1024 + (ob ^ (((ob >> 9) & 1) << 5)); }
__device__ __forceinline__ void stage_rc(int b, int& R, int& C) { const int st = b / 1024, sb = b % 1024, swz = sb ^ (((sb >> 9) & 1) << 5); R = (st >> 1) * 16 + swz / 64; C = (st & 1) * 32 + (swz % 64) / 2; }
__device__ __forceinline__ int perm32(int rho) { const int n = rho >> 4, i = rho & 15; return 8 * (i >> 2) + 4 * n + (i & 3); }
struct Unit { int pm, pn, aux; const char* A; const char* B; };
__device__ __forceinline__ void tile_of(int L, int nM, int nN, int& pm, int& pn) {
    const int nwg = nM * nN; int wgid = L;
    { const int q = nwg / NXCD, r = nwg % NXCD, xcd = wgid % NXCD, off = wgid / NXCD; wgid = (xcd < r ? xcd * (q + 1) : r * (q + 1) + (xcd - r) * q) + off; }
    const int nig = WGM * nN, gid = wgid / nig, fm = gid * WGM, gsz = (nM - fm) < WGM ? (nM - fm) : WGM;
    pm = fm + ((wgid % nig) % gsz); pn = (wgid % nig) / gsz;
}
template <class Epi, class Sched>
__device__ __forceinline__ void gemm_phase(LAS unsigned char* lds, const int K, const Sched& S, const Epi& E) {
    int tid = tidx();
    const int wid = __builtin_amdgcn_readfirstlane(tid >> 6), lane = tid & 63, wr = wid >> 2, wc = wid & 3, fr = lane & 15, fq = lane >> 4;
    const int nt = K / BK;
    unsigned voffA[2], voffB[2];
#pragma unroll
    for (int i = 0; i < 2; ++i) { int R, C; stage_rc(tid * 16 + i * 8192, R, C); const int Rb = Epi::PERM ? ((R & ~31) + perm32(R & 31)) : R;
        voffA[i] = (unsigned)(R * K + C) * 2u; voffB[i] = (unsigned)(Rb * K + C) * 2u; }
    const size_t kstep = (size_t)(BK * 2);
    const size_t hstep = (size_t)HALF * K * 2;
    const unsigned ldsw = (unsigned)wid * 1024u;
    const int aoff = lds_byte(wr * 64 + fr, fq * 8), boff = lds_byte(wc * 32 + fr, fq * 8);
#define PG_SA(b, h) (((b) * 2 + (h)) * HTB)
#define PG_SB(b, h) ((4 + (b) * 2 + (h)) * HTB)
#define PG_STAGE(bufoff, gbase, voff) do { _Pragma("unroll") for (int _i = 0; _i < 2; ++_i) \
        __builtin_amdgcn_global_load_lds((const unsigned*)((const char*)(gbase) + (voff)[_i]), (LAS unsigned*)(lds + (bufoff) + ldsw + _i * 8192), 16, 0, 0); } while (0)
#define PG_LDA(dst, b, h) do { _Pragma("unroll") for (int m = 0; m < 4; ++m) _Pragma("unroll") for (int k = 0; k < 2; ++k) dst[m][k] = *(const LAS h8*)(lds + PG_SA(b, h) + aoff + m * 2048 + k * 1024); } while (0)
#define PG_LDB(dst, b, h) do { _Pragma("unroll") for (int n = 0; n < 2; ++n) _Pragma("unroll") for (int k = 0; k < 2; ++k) dst[n][k] = *(const LAS h8*)(lds + PG_SB(b, h) + boff + n * 2048 + k * 1024); } while (0)
#define PG_MMA(ai, bj, At, Bt) do { __builtin_amdgcn_s_setprio(1); _Pragma("unroll") for (int m = 0; m < 4; ++m) _Pragma("unroll") for (int n = 0; n < 2; ++n) _Pragma("unroll") for (int k = 0; k < 2; ++k) \
        acc[ai][bj][m][n] = __builtin_amdgcn_mfma_f32_16x16x32_f16(Bt[n][k], At[m][k], acc[ai][bj][m][n], 0, 0, 0); __builtin_amdgcn_s_setprio(0); } while (0)
#define PG_WAIT_V(n) asm volatile("s_waitcnt vmcnt(" #n ")" ::: "memory")
#define PG_WAIT_L(n) asm volatile("s_waitcnt lgkmcnt(" #n ")" ::: "memory")
#define PG_BAR __builtin_amdgcn_s_barrier()
#define PG_SCHED __builtin_amdgcn_sched_barrier(0)
    Unit cur, nxt; int ui = 0;
    if (!S.next(0, cur)) return;
    f32x4 acc[2][2][4][2];
#pragma unroll
    for (int a = 0; a < 2; ++a)
#pragma unroll
        for (int b = 0; b < 2; ++b)
#pragma unroll
            for (int m = 0; m < 4; ++m)
#pragma unroll
                for (int n = 0; n < 2; ++n) acc[a][b][m][n] = (f32x4){0.f, 0.f, 0.f, 0.f};
    h8 At[4][2], B0[2][2], B1[2][2];
    const char* cA = cur.A; const char* cB = cur.B;
    PG_STAGE(PG_SB(0, 0), cB, voffB); PG_STAGE(PG_SA(0, 0), cA, voffA); PG_STAGE(PG_SB(0, 1), cB + hstep, voffB); PG_STAGE(PG_SA(0, 1), cA + hstep, voffA);
    if (wr == 1) PG_BAR;
    PG_WAIT_V(4); PG_BAR;
    PG_STAGE(PG_SB(1, 0), cB + kstep, voffB); PG_STAGE(PG_SA(1, 0), cA + kstep, voffA); PG_STAGE(PG_SB(1, 1), cB + hstep + kstep, voffB);
    PG_WAIT_V(6); PG_BAR;
    for (;;) {
        const bool has_next = S.next(ui + 1, nxt);
        const char* nA = has_next ? nxt.A : cA; const char* nB = has_next ? nxt.B : cB;
        for (int t = 0; t < nt; t += 2) {
            const bool last = (t == nt - 2);
            const char* a1 = cA + (size_t)(t + 1) * kstep;
            const char* a2 = last ? nA : cA + (size_t)(t + 2) * kstep; const char* b2 = last ? nB : cB + (size_t)(t + 2) * kstep;
            const char* a3 = a2 + kstep; const char* b3 = b2 + kstep;
            PG_LDB(B0, 0, 0); PG_SCHED; PG_LDA(At, 0, 0); PG_STAGE(PG_SA(1, 1), a1 + hstep, voffA);
            PG_WAIT_L(8); PG_BAR; PG_WAIT_L(0); PG_MMA(0, 0, At, B0); PG_BAR; PG_SCHED;
            PG_LDB(B1, 0, 1); PG_STAGE(PG_SB(0, 0), b2, voffB);
            PG_BAR; PG_WAIT_L(0); PG_MMA(0, 1, At, B1); PG_BAR;
            PG_LDA(At, 0, 1); PG_STAGE(PG_SA(0, 0), a2, voffA);
            PG_BAR; PG_WAIT_L(0); PG_MMA(1, 0, At, B0); PG_BAR; PG_SCHED;
            PG_STAGE(PG_SB(0, 1), b2 + hstep, voffB);
            PG_WAIT_V(6); PG_BAR; PG_MMA(1, 1, At, B1); PG_BAR;
            PG_LDB(B0, 1, 0); PG_SCHED; PG_LDA(At, 1, 0); PG_STAGE(PG_SA(0, 1), a2 + hstep, voffA);
            PG_WAIT_L(8); PG_BAR; PG_WAIT_L(0); PG_MMA(0, 0, At, B0); PG_BAR; PG_SCHED;
            PG_LDB(B1, 1, 1); PG_STAGE(PG_SB(1, 0), b3, voffB);
            PG_BAR; PG_WAIT_L(0); PG_MMA(0, 1, At, B1); PG_BAR;
            PG_LDA(At, 1, 1); PG_STAGE(PG_SA(1, 0), a3, voffA);
            PG_BAR; PG_WAIT_L(0); PG_MMA(1, 0, At, B0); PG_BAR; PG_SCHED;
            PG_STAGE(PG_SB(1, 1), b3 + hstep, voffB);
            PG_WAIT_V(6); PG_BAR; PG_MMA(1, 1, At, B1); PG_BAR;
        }
        E(acc, cur, wr, wc, fr, fq);
        if (!has_next) break;
        if constexpr (!Epi::KEEP_ACC) {
#pragma unroll
        for (int a = 0; a < 2; ++a)
#pragma unroll
            for (int b = 0; b < 2; ++b)
#pragma unroll
                for (int m = 0; m < 4; ++m)
#pragma unroll
                    for (int n = 0; n < 2; ++n) acc[a][b][m][n] = (f32x4){0.f, 0.f, 0.f, 0.f};
        }
        cur = nxt; cA = nA; cB = nB; ++ui;
    }
    PG_WAIT_V(0);
    if (wr == 0) PG_BAR;
    PG_BAR;
#undef PG_SA
#undef PG_SB
#undef PG_STAGE
#undef PG_LDA
#undef PG_LDB
#undef PG_MMA
#undef PG_WAIT_V
#undef PG_WAIT_L
#undef PG_BAR
#undef PG_SCHED
}
}
__device__ __forceinline__ float fsig(float v) { return __builtin_amdgcn_rcpf(1.f + __builtin_amdgcn_exp2f(-1.4426950408889634f * v)); }
__device__ __forceinline__ float fsilu(float v) { return v * fsig(v); }
__device__ __forceinline__ u32x4 pack8(const f32x4 a, const f32x4 b) {
    const h8 v = {(_Float16)a[0], (_Float16)a[1], (_Float16)a[2], (_Float16)a[3], (_Float16)b[0], (_Float16)b[1], (_Float16)b[2], (_Float16)b[3]};
    return __builtin_bit_cast(u32x4, v);
}
__device__ __forceinline__ void unpack8(const u32x4 w, float (&o)[8]) {
    const h8 v = __builtin_bit_cast(h8, w);
#pragma unroll
    for (int j = 0; j < 8; ++j) o[j] = (float)v[j];
}
struct SchedPlain {
    const char* A; const char* B; int nM, nN, G, c, K;
    __device__ bool next(int i, pg::Unit& u) const {
        const long L = (long)i * G + c; if (L >= (long)nM * nN) return false;
        pg::tile_of((int)L, nM, nN, u.pm, u.pn); u.aux = 0;
        u.A = A + (size_t)u.pm * 256 * K * 2; u.B = B + (size_t)u.pn * 256 * K * 2; return true;
    }
};
struct SchedMerge {
    const char* ys; const char* wb; int G, c;
    __device__ bool next(int i, pg::Unit& u) const {
        const int r = i / 3, n = i - 3 * r; const long L = (long)r * G + c; if (L >= 64 * 4) return false;
        pg::tile_of((int)L, 64, 4, u.pm, u.pn); u.aux = n;
        u.A = ys + ((size_t)n * T + (size_t)u.pm * 256) * W * 2; u.B = wb + ((size_t)n * D + (size_t)u.pn * 256) * W * 2; return true;
    }
};

template <int ACT> __device__ __forceinline__ f32x4 actv(f32x4 v) {
    if (ACT == 1) { for (int j = 0; j < 4; ++j) v[j] = fsilu(v[j]); }
    if (ACT == 2) { for (int j = 0; j < 4; ++j) v[j] = fsig(v[j]); }
    return v;
}
template <int ACT> __device__ __forceinline__ void st16(const f32x4 (&acc)[2][2][4][2], __half* base, int ld, int c8, int bj0, int bj1) {
#pragma unroll
    for (int ai = 0; ai < 2; ++ai)
#pragma unroll
        for (int m = 0; m < 4; ++m) {
            __half* rowp = base + (size_t)(ai * 128 + m * 16) * ld + c8;
#pragma unroll
            for (int bj = 0; bj < 2; ++bj) if (bj >= bj0 && bj < bj1)
                *(u32x4*)(rowp + (bj - bj0) * 128) = pack8(actv<ACT>(acc[ai][bj][m][0]), actv<ACT>(acc[ai][bj][m][1]));
        }
}
struct EpiProj {
    static constexpr bool PERM = true, KEEP_ACC = false;
    __half *q16, *v16, *hgg16, *atq16, *atk16, *atv16, *atg16, *ixq16, *ixk16, *s5u16, *s5g16, *mg16; float *lf32, *ixw32; const float* lb;
    __device__ __forceinline__ void operator()(f32x4 (&acc)[2][2][4][2], const pg::Unit& u, int wr, int wc, int fr, int fq) const {
        const size_t row0 = (size_t)u.pm * 256 + wr * 64 + fr; const int c8 = wc * 32 + 8 * fq, pn = u.pn;
        if (pn < 2)        st16<0>(acc, q16 + row0 * W + pn * 256, W, c8, 0, 2);
        else if (pn < 4) {
            const int cb = (pn - 2) * 256 + c8;
#pragma unroll
            for (int bj = 0; bj < 2; ++bj) {
                const f32x4 l0 = *(const f32x4*)(lb + cb + bj * 128), l1 = *(const f32x4*)(lb + cb + bj * 128 + 4);
#pragma unroll
                for (int ai = 0; ai < 2; ++ai)
#pragma unroll
                    for (int m = 0; m < 4; ++m) {
                        f32x4 a = acc[ai][bj][m][0], b = acc[ai][bj][m][1];
#pragma unroll
                        for (int j = 0; j < 4; ++j) { a[j] = __builtin_amdgcn_logf(fmaxf(l0[j] + (1.f - l0[j]) * fsig(a[j]), 1e-30f)); b[j] = __builtin_amdgcn_logf(fmaxf(l1[j] + (1.f - l1[j]) * fsig(b[j]), 1e-30f)); }
                        float* o = lf32 + (row0 + ai * 128 + m * 16) * W + cb + bj * 128;
                        *(f32x4*)o = a; *(f32x4*)(o + 4) = b;
                    }
            }
        }
        else if (pn < 6)   st16<0>(acc, v16 + row0 * W + (pn - 4) * 256, W, c8, 0, 2);
        else if (pn < 8)   st16<1>(acc, hgg16 + row0 * W + (pn - 6) * 256, W, c8, 0, 2);
        else if (pn < 10)  st16<0>(acc, atq16 + row0 * W + (pn - 8) * 256, W, c8, 0, 2);
        else if (pn == 10) { st16<0>(acc, atk16 + row0 * 128, 128, c8, 0, 1); st16<0>(acc, atv16 + row0 * 128, 128, c8, 1, 2); }
        else if (pn < 13)  st16<1>(acc, atg16 + row0 * W + (pn - 11) * 256, W, c8, 0, 2);
        else if (pn < 15)  st16<0>(acc, ixq16 + row0 * W + (pn - 13) * 256, W, c8, 0, 2);
        else if (pn == 15) {
            if (wc < 2) {
#pragma unroll
                for (int ai = 0; ai < 2; ++ai)
#pragma unroll
                    for (int m = 0; m < 4; ++m) *(u32x4*)(ixk16 + (row0 + ai * 128 + m * 16) * 64 + c8) = pack8(acc[ai][0][m][0], acc[ai][0][m][1]);
            } else if (wc == 2 && fq == 0) {
#pragma unroll
                for (int ai = 0; ai < 2; ++ai)
#pragma unroll
                    for (int m = 0; m < 4; ++m) { float* o = ixw32 + (row0 + ai * 128 + m * 16) * 8; *(f32x4*)o = acc[ai][0][m][0]; *(f32x4*)(o + 4) = acc[ai][0][m][1]; }
            }
        }
        else if (pn < 18)  st16<0>(acc, s5u16 + row0 * W + (pn - 16) * 256, W, c8, 0, 2);
        else if (pn < 20)  st16<1>(acc, s5g16 + row0 * W + (pn - 18) * 256, W, c8, 0, 2);
        else {
            int lane = fq * 16 + fr;
            asm volatile("" : "+v"(lane));
            unsigned char* base = (unsigned char*)mg16 + ((((size_t)u.pm * 12 + (pn - 20)) * 8 + wr * 4 + wc) * 16) * 512 + lane * 8;
#pragma unroll
            for (int ai = 0; ai < 2; ++ai)
#pragma unroll
                for (int m = 0; m < 4; ++m)
#pragma unroll
                    for (int bj = 0; bj < 2; ++bj) {
                        const f32x4 xa = acc[ai][bj][m][0], xb = acc[ai][bj][m][1];
                        unsigned lo = 0, hi = 0;
#pragma unroll
                        for (int j = 0; j < 4; ++j) {
                            const float qa = fmaxf(__builtin_amdgcn_rcpf(__builtin_fmaf(__builtin_amdgcn_exp2f(-1.4426950408889634f * xa[j]), 1.f / 255.f, 1.f / 255.f)), 1.f);
                            const float qb = fmaxf(__builtin_amdgcn_rcpf(__builtin_fmaf(__builtin_amdgcn_exp2f(-1.4426950408889634f * xb[j]), 1.f / 255.f, 1.f / 255.f)), 1.f);
                            lo = __builtin_amdgcn_cvt_pk_u8_f32(qa, j, lo);
                            hi = __builtin_amdgcn_cvt_pk_u8_f32(qb, j, hi);
                        }
                        *(uint2*)(base + ((ai * 4 + m) * 2 + bj) * 512) = make_uint2(lo, hi);
                    }
        }
    }
};
struct EpiGlu {
    static constexpr bool PERM = true, KEEP_ACC = false;
    const __half* ypre16; const __half* s5g16; const float* bias; __half* yc; float* raw;
    __device__ __forceinline__ void operator()(f32x4 (&acc)[2][2][4][2], const pg::Unit& u, int wr, int wc, int fr, int fq) const {
        size_t row0 = (size_t)u.pm * 256 + wr * 64 + fr; const int c0 = u.pn * 256 + wc * 32 + 8 * fq;
        asm volatile("" : "+v"(row0));
        f32x4 bv[2][2];
#pragma unroll
        for (int bj = 0; bj < 2; ++bj) { bv[bj][0] = *(const f32x4*)(bias + c0 + bj * 128); bv[bj][1] = *(const f32x4*)(bias + c0 + bj * 128 + 4); }
#pragma unroll
        for (int am = 0; am < 4; ++am) {
            u32x4 yv[2][2], gv[2][2];
#pragma unroll
            for (int mm = 0; mm < 2; ++mm)
#pragma unroll
                for (int bj = 0; bj < 2; ++bj) {
                    const size_t off = (row0 + (am >> 1) * 128 + ((am & 1) * 2 + mm) * 16) * W + c0 + bj * 128;
                    yv[mm][bj] = *(const u32x4*)(ypre16 + off); gv[mm][bj] = *(const u32x4*)(s5g16 + off);
                }
#pragma unroll
            for (int mm = 0; mm < 2; ++mm)
#pragma unroll
                for (int bj = 0; bj < 2; ++bj) {
                    const int ai = am >> 1, m = (am & 1) * 2 + mm;
                    const size_t off = (row0 + ai * 128 + m * 16) * W + c0 + bj * 128;
                    float y[8], g[8]; unpack8(yv[mm][bj], y); unpack8(gv[mm][bj], g);
                    f32x4 a = acc[ai][bj][m][0] + bv[bj][0], b = acc[ai][bj][m][1] + bv[bj][1];
#pragma unroll
                    for (int j = 0; j < 4; ++j) { a[j] = y[j] * fsig(a[j]) * g[j]; b[j] = y[4 + j] * fsig(b[j]) * g[4 + j]; }
                    *(u32x4*)(yc + off) = pack8(a, b);
                }
        }
    }
};
struct EpiMerge {
    static constexpr bool PERM = true, KEEP_ACC = true;
    const unsigned char* mg8; __half* merged16;
    static __device__ __forceinline__ void dec8(const uint2 w, float (&g)[8]) {
#pragma unroll
        for (int j = 0; j < 4; ++j) { g[j] = (float)((w.x >> (8 * j)) & 255u); g[4 + j] = (float)((w.y >> (8 * j)) & 255u); }
    }
    __device__ __forceinline__ void operator()(f32x4 (&acc)[2][2][4][2], const pg::Unit& u, int wr, int wc, int fr, int fq) const {
        const size_t row0 = (size_t)u.pm * 256 + wr * 64 + fr; const int c0 = u.pn * 256 + wc * 32 + 8 * fq, n = u.aux;
        int lofs = ((wr * 4 + wc) * 16) * 512 + (fq * 16 + fr) * 8;
        asm volatile("" : "+v"(lofs));
        const unsigned char* gp = mg8 + ((size_t)u.pm * 12 + n * 4 + u.pn) * 16 * 8 * 512 + lofs;
        uint2 gq[16], gnq[16];
#pragma unroll
        for (int k = 0; k < 16; ++k) gq[k] = *(const uint2*)(gp + k * 512);
        if (n < 2) {
#pragma unroll
            for (int k = 0; k < 16; ++k) gnq[k] = *(const uint2*)(gp + (size_t)4 * 16 * 8 * 512 + k * 512);
        }
#pragma unroll
        for (int ai = 0; ai < 2; ++ai)
#pragma unroll
            for (int m = 0; m < 4; ++m)
#pragma unroll
                for (int bj = 0; bj < 2; ++bj) {
                    const int k = (ai * 4 + m) * 2 + bj;
                    float g[8]; dec8(gq[k], g);
                    f32x4 a = acc[ai][bj][m][0], b = acc[ai][bj][m][1];
                    if (n < 2) {
                        float gn[8]; dec8(gnq[k], gn);
#pragma unroll
                        for (int j = 0; j < 4; ++j) { a[j] *= g[j] * __builtin_amdgcn_rcpf(gn[j]); b[j] *= g[4 + j] * __builtin_amdgcn_rcpf(gn[4 + j]); }
                        acc[ai][bj][m][0] = a; acc[ai][bj][m][1] = b;
                    } else {
#pragma unroll
                        for (int j = 0; j < 4; ++j) { a[j] *= g[j] * (1.f / 255.f); b[j] *= g[4 + j] * (1.f / 255.f); }
                        *(u32x4*)(merged16 + (row0 + ai * 128 + m * 16) * D + c0 + bj * 128) = pack8(a, b);
                        acc[ai][bj][m][0] = (f32x4){0.f, 0.f, 0.f, 0.f}; acc[ai][bj][m][1] = (f32x4){0.f, 0.f, 0.f, 0.f};
                    }
                }
    }
};
struct EpiOut {
    static constexpr bool PERM = true, KEEP_ACC = false;
    const float* xin32; __half* xr16; float* out32; const float* gate; int in16, out16;
    template <bool IN16, bool OUT16>
    __device__ __forceinline__ void run(f32x4 (&acc)[2][2][4][2], const pg::Unit& u, int wr, int wc, int fr, int fq) const {
        size_t row0 = (size_t)u.pm * 256 + wr * 64 + fr; const int c0 = u.pn * 256 + wc * 32 + 8 * fq;
        asm volatile("" : "+v"(row0));
        const int b = (u.pm * 256) / S;
        f32x4 gv[2][2];
#pragma unroll
        for (int bj = 0; bj < 2; ++bj)
#pragma unroll
            for (int n = 0; n < 2; ++n) gv[bj][n] = *(const f32x4*)(gate + (size_t)b * 3072 + c0 + bj * 128 + n * 4);
#pragma unroll
        for (int am = 0; am < 4; ++am) {
            f32x4 xa[2][2], xb[2][2]; u32x4 xh[2][2];
#pragma unroll
            for (int mm = 0; mm < 2; ++mm)
#pragma unroll
                for (int bj = 0; bj < 2; ++bj) {
                    const size_t off = (row0 + (am >> 1) * 128 + ((am & 1) * 2 + mm) * 16) * D + c0 + bj * 128;
                    if (IN16) xh[mm][bj] = *(const u32x4*)(xr16 + off);
                    else { xa[mm][bj] = *(const f32x4*)(xin32 + off); xb[mm][bj] = *(const f32x4*)(xin32 + off + 4); }
                }
#pragma unroll
            for (int mm = 0; mm < 2; ++mm)
#pragma unroll
                for (int bj = 0; bj < 2; ++bj) {
                    const int ai = am >> 1, m = (am & 1) * 2 + mm;
                    const size_t off = (row0 + ai * 128 + m * 16) * D + c0 + bj * 128;
                    f32x4 a, c;
                    if (IN16) { float y[8]; unpack8(xh[mm][bj], y); a = (f32x4){y[0], y[1], y[2], y[3]}; c = (f32x4){y[4], y[5], y[6], y[7]}; }
                    else { a = xa[mm][bj]; c = xb[mm][bj]; }
                    a += gv[bj][0] * acc[ai][bj][m][0]; c += gv[bj][1] * acc[ai][bj][m][1];
                    if (OUT16) *(u32x4*)(xr16 + off) = pack8(a, c);
                    else { *(f32x4*)(out32 + off) = a; *(f32x4*)(out32 + off + 4) = c; }
                }
        }
    }
    __device__ __forceinline__ void operator()(f32x4 (&acc)[2][2][4][2], const pg::Unit& u, int wr, int wc, int fr, int fq) const {
        if (!in16) run<false, true>(acc, u, wr, wc, fr, fq);
        else if (out16) run<true, true>(acc, u, wr, wc, fr, fq);
        else run<true, false>(acc, u, wr, wc, fr, fq);
    }
};
constexpr float QSCALE = 0.08838834764831845f * 1.4426950408889634f;
__device__ void phase_fix(const Params& p, int l, float* lds) {
    {
        __half* tl = (__half*)lds;
        const int tid = tidx();
        for (int tile = blockIdx.x; tile < T / 64; tile += gridDim.x) {
            const int t0 = tile * 64, b = t0 / S, s0 = t0 % S;
            __syncthreads();
            for (int i = tid; i < 64 * 64; i += 512) { const int tt = i >> 6, e2 = (i & 63) * 2; *(h2*)(tl + tt * 130 + e2) = *(const h2*)(p.atv16 + (size_t)(t0 + tt) * 128 + e2); }
            __syncthreads();
#pragma unroll
            for (int rep = 0; rep < 2; ++rep) {
                const int ch = tid + 512 * rep;
                const int ln = ch & 63, s2 = (ch >> 6) & 1, et = (ch >> 7) & 3, ktl = ch >> 9, colv = ln & 31, hf = ln >> 5;
                h8 v;
#pragma unroll
                for (int j = 0; j < 8; ++j) v[j] = __builtin_bit_cast(_Float16, tl[(ktl * 32 + 16 * s2 + 8 * (j >> 2) + 4 * hf + (j & 3)) * 130 + 32 * et + colv]);
                *(h8*)(p.vf16 + ((((size_t)(b * 64 + (s0 >> 5) + ktl) * 4 + et) * 2 + s2) * 64 + ln) * 8) = v;
            }
        }
        __syncthreads();
    }
    const int w = tidx() >> 6, lane = tidx() & 63;
    __half* wl = (__half*)lds + w * 192;
    const float gq0 = p.qn_g[l * 128 + lane], gq1 = p.qn_g[l * 128 + 64 + lane], gk0 = p.kn_g[l * 128 + lane], gk1 = p.kn_g[l * 128 + 64 + lane];
    struct TokIn { __half q1[5], q2[5], i1[4], i2[4], z1, z2; float2 csA, csI; };
    auto tok_load = [&](int t, TokIn& in) {
        const __half* qrow = p.atq16 + (size_t)t * W; const __half* krow = p.atk16 + (size_t)t * 128;
        const __half* iqrow = p.ixq16 + (size_t)t * W; const __half* ikrow = p.ixk16 + (size_t)t * 64;
#pragma unroll
        for (int hh = 0; hh < 4; ++hh) { in.q1[hh] = qrow[hh * 128 + lane]; in.q2[hh] = qrow[hh * 128 + 64 + lane]; }
        in.q1[4] = krow[lane]; in.q2[4] = krow[64 + lane];
        in.csA = *(const float2*)(p.ropeA + ((size_t)t * 64 + lane) * 2);
        in.csI = *(const float2*)(p.ropeI + ((size_t)t * 32 + (lane & 31)) * 2);
#pragma unroll
        for (int i = 0; i < 4; ++i) { const int hh = (lane >> 5) + 2 * i; in.i1[i] = iqrow[hh * 64 + (lane & 31)]; in.i2[i] = iqrow[hh * 64 + 32 + (lane & 31)]; }
        in.z1 = ikrow[lane & 31]; in.z2 = ikrow[32 + (lane & 31)];
    };
    const int tstep = gridDim.x * 8;
    TokIn cur;
    if (blockIdx.x * 8 + w < T) tok_load(blockIdx.x * 8 + w, cur);
#pragma unroll 1
    for (int t = blockIdx.x * 8 + w; t < T; t += tstep) {
        const int b = t / S, s = t % S, kt = s >> 5, colk = s & 31;
        TokIn nxt;
        tok_load(t + tstep < T ? t + tstep : t, nxt);
        __half* qrow = p.atq16 + (size_t)t * W;
        __half* iqrow = p.ixq16 + (size_t)t * W;
        float x1[5], x2[5];
#pragma unroll
        for (int hh = 0; hh < 5; ++hh) { x1[hh] = __half2float(cur.q1[hh]); x2[hh] = __half2float(cur.q2[hh]); }
        const float2 csA = cur.csA, csI = cur.csI;
        float y1[4], y2[4];
#pragma unroll
        for (int i = 0; i < 4; ++i) { y1[i] = __half2float(cur.i1[i]); y2[i] = __half2float(cur.i2[i]); }
        const float z1 = __half2float(cur.z1), z2 = __half2float(cur.z2);
        float ss[5];
#pragma unroll
        for (int hh = 0; hh < 5; ++hh) ss[hh] = x1[hh] * x1[hh] + x2[hh] * x2[hh];
#pragma unroll
        for (int o = 32; o > 0; o >>= 1) {
#pragma unroll
            for (int hh = 0; hh < 5; ++hh) ss[hh] += __shfl_xor(ss[hh], o);
        }
#pragma unroll
        for (int hh = 0; hh < 5; ++hh) {
            const float r = rsqrtf(ss[hh] * (1.f / 128.f) + EPS) * (hh < 4 ? QSCALE : 1.f);
            const float a = x1[hh] * r * (hh < 4 ? gq0 : gk0), b2 = x2[hh] * r * (hh < 4 ? gq1 : gk1);
            const __half o1 = __float2half(a * csA.x - b2 * csA.y), o2 = __float2half(b2 * csA.x + a * csA.y);
            if (hh < 4) { qrow[hh * 128 + lane] = o1; qrow[hh * 128 + 64 + lane] = o2; } else { wl[lane] = o1; wl[64 + lane] = o2; }
        }
#pragma unroll
        for (int i = 0; i < 4; ++i) {
            const int hh = (lane >> 5) + 2 * i;
            iqrow[hh * 64 + (lane & 31)] = __float2half(y1[i] * csI.x - y2[i] * csI.y); iqrow[hh * 64 + 32 + (lane & 31)] = __float2half(y2[i] * csI.x + y1[i] * csI.y);
        }
        if (lane < 32) { wl[128 + lane] = __float2half(z1 * csI.x - z2 * csI.y); wl[160 + lane] = __float2half(z2 * csI.x + z1 * csI.y); }
        lds_fence();
        if (lane < 16) {
            const h8 v = *(const h8*)(wl + lane * 8);
            *(h8*)(p.kf16 + ((((size_t)(b * 64 + kt) * 8 + (lane >> 1)) * 64) + (lane & 1) * 32 + colk) * 8) = v;
        } else if (lane < 24) {
            const int c2 = lane - 16;
            const h8 v = *(const h8*)(wl + 128 + c2 * 8);
            *(h8*)(p.ikf16 + ((((size_t)(b * 64 + kt) * 4 + (c2 >> 1)) * 64) + (c2 & 1) * 32 + colk) * 8) = v;
        }
        lds_fence();
        cur = nxt;
    }
}

__device__ __forceinline__ unsigned f2key(float f) { const unsigned u = __float_as_uint(f); return (u & 0x80000000u) ? ~u : (u | 0x80000000u); }
typedef float f32x16 __attribute__((ext_vector_type(16)));
typedef _Float16 h4 __attribute__((ext_vector_type(4)));
template <int NR>
__device__ __forceinline__ void sel_query(const float* scl, int lane, bool all, unsigned& mylo, unsigned& myhi) {
    constexpr int NB = NR < 12 ? NR : 12, NV = NR - NB;
    constexpr int VB = NV == 0 ? 0 : (NV < 2 ? 1 : (NV < 4 ? 2 : (NV < 8 ? 3 : (NV < 16 ? 4 : 5))));
    unsigned key[NR];
#pragma unroll
    for (int i = 0; i < NR; ++i) key[i] = f2key(scl[lane + 64 * i]);
    unsigned tge = 0x00800000u;
    int rrem = 0; bool split = false;
    if (!all) {
        unsigned prefix = 0; bool exact = false;
        asm volatile(".p2align 6" ::: "memory");
#pragma unroll 1
        for (int bit = 31; bit >= 0; --bit) {
            const unsigned cand = prefix | (1u << bit);
            int c = 0, cl = 0;
#pragma unroll
            for (int i = 0; i < NB; ++i) c += __popcll(__ballot(key[i] >= cand));
#pragma unroll
            for (int i = NB; i < NR; ++i) cl += (key[i] >= cand) ? 1 : 0;
#pragma unroll
            for (int bb = 0; bb < VB; ++bb) c += __popcll(__ballot((cl >> bb) & 1)) << bb;
            if (c >= 256) prefix = cand;
            if (c == 256) { exact = true; break; }
        }
        tge = prefix;
        if (!exact) {
            int cge = 0, cgt = 0;
#pragma unroll
            for (int i = 0; i < NR; ++i) { cge += __popcll(__ballot(key[i] >= prefix)); cgt += __popcll(__ballot(key[i] > prefix)); }
            if (cge > 256) { split = true; tge = prefix + 1u; rrem = 256 - cgt; }
        }
    }
    const unsigned long long lt = (1ull << lane) - 1ull;
    mylo = 0; myhi = 0;
    if (!split) {
#pragma unroll
        for (int i = 0; i < NR; ++i) {
            const unsigned long long m2 = __ballot(key[i] >= tge);
            if (lane == i) { mylo = (unsigned)m2; myhi = (unsigned)(m2 >> 32); }
        }
    } else {
#pragma unroll 1
        for (int i = 0; i < NR; ++i) {
            const unsigned k = f2key(scl[lane + 64 * i]);
            const bool eq = k == tge - 1u;
            const unsigned long long m = __ballot(eq);
            const bool sl = (k >= tge) || (eq && __popcll(m & lt) < rrem);
            rrem -= __popcll(m); if (rrem < 0) rrem = 0;
            const unsigned long long m2 = __ballot(sl);
            if (lane == i) { mylo = (unsigned)m2; myhi = (unsigned)(m2 >> 32); }
        }
    }
}
__device__ void dsa_select(const Params& p, int b, int q0, float* lds) {
    const int tid = tidx(), w = tid >> 6, lane = tid & 63, half = lane >> 5, col = lane & 31;
    float* sc = lds;
    {
        const int wq = w & 3, par = w >> 2;
        const int blk = col >> 2, wi = col & 3, ql = 2 * (blk & 1) + (blk >> 2), head = 4 * ((blk >> 1) & 1) + wi;
        const __half* qrow = p.ixq16 + (size_t)(b * S + q0 + wq * 4 + ql) * W + head * 64 + 8 * half;
        h8 af[4];
#pragma unroll
        for (int ks = 0; ks < 4; ++ks) af[ks] = *(const h8*)(qrow + 16 * ks);
        const int qa = wq * 4 + 2 * half;
        float iw0[8], iw1[8];
#pragma unroll
        for (int hh = 0; hh < 8; ++hh) { iw0[hh] = p.ixw32[(size_t)(b * S + q0 + qa) * 8 + hh]; iw1[hh] = p.ixw32[(size_t)(b * S + q0 + qa + 1) * 8 + hh]; }
        const int ntiles = (q0 + 15) / 32 + 1;
        const __half* ikb = p.ikf16 + (size_t)b * 64 * 4 * 512 + lane * 8;
        h8 bc[4];
        if (par < ntiles) {
#pragma unroll
            for (int ks = 0; ks < 4; ++ks) bc[ks] = *(const h8*)(ikb + ((size_t)par * 4 + ks) * 512);
        }
        asm volatile(".p2align 6" ::: "memory");
        for (int kt = par; kt < ntiles; kt += 2) {
            const int key = kt * 32 + col;
            const int ktn = kt + 2 < ntiles ? kt + 2 : kt;
            h8 bn[4];
#pragma unroll
            for (int ks = 0; ks < 4; ++ks) bn[ks] = *(const h8*)(ikb + ((size_t)ktn * 4 + ks) * 512);
            f32x16 acc;
#pragma unroll
            for (int r = 0; r < 16; ++r) acc[r] = 0.f;
#pragma unroll
            for (int ks = 0; ks < 4; ++ks) acc = __builtin_amdgcn_mfma_f32_32x32x16_f16(af[ks], bc[ks], acc, 0, 0, 0);
            float s0 = 0.f, s1 = 0.f;
#pragma unroll
            for (int r = 0; r < 8; ++r) { s0 += fmaxf(acc[r], 0.f) * iw0[r]; s1 += fmaxf(acc[8 + r], 0.f) * iw1[r]; }
            sc[qa * 2048 + key] = key <= q0 + qa ? s0 : -INFINITY;
            sc[(qa + 1) * 2048 + key] = key <= q0 + qa + 1 ? s1 : -INFINITY;
#pragma unroll
            for (int ks = 0; ks < 4; ++ks) bc[ks] = bn[ks];
        }
        const int kend = ((q0 + 16 + 255) >> 8) << 8;
        for (int i = ntiles * 32 + tid; i < kend; i += 512) {
#pragma unroll
            for (int q = 0; q < 16; ++q) sc[q * 2048 + i] = -INFINITY;
        }
    }
    __syncthreads();
#pragma unroll 1
    for (int qq = 0; qq < 2; ++qq) {
        const int ql = 2 * w + qq, qi = q0 + ql;
        const float* scl = sc + ql * 2048;
        const bool all = qi + 1 <= 256;
        unsigned mylo, myhi;
        switch ((q0 + 16 + 255) >> 8) {
            case 1: sel_query<4>(scl, lane, all, mylo, myhi); break;
            case 2: sel_query<8>(scl, lane, all, mylo, myhi); break;
            case 3: sel_query<12>(scl, lane, all, mylo, myhi); break;
            case 4: sel_query<16>(scl, lane, all, mylo, myhi); break;
            case 5: sel_query<20>(scl, lane, all, mylo, myhi); break;
            case 6: sel_query<24>(scl, lane, all, mylo, myhi); break;
            case 7: sel_query<28>(scl, lane, all, mylo, myhi); break;
            default: sel_query<32>(scl, lane, all, mylo, myhi); break;
        }
        if (lane < 32) *(uint2*)(p.mask + (size_t)(b * S + qi) * 64 + 2 * lane) = make_uint2(mylo, myhi);
    }
    __syncthreads();
}

__device__ void dsa_attend(const Params& p, int b, int g) {
    const int lane = tidx() & 63, half = lane >> 5, col = lane & 31;
    const int q0 = 8 * g, qi = q0 + (col >> 2), hd = col & 3;
    const __half* qp = p.atq16 + (size_t)(b * S + qi) * W + hd * 128 + 8 * half;
    h8 qf[8];
#pragma unroll
    for (int ks = 0; ks < 8; ++ks) qf[ks] = *(const h8*)(qp + 16 * ks);
    f32x16 o[4];
#pragma unroll
    for (int et = 0; et < 4; ++et)
#pragma unroll
        for (int r = 0; r < 16; ++r) o[et][r] = 0.f;
    float m = -INFINITY, l = 0.f;
    const int ntiles = (q0 + 7) / 32 + 1;
    const unsigned* mrow = p.mask + (size_t)(b * S + qi) * 64;
    const __half* kfb = p.kf16 + (size_t)b * 64 * 8 * 512 + lane * 8;
    const __half* vfb = p.vf16 + (size_t)b * 64 * 8 * 512 + lane * 8;
    h8 kA[8], kB[8];
#pragma unroll
    for (int ks = 0; ks < 8; ++ks) kA[ks] = *(const h8*)(kfb + (size_t)ks * 512);
#define DSA_TILE(kcur, knext, KT) do { \
        const int _kt = (KT), _ktn = _kt + 1 < ntiles ? _kt + 1 : _kt; \
        _Pragma("unroll") for (int ks = 0; ks < 8; ++ks) knext[ks] = *(const h8*)(kfb + ((size_t)_ktn * 8 + ks) * 512); \
        const unsigned mws = mrow[_kt] >> (4 * half); \
        f32x16 s; \
        _Pragma("unroll") for (int r = 0; r < 16; ++r) s[r] = 0.f; \
        _Pragma("unroll") for (int ks = 0; ks < 8; ++ks) s = __builtin_amdgcn_mfma_f32_32x32x16_f16(kcur[ks], qf[ks], s, 0, 0, 0); \
        h8 vf[8]; \
        _Pragma("unroll") for (int i = 0; i < 8; ++i) vf[i] = *(const h8*)(vfb + ((size_t)_kt * 8 + i) * 512); \
        float tmax = -INFINITY; \
        _Pragma("unroll") for (int r = 0; r < 16; ++r) { s[r] = (mws & (1u << ((r & 3) + 8 * (r >> 2)))) ? s[r] : -INFINITY; tmax = fmaxf(tmax, s[r]); } \
        tmax = fmaxf(tmax, __shfl_xor(tmax, 32)); \
        if (__any(tmax > m + 11.5f)) {          \
            const float mn = fmaxf(m, tmax), msf = mn == -INFINITY ? 0.f : mn; \
            const float cs = __builtin_amdgcn_exp2f(m - msf); \
            l *= cs; m = mn; \
            _Pragma("unroll") for (int et = 0; et < 4; ++et) _Pragma("unroll") for (int r = 0; r < 16; ++r) o[et][r] *= cs; \
        } \
        const float ms2 = m == -INFINITY ? 0.f : m; \
        float ps = 0.f; \
        _Pragma("unroll") for (int r = 0; r < 16; ++r) { s[r] = __builtin_amdgcn_exp2f(s[r] - ms2); ps += s[r]; } \
        l += ps; \
        h8 pb[2]; \
        _Pragma("unroll") for (int s2 = 0; s2 < 2; ++s2) _Pragma("unroll") for (int j = 0; j < 8; ++j) pb[s2][j] = (_Float16)s[8 * s2 + j]; \
        _Pragma("unroll") for (int et = 0; et < 4; ++et) _Pragma("unroll") for (int s2 = 0; s2 < 2; ++s2) \
            o[et] = __builtin_amdgcn_mfma_f32_32x32x16_f16(vf[et * 2 + s2], pb[s2], o[et], 0, 0, 0); \
    } while (0)
    int kt = 0;
#pragma unroll 1
    for (; kt + 1 < ntiles; kt += 2) { DSA_TILE(kA, kB, kt); DSA_TILE(kB, kA, kt + 1); }
    if (kt < ntiles) DSA_TILE(kA, kB, kt);
#undef DSA_TILE
    l += __shfl_xor(l, 32);
    const float inv = 1.f / l;
    __half* yb = p.ys + (size_t)T * W + (size_t)(b * S + qi) * W + hd * 128;
    const __half* gp = p.atg16 + (size_t)(b * S + qi) * W + hd * 128;
#pragma unroll
    for (int et = 0; et < 4; ++et)
#pragma unroll
        for (int r4 = 0; r4 < 4; ++r4) {
            const int e0 = 32 * et + 8 * r4 + 4 * half;
            const h4 gv = *(const h4*)(gp + e0);
            h4 ov;
#pragma unroll
            for (int j = 0; j < 4; ++j) ov[j] = (_Float16)(o[et][4 * r4 + j] * inv * (float)gv[j]);
            *(h4*)(yb + e0) = ov;
        }
}

__device__ __forceinline__ void dsa_attend_block(const Params& p, int b, int jq, float* lds) {
    const int tid = tidx(), w = tid >> 6, lane = tid & 63, half = lane >> 5, col = lane & 31;
    const int grp = w & 3, hf = w >> 2, th = tid & 255;
    const int q0 = 32 * jq + 8 * grp, qi = q0 + (col >> 2), hd = col & 3;
    const int Tt = jq + 1, Th = (Tt + 1) >> 1;
    const int t0 = hf ? Th : 0, nt = hf ? Tt - Th : Th;
    __half* stg = (__half*)lds;
    const __half* qp = p.atq16 + (size_t)(b * S + qi) * W + hd * 128 + 8 * half;
    h8 qf[8];
#pragma unroll
    for (int ks = 0; ks < 8; ++ks) qf[ks] = *(const h8*)(qp + 16 * ks);
    f32x16 o[4];
#pragma unroll
    for (int et = 0; et < 4; ++et)
#pragma unroll
        for (int r = 0; r < 16; ++r) o[et][r] = 0.f;
    float m = -INFINITY, l = 0.f;
    const unsigned* mrow = p.mask + (size_t)(b * S + qi) * 64;
    const __half* kfb = p.kf16 + (size_t)b * 64 * 4096;
    const __half* vfb = p.vf16 + (size_t)b * 64 * 4096;
    h8 sr[4];
    __syncthreads();
    if (nt > 0) {
        sr[0] = *(const h8*)(kfb + (size_t)t0 * 4096 + th * 8); sr[1] = *(const h8*)(kfb + (size_t)t0 * 4096 + (th + 256) * 8);
        sr[2] = *(const h8*)(vfb + (size_t)t0 * 4096 + th * 8); sr[3] = *(const h8*)(vfb + (size_t)t0 * 4096 + (th + 256) * 8);
        __half* d = stg + (size_t)hf * 8192;
        *(h8*)(d + th * 8) = sr[0]; *(h8*)(d + (th + 256) * 8) = sr[1]; *(h8*)(d + 4096 + th * 8) = sr[2]; *(h8*)(d + 4096 + (th + 256) * 8) = sr[3];
    }
    unsigned mw = nt > 0 ? mrow[t0] : 0u;
    __syncthreads();
    asm volatile(".p2align 6" ::: "memory");
#pragma unroll 1
    for (int r = 0; r < Th; ++r) {
        const bool act = r < nt, nxt = r + 1 < nt;
        unsigned mwn = 0u;
        if (nxt) {
            const size_t tn = (size_t)(t0 + r + 1) * 4096;
            sr[0] = *(const h8*)(kfb + tn + th * 8); sr[1] = *(const h8*)(kfb + tn + (th + 256) * 8);
            sr[2] = *(const h8*)(vfb + tn + th * 8); sr[3] = *(const h8*)(vfb + tn + (th + 256) * 8);
            mwn = mrow[t0 + r + 1];
        }
        if (act) {
            const __half* st = stg + (size_t)((r & 1) * 2 + hf) * 8192 + lane * 8;
            const unsigned mws = mw >> (4 * half);
            f32x16 s;
#pragma unroll
            for (int i = 0; i < 16; ++i) s[i] = 0.f;
            h8 kf[8];
#pragma unroll
            for (int ks = 0; ks < 8; ++ks) kf[ks] = *(const h8*)(st + ks * 512);
#pragma unroll
            for (int ks = 0; ks < 8; ++ks) s = __builtin_amdgcn_mfma_f32_32x32x16_f16(kf[ks], qf[ks], s, 0, 0, 0);
            h8 vf[8];
#pragma unroll
            for (int i = 0; i < 8; ++i) vf[i] = *(const h8*)(st + 4096 + i * 512);
            float tmax = -INFINITY;
#pragma unroll
            for (int i = 0; i < 16; ++i) { s[i] = (mws & (1u << ((i & 3) + 8 * (i >> 2)))) ? s[i] : -INFINITY; tmax = fmaxf(tmax, s[i]); }
            { const auto sw = __builtin_amdgcn_permlane32_swap(__float_as_uint(tmax), __float_as_uint(tmax), false, false); tmax = fmaxf(__uint_as_float(sw[0]), __uint_as_float(sw[1])); }
            if (__any(tmax > m + 11.5f)) {
                const float mn = fmaxf(m, tmax), msf = mn == -INFINITY ? 0.f : mn;
                const float cs = __builtin_amdgcn_exp2f(m - msf);
                l *= cs; m = mn;
#pragma unroll
                for (int et = 0; et < 4; ++et)
#pragma unroll
                    for (int i = 0; i < 16; ++i) o[et][i] *= cs;
            }
            const float ms2 = m == -INFINITY ? 0.f : m;
            float ps = 0.f;
#pragma unroll
            for (int i = 0; i < 16; ++i) { s[i] = __builtin_amdgcn_exp2f(s[i] - ms2); ps += s[i]; }
            l += ps;
            h8 pb[2];
#pragma unroll
            for (int s2 = 0; s2 < 2; ++s2)
#pragma unroll
                for (int j = 0; j < 8; ++j) pb[s2][j] = (_Float16)s[8 * s2 + j];
#pragma unroll
            for (int et = 0; et < 4; ++et)
#pragma unroll
                for (int s2 = 0; s2 < 2; ++s2) o[et] = __builtin_amdgcn_mfma_f32_32x32x16_f16(vf[et * 2 + s2], pb[s2], o[et], 0, 0, 0);
        }
        if (nxt) {
            __half* d = stg + (size_t)(((r + 1) & 1) * 2 + hf) * 8192;
            *(h8*)(d + th * 8) = sr[0]; *(h8*)(d + (th + 256) * 8) = sr[1]; *(h8*)(d + 4096 + th * 8) = sr[2]; *(h8*)(d + 4096 + (th + 256) * 8) = sr[3];
        }
        mw = mwn;
        __syncthreads();
    }
    l += __shfl_xor(l, 32);
    float* mg = lds;
    if (hf == 1) {
        float* d = mg + (size_t)grp * 66 * 64 + lane;
#pragma unroll
        for (int et = 0; et < 4; ++et)
#pragma unroll
            for (int i = 0; i < 16; ++i) d[(et * 16 + i) * 64] = o[et][i];
        d[64 * 64] = m; d[65 * 64] = l;
    }
    __syncthreads();
    if (hf == 0) {
        const float* d = mg + (size_t)grp * 66 * 64 + lane;
        const float m2 = d[64 * 64], l2 = d[65 * 64];
        const float mn = fmaxf(m, m2), msf = mn == -INFINITY ? 0.f : mn;
        const float a1 = __builtin_amdgcn_exp2f(m - msf), a2 = __builtin_amdgcn_exp2f(m2 - msf);
        const float inv = 1.f / (l * a1 + l2 * a2);
        __half* yb = p.ys + (size_t)T * W + (size_t)(b * S + qi) * W + hd * 128;
        const __half* gp = p.atg16 + (size_t)(b * S + qi) * W + hd * 128;
#pragma unroll
        for (int et = 0; et < 4; ++et)
#pragma unroll
            for (int k2 = 0; k2 < 2; ++k2) {
                unsigned pk[2][2];
#pragma unroll
                for (int q = 0; q < 2; ++q) {
                    const int r4 = 2 * k2 + q, e0 = 32 * et + 8 * r4 + 4 * half;
                    const h4 gv = *(const h4*)(gp + e0);
                    h4 ov;
#pragma unroll
                    for (int j = 0; j < 4; ++j) ov[j] = (_Float16)((o[et][4 * r4 + j] * a1 + d[(et * 16 + 4 * r4 + j) * 64] * a2) * inv * (float)gv[j]);
                    const uint2 w2 = __builtin_bit_cast(uint2, ov);
                    pk[q][0] = w2.x; pk[q][1] = w2.y;
                }
                const auto s0 = __builtin_amdgcn_permlane32_swap(pk[0][0], pk[1][0], false, false); const auto s1 = __builtin_amdgcn_permlane32_swap(pk[0][1], pk[1][1], false, false);
                *(u32x4*)(yb + 32 * et + 16 * k2 + 8 * half) = (u32x4){s0[0], s1[0], s0[1], s1[1]};
            }
    }
    __syncthreads();
}

typedef __bf16 bf8 __attribute__((ext_vector_type(8)));
constexpr int HG_QS = 136;
constexpr int HG_VS = 72;
struct HgIn { float lf[16]; h8 q0, q1, v0, v1; };
__device__ __forceinline__ void hg_issue_loads(const Params& p, int tok0, int hd, int tid, bool need_q, HgIn& in) {
    const int d = tid & 127, seg = tid >> 7;
    const size_t base = (size_t)(tok0 + seg * 16) * W + hd * 128 + d;
#pragma unroll
    for (int i = 0; i < 16; ++i) in.lf[i] = p.lf32[base + (size_t)i * W];
#pragma unroll
    for (int i = 0; i < 8; ++i) { in.v0[i] = __builtin_bit_cast(_Float16, p.v16[base + (size_t)i * W]); in.v1[i] = __builtin_bit_cast(_Float16, p.v16[base + (size_t)(8 + i) * W]); }
    if (need_q) {
#pragma unroll
        for (int i = 0; i < 8; ++i) { in.q0[i] = __builtin_bit_cast(_Float16, p.q16[base + (size_t)i * W]); in.q1[i] = __builtin_bit_cast(_Float16, p.q16[base + (size_t)(8 + i) * W]); }
    }
}
__device__ __forceinline__ void hg_cumsum(int tid, float* segt, const float (&lf)[16], float (&bcs)[16], float& blast, float& bref) {
    const int d = tid & 127, seg = tid >> 7;
    float run = 0.f;
#pragma unroll
    for (int i = 0; i < 16; ++i) { run += lf[i]; bcs[i] = run; }
    segt[seg * 128 + d] = run;
    BAR_LDS();
    const float s0 = segt[d], s1 = segt[128 + d], s2 = segt[256 + d], s3 = segt[384 + d];
    const float off = seg == 0 ? 0.f : (seg == 1 ? s0 : (seg == 2 ? s0 + s1 : s0 + s1 + s2));
#pragma unroll
    for (int i = 0; i < 16; ++i) bcs[i] += off;
    blast = s0 + s1 + s2 + s3; bref = s0 + s1;
}
__device__ __forceinline__ void hg_pass1(const Params& p, int u, float* lds, const HgIn& in) {
    const int tid = tidx(), w = tid >> 6, lane = tid & 63, half = lane >> 5, col = lane & 31;
    const int c = u & 31, bh = u >> 5, hd = bh & 3, b = bh >> 2, tok0 = b * S + c * 64;
    __half* KH = (__half*)lds;
    __half* VT = KH + 128 * HG_VS;
    float* segt = (float*)(VT + 128 * HG_VS);
    BAR_LDS();
    float bcs[16], blast, bref;
    hg_cumsum(tid, segt, in.lf, bcs, blast, bref);
    {
        const int d = tid & 127, seg = tid >> 7;
        h8 k0, k1;
#pragma unroll
        for (int i = 0; i < 8; ++i) { k0[i] = (_Float16)((1.f - __builtin_amdgcn_exp2f(in.lf[i])) * __builtin_amdgcn_exp2f(blast - bcs[i])); k1[i] = (_Float16)((1.f - __builtin_amdgcn_exp2f(in.lf[8 + i])) * __builtin_amdgcn_exp2f(blast - bcs[8 + i])); }
        *(h8*)(KH + d * HG_VS + seg * 16) = k0; *(h8*)(KH + d * HG_VS + seg * 16 + 8) = k1;
        if (seg == 0) p.dec32[(size_t)u * 128 + d] = __builtin_amdgcn_exp2f(blast);
        *(h8*)(VT + d * HG_VS + seg * 16) = in.v0; *(h8*)(VT + d * HG_VS + seg * 16 + 8) = in.v1;
    }
    BAR_LDS();
    const int dt = w >> 1;
    h8 af[4];
#pragma unroll
    for (int ks = 0; ks < 4; ++ks) af[ks] = *(const h8*)(KH + (dt * 32 + col) * HG_VS + 16 * ks + 8 * half);
#pragma unroll
    for (int ee = 0; ee < 2; ++ee) {
        const int et = (w & 1) * 2 + ee;
        f32x16 acc;
#pragma unroll
        for (int r = 0; r < 16; ++r) acc[r] = 0.f;
#pragma unroll
        for (int ks = 0; ks < 4; ++ks) acc = __builtin_amdgcn_mfma_f32_32x32x16_f16(af[ks], *(const h8*)(VT + (et * 32 + col) * HG_VS + 16 * ks + 8 * half), acc, 0, 0, 0);
        __half* dst = p.stT16 + ((((size_t)u * 4 + et) * 8 + dt * 2) * 64 + lane) * 8;
#pragma unroll
        for (int k2 = 0; k2 < 2; ++k2) {
            unsigned pk[2][2];
#pragma unroll
            for (int q = 0; q < 2; ++q) { const int r4 = 2 * k2 + q; const h4 o = {(_Float16)acc[4 * r4], (_Float16)acc[4 * r4 + 1], (_Float16)acc[4 * r4 + 2], (_Float16)acc[4 * r4 + 3]}; const uint2 w2 = __builtin_bit_cast(uint2, o); pk[q][0] = w2.x; pk[q][1] = w2.y; }
            const auto s0 = __builtin_amdgcn_permlane32_swap(pk[0][0], pk[1][0], false, false); const auto s1 = __builtin_amdgcn_permlane32_swap(pk[0][1], pk[1][1], false, false);
            *(u32x4*)(dst + 512 * k2) = (u32x4){s0[0], s1[0], s0[1], s1[1]};
        }
    }
}
__device__ void hg_scan(const Params& p) {
    const int t = tidx();
    if (t >= 256) return;
    for (int gt = blockIdx.x * 256 + t; gt < 32 * 128 * 16; gt += gridDim.x * 256) {
    const int l6 = gt & 63, ksd = (gt >> 6) & 7, ets = (gt >> 9) & 3, bh = gt >> 11;
    const int d8 = ksd * 16 + (l6 >> 5) * 8;
    const size_t fo = (((size_t)ets * 8 + ksd) * 64 + l6) * 8;
    float s[8];
#pragma unroll
    for (int j = 0; j < 8; ++j) s[j] = 0.f;
#pragma unroll 1
    for (int c0 = 0; c0 < 32; c0 += 8) {
        h8 tv[8]; f32x4 g0[8], g1[8];
#pragma unroll
        for (int i = 0; i < 8; ++i) {
            const size_t u = (size_t)bh * 32 + c0 + i;
            tv[i] = *(const h8*)(p.stT16 + u * 16384 + fo);
            g0[i] = *(const f32x4*)(p.dec32 + u * 128 + d8); g1[i] = *(const f32x4*)(p.dec32 + u * 128 + d8 + 4);
        }
#pragma unroll
        for (int i = 0; i < 8; ++i) {
            const size_t u = (size_t)bh * 32 + c0 + i;
            h8 o;
#pragma unroll
            for (int j = 0; j < 8; ++j) o[j] = (_Float16)s[j];
            *(h8*)(p.stT16 + u * 16384 + fo) = o;
#pragma unroll
            for (int j = 0; j < 4; ++j) { s[j] = g0[i][j] * s[j] + (float)tv[i][j]; s[4 + j] = g1[i][j] * s[4 + j] + (float)tv[i][4 + j]; }
        }
    }
    }
}
__device__ __forceinline__ void hg_pass3(const Params& p, int l, int u, float* lds, const HgIn& in) {
    const int tid = tidx(), w = tid >> 6, lane = tid & 63, half = lane >> 5, col = lane & 31;
    const int c = u & 31, bh = u >> 5, hd = bh & 3, b = bh >> 2, tok0 = b * S + c * 64;
    __half* QI = (__half*)lds;
    __bf16* QM = (__bf16*)(QI + 64 * HG_QS);
    __bf16* KM = QM + 64 * HG_QS;
    __half* VT = (__half*)(KM + 64 * HG_QS);
    float* segt = (float*)(VT + 128 * HG_VS);
    float* part = segt + 512;
    const int tt = w & 1, et = w >> 1;
    h8 sf[8];
    {
        const __half* sp = p.stT16 + ((((size_t)u * 4 + et) * 8) * 64 + lane) * 8;
#pragma unroll
        for (int ks = 0; ks < 8; ++ks) sf[ks] = *(const h8*)(sp + 512 * ks);
    }
    const size_t ob = (size_t)(tok0 + tt * 32 + col) * W + hd * 128;
    h4 gv[4];
#pragma unroll
    for (int r4 = 0; r4 < 4; ++r4) gv[r4] = *(const h4*)(p.hgg16 + ob + et * 32 + 8 * r4 + 4 * half);
    BAR_LDS();
    float bcs[16], blast, bref;
    hg_cumsum(tid, segt, in.lf, bcs, blast, bref);
    {
        const int d = tid & 127, seg = tid >> 7;
#pragma unroll
        for (int i = 0; i < 16; ++i) {
            const int tk = seg * 16 + i;
            const float q = (float)(i < 8 ? in.q0[i & 7] : in.q1[i & 7]);
            QI[tk * HG_QS + d] = __float2half(q * __builtin_amdgcn_exp2f(bcs[i]));
            QM[tk * HG_QS + d] = (__bf16)(q * __builtin_amdgcn_exp2f(bcs[i] - bref));
            KM[tk * HG_QS + d] = (__bf16)((1.f - __builtin_amdgcn_exp2f(in.lf[i])) * __builtin_amdgcn_exp2f(bref - bcs[i]));
        }
        *(h8*)(VT + d * HG_VS + seg * 16) = in.v0; *(h8*)(VT + d * HG_VS + seg * 16 + 8) = in.v1;
    }
    BAR_LDS();
    h8 pb[2][2];
    bf8 qm[8];
#pragma unroll
    for (int ks = 0; ks < 8; ++ks) qm[ks] = *(const bf8*)(QM + (tt * 32 + col) * HG_QS + 16 * ks + 8 * half);
#pragma unroll
    for (int st = 0; st < 2; ++st) {
        if (st <= tt) {
            f32x16 sacc;
#pragma unroll
            for (int r = 0; r < 16; ++r) sacc[r] = 0.f;
#pragma unroll
            for (int ks = 0; ks < 8; ++ks) sacc = __builtin_amdgcn_mfma_f32_32x32x16_bf16(*(const bf8*)(KM + (st * 32 + col) * HG_QS + 16 * ks + 8 * half), qm[ks], sacc, 0, 0, 0);
#pragma unroll
            for (int r = 0; r < 16; ++r) {
                const int sl = (r & 3) + 8 * (r >> 2) + 4 * half;
                const float v = (st < tt || sl <= col) ? sacc[r] : 0.f;
                pb[st][r >> 3][r & 7] = (_Float16)v;
            }
        } else {
#pragma unroll
            for (int j = 0; j < 8; ++j) { pb[st][0][j] = (_Float16)0.f; pb[st][1][j] = (_Float16)0.f; }
        }
    }
    f32x16 o;
#pragma unroll
    for (int r = 0; r < 16; ++r) o[r] = 0.f;
#pragma unroll
    for (int st = 0; st < 2; ++st) {
        if (st <= tt) {
#pragma unroll
            for (int s2 = 0; s2 < 2; ++s2) {
                const __half* vp = VT + (et * 32 + col) * HG_VS + st * 32 + 16 * s2 + 4 * half;
                const h4 v0 = *(const h4*)vp, v1 = *(const h4*)(vp + 8);
                const h8 vf = {v0[0], v0[1], v0[2], v0[3], v1[0], v1[1], v1[2], v1[3]};
                o = __builtin_amdgcn_mfma_f32_32x32x16_f16(vf, pb[st][s2], o, 0, 0, 0);
            }
        }
    }
    {
#pragma unroll
        for (int ks = 0; ks < 8; ++ks) o = __builtin_amdgcn_mfma_f32_32x32x16_f16(sf[ks], *(const h8*)(QI + (tt * 32 + col) * HG_QS + 16 * ks + 8 * half), o, 0, 0, 0);
    }
    float ss = 0.f;
#pragma unroll
    for (int r = 0; r < 16; ++r) ss += o[r] * o[r];
    ss += __shfl_xor(ss, 32);
    if (half == 0) part[et * 64 + tt * 32 + col] = ss;
    BAR_LDS();
    const int tk = tt * 32 + col;
    const float tot = part[tk] + part[64 + tk] + part[128 + tk] + part[192 + tk];
    const float rs = rsqrtf(tot * (1.f / 128.f) + EPS);
    const float* on = p.onorm_g + l * 128;
#pragma unroll
    for (int k2 = 0; k2 < 2; ++k2) {
        unsigned pk[2][2];
#pragma unroll
        for (int q = 0; q < 2; ++q) {
            const int r4 = 2 * k2 + q, e0 = et * 32 + 8 * r4 + 4 * half;
            const f32x4 nv = *(const f32x4*)(on + e0);
            h4 ov;
#pragma unroll
            for (int j = 0; j < 4; ++j) ov[j] = (_Float16)(o[4 * r4 + j] * rs * nv[j] * (float)gv[r4][j]);
            const uint2 w2 = __builtin_bit_cast(uint2, ov);
            pk[q][0] = w2.x; pk[q][1] = w2.y;
        }
        const auto s0 = __builtin_amdgcn_permlane32_swap(pk[0][0], pk[1][0], false, false); const auto s1 = __builtin_amdgcn_permlane32_swap(pk[0][1], pk[1][1], false, false);
        *(u32x4*)(p.ys + ob + et * 32 + 16 * k2 + 8 * half) = (u32x4){s0[0], s1[0], s0[1], s1[1]};
    }
}

constexpr int S5_UP = 1032;
__device__ void s5_pow_table(const Params& p) {
    const size_t gtid = (size_t)blockIdx.x * 512 + tidx(), nth = (size_t)gridDim.x * 512;
    for (size_t i = gtid; i < (size_t)NL * 32 * 64 * 65; i += nth) {
        const int tau = (int)(i % 65); const size_t lgp = i / 65; const int lg = (int)(lgp / 64);
        const double dt = exp((double)p.log_dt[lg]);
        const double are = p.a_re[lgp], aim = p.a_im[lgp];
        const double mag = exp(are * dt * tau), ang = aim * dt * tau;
        p.pw[i * 2] = (float)(mag * cos(ang)); p.pw[i * 2 + 1] = (float)(mag * sin(ang));
    }
    for (int i = (int)blockIdx.x * 512 + tidx(); i < NL * 32; i += (int)gridDim.x * 512) {
        const int se = (int)rintf(-p.log_dt[i] * 1.4426950408889634f);
        p.sg[i * 2] = ldexpf(1.f, se); p.sg[i * 2 + 1] = ldexpf(1.f, -se);
    }
}
constexpr size_t S5_KM_SZ = (size_t)32 * 64 * 256, S5_HG_SZ = (size_t)32 * 128 * 1024;
__device__ void s5_build_tables(const Params& p, int l, float* lds, int part, int nparts) {
    float* Cr = lds; float* Ci = Cr + 16 * 65; float* Br = Ci + 16 * 65; float* Bi = Br + 64 * 17; float* Wr = Bi + 64 * 17; float* Wi = Wr + 65 * 65;
    const int tid = tidx();
    __half* kmat16 = p.kmat16 + (size_t)(l & 1) * S5_KM_SZ; __half* hs16 = p.hs16 + (size_t)(l & 1) * S5_HG_SZ; __half* gs16 = p.gs16 + (size_t)(l & 1) * S5_HG_SZ;
    for (int item = part; item < 128; item += nparts) {
        const int g = item >> 2, q4 = item & 3; const size_t lg = (size_t)l * 32 + g;
        __syncthreads();
        for (int i = tid; i < 1024; i += 512) {
            const int c = i >> 6, s = i & 63; Cr[c * 65 + s] = p.c_re[(lg * 16 + c) * 64 + s]; Ci[c * 65 + s] = p.c_im[(lg * 16 + c) * 64 + s];
            const int s2 = i >> 4, cp = i & 15; Br[s2 * 17 + cp] = p.bbar[((lg * 64 + s2) * 16 + cp) * 2]; Bi[s2 * 17 + cp] = p.bbar[((lg * 64 + s2) * 16 + cp) * 2 + 1];
        }
        for (int i = tid; i < 64 * 65; i += 512) { const int s = i / 65, lag = i - 65 * s; Wr[lag * 65 + s] = p.pw[((lg * 64 + s) * 65 + lag) * 2]; Wi[lag * 65 + s] = p.pw[((lg * 64 + s) * 65 + lag) * 2 + 1]; }
        __syncthreads();
        const float sgv = p.sg[lg * 2];
        {
            const int cp = tid & 15, c = (tid >> 4) & 15, lag0 = q4 * 16 + (tid >> 8) * 8;
            float acc[8];
#pragma unroll
            for (int j = 0; j < 8; ++j) acc[j] = 0.f;
#pragma unroll 4
            for (int s = 0; s < 64; ++s) {
                const float cr = Cr[c * 65 + s], ci = Ci[c * 65 + s], br = Br[s * 17 + cp], bi = Bi[s * 17 + cp];
                const float pr = cr * br - ci * bi, pi = cr * bi + ci * br;
#pragma unroll
                for (int j = 0; j < 8; ++j) acc[j] += pr * Wr[(lag0 + j) * 65 + s] - pi * Wi[(lag0 + j) * 65 + s];
            }
#pragma unroll
            for (int j = 0; j < 8; ++j) kmat16[(((size_t)g * 64 + lag0 + j) * 16 + c) * 16 + cp] = __float2half(acc[j] * sgv);
        }
#pragma unroll 1
        for (int k = 0; k < 8; ++k) {
            const int ch = tid + 512 * k, l6 = ch & 63, cp0 = (l6 >> 5) * 8, sig = (ch >> 6) & 63, n = q4 * 32 + (l6 & 31), s = n & 63;
            const float wr = Wr[(63 - sig) * 65 + s], wi = Wi[(63 - sig) * 65 + s];
            h8 o;
#pragma unroll
            for (int j = 0; j < 8; ++j) { const float br = Br[s * 17 + cp0 + j], bi = Bi[s * 17 + cp0 + j]; o[j] = (_Float16)((n < 64 ? wr * br - wi * bi : wr * bi + wi * br) * sgv); }
            *(h8*)(hs16 + ((((size_t)g * 4 + q4) * 64 + sig) * 64 + l6) * 8) = o;
        }
#pragma unroll 1
        for (int k = 0; k < 8; ++k) {
            const int ch = tid + 512 * k, l6 = ch & 63, ks = (ch >> 6) & 7, rtl = ch >> 9, c = l6 & 15, tau = q4 * 16 + 2 * rtl + ((l6 >> 4) & 1), n0 = ks * 16 + (l6 >> 5) * 8, s0 = n0 & 63;
            h8 o;
#pragma unroll
            for (int j = 0; j < 8; ++j) {
                const float cr = Cr[c * 65 + s0 + j], ci = Ci[c * 65 + s0 + j], wr = Wr[(tau + 1) * 65 + s0 + j], wi = Wi[(tau + 1) * 65 + s0 + j];
                o[j] = (_Float16)(n0 < 64 ? cr * wr - ci * wi : -(cr * wi + ci * wr));
            }
            *(h8*)(gs16 + ((((size_t)g * 32 + q4 * 8 + rtl) * 8 + ks) * 64 + l6) * 8) = o;
        }
    }
    __syncthreads();
}
__device__ __forceinline__ void s5_load_u(const Params& p, int g, int b, int tid, __half* U) {
#pragma unroll
    for (int i = 0; i < 4; ++i) {
        const int idx = tid + 512 * i, ch = idx >> 6, sig = idx & 63;
        const h8* src = (const h8*)(p.s5u16 + (size_t)(b * S + ch * 64 + sig) * W + g * 16);
        const h8 a = src[0], c2 = src[1];
        *(h8*)(U + ch * S5_UP + sig * 16) = a; *(h8*)(U + ch * S5_UP + sig * 16 + 8) = c2;
    }
}
__device__ void s5_pass1(const Params& p, int l, int g, int b, float* lds) {
    const int tid = tidx(), w = tid >> 6, lane = tid & 63, half = lane >> 5, col = lane & 31;
    __half* U = (__half*)lds;
    float* part = (float*)(U + 32 * S5_UP);
    __syncthreads();
    s5_load_u(p, g, b, tid, U);
    __syncthreads();
    const int nt = w & 3, sh = w >> 2;
    const __half* hp = p.hs16 + (size_t)(l & 1) * S5_HG_SZ + (((size_t)g * 4 + nt) * 64 * 64 + lane) * 8;
    const __half* up = U + col * S5_UP + 8 * half;
    f32x16 acc;
#pragma unroll
    for (int r = 0; r < 16; ++r) acc[r] = 0.f;
#pragma unroll 8
    for (int sig = sh * 32; sig < sh * 32 + 32; ++sig) acc = __builtin_amdgcn_mfma_f32_32x32x16_f16(*(const h8*)(hp + sig * 512), *(const h8*)(up + sig * 16), acc, 0, 0, 0);
    if (sh == 1) {
#pragma unroll
        for (int r = 0; r < 16; ++r) part[(nt * 16 + r) * 64 + lane] = acc[r];
    }
    __syncthreads();
    if (sh == 0) {
        float* ep = p.e32 + (((size_t)g * 8 + b) * 32 + col) * 128 + nt * 32 + 4 * half;
#pragma unroll
        for (int r4 = 0; r4 < 4; ++r4) {
            f32x4 o;
#pragma unroll
            for (int j = 0; j < 4; ++j) o[j] = acc[4 * r4 + j] + part[(nt * 16 + 4 * r4 + j) * 64 + lane];
            *(f32x4*)(ep + 8 * r4) = o;
        }
    }
}
__device__ void s5_scan(const Params& p, int l) {
    const int t = tidx();
    if (t < 256 || t >= 320) return;
    for (int gt = blockIdx.x * 64 + (t - 256); gt < 32 * 8 * 64; gt += gridDim.x * 64) {
    const int s = gt & 63, b = (gt >> 6) & 7, g = gt >> 9;
    const size_t lg = (size_t)l * 32 + g;
    const float ar = p.pw[((lg * 64 + s) * 65 + 64) * 2], ai = p.pw[((lg * 64 + s) * 65 + 64) * 2 + 1];
    float xr = 0.f, xi = 0.f;
    float er[32], ei[32];
#pragma unroll
    for (int i = 0; i < 32; ++i) { const size_t base = (((size_t)g * 8 + b) * 32 + i) * 128; er[i] = p.e32[base + s]; ei[i] = p.e32[base + 64 + s]; }
#pragma unroll
    for (int i = 0; i < 32; ++i) {
        const size_t base = (((size_t)g * 8 + b) * 32 + i) * 128;
        p.x16[base + s] = __float2half(xr); p.x16[base + 64 + s] = __float2half(xi);
        const float nr = ar * xr - ai * xi + er[i], ni = ar * xi + ai * xr + ei[i];
        xr = nr; xi = ni;
    }
    }
}
__device__ void s5_pass3(const Params& p, int l, int g, int b, float* lds) {
    const int tid = tidx(), w = tid >> 6, lane = tid & 63, half = lane >> 5, col = lane & 31;
    __half* U = (__half*)lds;
    __half* KM = U + 32 * S5_UP;
    __syncthreads();
    s5_load_u(p, g, b, tid, U);
    for (int i = tid; i < 64 * 256 / 8; i += 512) *(h8*)(KM + 384 + (i >> 5) * 384 + ((i >> 1) & 15) * 24 + (i & 1) * 8) = *(const h8*)(p.kmat16 + (size_t)(l & 1) * S5_KM_SZ + (size_t)g * 64 * 256 + i * 8);
    if (tid < 48) { unsigned zz; asm volatile("v_mov_b32 %0, 0" : "=v"(zz)); *(u32x4*)(KM + tid * 8) = (u32x4){zz, zz, zz, zz}; }
    __syncthreads();
    h8 xb[8];
    {
        const __half* xp = p.x16 + (((size_t)g * 8 + b) * 32 + col) * 128 + 8 * half;
#pragma unroll
        for (int ks = 0; ks < 8; ++ks) xb[ks] = *(const h8*)(xp + 16 * ks);
    }
    const float isg = p.sg[((size_t)l * 32 + g) * 2 + 1];
    const __half* up = U + col * S5_UP + 8 * half;
    const int cch = col & 15, tl = col >> 4;
    f32x4 dvh[2];
#pragma unroll
    for (int q = 0; q < 2; ++q) dvh[q] = *(const f32x4*)(p.s5_d + l * W + g * 16 + 8 * q + 4 * half);
#pragma unroll 1
    for (int rt = w; rt < 32; rt += 8) {
        f32x16 acc;
#pragma unroll
        for (int r = 0; r < 16; ++r) acc[r] = 0.f;
        const int tau = 2 * rt + tl, nst = 2 * rt + 2;
        h8 gf[8];
        {
            const __half* gp = p.gs16 + (size_t)(l & 1) * S5_HG_SZ + ((((size_t)g * 32 + rt) * 8) * 64 + lane) * 8;
#pragma unroll
            for (int ks = 0; ks < 8; ++ks) gf[ks] = *(const h8*)(gp + 512 * ks);
        }
        {
            const __half* ka = KM + (tau + 1) * 384 + cch * 24 + 8 * half;
            h8 a0 = *(const h8*)(ka), b0 = *(const h8*)(up), a1 = *(const h8*)(ka - 384), b1 = *(const h8*)(up + 16);
#pragma unroll 1
            for (int sig = 0; sig < nst; sig += 2) {
                const int s2 = sig + 2 < nst ? sig + 2 : sig;
                const h8 a2 = *(const h8*)(ka - s2 * 384), b2 = *(const h8*)(up + s2 * 16), a3 = *(const h8*)(ka - (s2 + 1) * 384), b3 = *(const h8*)(up + (s2 + 1) * 16);
                acc = __builtin_amdgcn_mfma_f32_32x32x16_f16(a0, b0, acc, 0, 0, 0);
                acc = __builtin_amdgcn_mfma_f32_32x32x16_f16(a1, b1, acc, 0, 0, 0);
                a0 = a2; b0 = b2; a1 = a3; b1 = b3;
            }
        }
#pragma unroll
        for (int ks = 0; ks < 8; ++ks) acc = __builtin_amdgcn_mfma_f32_32x32x16_f16(gf[ks], xb[ks], acc, 0, 0, 0);
#pragma unroll
        for (int tloc = 0; tloc < 2; ++tloc) {
            const int tk = 2 * rt + tloc;
            unsigned pk[2][2];
#pragma unroll
            for (int q = 0; q < 2; ++q) {
                const int r4 = 2 * tloc + q, c0 = 8 * q + 4 * half;
                const h4 uv = *(const h4*)(U + col * S5_UP + tk * 16 + c0);
                const f32x4 dv = dvh[q];
                h4 ov;
#pragma unroll
                for (int j = 0; j < 4; ++j) ov[j] = (_Float16)gelu_tanh_f(acc[4 * r4 + j] * isg + dv[j] * (float)uv[j]);
                const uint2 w2 = __builtin_bit_cast(uint2, ov);
                pk[q][0] = w2.x; pk[q][1] = w2.y;
            }
            u32x4 o16;
            { const auto s0 = __builtin_amdgcn_permlane32_swap(pk[0][0], pk[1][0], false, false); const auto s1 = __builtin_amdgcn_permlane32_swap(pk[0][1], pk[1][1], false, false);
              o16 = (u32x4){s0[0], s1[0], s0[1], s1[1]}; }
            *(u32x4*)(p.ypre16 + (size_t)(b * S + col * 64 + tk) * W + g * 16 + 8 * half) = o16;
        }
    }
}

__device__ void phase_mix1(const Params& p, int l, float* lds) {
    const int c = blockIdx.x, G = gridDim.x;
    phase_fix(p, l, lds);
    for (int u = c; u < 256; u += G) s5_pass1(p, l, u >> 3, u & 7, lds);
#pragma unroll 1
    for (int u = c; u < 1024; u += G) {
        HgIn cur; const int bh = u >> 5;
        hg_issue_loads(p, (bh >> 2) * S + (u & 31) * 64, bh & 3, tidx(), false, cur);
        hg_pass1(p, u, lds, cur);
    }
    __syncthreads();
}
__device__ void phase_mix2(const Params& p, int l, float* lds) {
    const int c = blockIdx.x, G = gridDim.x;
    s5_scan(p, l);
    hg_scan(p);
    __syncthreads();
    for (int cb = c; cb < 256; cb += G) {
        const int b = cb >> 5, cc = cb & 31, k = cc & 15;
#pragma unroll 1
        for (int i = 0; i < 4; ++i) {
            const int j = i == 0 ? cc : (i == 1 ? 63 - cc : (i == 2 ? 64 + cc : 127 - cc));
            dsa_select(p, b, j * 16, lds);
        }
    }
}
__device__ void phase_mix3(const Params& p, int l, float* lds) {
    for (int c = blockIdx.x; c < 256; c += gridDim.x) {
        const int b = c & 7, cc = c >> 3;
#pragma unroll 1
        for (int k = 0; k < 2; ++k) dsa_attend_block(p, b, k ? 63 - cc : cc, lds);
    }
    for (int u = blockIdx.x; u < 256; u += gridDim.x) s5_pass3(p, l, u >> 3, u & 7, lds);
#pragma unroll 1
    for (int u = blockIdx.x; u < 1024; u += gridDim.x) {
        HgIn cur; const int bh = u >> 5;
        hg_issue_loads(p, (bh >> 2) * S + (u & 31) * 64, bh & 3, tidx(), true, cur);
        hg_pass3(p, l, u, lds, cur);
    }
    __syncthreads();
}

#define XB_TMO      128
#define XB_XCNT(j)  (256  + 64 * (j))
#define XB_XSUB(j)  (1280 + 64 * (j))
#define XB_XGEN(j)  (2304 + 64 * (j))
#define XB_TOP      3328
#define XB_TOPGEN   3392
#define XCD_BAR_WORDS 3456
#define XB_SPIN_CAP (1u << 22)
__device__ __forceinline__ unsigned xb_ld(unsigned* p)              { return __hip_atomic_load(p, __ATOMIC_RELAXED, __HIP_MEMORY_SCOPE_AGENT); }
__device__ __forceinline__ unsigned xb_add(unsigned* p, unsigned v) { return __hip_atomic_fetch_add(p, v, __ATOMIC_RELAXED, __HIP_MEMORY_SCOPE_AGENT); }
__device__ __forceinline__ unsigned xb_xcc_id() { return (unsigned)__builtin_amdgcn_s_getreg((3 << 11) | 20) & 0xFu; }
#define XB_SPIN(cond, bar) do { unsigned _sp = 0; while (cond) { __builtin_amdgcn_s_sleep(1); \
    if ((++_sp & 255u) == 0u) { if (xb_ld(&(bar)[XB_TMO])) break; if (_sp > XB_SPIN_CAP) { atomicAdd(&(bar)[XB_TMO], 1u); break; } } } } while (0)
struct XcdBarrier { unsigned* bar; unsigned x; volatile LAS unsigned* st; };
__device__ __forceinline__ XcdBarrier xcd_barrier_post(unsigned* bar, volatile LAS unsigned* st) {
    XcdBarrier b; b.bar = bar; b.x = xb_xcc_id(); b.st = st;
    if (threadIdx.x == 0) (void)xb_add(&bar[XB_XCNT(b.x)], 1u);
    return b;
}
__device__ __forceinline__ void xcd_barrier_complete(unsigned* bar, unsigned x, unsigned& nloc, unsigned& nx) {
    const unsigned G = gridDim.x * gridDim.y * gridDim.z;
    unsigned sum, cnt, mine, sp = 0u;
    for (;;) {
        sum = 0u; cnt = 0u; mine = 0u;
#pragma unroll
        for (unsigned j = 0; j < 16; ++j) { const unsigned c = xb_ld(&bar[XB_XCNT(j)]); sum += c; cnt += (c > 0u) ? 1u : 0u; mine = (j == x) ? c : mine; }
        if (sum == G) break;
        __builtin_amdgcn_s_sleep(1);
        if ((++sp & 255u) == 0u) { if (xb_ld(&bar[XB_TMO])) break; if (sp > XB_SPIN_CAP) { atomicAdd(&bar[XB_TMO], 1u); break; } }
    }
    nloc = mine > 0u ? mine : 1u; nx = cnt > 0u ? cnt : 1u;
}
__device__ __forceinline__ void xcd_barrier(const XcdBarrier& b) {
    asm volatile("s_waitcnt vmcnt(0)" ::: "memory");
    __syncthreads();
    if (threadIdx.x == 0) {
        unsigned* bar = b.bar;
        __builtin_amdgcn_s_waitcnt(0);
        unsigned nloc = b.st[0], nx = b.st[1];
        if (nloc == 0u) { xcd_barrier_complete(bar, b.x, nloc, nx); b.st[0] = nloc; b.st[1] = nx; }
        const unsigned old = xb_add(&bar[XB_XSUB(b.x)], 1u);
        const unsigned gen = old / nloc;
        if (old + 1u == (gen + 1u) * nloc) {
            __builtin_amdgcn_fence(__ATOMIC_RELEASE, "agent");
            asm volatile("s_waitcnt vmcnt(0)" ::: "memory");
            const unsigned og = xb_add(&bar[XB_TOP], 1u);
            const unsigned tg = og / nx;
            if (og + 1u == (tg + 1u) * nx) xb_add(&bar[XB_TOPGEN], 1u);
            else XB_SPIN(xb_ld(&bar[XB_TOPGEN]) == tg, bar);
            __builtin_amdgcn_fence(__ATOMIC_ACQUIRE, "agent");
            xb_add(&bar[XB_XGEN(b.x)], 1u);
            asm volatile("s_waitcnt vmcnt(0)" ::: "memory");
        } else {
            XB_SPIN(xb_ld(&bar[XB_XGEN(b.x)]) == gen, bar);
            __builtin_amdgcn_fence(__ATOMIC_ACQUIRE, "agent");
            asm volatile("s_waitcnt vmcnt(0)" ::: "memory");
        }
    }
    __syncthreads();
}

typedef const __attribute__((address_space(4))) Params* KParams;
#define PHASE_PARAMS() KParams _kp = (KParams)__builtin_amdgcn_kernarg_segment_ptr(); asm volatile("" : "+s"(_kp)); const Params& p = *(const Params*)_kp
__global__ void __launch_bounds__(512, 2) mega(Params p_unused) {
    extern __shared__ __attribute__((aligned(16))) float lds[];
    LAS unsigned char* ldsb = (LAS unsigned char*)lds;
    cg::grid_group grid = cg::this_grid();
    const int G = gridDim.x, c = blockIdx.x;
    __shared__ uint4 xb_words;
    if (threadIdx.x == 0) xb_words = make_uint4(0u, 0u, 0u, 0u);
    __syncthreads();
    XcdBarrier xbar;
    { PHASE_PARAMS(); xbar = xcd_barrier_post(p.xbar, (volatile LAS unsigned*)&xb_words); }
    { PHASE_PARAMS(); phase0(p); s5_pow_table(p); }
    grid.sync();
    for (int l = 0; l < NL; ++l) {
        { PHASE_PARAMS(); conv_in(p, l, lds); phase_h(p, l); if (l == 0) s5_build_tables(p, 0, lds, c, G); }
        xcd_barrier(xbar);
        {
            PHASE_PARAMS();
            SchedPlain sc{(const char*)p.h16, (const char*)p.win16, 64, 32, G, c, D};
            EpiProj ep{p.q16, p.v16, p.hgg16, p.atq16, p.atk16, p.atv16, p.atg16, p.ixq16, p.ixk16, p.s5u16, p.s5g16, p.mg16, p.lf32, p.ixw32, p.lb + l * 512};
            const bool early = (c >> 3) & 1;
#pragma unroll 1
            for (int pass = 0; pass < 2; ++pass) {
                if ((pass == 0) == early) conv_rest(p, l, lds);
                if (pass == 0) pg::gemm_phase(ldsb, D, sc, ep);
            }
        }
        xcd_barrier(xbar);
        { PHASE_PARAMS(); phase_mix1(p, l, lds); }
        xcd_barrier(xbar);
        { PHASE_PARAMS(); phase_mix2(p, l, lds); }
        xcd_barrier(xbar);
        { PHASE_PARAMS(); phase_mix3(p, l, lds); }
        xcd_barrier(xbar);
        {
            PHASE_PARAMS();
            SchedPlain sc{(const char*)p.ypre16, (const char*)p.wglu16, 64, 2, G, c, W};
            EpiGlu ep{p.ypre16, p.s5g16, p.glu_b + l * W, p.ys + (size_t)2 * T * W, nullptr};
            pg::gemm_phase(ldsb, W, sc, ep);
            if (c >= 128 && l + 1 < NL) s5_build_tables(p, l + 1, lds, c - 128, G - 128);
        }
        xcd_barrier(xbar);
        {
            PHASE_PARAMS();
            SchedMerge sc{(const char*)p.ys, (const char*)p.wb16, G, c};
            EpiMerge ep{(const unsigned char*)p.mg16, p.merged16};
            pg::gemm_phase(ldsb, W, sc, ep);
        }
        xcd_barrier(xbar);
        {
            PHASE_PARAMS();
            SchedPlain sc{(const char*)p.merged16, (const char*)p.wo16, 64, 4, G, c, D};
            EpiOut ep{p.x, p.xr16, p.out, p.mod + (size_t)l * NB * 3072 + 2 * D, l > 0, l + 1 < NL};
            pg::gemm_phase(ldsb, D, sc, ep);
        }
        xcd_barrier(xbar);
    }
}

extern "C" void kernel_launch(void* const* d_in, const int* in_sizes, int n_in,
                              void* d_out, int out_size, void* d_ws, size_t ws_size,
                              hipStream_t stream) {
    static int grid_blocks = 0;
    if (!grid_blocks) {
        int dev = 0, cus = 0, per_cu = 0;
        (void)hipGetDevice(&dev);
        (void)hipDeviceGetAttribute(&cus, hipDeviceAttributeMultiprocessorCount, dev);
        (void)hipFuncSetAttribute((const void*)mega, hipFuncAttributeMaxDynamicSharedMemorySize, LDS_BYTES);
        (void)hipOccupancyMaxActiveBlocksPerMultiprocessor(&per_cu, mega, 512, LDS_BYTES);
        if (per_cu > 1) per_cu = 1;
        grid_blocks = cus * per_cu;
    }
    Params p{};
    const float* const* in = (const float* const*)d_in;
    p.x = in[0]; p.c = in[1]; p.pos = (const int*)d_in[2];
    p.ada_w = in[3]; p.ada_b = in[4]; p.norm_g = in[5]; p.w_in = in[6]; p.lb_logits = in[7]; p.onorm_g = in[8]; p.qn_g = in[9]; p.kn_g = in[10];
    p.a_re = in[11]; p.a_im = in[12]; p.log_dt = in[13]; p.b_re = in[14]; p.b_im = in[15]; p.c_re = in[16]; p.c_im = in[17]; p.s5_d = in[18];
    p.glu_w = in[19]; p.glu_b = in[20]; p.w_branch = in[21]; p.w_out = in[22];
    p.out = (float*)d_out;
    char* ws = (char*)d_ws; size_t off = 0;
    auto take = [&](size_t bytes) { char* q = ws + off; off += (bytes + 255) & ~(size_t)255; return q; };
    const size_t TW2 = (size_t)T * W * 2;
    p.mod = (float*)take((size_t)NL * NB * 3072 * 4);
    p.lb = (float*)take((size_t)NL * 512 * 4);
    p.abar = (float*)take((size_t)NL * 32 * 64 * 2 * 4);
    p.bbar = (float*)take((size_t)NL * 32 * 64 * 16 * 2 * 4);
    p.ropeA = (float*)take((size_t)T * 64 * 2 * 4);
    p.ropeI = (float*)take((size_t)T * 32 * 2 * 4);
    p.win16 = (__half*)take((size_t)NPK * D * 2);
    p.wb16 = (__half*)take((size_t)3 * D * W * 2);
    p.wo16 = (__half*)take((size_t)D * D * 2);
    p.wglu16 = (__half*)take((size_t)W * W * 2);
    p.h16 = (__half*)take((size_t)T * D * 2);       p.merged16 = p.h16; p.stT16 = p.h16;
    p.q16 = (__half*)take(TW2);                     p.mp32 = (float*)p.q16;
    p.lf32 = (float*)take((size_t)T * W * 4);
    p.v16 = (__half*)take(TW2);
    p.hgg16 = (__half*)take(TW2);
    p.atq16 = (__half*)take(TW2);
    p.atk16 = (__half*)take((size_t)T * 128 * 2);
    p.atv16 = (__half*)take((size_t)T * 128 * 2);
    p.atg16 = (__half*)take(TW2);
    p.ixq16 = (__half*)take(TW2);
    p.ixk16 = (__half*)take((size_t)T * 64 * 2);
    p.ixw32 = (float*)take((size_t)T * 8 * 4);
    p.s5u16 = (__half*)take(TW2);
    p.s5g16 = (__half*)take(TW2);
    p.mg16 = (__half*)take((size_t)T * 3072);
    p.xr16 = (__half*)take((size_t)T * D * 2);
    p.ys = (__half*)take(3 * TW2);
    p.ypre16 = (__half*)take(TW2);
    p.dbg = (unsigned*)take(256);
    p.xbar = (unsigned*)take((size_t)XCD_BAR_WORDS * 4);
    p.pw = (float*)take((size_t)NL * 32 * 64 * 65 * 2 * 4);
    p.sg = (float*)take((size_t)NL * 32 * 2 * 4);
    p.kmat16 = (__half*)take((size_t)2 * 32 * 64 * 256 * 2);
    p.hs16 = (__half*)take((size_t)2 * 32 * 128 * 1024 * 2);
    p.gs16 = (__half*)take((size_t)2 * 32 * 1024 * 128 * 2);
    p.e32 = (float*)take((size_t)32 * 8 * 32 * 128 * 4);
    p.x16 = (__half*)take((size_t)32 * 8 * 32 * 128 * 2);
    p.dec32 = (float*)take((size_t)1024 * 128 * 4);
    p.mask = (unsigned*)take((size_t)T * 64 * 4);
    p.kf16 = (__half*)take((size_t)T * 128 * 2);
    p.vf16 = (__half*)take((size_t)T * 128 * 2);
    p.ikf16 = (__half*)take((size_t)T * 64 * 2);
    if (off > ws_size) { fprintf(stderr, "workspace too small: need %zu have %zu\n", off, ws_size); return; }
    (void)hipMemsetAsync(p.xbar, 0, (size_t)XCD_BAR_WORDS * 4, stream);
    (void)hipMemsetAsync(p.mod, 0, (size_t)NL * NB * 3072 * 4, stream);
    void* args[] = {&p};
    hipError_t e = hipLaunchCooperativeKernel((void*)mega, dim3(grid_blocks), dim3(512), args, LDS_BYTES, stream);
    if (e != hipSuccess) fprintf(stderr, "cooperative launch failed: %s (grid %d)\n", hipGetErrorString(e), grid_blocks);
}
```
